# Optimizing an MI355X kernel written in HIP

```python
import jax, jax.numpy as jnp
from jax import lax
import numpy as np

D_MODEL = 1024
BATCH = 8
SEQ = 4096
DEPTH = 1

CTX_LEN = 256
GRID_W = 64

RW_HEADS = 16
RW_HEAD_DIM = 64
RW_WIDTH = RW_HEADS * RW_HEAD_DIM
RW_DECAY_RANK = 64
RW_ICL_RANK = 64
RW_GATE_RANK = 128
RW_GN_EPS = 64e-5

HG_HEADS = 8
HG_KEY_DIM = 128
HG_VAL_DIM = 128
HG_WIDTH = HG_HEADS * HG_KEY_DIM
HG_CHUNK = 64

FFN_HIDDEN = 4 * D_MODEL
N_MOD = 6
RMS_EPS = 1e-6

RW_SHIFT_COLS = 3 * RW_WIDTH + RW_DECAY_RANK + RW_ICL_RANK + RW_GATE_RANK
HG_COLS = 5 * HG_WIDTH
GATE_COLS = 2 * D_MODEL
IN_COLS = RW_SHIFT_COLS + HG_COLS + GATE_COLS
RW_SPLITS = (RW_WIDTH, 2 * RW_WIDTH, 3 * RW_WIDTH, 3 * RW_WIDTH + RW_DECAY_RANK,
             3 * RW_WIDTH + RW_DECAY_RANK + RW_ICL_RANK)

kernel_name = "hybrid_rwkv7_hgrn2_dit_block"


def _rmsnorm(x, w):
    xf = x.astype(jnp.float32)
    y = xf * lax.rsqrt(jnp.mean(xf * xf, axis=-1, keepdims=True) + RMS_EPS)
    return (y * w.astype(jnp.float32)).astype(x.dtype)


def _modulate(x, w, shift, scale):
    return _rmsnorm(x, w) * (1 + scale) + shift


def _heads(t, h):
    return t.reshape(*t.shape[:-1], h, t.shape[-1] // h)


def _shift_seq(z, mu):
    prev = jnp.pad(z[:, :-1], ((0, 0), (1, 0), (0, 0)))
    nxt = jnp.pad(z[:, 1:], ((0, 0), (0, 1), (0, 0)))
    return z + mu[0] * (prev - z) + mu[1] * (nxt - z)


def _shift_grid(z, mu, rows):
    bsz, t_len, ch = z.shape
    g = z.reshape(bsz, rows, GRID_W, ch)
    left = jnp.pad(g[:, :, :-1], ((0, 0), (0, 0), (1, 0), (0, 0)))
    right = jnp.pad(g[:, :, 1:], ((0, 0), (0, 0), (0, 1), (0, 0)))
    up = jnp.pad(g[:, :-1], ((0, 0), (1, 0), (0, 0), (0, 0)))
    down = jnp.pad(g[:, 1:], ((0, 0), (0, 1), (0, 0), (0, 0)))
    out = g + mu[0] * (left - g) + mu[1] * (right - g) + mu[2] * (up - g) + mu[3] * (down - g)
    return out.reshape(bsz, t_len, ch)


def _l2norm_heads(t):
    tf = t.astype(jnp.float32)
    n = jnp.sqrt(jnp.sum(tf * tf, axis=-1, keepdims=True))
    return (tf / jnp.maximum(n, 1e-12)).astype(t.dtype)


def _rwkv7_scan(r, w, k, v, kk, a, s0):
    def step(S, inp):
        r_t, w_t, k_t, v_t, kk_t, a_t = inp
        sa = jnp.einsum('bhvk,bhk->bhv', S, -kk_t)
        S = (S * w_t[:, :, None, :] + sa[..., None] * (kk_t * a_t)[:, :, None, :]
             + v_t[..., None] * k_t[:, :, None, :])
        return S, jnp.einsum('bhvk,bhk->bhv', S, r_t)
    xs = tuple(jnp.moveaxis(t, 1, 0) for t in (r, w, k, v, kk, a))
    s_fin, ys = lax.scan(step, s0, xs)
    return jnp.moveaxis(ys, 0, 1), s_fin


def _rwkv7_mix(r, k_raw, v, xw, xa, w0, w_up, a0, a_up, k_k, k_a, s0_f, s0_b):
    r_h, v_h = _heads(r, RW_HEADS), _heads(v, RW_HEADS)
    kk = _l2norm_heads(_heads(k_raw * k_k, RW_HEADS))
    xw_t = jnp.tanh(xw)
    ys, ks, states = [], [], []
    for d, s0 in enumerate((s0_f, s0_b)):
        wlog = -jax.nn.softplus(-(w0[d] + xw_t @ w_up[d])) - 0.5
        decay = _heads(jnp.exp(-jnp.exp(wlog)), RW_HEADS)
        a = jax.nn.sigmoid(a0[d] + xa @ a_up[d])
        k = _heads(k_raw * (1 + (a - 1) * k_a), RW_HEADS)
        seq = (r_h, decay, k, v_h, kk, _heads(a, RW_HEADS))
        if d == 1:
            seq = tuple(t[:, ::-1] for t in seq)
        y, s_fin = _rwkv7_scan(*seq, s0)
        ys.append(y[:, ::-1] if d == 1 else y)
        ks.append(k)
        states.append(s_fin)
    return ys[0] + ys[1], r_h, ks[0] + ks[1], v_h, states[0], states[1]


def _rwkv7_readout(y, r_h, k_sum, v_h, xg, g_up, r_k, ln_w, ln_b):
    yf = y.astype(jnp.float32)
    mean = jnp.mean(yf, axis=-1, keepdims=True)
    var = jnp.mean(jnp.square(yf - mean), axis=-1, keepdims=True)
    yn = (yf - mean) * lax.rsqrt(var + RW_GN_EPS) * _heads(ln_w, RW_HEADS) + _heads(ln_b, RW_HEADS)
    bonus = jnp.sum(r_h * k_sum * r_k, axis=-1, keepdims=True) * v_h
    out = (yn.astype(y.dtype) + bonus).reshape(*y.shape[:-2], RW_WIDTH)
    return out * (jax.nn.sigmoid(xg) @ g_up)


def _chunk_gla(q, k, v, logf, s0):
    bsz, t_len, h, dk = q.shape
    dv = v.shape[-1]
    n = t_len // HG_CHUNK
    dt = q.dtype
    q = q.reshape(bsz, n, HG_CHUNK, h, dk)
    k = k.reshape(bsz, n, HG_CHUNK, h, dk)
    v = v.reshape(bsz, n, HG_CHUNK, h, dv)
    b = jnp.cumsum(logf.reshape(bsz, n, HG_CHUNK, h, dk).astype(jnp.float32), axis=2)
    b_ref = b[:, :, HG_CHUNK // 2 - 1:HG_CHUNK // 2]
    b_last = b[:, :, HG_CHUNK - 1:]
    q_in = q * jnp.exp(b - b_ref).astype(dt)
    k_in = k * jnp.exp(b_ref - b).astype(dt)
    scores = jnp.einsum('bnthk,bnshk->bnhts', q_in, k_in)
    mask = jnp.tril(jnp.ones((HG_CHUNK, HG_CHUNK), dtype=bool))
    scores = jnp.where(mask, scores, 0)
    o_intra = jnp.einsum('bnhts,bnshv->bnthv', scores, v)
    kv = jnp.einsum('bnshk,bnshv->bnhkv', k * jnp.exp(b_last - b).astype(dt), v)
    chunk_decay = jnp.exp(b_last[:, :, 0]).astype(dt)

    def step(S, inp):
        dec, kv_c = inp
        return dec[..., None] * S + kv_c, S
    s_fin, s_prev = lax.scan(step, s0, (jnp.moveaxis(chunk_decay, 1, 0), jnp.moveaxis(kv, 1, 0)))
    s_prev = jnp.moveaxis(s_prev, 0, 1)
    o_inter = jnp.einsum('bnthk,bnhkv->bnthv', q * jnp.exp(b).astype(dt), s_prev)
    return (o_intra + o_inter).reshape(bsz, t_len, h, dv), s_fin


def _hgrn2_mix(q, f_f, f_b, i, lb, s0_f, s0_b):
    q_h, i_h = _heads(q, HG_HEADS), _heads(i, HG_HEADS)
    outs, states = [], []
    for d, (fz, s0) in enumerate(((f_f, s0_f), (f_b, s0_b))):
        f = lb + (1 - lb) * jax.nn.sigmoid(fz)
        seq = (q_h, _heads(1 - f, HG_HEADS), i_h, _heads(jnp.log(f), HG_HEADS))
        if d == 1:
            seq = tuple(t[:, ::-1] for t in seq)
        o, s_fin = _chunk_gla(*seq, s0)
        outs.append(o[:, ::-1] if d == 1 else o)
        states.append(s_fin)
    return outs[0] + outs[1], states[0], states[1]


def _hgrn2_readout(o, gz, norm_w):
    on = _rmsnorm(o, _heads(norm_w, HG_HEADS))
    return on.reshape(*o.shape[:-2], HG_WIDTH) * jax.nn.silu(gz)


def _merge(y_rw, y_hg, zg, p_a, p_b, w_out):
    ga, gb = jnp.split(zg, 2, axis=-1)
    return (jax.nn.sigmoid(ga) * (y_rw @ p_a) + jax.nn.sigmoid(gb) * (y_hg @ p_b)) @ w_out


def _sqrelu_mlp(h, w1, w2):
    return jnp.square(jax.nn.relu(h @ w1)) @ w2


def setup_inputs(seed: int = 0) -> dict:
    key = jax.random.key(seed)
    ks = jax.random.split(key, 28)
    nrm = lambda k, shape, s: jax.random.normal(k, shape, jnp.float32) * s
    L = DEPTH
    return {
        "x": nrm(ks[0], (BATCH, SEQ, D_MODEL), 1.0),
        "c": nrm(ks[1], (BATCH, D_MODEL), 1.0),
        "ctx": nrm(ks[2], (BATCH, CTX_LEN, D_MODEL), 1.0),
        "c_ctx": nrm(ks[3], (D_MODEL,), 1.0),
        "norm1_w": 1.0 + nrm(ks[4], (L, D_MODEL), 0.02),
        "norm2_w": 1.0 + nrm(ks[5], (L, D_MODEL), 0.02),
        "w_mod": nrm(ks[6], (L, D_MODEL, N_MOD * D_MODEL), 0.5 * D_MODEL ** -0.5),
        "b_mod": nrm(ks[7], (L, N_MOD * D_MODEL), 0.02),
        "w_in": nrm(ks[8], (L, D_MODEL, IN_COLS), D_MODEL ** -0.5),
        "rw_mu": jax.random.uniform(ks[9], (L, 4, RW_SHIFT_COLS), jnp.float32, 0.05, 0.45),
        "rw_w0": jax.random.uniform(ks[10], (L, 2, RW_WIDTH), jnp.float32, -6.0, -1.0),
        "rw_w_up": nrm(ks[11], (L, 2, RW_DECAY_RANK, RW_WIDTH), 0.1),
        "rw_a0": nrm(ks[12], (L, 2, RW_WIDTH), 0.1),
        "rw_a_up": nrm(ks[13], (L, 2, RW_ICL_RANK, RW_WIDTH), 0.5 * RW_ICL_RANK ** -0.5),
        "rw_g_up": nrm(ks[14], (L, RW_GATE_RANK, RW_WIDTH), RW_GATE_RANK ** -0.5),
        "rw_k_k": 0.85 + nrm(ks[15], (L, RW_WIDTH), 0.02),
        "rw_k_a": 1.0 + nrm(ks[16], (L, RW_WIDTH), 0.02),
        "rw_r_k": nrm(ks[17], (L, RW_HEADS, RW_HEAD_DIM), 0.1),
        "rw_ln_w": 1.0 + nrm(ks[18], (L, RW_WIDTH), 0.02),
        "rw_ln_b": nrm(ks[19], (L, RW_WIDTH), 0.02),
        "hg_lb": nrm(ks[20], (L + 1, HG_WIDTH), 0.1),
        "hg_norm_w": 1.0 + nrm(ks[21], (L, HG_WIDTH), 0.02),
        "p_a": nrm(ks[22], (L, RW_WIDTH, D_MODEL), RW_WIDTH ** -0.5),
        "p_b": nrm(ks[23], (L, HG_WIDTH, D_MODEL), HG_WIDTH ** -0.5),
        "w_out": nrm(ks[24], (L, D_MODEL, D_MODEL), D_MODEL ** -0.5),
        "w_fc1": nrm(ks[25], (L, D_MODEL, FFN_HIDDEN), D_MODEL ** -0.5),
        "w_fc2": nrm(ks[26], (L, FFN_HIDDEN, D_MODEL), FFN_HIDDEN ** -0.5),
        "final_norm_w": 1.0 + nrm(ks[27], (D_MODEL,), 0.02),
    }


def reference(x, c, ctx, c_ctx, norm1_w, norm2_w, w_mod, b_mod, w_in, rw_mu, rw_w0, rw_w_up, rw_a0,
              rw_a_up, rw_g_up, rw_k_k, rw_k_a, rw_r_k, rw_ln_w, rw_ln_b, hg_lb, hg_norm_w, p_a, p_b,
              w_out, w_fc1, w_fc2, final_norm_w):
    bsz = x.shape[0]
    rows = x.shape[1] // GRID_W
    dt = x.dtype
    c_act = jax.nn.silu(c)
    cc_act = jax.nn.silu(c_ctx)
    lb_all = jnp.cumsum(jax.nn.softmax(hg_lb.astype(jnp.float32), axis=0), axis=0)
    zeros_rw = jnp.zeros((bsz, RW_HEADS, RW_HEAD_DIM, RW_HEAD_DIM), dt)
    zeros_hg = jnp.zeros((bsz, HG_HEADS, HG_KEY_DIM, HG_VAL_DIM), dt)
    for l in range(DEPTH):
        mod = (c_act @ w_mod[l] + b_mod[l])[:, None, :]
        mod_c = cc_act @ w_mod[l] + b_mod[l]
        sh1, sc1, g1, sh2, sc2, g2 = jnp.split(mod, N_MOD, axis=-1)
        sh1c, sc1c, g1c, sh2c, sc2c, g2c = jnp.split(mod_c, N_MOD, axis=-1)
        lb = lb_all[l].astype(dt)
        rw_args = (rw_w0[l], rw_w_up[l], rw_a0[l], rw_a_up[l], rw_k_k[l], rw_k_a[l])

        h = _modulate(x, norm1_w[l], sh1, sc1)
        hc = _modulate(ctx, norm1_w[l], sh1c, sc1c)
        zr, zh, zg = jnp.split(h @ w_in[l], [RW_SHIFT_COLS, RW_SHIFT_COLS + HG_COLS], axis=-1)
        zrc, zhc, zgc = jnp.split(hc @ w_in[l], [RW_SHIFT_COLS, RW_SHIFT_COLS + HG_COLS], axis=-1)
        zr = _shift_grid(zr, rw_mu[l], rows)
        zrc = _shift_seq(zrc, rw_mu[l])
        r, k_raw, v, xw, xa, xg = jnp.split(zr, RW_SPLITS, axis=-1)
        rc, k_rawc, vc, xwc, xac, xgc = jnp.split(zrc, RW_SPLITS, axis=-1)
        q, f_f, f_b, i_in, gz = jnp.split(zh, 5, axis=-1)
        qc, f_fc, f_bc, i_inc, gzc = jnp.split(zhc, 5, axis=-1)

        yc_rw, rc_h, kc_sum, vc_h, s_rw_f, s_rw_b = _rwkv7_mix(rc, k_rawc, vc, xwc, xac, *rw_args,
                                                               zeros_rw, zeros_rw)
        oc_hg, s_hg_f, s_hg_b = _hgrn2_mix(qc, f_fc, f_bc, i_inc, lb, zeros_hg, zeros_hg)
        y_rw, r_h, k_sum, v_h, _, _ = _rwkv7_mix(r, k_raw, v, xw, xa, *rw_args, s_rw_f, s_rw_b)
        o_hg, _, _ = _hgrn2_mix(q, f_f, f_b, i_in, lb, s_hg_f, s_hg_b)

        y_rw = _rwkv7_readout(y_rw, r_h, k_sum, v_h, xg, rw_g_up[l], rw_r_k[l], rw_ln_w[l], rw_ln_b[l])
        y_hg = _hgrn2_readout(o_hg, gz, hg_norm_w[l])
        x = x + g1 * _merge(y_rw, y_hg, zg, p_a[l], p_b[l], w_out[l])
        x = x + g2 * _sqrelu_mlp(_modulate(x, norm2_w[l], sh2, sc2), w_fc1[l], w_fc2[l])

        if l < DEPTH - 1:
            yc_rw = _rwkv7_readout(yc_rw, rc_h, kc_sum, vc_h, xgc, rw_g_up[l], rw_r_k[l], rw_ln_w[l],
                                   rw_ln_b[l])
            yc_hg = _hgrn2_readout(oc_hg, gzc, hg_norm_w[l])
            ctx = ctx + g1c * _merge(yc_rw, yc_hg, zgc, p_a[l], p_b[l], w_out[l])
            ctx = ctx + g2c * _sqrelu_mlp(_modulate(ctx, norm2_w[l], sh2c, sc2c), w_fc1[l], w_fc2[l])
    return _rmsnorm(x, final_norm_w)
```

```cpp
#include <hip/hip_runtime.h>
#include <hip/hip_cooperative_groups.h>
#include <cstdio>
#include <cstdint>
namespace cg = cooperative_groups;

#ifndef MK_ONE_LAUNCH
#define MK_ONE_LAUNCH 0
#endif

#define LAS __attribute__((address_space(3)))
typedef unsigned short bf16_t;
typedef short bf16x8 __attribute__((ext_vector_type(8)));
typedef float f32x4 __attribute__((ext_vector_type(4)));
typedef float f32x2 __attribute__((ext_vector_type(2)));
typedef unsigned u32x4 __attribute__((ext_vector_type(4)));
typedef unsigned u32x2 __attribute__((ext_vector_type(2)));

constexpr int D = 1024, NB = 8, T = 4096, TC = 256, GW = 64;
constexpr int ML = NB * T;
constexpr int MC = NB * TC;
constexpr int MR = ML + MC;
constexpr int NZR = 3328, NZH = 4096, NZG = 3072, NIN = 10496, FF = 4096;
constexpr float RMS_EPS = 1e-6f, GN_EPS = 64e-5f;

constexpr size_t MiB = 1u << 20;
constexpr size_t WS_CTL = 0, WS_MOD = 1 * MiB;
constexpr size_t WS_R1 = 2 * MiB;
constexpr size_t WS_YF = 2 * MiB, WS_YB = 66 * MiB, WS_YRW = 130 * MiB;
constexpr size_t WS_OF = 2 * MiB, WS_OB = 66 * MiB;
constexpr size_t WS_X1 = 2 * MiB;
constexpr size_t WS_H2 = 130 * MiB;
constexpr size_t WS_ZRS = 223 * MiB;
constexpr size_t WS_XGS = 444 * MiB;
constexpr size_t WS_BON = 460 * MiB;
constexpr size_t WS_ZH = 194 * MiB;
constexpr size_t WS_ZG = 194 * MiB;
constexpr size_t WS_MRG = 386 * MiB;
constexpr size_t WS_U = 194 * MiB;
constexpr size_t WS_END = 466 * MiB;
constexpr size_t DO_H = 0;
constexpr size_t DO_WIN = 68 * MiB;
constexpr size_t DO_PA = DO_WIN + (size_t)NIN * D * 2;
constexpr size_t DO_PB = DO_PA + 2 * MiB, DO_WO = DO_PB + 2 * MiB, DO_FC1 = DO_WO + 2 * MiB, DO_FC2 = DO_FC1 + 8 * MiB, DO_GUP = DO_FC2 + 8 * MiB;
constexpr size_t DO_END = DO_GUP + (size_t)1024 * 256 * 2;
static_assert(DO_END <= 128 * MiB, "d_out scratch overflow");

constexpr int LDS_BYTES = 140 * 1024;
constexpr int NPHASE = 17;

__device__ __forceinline__ unsigned f2bf(float f) { unsigned u = __builtin_bit_cast(unsigned, f); return (u + 0x7fffu + ((u >> 16) & 1u)) >> 16; }
__device__ __forceinline__ unsigned pk2(float lo, float hi) { return f2bf(lo) | (f2bf(hi) << 16); }
__device__ __forceinline__ float bflo(unsigned w) { return __builtin_bit_cast(float, w << 16); }
__device__ __forceinline__ float bfhi(unsigned w) { return __builtin_bit_cast(float, w & 0xffff0000u); }
__device__ __forceinline__ float sigmoidf_(float x) { return 1.0f / (1.0f + __expf(-x)); }
__device__ __forceinline__ float wave_sum(float v) {
#pragma unroll
    for (int o = 1; o < 64; o <<= 1) v += __shfl_xor(v, o);
    return v;
}
__device__ __forceinline__ float sum16(float v) { v += __shfl_xor(v, 1); v += __shfl_xor(v, 2); v += __shfl_xor(v, 4); v += __shfl_xor(v, 8); return v; }
__device__ __forceinline__ float sum32(float v) { v = sum16(v); v += __shfl_xor(v, 16); return v; }

namespace pg8 {
constexpr int BM = 256, BK = 64, HALF = 128, HTB = HALF * BK * 2, STAGE_BYTES = 8 * HTB, NXCD = 8, WGM = 8;
__host__ __device__ __forceinline__ int lds_byte(int r, int c) { const int st = (r >> 4) * 2 + (c >> 5), rr = r & 15, cc = c & 31, ob = rr * 64 + cc * 2; return st * 1024 + (ob ^ (((ob >> 9) & 1) << 5)); }
__host__ __device__ __forceinline__ void stage_rc(int b, int& R, int& C) { const int st = b / 1024, sb = b % 1024, swz = sb ^ (((sb >> 9) & 1) << 5); R = (st >> 1) * 16 + swz / 64; C = (st & 1) * 32 + (swz % 64) / 2; }
__host__ __device__ __forceinline__ int perm32(int rho) { const int n = rho >> 4, i = rho & 15; return 8 * (i >> 2) + 4 * n + (i & 3); }

struct Unit { int pm, pn, sel; };
struct Sched {
    const char* A0; const char* B0; const char* A1; const char* B1;
    int nM, nN, nwg, G, c, nsel; size_t tstep;
    __device__ void init(const void* a0, const void* b0, const void* a1, const void* b1, int M, int N, int K, int G_, int c_, int nsel_) {
        A0 = (const char*)a0; B0 = (const char*)b0; A1 = (const char*)a1; B1 = (const char*)b1; nM = M / BM; nN = N / BM; nwg = nM * nN; G = G_; c = c_; nsel = nsel_; tstep = (size_t)BM * K * 2; }
    __device__ bool next(int i, Unit& u) const {
        const int j = (nsel == 2) ? (i >> 1) : i;
        const long L = (long)j * G + c; if (L >= nwg) return false;
        int wgid = (int)L; { const int q = nwg / NXCD, r = nwg % NXCD, xcd = wgid % NXCD, off = wgid / NXCD; wgid = (xcd < r ? xcd * (q + 1) : r * (q + 1) + (xcd - r) * q) + off; }
        const int nig = WGM * nN, gid = wgid / nig, fm = gid * WGM, gsz = (nM - fm) < WGM ? (nM - fm) : WGM;
        u.pm = fm + ((wgid % nig) % gsz); u.pn = (wgid % nig) / gsz; u.sel = (nsel == 2) ? (i & 1) : 0; return true;
    }
    __device__ __forceinline__ const char* abase(const Unit& u) const { return (u.sel ? A1 : A0) + (size_t)u.pm * tstep; }
    __device__ __forceinline__ const char* bbase(const Unit& u) const { return (u.sel ? B1 : B0) + (size_t)u.pn * tstep; }
};

template <class Epi>
__device__ __forceinline__ void gemm_phase(LAS unsigned char* lds, const int K, const Sched& S, const Epi& E) {
    const int tid = threadIdx.x, wid = __builtin_amdgcn_readfirstlane(tid >> 6), lane = tid & 63, wr = wid >> 2, wc = wid & 3, fr = lane & 15, fq = lane >> 4;
    const int nt = K / BK;
    unsigned voffA[2], voffB[2];
#pragma unroll
    for (int i = 0; i < 2; ++i) { int R, C; stage_rc(tid * 16 + i * 8192, R, C); const int Rb = Epi::PERM ? ((R & ~31) + perm32(R & 31)) : R;
        voffA[i] = (unsigned)(R * K + C) * 2u; voffB[i] = (unsigned)(Rb * K + C) * 2u; }
    const size_t kstep = (size_t)(BK * 2);
    const size_t hstep = (size_t)HALF * K * 2;
    const unsigned ldsw = (unsigned)wid * 1024u;
    const int aoff = lds_byte(wr * 64 + fr, fq * 8), boff = lds_byte(wc * 32 + fr, fq * 8);
#define PG8_SA(b, h) (((b) * 2 + (h)) * HTB)
#define PG8_SB(b, h) ((4 + (b) * 2 + (h)) * HTB)
#define PG8_STAGE(bufoff, gbase, voff) do { _Pragma("unroll") for (int _i = 0; _i < 2; ++_i) \
        __builtin_amdgcn_global_load_lds((const unsigned*)((const char*)(gbase) + (voff)[_i]), (LAS unsigned*)(lds + (bufoff) + ldsw + _i * 8192), 16, 0, 0); } while (0)
#define PG8_LDA(dst, b, h) do { _Pragma("unroll") for (int m = 0; m < 4; ++m) _Pragma("unroll") for (int k = 0; k < 2; ++k) dst[m][k] = *(const LAS bf16x8*)(lds + PG8_SA(b, h) + aoff + m * 2048 + k * 1024); } while (0)
#define PG8_LDB(dst, b, h) do { _Pragma("unroll") for (int n = 0; n < 2; ++n) _Pragma("unroll") for (int k = 0; k < 2; ++k) dst[n][k] = *(const LAS bf16x8*)(lds + PG8_SB(b, h) + boff + n * 2048 + k * 1024); } while (0)
#define PG8_MMA(ai, bj, At, Bt) do { __builtin_amdgcn_s_setprio(1); _Pragma("unroll") for (int m = 0; m < 4; ++m) _Pragma("unroll") for (int n = 0; n < 2; ++n) _Pragma("unroll") for (int k = 0; k < 2; ++k) \
        acc[ai][bj][m][n] = __builtin_amdgcn_mfma_f32_16x16x32_bf16(Bt[n][k], At[m][k], acc[ai][bj][m][n], 0, 0, 0); __builtin_amdgcn_s_setprio(0); } while (0)
#define PG8_WAIT_V(n) asm volatile("s_waitcnt vmcnt(" #n ")" ::: "memory")
#define PG8_WAIT_L(n) asm volatile("s_waitcnt lgkmcnt(" #n ")" ::: "memory")
#define PG8_BAR __builtin_amdgcn_s_barrier()
#define PG8_SCHED __builtin_amdgcn_sched_barrier(0)
    Unit cur, nxt; int ui = 0;
    if (!S.next(0, cur)) return;
    f32x4 acc[2][2][4][2];
#pragma unroll
    for (int a = 0; a < 2; ++a)
#pragma unroll
        for (int b = 0; b < 2; ++b)
#pragma unroll
            for (int m = 0; m < 4; ++m)
#pragma unroll
                for (int n = 0; n < 2; ++n) acc[a][b][m][n] = (f32x4){0.f, 0.f, 0.f, 0.f};
    bf16x8 At[4][2], B0[2][2], B1[2][2];
    const char* cA = S.abase(cur); const char* cB = S.bbase(cur);
    PG8_STAGE(PG8_SB(0, 0), cB, voffB); PG8_STAGE(PG8_SB(0, 1), cB + hstep, voffB); PG8_STAGE(PG8_SA(0, 0), cA, voffA); PG8_STAGE(PG8_SA(0, 1), cA + hstep, voffA);
    if (wr == 1) PG8_BAR;
    PG8_WAIT_V(2); PG8_BAR;
    PG8_STAGE(PG8_SB(1, 0), cB + kstep, voffB); PG8_STAGE(PG8_SA(1, 0), cA + kstep, voffA); PG8_STAGE(PG8_SB(1, 1), cB + hstep + kstep, voffB);
    PG8_WAIT_V(6); PG8_BAR;
    for (;;) {
        const bool has_next = S.next(ui + 1, nxt);
        const char* nA = has_next ? S.abase(nxt) : cA; const char* nB = has_next ? S.bbase(nxt) : cB;
        for (int t = 0; t < nt; t += 2) {
            const bool last = (t == nt - 2);
            const char* a1 = cA + (size_t)(t + 1) * kstep;
            const char* a2 = last ? nA : cA + (size_t)(t + 2) * kstep; const char* b2 = last ? nB : cB + (size_t)(t + 2) * kstep;
            const char* a3 = a2 + kstep; const char* b3 = b2 + kstep;
            PG8_LDB(B0, 0, 0); PG8_LDB(B1, 0, 1); PG8_SCHED; PG8_LDA(At, 0, 0); PG8_STAGE(PG8_SA(1, 1), a1 + hstep, voffA);
            PG8_WAIT_V(8); PG8_WAIT_L(0); PG8_BAR; PG8_MMA(0, 0, At, B0); PG8_MMA(0, 1, At, B1); PG8_BAR; PG8_SCHED;
            PG8_LDA(At, 0, 1); PG8_STAGE(PG8_SB(0, 0), b2, voffB); PG8_STAGE(PG8_SB(0, 1), b2 + hstep, voffB); PG8_STAGE(PG8_SA(0, 0), a2, voffA);
            PG8_WAIT_V(8); PG8_WAIT_L(0); PG8_BAR; PG8_MMA(1, 0, At, B0); PG8_MMA(1, 1, At, B1); PG8_BAR; PG8_SCHED;
            PG8_LDB(B0, 1, 0); PG8_LDB(B1, 1, 1); PG8_SCHED; PG8_LDA(At, 1, 0); PG8_STAGE(PG8_SA(0, 1), a2 + hstep, voffA);
            PG8_WAIT_V(8); PG8_WAIT_L(0); PG8_BAR; PG8_MMA(0, 0, At, B0); PG8_MMA(0, 1, At, B1); PG8_BAR; PG8_SCHED;
            PG8_LDA(At, 1, 1); PG8_STAGE(PG8_SB(1, 0), b3, voffB); PG8_STAGE(PG8_SB(1, 1), b3 + hstep, voffB); PG8_STAGE(PG8_SA(1, 0), a3, voffA);
            PG8_WAIT_V(8); PG8_WAIT_L(0); PG8_BAR; PG8_MMA(1, 0, At, B0); PG8_MMA(1, 1, At, B1); PG8_BAR; PG8_SCHED;
        }
        if (wr == 0) PG8_BAR;
        E(acc, cur, wr, wc, fr, fq);
        if (!has_next) break;
#pragma unroll
        for (int a = 0; a < 2; ++a)
#pragma unroll
            for (int b = 0; b < 2; ++b)
#pragma unroll
                for (int m = 0; m < 4; ++m)
#pragma unroll
                    for (int n = 0; n < 2; ++n) acc[a][b][m][n] = (f32x4){0.f, 0.f, 0.f, 0.f};
        cur = nxt; cA = nA; cB = nB; ++ui;
        if (wr == 1) PG8_BAR;
    }
    PG8_WAIT_V(0);
    PG8_BAR;
#undef PG8_SA
#undef PG8_SB
#undef PG8_STAGE
#undef PG8_LDA
#undef PG8_LDB
#undef PG8_MMA
#undef PG8_WAIT_V
#undef PG8_WAIT_L
#undef PG8_BAR
#undef PG8_SCHED
}

struct EpiBf16 {
    static constexpr bool PERM = true;
    bf16_t* O; int ldc;
    __device__ __forceinline__ void operator()(const f32x4 (&acc)[2][2][4][2], const Unit& u, int wr, int wc, int fr, int fq) const {
        const int row0 = u.pm * BM + wr * 64 + fr, col0 = u.pn * BM + wc * 32 + 8 * fq;
#pragma unroll
        for (int ai = 0; ai < 2; ++ai)
#pragma unroll
            for (int m = 0; m < 4; ++m) { bf16_t* rowp = O + (size_t)(row0 + ai * HALF + m * 16) * ldc + col0;
#pragma unroll
                for (int bj = 0; bj < 2; ++bj) { const f32x4 v0 = acc[ai][bj][m][0], v1 = acc[ai][bj][m][1];
                    u32x4 w; w.x = pk2(v0[0], v0[1]); w.y = pk2(v0[2], v0[3]); w.z = pk2(v1[0], v1[1]); w.w = pk2(v1[2], v1[3]);
                    *(u32x4*)(rowp + bj * HALF) = w; } }
    }
};
struct EpiSqRelu {
    static constexpr bool PERM = true;
    bf16_t* O; int ldc;
    __device__ __forceinline__ void operator()(const f32x4 (&acc)[2][2][4][2], const Unit& u, int wr, int wc, int fr, int fq) const {
        const int row0 = u.pm * BM + wr * 64 + fr, col0 = u.pn * BM + wc * 32 + 8 * fq;
#pragma unroll
        for (int ai = 0; ai < 2; ++ai)
#pragma unroll
            for (int m = 0; m < 4; ++m) { bf16_t* rowp = O + (size_t)(row0 + ai * HALF + m * 16) * ldc + col0;
#pragma unroll
                for (int bj = 0; bj < 2; ++bj) { f32x4 v0 = acc[ai][bj][m][0], v1 = acc[ai][bj][m][1];
#pragma unroll
                    for (int j = 0; j < 4; ++j) { const float a = fmaxf(v0[j], 0.f), b = fmaxf(v1[j], 0.f); v0[j] = a * a; v1[j] = b * b; }
                    u32x4 w; w.x = pk2(v0[0], v0[1]); w.y = pk2(v0[2], v0[3]); w.z = pk2(v1[0], v1[1]); w.w = pk2(v1[2], v1[3]);
                    *(u32x4*)(rowp + bj * HALF) = w; } }
    }
};
struct EpiMulBf16 {
    static constexpr bool PERM = true;
    const bf16_t* Y; bf16_t* O; int ldc;
    __device__ __forceinline__ void operator()(const f32x4 (&acc)[2][2][4][2], const Unit& u, int wr, int wc, int fr, int fq) const {
        const int row0 = u.pm * BM + wr * 64 + fr, col0 = u.pn * BM + wc * 32 + 8 * fq;
#pragma unroll
        for (int ai = 0; ai < 2; ++ai)
#pragma unroll
            for (int m = 0; m < 4; ++m) { const size_t off = (size_t)(row0 + ai * HALF + m * 16) * ldc + col0;
#pragma unroll
                for (int bj = 0; bj < 2; ++bj) { const f32x4 v0 = acc[ai][bj][m][0], v1 = acc[ai][bj][m][1];
                    const u32x4 y = *(const u32x4*)(Y + off + bj * HALF);
                    u32x4 w; w.x = pk2(v0[0] * bflo(y.x), v0[1] * bfhi(y.x)); w.y = pk2(v0[2] * bflo(y.y), v0[3] * bfhi(y.y));
                    w.z = pk2(v1[0] * bflo(y.z), v1[1] * bfhi(y.z)); w.w = pk2(v1[2] * bflo(y.w), v1[3] * bfhi(y.w));
                    *(u32x4*)(O + off + bj * HALF) = w; }
                asm volatile("" ::: "memory"); }
    }
};
struct EpiMerge {
    static constexpr bool PERM = true;
    const bf16_t* ZG; bf16_t* O;
    __device__ __forceinline__ void operator()(const f32x4 (&acc)[2][2][4][2], const Unit& u, int wr, int wc, int fr, int fq) const {
        const int row0 = u.pm * BM + wr * 64 + fr, col0 = u.pn * BM + wc * 32 + 8 * fq;
        const int goff = u.sel ? 2048 : 1024;
#pragma unroll
        for (int ai = 0; ai < 2; ++ai)
#pragma unroll
            for (int m = 0; m < 4; ++m) { const size_t r = (size_t)(row0 + ai * HALF + m * 16);
#pragma unroll
                for (int bj = 0; bj < 2; ++bj) { const f32x4 v0 = acc[ai][bj][m][0], v1 = acc[ai][bj][m][1];
                    const u32x4 g = *(const u32x4*)(ZG + r * NZG + goff + col0 + bj * HALF);
                    float o[8];
                    o[0] = v0[0] * sigmoidf_(bflo(g.x)); o[1] = v0[1] * sigmoidf_(bfhi(g.x)); o[2] = v0[2] * sigmoidf_(bflo(g.y)); o[3] = v0[3] * sigmoidf_(bfhi(g.y));
                    o[4] = v1[0] * sigmoidf_(bflo(g.z)); o[5] = v1[1] * sigmoidf_(bfhi(g.z)); o[6] = v1[2] * sigmoidf_(bflo(g.w)); o[7] = v1[3] * sigmoidf_(bfhi(g.w));
                    bf16_t* op = O + r * D + col0 + bj * HALF;
                    if (u.sel) { const u32x4 p = *(const u32x4*)op;
                        o[0] += bflo(p.x); o[1] += bfhi(p.x); o[2] += bflo(p.y); o[3] += bfhi(p.y); o[4] += bflo(p.z); o[5] += bfhi(p.z); o[6] += bflo(p.w); o[7] += bfhi(p.w); }
                    u32x4 w; w.x = pk2(o[0], o[1]); w.y = pk2(o[2], o[3]); w.z = pk2(o[4], o[5]); w.w = pk2(o[6], o[7]);
                    *(u32x4*)op = w; }
                asm volatile("" ::: "memory"); }
    }
};
struct EpiResid {
    static constexpr bool PERM = false;
    const float* base; float* out; const float* gate;
    __device__ __forceinline__ void operator()(const f32x4 (&acc)[2][2][4][2], const Unit& u, int wr, int wc, int fr, int fq) const {
        const int row0 = u.pm * BM + wr * 64 + fr, col0 = u.pn * BM + wc * 32 + 4 * fq;
        const float* gp = gate + (size_t)((u.pm * BM) / T) * 6144 + col0;
        f32x4 gv[2][2];
#pragma unroll
        for (int bj = 0; bj < 2; ++bj)
#pragma unroll
            for (int n = 0; n < 2; ++n) gv[bj][n] = *(const f32x4*)(gp + bj * HALF + n * 16);
#pragma unroll
        for (int ai = 0; ai < 2; ++ai)
#pragma unroll
            for (int m = 0; m < 4; ++m) { const size_t off = (size_t)(row0 + ai * HALF + m * 16) * D + col0;
#pragma unroll
                for (int bj = 0; bj < 2; ++bj)
#pragma unroll
                    for (int n = 0; n < 2; ++n) { const f32x4 bs = *(const f32x4*)(base + off + bj * HALF + n * 16);
                        *(f32x4*)(out + off + bj * HALF + n * 16) = bs + gv[bj][n] * acc[ai][bj][m][n]; }
                asm volatile("" ::: "memory"); }
    }
};
}

struct Args { const float* in[28]; float* out; unsigned char* ws; int ph_lo, ph_hi; };

struct Frame {
    LAS unsigned char* lds;
    int tid, lane, wave, G, bid;
    const float* const* in;
    unsigned char* ws; unsigned char* dob;
};
enum { I_X = 0, I_C, I_CTX, I_CCTX, I_N1W, I_N2W, I_WMOD, I_BMOD, I_WIN, I_MU, I_W0, I_WUP, I_A0, I_AUP, I_GUP, I_KK, I_KA, I_RK, I_LNW, I_LNB, I_HGLB, I_HGNW, I_PA, I_PB, I_WOUT, I_FC1, I_FC2, I_FNW };

__device__ __forceinline__ void transpose_item(const float* W, int N, bf16_t* WT, int ldk, LAS float* scr, int item, int lane) {
    const int nblk = N / 32, kb = item / nblk, nb = item % nblk, k0 = 64 * kb, n0 = 32 * nb;
#pragma unroll 8
    for (int i = 0; i < 32; ++i) { const int kk = 2 * i + (lane >> 5); scr[kk * 33 + (lane & 31)] = W[(size_t)(k0 + kk) * N + n0 + (lane & 31)]; }
    asm volatile("s_waitcnt lgkmcnt(0)" ::: "memory");
    const int c = lane & 7;
#pragma unroll
    for (int j = 0; j < 4; ++j) { const int n = (lane >> 3) + 8 * j; const LAS float* s = scr + (8 * c) * 33 + n;
        u32x4 o; o.x = pk2(s[0 * 33], s[1 * 33]); o.y = pk2(s[2 * 33], s[3 * 33]); o.z = pk2(s[4 * 33], s[5 * 33]); o.w = pk2(s[6 * 33], s[7 * 33]);
        *(u32x4*)(WT + (size_t)(n0 + n) * ldk + k0 + 8 * c) = o; }
    asm volatile("s_waitcnt lgkmcnt(0)" ::: "memory");
}

__device__ __forceinline__ void p0_prologue(const Frame& F) {
    float* MOD = (float*)(F.ws + WS_MOD);
    if (F.bid < 96) {
        LAS float* act = (LAS float*)F.lds;
        LAS float* red = act + 9 * 1024;
        for (int i = F.tid; i < 9 * 1024; i += 512) { const float v = (i < 8 * 1024) ? F.in[I_C][i] : F.in[I_CCTX][i - 8 * 1024]; act[i] = v * sigmoidf_(v); }
        __syncthreads();
        const float* wm = F.in[I_WMOD];
        const int n = F.bid * 64 + F.lane;
        float a[9];
#pragma unroll
        for (int r = 0; r < 9; ++r) a[r] = 0.f;
        const int kb = F.wave * 128;
#pragma unroll 4
        for (int k = kb; k < kb + 128; ++k) { const float w = wm[(size_t)k * 6144 + n];
#pragma unroll
            for (int r = 0; r < 9; ++r) a[r] += act[r * 1024 + k] * w; }
#pragma unroll
        for (int r = 0; r < 9; ++r) red[(F.wave * 9 + r) * 64 + F.lane] = a[r];
        __syncthreads();
        for (int i = F.tid; i < 9 * 64; i += 512) { const int r = i >> 6, l = i & 63; float s = 0.f;
#pragma unroll
            for (int w = 0; w < 8; ++w) s += red[(w * 9 + r) * 64 + l];
            MOD[r * 6144 + F.bid * 64 + l] = s + F.in[I_BMOD][F.bid * 64 + l]; }
        __syncthreads();
    }
    LAS float* scr = (LAS float*)(F.lds + 48 * 1024) + F.wave * (64 * 33);
    const int gw = F.bid * 8 + F.wave, NGW = F.G * 8;
    constexpr int I_IN = 16 * (NIN / 32), I_SQ = 16 * 32, I_F1 = 16 * (FF / 32), I_F2 = 64 * 32, I_GU = 2 * 32;
    constexpr int NITEMS = I_IN + 3 * I_SQ + I_F1 + I_F2 + I_GU;
    for (int it = gw; it < NITEMS; it += NGW) {
        int r = it;
        if (r < I_IN) { transpose_item(F.in[I_WIN], NIN, (bf16_t*)(F.dob + DO_WIN), D, scr, r, F.lane); continue; } r -= I_IN;
        if (r < I_SQ) { transpose_item(F.in[I_PA], D, (bf16_t*)(F.dob + DO_PA), D, scr, r, F.lane); continue; } r -= I_SQ;
        if (r < I_SQ) { transpose_item(F.in[I_PB], D, (bf16_t*)(F.dob + DO_PB), D, scr, r, F.lane); continue; } r -= I_SQ;
        if (r < I_SQ) { transpose_item(F.in[I_WOUT], D, (bf16_t*)(F.dob + DO_WO), D, scr, r, F.lane); continue; } r -= I_SQ;
        if (r < I_F1) { transpose_item(F.in[I_FC1], FF, (bf16_t*)(F.dob + DO_FC1), D, scr, r, F.lane); continue; } r -= I_F1;
        if (r < I_F2) { transpose_item(F.in[I_FC2], D, (bf16_t*)(F.dob + DO_FC2), FF, scr, r, F.lane); continue; } r -= I_F2;
        transpose_item(F.in[I_GUP], D, (bf16_t*)(F.dob + DO_GUP), 256, scr, r, F.lane);
    }
    { bf16_t* gu = (bf16_t*)(F.dob + DO_GUP);
      for (int i = F.bid * 512 + F.tid; i < 1024 * 16; i += F.G * 512) { const int n = i >> 4, ch = i & 15; *(u32x4*)(gu + (size_t)n * 256 + 128 + ch * 8) = (u32x4){0u, 0u, 0u, 0u}; } }
}

__device__ __forceinline__ void modnorm_row(const float* xrow, const float* nw, const float* sh, const float* sc, bf16_t* orow, int lane) {
    f32x4 v[4]; float s = 0.f;
#pragma unroll
    for (int j = 0; j < 4; ++j) { v[j] = *(const f32x4*)(xrow + 4 * lane + 256 * j); s += (v[j].x * v[j].x + v[j].y * v[j].y) + (v[j].z * v[j].z + v[j].w * v[j].w); }
    const float rs = 1.0f / sqrtf(wave_sum(s) * (1.f / D) + RMS_EPS);
#pragma unroll
    for (int j = 0; j < 4; ++j) { const int c = 4 * lane + 256 * j;
        const f32x4 w = *(const f32x4*)(nw + c), a = *(const f32x4*)(sc + c), b = *(const f32x4*)(sh + c);
        const f32x4 y = (v[j] * rs * w) * (1.0f + a) + b;
        u32x2 o; o.x = pk2(y.x, y.y); o.y = pk2(y.z, y.w); *(u32x2*)(orow + c) = o; }
}

__device__ __forceinline__ void unpack8(const u32x4 w, float (&f)[8]) { f[0] = bflo(w.x); f[1] = bfhi(w.x); f[2] = bflo(w.y); f[3] = bfhi(w.y); f[4] = bflo(w.z); f[5] = bfhi(w.z); f[6] = bflo(w.w); f[7] = bfhi(w.w); }
__device__ __forceinline__ void p3_shift(const Frame& F) {
    const bf16_t* ZR = (const bf16_t*)(F.ws + WS_R1); bf16_t* ZS = (bf16_t*)(F.ws + WS_ZRS); bf16_t* XG = (bf16_t*)(F.ws + WS_XGS);
    const float* mu = F.in[I_MU];
    constexpr int CH = NZR / 8;
    const size_t total = (size_t)MR * CH;
    for (size_t i = (size_t)F.bid * 512 + F.tid; i < total; i += (size_t)F.G * 512) {
        const int row = (int)(i / CH), ch = (int)(i % CH), c0 = ch * 8;
        const bf16_t* p = ZR + (size_t)row * NZR + c0;
        float z[8], a[8], o[8];
        unpack8(*(const u32x4*)p, z);
        float m0[8], m1[8];
        { const f32x4 t0 = *(const f32x4*)(mu + c0), t1 = *(const f32x4*)(mu + c0 + 4); m0[0] = t0.x; m0[1] = t0.y; m0[2] = t0.z; m0[3] = t0.w; m0[4] = t1.x; m0[5] = t1.y; m0[6] = t1.z; m0[7] = t1.w; }
        { const f32x4 t0 = *(const f32x4*)(mu + NZR + c0), t1 = *(const f32x4*)(mu + NZR + c0 + 4); m1[0] = t0.x; m1[1] = t0.y; m1[2] = t0.z; m1[3] = t0.w; m1[4] = t1.x; m1[5] = t1.y; m1[6] = t1.z; m1[7] = t1.w; }
        if (row < ML) {
            const int t = row & (T - 1), gc = t & 63, gr = t >> 6;
            float m2[8], m3[8];
            { const f32x4 t0 = *(const f32x4*)(mu + 2 * NZR + c0), t1 = *(const f32x4*)(mu + 2 * NZR + c0 + 4); m2[0] = t0.x; m2[1] = t0.y; m2[2] = t0.z; m2[3] = t0.w; m2[4] = t1.x; m2[5] = t1.y; m2[6] = t1.z; m2[7] = t1.w; }
            { const f32x4 t0 = *(const f32x4*)(mu + 3 * NZR + c0), t1 = *(const f32x4*)(mu + 3 * NZR + c0 + 4); m3[0] = t0.x; m3[1] = t0.y; m3[2] = t0.z; m3[3] = t0.w; m3[4] = t1.x; m3[5] = t1.y; m3[6] = t1.z; m3[7] = t1.w; }
#pragma unroll
            for (int j = 0; j < 8; ++j) o[j] = z[j];
            if (gc > 0) unpack8(*(const u32x4*)(p - NZR), a); else {
#pragma unroll
                for (int j = 0; j < 8; ++j) a[j] = 0.f; }
#pragma unroll
            for (int j = 0; j < 8; ++j) o[j] += m0[j] * (a[j] - z[j]);
            if (gc < 63) unpack8(*(const u32x4*)(p + NZR), a); else {
#pragma unroll
                for (int j = 0; j < 8; ++j) a[j] = 0.f; }
#pragma unroll
            for (int j = 0; j < 8; ++j) o[j] += m1[j] * (a[j] - z[j]);
            if (gr > 0) unpack8(*(const u32x4*)(p - (size_t)64 * NZR), a); else {
#pragma unroll
                for (int j = 0; j < 8; ++j) a[j] = 0.f; }
#pragma unroll
            for (int j = 0; j < 8; ++j) o[j] += m2[j] * (a[j] - z[j]);
            if (gr < 63) unpack8(*(const u32x4*)(p + (size_t)64 * NZR), a); else {
#pragma unroll
                for (int j = 0; j < 8; ++j) a[j] = 0.f; }
#pragma unroll
            for (int j = 0; j < 8; ++j) o[j] += m3[j] * (a[j] - z[j]);
            if (c0 >= 3200) {
                u32x4 w; w.x = pk2(sigmoidf_(o[0]), sigmoidf_(o[1])); w.y = pk2(sigmoidf_(o[2]), sigmoidf_(o[3])); w.z = pk2(sigmoidf_(o[4]), sigmoidf_(o[5])); w.w = pk2(sigmoidf_(o[6]), sigmoidf_(o[7]));
                *(u32x4*)(XG + (size_t)row * 256 + (c0 - 3200)) = w;
                *(u32x4*)(XG + (size_t)row * 256 + 128 + (c0 - 3200)) = (u32x4){0u, 0u, 0u, 0u};
            }
        } else {
            const int tc = (row - ML) & (TC - 1);
#pragma unroll
            for (int j = 0; j < 8; ++j) o[j] = z[j];
            if (tc > 0) unpack8(*(const u32x4*)(p - NZR), a); else {
#pragma unroll
                for (int j = 0; j < 8; ++j) a[j] = 0.f; }
#pragma unroll
            for (int j = 0; j < 8; ++j) o[j] += m0[j] * (a[j] - z[j]);
            if (tc < TC - 1) unpack8(*(const u32x4*)(p + NZR), a); else {
#pragma unroll
                for (int j = 0; j < 8; ++j) a[j] = 0.f; }
#pragma unroll
            for (int j = 0; j < 8; ++j) o[j] += m1[j] * (a[j] - z[j]);
        }
        u32x4 w; w.x = pk2(o[0], o[1]); w.y = pk2(o[2], o[3]); w.z = pk2(o[4], o[5]); w.w = pk2(o[6], o[7]);
        *(u32x4*)(ZS + (size_t)row * NZR + c0) = w;
    }
}

constexpr int RC = 32;
__device__ __forceinline__ void p4_rwkv_scan(const Frame& F) {
    const bf16_t* ZS = (const bf16_t*)(F.ws + WS_ZRS);
    float* BON = (float*)(F.ws + WS_BON);
    LAS float* WUP = (LAS float*)F.lds;
    LAS float* AUP = WUP + 4096;
    LAS float* PRM = AUP + 4096;
    LAS float* TW = PRM + 512;
    LAS float* XA = TW + RC * 65;
    LAS float* SV = XA + RC * 65;
    LAS float* YB = SV + RC * 384;
    const int tid = F.tid, lane = F.lane, w8 = F.wave;
    for (int cid = F.bid; cid < 256; cid += F.G) {
        const int b = cid >> 5, h = (cid >> 1) & 15, d = cid & 1;
        bf16_t* Yd = (bf16_t*)(F.ws + (d ? WS_YB : WS_YF));
        __syncthreads();
        for (int i = tid; i < 4096; i += 512) { const int j = i >> 6, k = i & 63;
            WUP[i] = F.in[I_WUP][((size_t)(d * 64 + j)) * 1024 + h * 64 + k]; AUP[i] = F.in[I_AUP][((size_t)(d * 64 + j)) * 1024 + h * 64 + k]; }
        if (tid < 64) { PRM[tid] = F.in[I_W0][d * 1024 + h * 64 + tid]; PRM[64 + tid] = F.in[I_A0][d * 1024 + h * 64 + tid];
            PRM[128 + tid] = F.in[I_KK][h * 64 + tid]; PRM[192 + tid] = F.in[I_KA][h * 64 + tid]; PRM[256 + tid] = F.in[I_RK][h * 64 + tid]; }
        float S0[4] = {0.f, 0.f, 0.f, 0.f}, S1[4] = {0.f, 0.f, 0.f, 0.f};
        const int tl = tid >> 4, q16 = tid & 15;
        const int rp = lane >> 4, q = lane & 15, v0 = 8 * w8 + 2 * rp;
        const int sidx = d ? (RC - 1 - tl) : tl;
        int prev_row0 = -1;
        constexpr int NCH = (TC + T) / RC;
        for (int ci = 0; ci <= NCH; ++ci) {
            int row0 = 0; bool isctx = false;
            u32x2 gr_, gk_, gv_, gw_, ga_;
            if (ci < NCH) {
                isctx = ci < TC / RC; const int cj = isctx ? ci : ci - TC / RC, nch = isctx ? TC / RC : T / RC;
                const int pos = d ? (nch - 1 - cj) : cj;
                row0 = (isctx ? ML + b * TC : b * T) + pos * RC;
                const bf16_t* rp_ = ZS + (size_t)(row0 + tl) * NZR;
                gr_ = *(const u32x2*)(rp_ + h * 64 + 4 * q16); gk_ = *(const u32x2*)(rp_ + 1024 + h * 64 + 4 * q16); gv_ = *(const u32x2*)(rp_ + 2048 + h * 64 + 4 * q16);
                gw_ = *(const u32x2*)(rp_ + 3072 + 4 * q16); ga_ = *(const u32x2*)(rp_ + 3136 + 4 * q16);
                LAS float* tw = TW + tl * 65 + 4 * q16; LAS float* xa = XA + tl * 65 + 4 * q16;
                tw[0] = tanhf(bflo(gw_.x)); tw[1] = tanhf(bfhi(gw_.x)); tw[2] = tanhf(bflo(gw_.y)); tw[3] = tanhf(bfhi(gw_.y));
                xa[0] = bflo(ga_.x); xa[1] = bfhi(ga_.x); xa[2] = bflo(ga_.y); xa[3] = bfhi(ga_.y);
            }
            __syncthreads();
            if (prev_row0 >= 0) {
                const f32x4 y = *(const LAS f32x4*)(YB + sidx * 64 + 4 * q16);
                u32x2 o; o.x = pk2(y.x, y.y); o.y = pk2(y.z, y.w);
                *(u32x2*)(Yd + (size_t)(prev_row0 + tl) * D + h * 64 + 4 * q16) = o;
            }
            if (ci == NCH) break;
            {
                float zw[4], za[4];
#pragma unroll
                for (int i = 0; i < 4; ++i) { zw[i] = PRM[4 * q16 + i]; za[i] = PRM[64 + 4 * q16 + i]; }
#pragma unroll 8
                for (int j = 0; j < 64; ++j) { const float t = TW[tl * 65 + j], x = XA[tl * 65 + j];
                    const f32x4 wv = *(const LAS f32x4*)(WUP + j * 64 + 4 * q16), av = *(const LAS f32x4*)(AUP + j * 64 + 4 * q16);
                    zw[0] += t * wv.x; zw[1] += t * wv.y; zw[2] += t * wv.z; zw[3] += t * wv.w;
                    za[0] += x * av.x; za[1] += x * av.y; za[2] += x * av.z; za[3] += x * av.w; }
                const float kr[4] = {bflo(gk_.x), bfhi(gk_.x), bflo(gk_.y), bfhi(gk_.y)};
                const float rr[4] = {bflo(gr_.x), bfhi(gr_.x), bflo(gr_.y), bfhi(gr_.y)};
                const float vv[4] = {bflo(gv_.x), bfhi(gv_.x), bflo(gv_.y), bfhi(gv_.y)};
                float kkv[4], ss = 0.f;
#pragma unroll
                for (int i = 0; i < 4; ++i) { kkv[i] = kr[i] * PRM[128 + 4 * q16 + i]; ss += kkv[i] * kkv[i]; }
                ss = sum16(ss);
                const float inv = 1.0f / fmaxf(sqrtf(ss), 1e-12f);
                f32x4 okk, ow, ob, okd, orr, ov; float bon = 0.f;
#pragma unroll
                for (int i = 0; i < 4; ++i) {
                    const float kk = kkv[i] * inv;
                    const float sw = sigmoidf_(zw[i]);
                    const float dec = __expf(-0.6065306597126334f * sw);
                    const float a = sigmoidf_(za[i]);
                    const float kd = kr[i] * (1.0f + (a - 1.0f) * PRM[192 + 4 * q16 + i]);
                    bon += rr[i] * kd * PRM[256 + 4 * q16 + i];
                    okk[i] = kk; ow[i] = dec; ob[i] = kk * a; okd[i] = kd; orr[i] = rr[i]; ov[i] = vv[i];
                }
                bon = sum16(bon);
                if (!isctx && q16 == 0) BON[((size_t)d * ML + row0 + tl) * 16 + h] = bon;
                LAS float* sv = SV + sidx * 384 + 4 * q16;
                *(LAS f32x4*)(sv) = okk; *(LAS f32x4*)(sv + 64) = ow; *(LAS f32x4*)(sv + 128) = ob; *(LAS f32x4*)(sv + 192) = okd; *(LAS f32x4*)(sv + 256) = orr; *(LAS f32x4*)(sv + 320) = ov;
            }
            __syncthreads();
#pragma unroll 2
            for (int s = 0; s < RC; ++s) {
                const LAS float* base = SV + s * 384;
                const f32x4 kk4 = *(const LAS f32x4*)(base + 4 * q), w4 = *(const LAS f32x4*)(base + 64 + 4 * q), b4 = *(const LAS f32x4*)(base + 128 + 4 * q),
                            k4 = *(const LAS f32x4*)(base + 192 + 4 * q), r4 = *(const LAS f32x4*)(base + 256 + 4 * q);
                const f32x2 vv = *(const LAS f32x2*)(base + 320 + v0);
                float p0 = (S0[0] * kk4.x + S0[1] * kk4.y) + (S0[2] * kk4.z + S0[3] * kk4.w);
                float p1 = (S1[0] * kk4.x + S1[1] * kk4.y) + (S1[2] * kk4.z + S1[3] * kk4.w);
                p0 = sum16(p0); p1 = sum16(p1);
                const float sa0 = -p0, sa1 = -p1;
#pragma unroll
                for (int j = 0; j < 4; ++j) { S0[j] = S0[j] * w4[j] + (sa0 * b4[j] + vv.x * k4[j]); S1[j] = S1[j] * w4[j] + (sa1 * b4[j] + vv.y * k4[j]); }
                float y0 = (S0[0] * r4.x + S0[1] * r4.y) + (S0[2] * r4.z + S0[3] * r4.w);
                float y1 = (S1[0] * r4.x + S1[1] * r4.y) + (S1[2] * r4.z + S1[3] * r4.w);
                y0 = sum16(y0); y1 = sum16(y1);
                if (q == 0) *(LAS f32x2*)(YB + s * 64 + v0) = (f32x2){y0, y1};
            }
            prev_row0 = isctx ? -1 : row0;
        }
    }
}

__device__ __forceinline__ void p5_rwkv_norm(const Frame& F) {
    bf16_t* YF = (bf16_t*)(F.ws + WS_YF); const bf16_t* YBk = (const bf16_t*)(F.ws + WS_YB); const bf16_t* ZS = (const bf16_t*)(F.ws + WS_ZRS);
    const float* BON = (const float*)(F.ws + WS_BON);
    const float* lnw = F.in[I_LNW]; const float* lnb = F.in[I_LNB];
    const size_t total = (size_t)ML * 256;
    for (size_t i = (size_t)F.bid * 512 + F.tid; i < total; i += (size_t)F.G * 512) {
        const int row = (int)(i >> 8), c = ((int)i & 255) * 4, h = c >> 6;
        const u32x2 a = *(const u32x2*)(YF + (size_t)row * D + c), b = *(const u32x2*)(YBk + (size_t)row * D + c);
        float y[4] = {bflo(a.x) + bflo(b.x), bfhi(a.x) + bfhi(b.x), bflo(a.y) + bflo(b.y), bfhi(a.y) + bfhi(b.y)};
        const float mean = sum16((y[0] + y[1]) + (y[2] + y[3])) * (1.f / 64.f);
        float q = 0.f;
#pragma unroll
        for (int j = 0; j < 4; ++j) { y[j] -= mean; q += y[j] * y[j]; }
        const float rstd = 1.0f / sqrtf(sum16(q) * (1.f / 64.f) + GN_EPS);
        const float bon = BON[(size_t)row * 16 + h] + BON[((size_t)ML + row) * 16 + h];
        const u32x2 vw = *(const u32x2*)(ZS + (size_t)row * NZR + 2048 + c);
        const float v[4] = {bflo(vw.x), bfhi(vw.x), bflo(vw.y), bfhi(vw.y)};
        const f32x4 lw = *(const f32x4*)(lnw + c), lb = *(const f32x4*)(lnb + c);
        float o[4];
#pragma unroll
        for (int j = 0; j < 4; ++j) o[j] = y[j] * rstd * lw[j] + lb[j] + bon * v[j];
        u32x2 w; w.x = pk2(o[0], o[1]); w.y = pk2(o[2], o[3]);
        *(u32x2*)(YF + (size_t)row * D + c) = w;
    }
}

__device__ __forceinline__ void p8_hgrn_scan(const Frame& F) {
    const bf16_t* ZH = (const bf16_t*)(F.ws + WS_ZH);
    LAS float* SV = (LAS float*)F.lds;
    LAS float* OB = SV + RC * 448;
    const int tid = F.tid, lane = F.lane, w8 = F.wave;
    const float* hglb = F.in[I_HGLB];
    for (int cid = F.bid; cid < 256; cid += F.G) {
        const int b = cid >> 5, hh = (cid >> 2) & 7, d = (cid >> 1) & 1, vh = cid & 1;
        bf16_t* Od = (bf16_t*)(F.ws + (d ? WS_OB : WS_OF));
        float S[8][2];
#pragma unroll
        for (int j = 0; j < 8; ++j) { S[j][0] = 0.f; S[j][1] = 0.f; }
        const int tl = tid >> 4, c16 = tid & 15;
        const int sidx = d ? (RC - 1 - tl) : tl;
        const int ko = lane & 15, vp = w8 * 4 + (lane >> 4);
        float lbv[8];
#pragma unroll
        for (int j = 0; j < 8; ++j) { const int ch = hh * 128 + 8 * c16 + j; lbv[j] = sigmoidf_(hglb[ch] - hglb[1024 + ch]); }
        int prev_row0 = -1;
        constexpr int NCH = (TC + T) / RC;
        __syncthreads();
        for (int ci = 0; ci <= NCH; ++ci) {
            int row0 = 0; bool isctx = false;
            u32x4 gq, gf; u32x2 gi;
            if (ci < NCH) {
                isctx = ci < TC / RC; const int cj = isctx ? ci : ci - TC / RC, nch = isctx ? TC / RC : T / RC;
                const int pos = d ? (nch - 1 - cj) : cj;
                row0 = (isctx ? ML + b * TC : b * T) + pos * RC;
                const bf16_t* rp_ = ZH + (size_t)(row0 + tl) * NZH;
                gq = *(const u32x4*)(rp_ + hh * 128 + 8 * c16);
                gf = *(const u32x4*)(rp_ + (d ? 2048 : 1024) + hh * 128 + 8 * c16);
                gi = *(const u32x2*)(rp_ + 3072 + hh * 128 + vh * 64 + 4 * c16);
            }
            __syncthreads();
            if (prev_row0 >= 0) {
                const f32x4 y = *(const LAS f32x4*)(OB + sidx * 64 + 4 * c16);
                u32x2 o; o.x = pk2(y.x, y.y); o.y = pk2(y.z, y.w);
                *(u32x2*)(Od + (size_t)(prev_row0 + tl) * D + hh * 128 + vh * 64 + 4 * c16) = o;
            }
            if (ci == NCH) break;
            {
                float qv[8], fz[8]; unpack8(gq, qv); unpack8(gf, fz);
                LAS float* sv = SV + sidx * 448 + 8 * c16;
                f32x4 f0, f1, k0, k1;
#pragma unroll
                for (int j = 0; j < 4; ++j) { const float fa = lbv[j] + (1.0f - lbv[j]) * sigmoidf_(fz[j]), fb = lbv[4 + j] + (1.0f - lbv[4 + j]) * sigmoidf_(fz[4 + j]);
                    f0[j] = fa; f1[j] = fb; k0[j] = 1.0f - fa; k1[j] = 1.0f - fb; }
                *(LAS f32x4*)(sv) = f0; *(LAS f32x4*)(sv + 4) = f1; *(LAS f32x4*)(sv + 128) = k0; *(LAS f32x4*)(sv + 132) = k1;
                *(LAS f32x4*)(sv + 256) = (f32x4){qv[0], qv[1], qv[2], qv[3]}; *(LAS f32x4*)(sv + 260) = (f32x4){qv[4], qv[5], qv[6], qv[7]};
                *(LAS f32x4*)(SV + sidx * 448 + 384 + 4 * c16) = (f32x4){bflo(gi.x), bfhi(gi.x), bflo(gi.y), bfhi(gi.y)};
            }
            __syncthreads();
#pragma unroll 2
            for (int s = 0; s < RC; ++s) {
                const LAS float* base = SV + s * 448;
                const f32x4 fA = *(const LAS f32x4*)(base + 8 * ko), fB = *(const LAS f32x4*)(base + 8 * ko + 4);
                const f32x4 kA = *(const LAS f32x4*)(base + 128 + 8 * ko), kB = *(const LAS f32x4*)(base + 128 + 8 * ko + 4);
                const f32x4 qA = *(const LAS f32x4*)(base + 256 + 8 * ko), qB = *(const LAS f32x4*)(base + 256 + 8 * ko + 4);
                const f32x2 iv = *(const LAS f32x2*)(base + 384 + 2 * vp);
                float o0 = 0.f, o1 = 0.f;
#pragma unroll
                for (int j = 0; j < 4; ++j) {
                    S[j][0] = fA[j] * S[j][0] + kA[j] * iv.x; S[j][1] = fA[j] * S[j][1] + kA[j] * iv.y;
                    S[4 + j][0] = fB[j] * S[4 + j][0] + kB[j] * iv.x; S[4 + j][1] = fB[j] * S[4 + j][1] + kB[j] * iv.y;
                    o0 += S[j][0] * qA[j] + S[4 + j][0] * qB[j]; o1 += S[j][1] * qA[j] + S[4 + j][1] * qB[j];
                }
                o0 = sum16(o0); o1 = sum16(o1);
                if (ko == 0) *(LAS f32x2*)(OB + s * 64 + 2 * vp) = (f32x2){o0, o1};
            }
            prev_row0 = isctx ? -1 : row0;
        }
    }
}

__device__ __forceinline__ void p10_hgrn_read(const Frame& F) {
    bf16_t* OF = (bf16_t*)(F.ws + WS_OF); const bf16_t* OBk = (const bf16_t*)(F.ws + WS_OB); const bf16_t* ZG = (const bf16_t*)(F.ws + WS_ZG);
    const float* nw = F.in[I_HGNW];
    const size_t total = (size_t)ML * 256;
    for (size_t i = (size_t)F.bid * 512 + F.tid; i < total; i += (size_t)F.G * 512) {
        const int row = (int)(i >> 8), c = ((int)i & 255) * 4;
        const u32x2 a = *(const u32x2*)(OF + (size_t)row * D + c), b = *(const u32x2*)(OBk + (size_t)row * D + c);
        const float o[4] = {bflo(a.x) + bflo(b.x), bfhi(a.x) + bfhi(b.x), bflo(a.y) + bflo(b.y), bfhi(a.y) + bfhi(b.y)};
        const float ms = sum32((o[0] * o[0] + o[1] * o[1]) + (o[2] * o[2] + o[3] * o[3])) * (1.f / 128.f);
        const float rs = 1.0f / sqrtf(ms + RMS_EPS);
        const u32x2 gw = *(const u32x2*)(ZG + (size_t)row * NZG + c);
        const float g[4] = {bflo(gw.x), bfhi(gw.x), bflo(gw.y), bfhi(gw.y)};
        const f32x4 w = *(const f32x4*)(nw + c);
        float y[4];
#pragma unroll
        for (int j = 0; j < 4; ++j) y[j] = o[j] * rs * w[j] * (g[j] * sigmoidf_(g[j]));
        u32x2 ww; ww.x = pk2(y[0], y[1]); ww.y = pk2(y[2], y[3]);
        *(u32x2*)(OF + (size_t)row * D + c) = ww;
    }
}

template <bool COOP>
__device__ __forceinline__ void mk_body(const Args& args) {
    extern __shared__ __attribute__((aligned(16))) unsigned char lds_raw[];
    Frame F;
    F.lds = (LAS unsigned char*)lds_raw;
    F.tid = threadIdx.x; F.lane = F.tid & 63; F.wave = __builtin_amdgcn_readfirstlane(F.tid >> 6);
    F.G = gridDim.x; F.bid = blockIdx.x;
    F.in = args.in; F.ws = args.ws; F.dob = (unsigned char*)args.out;
    const int lo = args.ph_lo, hi = args.ph_hi;
    const float* MOD = (const float*)(F.ws + WS_MOD);
    const int gw = F.bid * 8 + F.wave, NGW = F.G * 8;
#define IN(k) (lo <= (k) && (k) < hi)
#define SEAM(k) do { if (COOP && IN(k) && IN((k) + 1)) cg::this_grid().sync(); } while (0)

    if (IN(0)) { p0_prologue(F); } SEAM(0);
    if (IN(1)) {
        bf16_t* H = (bf16_t*)(F.dob + DO_H);
        for (int m = gw; m < MR; m += NGW) {
            const bool lat = m < ML; const int b = lat ? (m >> 12) : 8;
            const float* xr = lat ? F.in[I_X] + (size_t)m * D : F.in[I_CTX] + (size_t)(m - ML) * D;
            modnorm_row(xr, F.in[I_N1W], MOD + b * 6144, MOD + b * 6144 + 1024, H + (size_t)m * D, F.lane);
        }
    } SEAM(1);
    if (IN(2)) {
        pg8::Sched S; S.init(F.dob + DO_H, F.dob + DO_WIN, nullptr, nullptr, MR, NZR, D, F.G, F.bid, 1);
        pg8::EpiBf16 E{(bf16_t*)(F.ws + WS_R1), NZR};
        pg8::gemm_phase(F.lds, D, S, E);
    } SEAM(2);
    if (IN(3)) { p3_shift(F); } SEAM(3);
    if (IN(4)) { p4_rwkv_scan(F); } SEAM(4);
    if (IN(5)) { p5_rwkv_norm(F); } SEAM(5);
    if (IN(6)) {
        pg8::Sched S; S.init(F.ws + WS_XGS, F.dob + DO_GUP, nullptr, nullptr, ML, D, 256, F.G, F.bid, 1);
        pg8::EpiMulBf16 E{(const bf16_t*)(F.ws + WS_YF), (bf16_t*)(F.ws + WS_YRW), D};
        pg8::gemm_phase(F.lds, 256, S, E);
    } SEAM(6);
    if (IN(7)) {
        pg8::Sched S; S.init(F.dob + DO_H, F.dob + DO_WIN + (size_t)NZR * D * 2, nullptr, nullptr, MR, NZH, D, F.G, F.bid, 1);
        pg8::EpiBf16 E{(bf16_t*)(F.ws + WS_ZH), NZH};
        pg8::gemm_phase(F.lds, D, S, E);
    } SEAM(7);
    if (IN(8)) { p8_hgrn_scan(F); } SEAM(8);
    if (IN(9)) {
        pg8::Sched S; S.init(F.dob + DO_H, F.dob + DO_WIN + (size_t)(NZR + NZH) * D * 2, nullptr, nullptr, ML, NZG, D, F.G, F.bid, 1);
        pg8::EpiBf16 E{(bf16_t*)(F.ws + WS_ZG), NZG};
        pg8::gemm_phase(F.lds, D, S, E);
    } SEAM(9);
    if (IN(10)) { p10_hgrn_read(F); } SEAM(10);
    if (IN(11)) {
        pg8::Sched S; S.init(F.ws + WS_YRW, F.dob + DO_PA, F.ws + WS_OF, F.dob + DO_PB, ML, D, D, F.G, F.bid, 2);
        pg8::EpiMerge E{(const bf16_t*)(F.ws + WS_ZG), (bf16_t*)(F.ws + WS_MRG)};
        pg8::gemm_phase(F.lds, D, S, E);
    } SEAM(11);
    if (IN(12)) {
        pg8::Sched S; S.init(F.ws + WS_MRG, F.dob + DO_WO, nullptr, nullptr, ML, D, D, F.G, F.bid, 1);
        pg8::EpiResid E{F.in[I_X], (float*)(F.ws + WS_X1), MOD + 2048};
        pg8::gemm_phase(F.lds, D, S, E);
    } SEAM(12);
    if (IN(13)) {
        const float* X1 = (const float*)(F.ws + WS_X1); bf16_t* H2 = (bf16_t*)(F.ws + WS_H2);
        for (int m = gw; m < ML; m += NGW) { const int b = m >> 12;
            modnorm_row(X1 + (size_t)m * D, F.in[I_N2W], MOD + b * 6144 + 3072, MOD + b * 6144 + 4096, H2 + (size_t)m * D, F.lane); }
    } SEAM(13);
    if (IN(14)) {
        pg8::Sched S; S.init(F.ws + WS_H2, F.dob + DO_FC1, nullptr, nullptr, ML, FF, D, F.G, F.bid, 1);
        pg8::EpiSqRelu E{(bf16_t*)(F.ws + WS_U), FF};
        pg8::gemm_phase(F.lds, D, S, E);
    } SEAM(14);
    if (IN(15)) {
        pg8::Sched S; S.init(F.ws + WS_U, F.dob + DO_FC2, nullptr, nullptr, ML, D, FF, F.G, F.bid, 1);
        pg8::EpiResid E{(const float*)(F.ws + WS_X1), (float*)(F.ws + WS_X1), MOD + 5120};
        pg8::gemm_phase(F.lds, FF, S, E);
    } SEAM(15);
    if (IN(16)) {
        const float* X2 = (const float*)(F.ws + WS_X1); const float* fw = F.in[I_FNW];
        for (int m = gw; m < ML; m += NGW) {
            const float* xr = X2 + (size_t)m * D; float* orow = args.out + (size_t)m * D;
            f32x4 v[4]; float s = 0.f;
#pragma unroll
            for (int j = 0; j < 4; ++j) { v[j] = *(const f32x4*)(xr + 4 * F.lane + 256 * j); s += (v[j].x * v[j].x + v[j].y * v[j].y) + (v[j].z * v[j].z + v[j].w * v[j].w); }
            const float rs = 1.0f / sqrtf(wave_sum(s) * (1.f / D) + RMS_EPS);
#pragma unroll
            for (int j = 0; j < 4; ++j) { const int c = 4 * F.lane + 256 * j; *(f32x4*)(orow + c) = v[j] * rs * *(const f32x4*)(fw + c); }
        }
    }
#undef IN
#undef SEAM
}

__global__ void __launch_bounds__(512, 2) mk_multi(Args args) { mk_body<false>(args); }
__global__ void __launch_bounds__(512, 2) mk_one(Args args) { mk_body<true>(args); }

extern "C" void kernel_launch(void* const* d_in, const int* in_sizes, int n_in, void* d_out, int out_size, void* d_ws, size_t ws_size, hipStream_t stream) {
    static int grid = 0;
    if (grid == 0) {
        if (n_in != 28 || out_size != ML * D || ws_size < WS_END) { fprintf(stderr, "kernel_launch: unexpected problem (n_in %d, out %d, ws %zu)\n", n_in, out_size, ws_size); grid = -1; return; }
        int dev = 0, cus = 0;
        if (hipGetDevice(&dev) != hipSuccess || hipDeviceGetAttribute(&cus, hipDeviceAttributeMultiprocessorCount, dev) != hipSuccess) { grid = -1; return; }
        (void)hipFuncSetAttribute((const void*)mk_multi, hipFuncAttributeMaxDynamicSharedMemorySize, LDS_BYTES);
        (void)hipFuncSetAttribute((const void*)mk_one, hipFuncAttributeMaxDynamicSharedMemorySize, LDS_BYTES);
        int per_cu = 0;
        (void)hipOccupancyMaxActiveBlocksPerMultiprocessor(&per_cu, (const void*)mk_one, 512, LDS_BYTES);
        (void)hipGetLastError();
        grid = cus;
        if (per_cu < 1) fprintf(stderr, "kernel_launch: occupancy query reports %d blocks per CU\n", per_cu);
    }
    if (grid < 0) return;
    Args a{};
    for (int i = 0; i < 28; ++i) a.in[i] = (const float*)d_in[i];
    a.out = (float*)d_out; a.ws = (unsigned char*)d_ws;
#if MK_ONE_LAUNCH
    a.ph_lo = 0; a.ph_hi = NPHASE;
    void* kargs[] = {&a};
    hipError_t e = hipLaunchCooperativeKernel((const void*)mk_one, dim3(grid), dim3(512), kargs, LDS_BYTES, stream);
    if (e != hipSuccess) fprintf(stderr, "cooperative launch failed: %s\n", hipGetErrorString(e));
#else
    for (int p = 0; p < NPHASE; ++p) { a.ph_lo = p; a.ph_hi = p + 1; hipLaunchKernelGGL(mk_multi, dim3(grid), dim3(512), LDS_BYTES, stream, a); }
#endif
}
```

```cpp
#include <hip/hip_runtime.h>
#include <hip/hip_cooperative_groups.h>
#include <cstdio>
#include <cstdint>
namespace cg = cooperative_groups;

#ifndef MK_ONE_LAUNCH
#define MK_ONE_LAUNCH 1
#endif

#define LAS __attribute__((address_space(3)))
typedef unsigned short bf16_t;
typedef short bf16x8 __attribute__((ext_vector_type(8)));
typedef float f32x4 __attribute__((ext_vector_type(4)));
typedef float f32x2 __attribute__((ext_vector_type(2)));
typedef unsigned u32x4 __attribute__((ext_vector_type(4)));
typedef unsigned u32x2 __attribute__((ext_vector_type(2)));

constexpr int D = 1024, NB = 8, T = 4096, TC = 256, GW = 64;
constexpr int ML = NB * T;
constexpr int MC = NB * TC;
constexpr int MR = ML + MC;
constexpr int NZR = 3328, NZH = 4096, NZG = 3072, NIN = 10496, FF = 4096;
constexpr float RMS_EPS = 1e-6f, GN_EPS = 64e-5f;

constexpr size_t MiB = 1u << 20;
constexpr size_t WS_CTL = 0, WS_MOD = 1 * MiB;
constexpr size_t WS_R1 = 2 * MiB;
constexpr size_t WS_YF = 2 * MiB, WS_YB = 66 * MiB, WS_YRW = 130 * MiB;
constexpr size_t WS_OF = 2 * MiB, WS_OB = 66 * MiB;
constexpr size_t WS_X1 = 2 * MiB;
constexpr size_t WS_H2 = 130 * MiB;
constexpr size_t WS_ZRS = 223 * MiB;
constexpr size_t WS_XGS = 444 * MiB;
constexpr size_t WS_BON = 460 * MiB;
constexpr size_t WS_ZH = 194 * MiB;
constexpr size_t WS_ZG = 194 * MiB;
constexpr size_t WS_MRG = 386 * MiB;
constexpr size_t WS_U = 194 * MiB;
constexpr size_t WS_END = 466 * MiB;
constexpr size_t DO_H = 0;
constexpr size_t DO_WIN = 68 * MiB;
constexpr size_t DO_PA = DO_WIN + (size_t)NIN * D * 2;
constexpr size_t DO_PB = DO_PA + 2 * MiB, DO_WO = DO_PB + 2 * MiB, DO_FC1 = DO_WO + 2 * MiB, DO_FC2 = DO_FC1 + 8 * MiB, DO_GUP = DO_FC2 + 8 * MiB;
constexpr size_t DO_END = DO_GUP + (size_t)1024 * 256 * 2;
static_assert(DO_END <= 128 * MiB, "d_out scratch overflow");

constexpr int LDS_BYTES = 140 * 1024;
constexpr int NPHASE = 17;

__device__ __forceinline__ unsigned f2bf(float f) { unsigned u = __builtin_bit_cast(unsigned, f); return (u + 0x7fffu + ((u >> 16) & 1u)) >> 16; }
__device__ __forceinline__ unsigned pk2(float lo, float hi) { return f2bf(lo) | (f2bf(hi) << 16); }
__device__ __forceinline__ float bflo(unsigned w) { return __builtin_bit_cast(float, w << 16); }
__device__ __forceinline__ float bfhi(unsigned w) { return __builtin_bit_cast(float, w & 0xffff0000u); }
__device__ __forceinline__ float sigmoidf_(float x) { return 1.0f / (1.0f + __expf(-x)); }
__device__ __forceinline__ float wave_sum(float v) {
#pragma unroll
    for (int o = 1; o < 64; o <<= 1) v += __shfl_xor(v, o);
    return v;
}
__device__ __forceinline__ float sum16(float v) { v += __shfl_xor(v, 1); v += __shfl_xor(v, 2); v += __shfl_xor(v, 4); v += __shfl_xor(v, 8); return v; }
__device__ __forceinline__ float sum32(float v) { v = sum16(v); v += __shfl_xor(v, 16); return v; }

namespace pg8 {
constexpr int BM = 256, BK = 64, HALF = 128, HTB = HALF * BK * 2, STAGE_BYTES = 8 * HTB, NXCD = 8, WGM = 8;
__host__ __device__ __forceinline__ int lds_byte(int r, int c) { const int st = (r >> 4) * 2 + (c >> 5), rr = r & 15, cc = c & 31, ob = rr * 64 + cc * 2; return st * 1024 + (ob ^ (((ob >> 9) & 1) << 5)); }
__host__ __device__ __forceinline__ void stage_rc(int b, int& R, int& C) { const int st = b / 1024, sb = b % 1024, swz = sb ^ (((sb >> 9) & 1) << 5); R = (st >> 1) * 16 + swz / 64; C = (st & 1) * 32 + (swz % 64) / 2; }
__host__ __device__ __forceinline__ int perm32(int rho) { const int n = rho >> 4, i = rho & 15; return 8 * (i >> 2) + 4 * n + (i & 3); }

struct Unit { int pm, pn, sel; };
struct Sched {
    const char* A0; const char* B0; const char* A1; const char* B1;
    int nM, nN, nwg, G, c, nsel; size_t tstep;
    __device__ void init(const void* a0, const void* b0, const void* a1, const void* b1, int M, int N, int K, int G_, int c_, int nsel_) {
        A0 = (const char*)a0; B0 = (const char*)b0; A1 = (const char*)a1; B1 = (const char*)b1; nM = M / BM; nN = N / BM; nwg = nM * nN; G = G_; c = c_; nsel = nsel_; tstep = (size_t)BM * K * 2; }
    __device__ bool next(int i, Unit& u) const {
        const int j = (nsel == 2) ? (i >> 1) : i;
        const long L = (long)j * G + c; if (L >= nwg) return false;
        int wgid = (int)L; { const int q = nwg / NXCD, r = nwg % NXCD, xcd = wgid % NXCD, off = wgid / NXCD; wgid = (xcd < r ? xcd * (q + 1) : r * (q + 1) + (xcd - r) * q) + off; }
        const int nig = WGM * nN, gid = wgid / nig, fm = gid * WGM, gsz = (nM - fm) < WGM ? (nM - fm) : WGM;
        u.pm = fm + ((wgid % nig) % gsz); u.pn = (wgid % nig) / gsz; u.sel = (nsel == 2) ? (i & 1) : 0; return true;
    }
    __device__ __forceinline__ const char* abase(const Unit& u) const { return (u.sel ? A1 : A0) + (size_t)u.pm * tstep; }
    __device__ __forceinline__ const char* bbase(const Unit& u) const { return (u.sel ? B1 : B0) + (size_t)u.pn * tstep; }
};

template <class Epi>
__device__ __forceinline__ void gemm_phase(LAS unsigned char* lds, const int K, const Sched& S, const Epi& E) {
    const int tid = threadIdx.x, wid = __builtin_amdgcn_readfirstlane(tid >> 6), lane = tid & 63, wr = wid >> 2, wc = wid & 3, fr = lane & 15, fq = lane >> 4;
    const int nt = K / BK;
    unsigned voffA[2], voffB[2];
#pragma unroll
    for (int i = 0; i < 2; ++i) { int R, C; stage_rc(tid * 16 + i * 8192, R, C); const int Rb = Epi::PERM ? ((R & ~31) + perm32(R & 31)) : R;
        voffA[i] = (unsigned)(R * K + C) * 2u; voffB[i] = (unsigned)(Rb * K + C) * 2u; }
    const size_t kstep = (size_t)(BK * 2);
    const size_t hstep = (size_t)HALF * K * 2;
    const unsigned ldsw = (unsigned)wid * 1024u;
    const int aoff = lds_byte(wr * 64 + fr, fq * 8), boff = lds_byte(wc * 32 + fr, fq * 8);
#define PG8_SA(b, h) (((b) * 2 + (h)) * HTB)
#define PG8_SB(b, h) ((4 + (b) * 2 + (h)) * HTB)
#define PG8_STAGE(bufoff, gbase, voff) do { _Pragma("unroll") for (int _i = 0; _i < 2; ++_i) \
        __builtin_amdgcn_global_load_lds((const unsigned*)((const char*)(gbase) + (voff)[_i]), (LAS unsigned*)(lds + (bufoff) + ldsw + _i * 8192), 16, 0, 0); } while (0)
#define PG8_LDA(dst, b, h) do { _Pragma("unroll") for (int m = 0; m < 4; ++m) _Pragma("unroll") for (int k = 0; k < 2; ++k) dst[m][k] = *(const LAS bf16x8*)(lds + PG8_SA(b, h) + aoff + m * 2048 + k * 1024); } while (0)
#define PG8_LDB(dst, b, h) do { _Pragma("unroll") for (int n = 0; n < 2; ++n) _Pragma("unroll") for (int k = 0; k < 2; ++k) dst[n][k] = *(const LAS bf16x8*)(lds + PG8_SB(b, h) + boff + n * 2048 + k * 1024); } while (0)
#define PG8_MMA(ai, bj, At, Bt) do { __builtin_amdgcn_s_setprio(1); _Pragma("unroll") for (int m = 0; m < 4; ++m) _Pragma("unroll") for (int n = 0; n < 2; ++n) _Pragma("unroll") for (int k = 0; k < 2; ++k) \
        acc[ai][bj][m][n] = __builtin_amdgcn_mfma_f32_16x16x32_bf16(Bt[n][k], At[m][k], acc[ai][bj][m][n], 0, 0, 0); __builtin_amdgcn_s_setprio(0); } while (0)
#define PG8_WAIT_V(n) asm volatile("s_waitcnt vmcnt(" #n ")" ::: "memory")
#define PG8_WAIT_L(n) asm volatile("s_waitcnt lgkmcnt(" #n ")" ::: "memory")
#define PG8_BAR __builtin_amdgcn_s_barrier()
#define PG8_SCHED __builtin_amdgcn_sched_barrier(0)
    Unit cur, nxt; int ui = 0;
    if (!S.next(0, cur)) return;
    f32x4 acc[2][2][4][2];
#pragma unroll
    for (int a = 0; a < 2; ++a)
#pragma unroll
        for (int b = 0; b < 2; ++b)
#pragma unroll
            for (int m = 0; m < 4; ++m)
#pragma unroll
                for (int n = 0; n < 2; ++n) acc[a][b][m][n] = (f32x4){0.f, 0.f, 0.f, 0.f};
    bf16x8 At[4][2], B0[2][2], B1[2][2];
    const char* cA = S.abase(cur); const char* cB = S.bbase(cur);
    PG8_STAGE(PG8_SB(0, 0), cB, voffB); PG8_STAGE(PG8_SB(0, 1), cB + hstep, voffB); PG8_STAGE(PG8_SA(0, 0), cA, voffA); PG8_STAGE(PG8_SA(0, 1), cA + hstep, voffA);
    if (wr == 1) PG8_BAR;
    PG8_WAIT_V(2); PG8_BAR;
    PG8_STAGE(PG8_SB(1, 0), cB + kstep, voffB); PG8_STAGE(PG8_SA(1, 0), cA + kstep, voffA); PG8_STAGE(PG8_SB(1, 1), cB + hstep + kstep, voffB);
    PG8_WAIT_V(6); PG8_BAR;
    for (;;) {
        const bool has_next = S.next(ui + 1, nxt);
        const char* nA = has_next ? S.abase(nxt) : cA; const char* nB = has_next ? S.bbase(nxt) : cB;
        for (int t = 0; t < nt; t += 2) {
            const bool last = (t == nt - 2);
            const char* a1 = cA + (size_t)(t + 1) * kstep;
            const char* a2 = last ? nA : cA + (size_t)(t + 2) * kstep; const char* b2 = last ? nB : cB + (size_t)(t + 2) * kstep;
            const char* a3 = a2 + kstep; const char* b3 = b2 + kstep;
            PG8_LDB(B0, 0, 0); PG8_LDB(B1, 0, 1); PG8_SCHED; PG8_LDA(At, 0, 0); PG8_STAGE(PG8_SA(1, 1), a1 + hstep, voffA);
            PG8_WAIT_V(8); PG8_WAIT_L(0); PG8_BAR; PG8_MMA(0, 0, At, B0); PG8_MMA(0, 1, At, B1); PG8_BAR; PG8_SCHED;
            PG8_LDA(At, 0, 1); PG8_STAGE(PG8_SB(0, 0), b2, voffB); PG8_STAGE(PG8_SB(0, 1), b2 + hstep, voffB); PG8_STAGE(PG8_SA(0, 0), a2, voffA);
            PG8_WAIT_V(8); PG8_WAIT_L(0); PG8_BAR; PG8_MMA(1, 0, At, B0); PG8_MMA(1, 1, At, B1); PG8_BAR; PG8_SCHED;
            PG8_LDB(B0, 1, 0); PG8_LDB(B1, 1, 1); PG8_SCHED; PG8_LDA(At, 1, 0); PG8_STAGE(PG8_SA(0, 1), a2 + hstep, voffA);
            PG8_WAIT_V(8); PG8_WAIT_L(0); PG8_BAR; PG8_MMA(0, 0, At, B0); PG8_MMA(0, 1, At, B1); PG8_BAR; PG8_SCHED;
            PG8_LDA(At, 1, 1); PG8_STAGE(PG8_SB(1, 0), b3, voffB); PG8_STAGE(PG8_SB(1, 1), b3 + hstep, voffB); PG8_STAGE(PG8_SA(1, 0), a3, voffA);
            PG8_WAIT_V(8); PG8_WAIT_L(0); PG8_BAR; PG8_MMA(1, 0, At, B0); PG8_MMA(1, 1, At, B1); PG8_BAR; PG8_SCHED;
        }
        if (wr == 0) PG8_BAR;
        E(acc, cur, wr, wc, fr, fq);
        if (!has_next) break;
#pragma unroll
        for (int a = 0; a < 2; ++a)
#pragma unroll
            for (int b = 0; b < 2; ++b)
#pragma unroll
                for (int m = 0; m < 4; ++m)
#pragma unroll
                    for (int n = 0; n < 2; ++n) acc[a][b][m][n] = (f32x4){0.f, 0.f, 0.f, 0.f};
        cur = nxt; cA = nA; cB = nB; ++ui;
        if (wr == 1) PG8_BAR;
    }
    PG8_WAIT_V(0);
    PG8_BAR;
#undef PG8_SA
#undef PG8_SB
#undef PG8_STAGE
#undef PG8_LDA
#undef PG8_LDB
#undef PG8_MMA
#undef PG8_WAIT_V
#undef PG8_WAIT_L
#undef PG8_BAR
#undef PG8_SCHED
}

struct EpiBf16 {
    static constexpr bool PERM = true;
    bf16_t* O; int ldc;
    __device__ __forceinline__ void operator()(const f32x4 (&acc)[2][2][4][2], const Unit& u, int wr, int wc, int fr, int fq) const {
        const int row0 = u.pm * BM + wr * 64 + fr, col0 = u.pn * BM + wc * 32 + 8 * fq;
#pragma unroll
        for (int ai = 0; ai < 2; ++ai)
#pragma unroll
            for (int m = 0; m < 4; ++m) { bf16_t* rowp = O + (size_t)(row0 + ai * HALF + m * 16) * ldc + col0;
#pragma unroll
                for (int bj = 0; bj < 2; ++bj) { const f32x4 v0 = acc[ai][bj][m][0], v1 = acc[ai][bj][m][1];
                    u32x4 w; w.x = pk2(v0[0], v0[1]); w.y = pk2(v0[2], v0[3]); w.z = pk2(v1[0], v1[1]); w.w = pk2(v1[2], v1[3]);
                    *(u32x4*)(rowp + bj * HALF) = w; } }
    }
};
struct EpiSqRelu {
    static constexpr bool PERM = true;
    bf16_t* O; int ldc;
    __device__ __forceinline__ void operator()(const f32x4 (&acc)[2][2][4][2], const Unit& u, int wr, int wc, int fr, int fq) const {
        const int row0 = u.pm * BM + wr * 64 + fr, col0 = u.pn * BM + wc * 32 + 8 * fq;
#pragma unroll
        for (int ai = 0; ai < 2; ++ai)
#pragma unroll
            for (int m = 0; m < 4; ++m) { bf16_t* rowp = O + (size_t)(row0 + ai * HALF + m * 16) * ldc + col0;
#pragma unroll
                for (int bj = 0; bj < 2; ++bj) { f32x4 v0 = acc[ai][bj][m][0], v1 = acc[ai][bj][m][1];
#pragma unroll
                    for (int j = 0; j < 4; ++j) { const float a = fmaxf(v0[j], 0.f), b = fmaxf(v1[j], 0.f); v0[j] = a * a; v1[j] = b * b; }
                    u32x4 w; w.x = pk2(v0[0], v0[1]); w.y = pk2(v0[2], v0[3]); w.z = pk2(v1[0], v1[1]); w.w = pk2(v1[2], v1[3]);
                    *(u32x4*)(rowp + bj * HALF) = w; } }
    }
};
struct EpiMulBf16 {
    static constexpr bool PERM = true;
    const bf16_t* Y; bf16_t* O; int ldc;
    __device__ __forceinline__ void operator()(const f32x4 (&acc)[2][2][4][2], const Unit& u, int wr, int wc, int fr, int fq) const {
        const int row0 = u.pm * BM + wr * 64 + fr, col0 = u.pn * BM + wc * 32 + 8 * fq;
#pragma unroll
        for (int ai = 0; ai < 2; ++ai)
#pragma unroll
            for (int m = 0; m < 4; ++m) { const size_t off = (size_t)(row0 + ai * HALF + m * 16) * ldc + col0;
#pragma unroll
                for (int bj = 0; bj < 2; ++bj) { const f32x4 v0 = acc[ai][bj][m][0], v1 = acc[ai][bj][m][1];
                    const u32x4 y = *(const u32x4*)(Y + off + bj * HALF);
                    u32x4 w; w.x = pk2(v0[0] * bflo(y.x), v0[1] * bfhi(y.x)); w.y = pk2(v0[2] * bflo(y.y), v0[3] * bfhi(y.y));
                    w.z = pk2(v1[0] * bflo(y.z), v1[1] * bfhi(y.z)); w.w = pk2(v1[2] * bflo(y.w), v1[3] * bfhi(y.w));
                    *(u32x4*)(O + off + bj * HALF) = w; }
                asm volatile("" ::: "memory"); }
    }
};
struct EpiMerge {
    static constexpr bool PERM = true;
    const bf16_t* ZG; bf16_t* O;
    __device__ __forceinline__ void operator()(const f32x4 (&acc)[2][2][4][2], const Unit& u, int wr, int wc, int fr, int fq) const {
        const int row0 = u.pm * BM + wr * 64 + fr, col0 = u.pn * BM + wc * 32 + 8 * fq;
        const int goff = u.sel ? 2048 : 1024;
#pragma unroll
        for (int ai = 0; ai < 2; ++ai)
#pragma unroll
            for (int m = 0; m < 4; ++m) { const size_t r = (size_t)(row0 + ai * HALF + m * 16);
#pragma unroll
                for (int bj = 0; bj < 2; ++bj) { const f32x4 v0 = acc[ai][bj][m][0], v1 = acc[ai][bj][m][1];
                    const u32x4 g = *(const u32x4*)(ZG + r * NZG + goff + col0 + bj * HALF);
                    float o[8];
                    o[0] = v0[0] * sigmoidf_(bflo(g.x)); o[1] = v0[1] * sigmoidf_(bfhi(g.x)); o[2] = v0[2] * sigmoidf_(bflo(g.y)); o[3] = v0[3] * sigmoidf_(bfhi(g.y));
                    o[4] = v1[0] * sigmoidf_(bflo(g.z)); o[5] = v1[1] * sigmoidf_(bfhi(g.z)); o[6] = v1[2] * sigmoidf_(bflo(g.w)); o[7] = v1[3] * sigmoidf_(bfhi(g.w));
                    bf16_t* op = O + r * D + col0 + bj * HALF;
                    if (u.sel) { const u32x4 p = *(const u32x4*)op;
                        o[0] += bflo(p.x); o[1] += bfhi(p.x); o[2] += bflo(p.y); o[3] += bfhi(p.y); o[4] += bflo(p.z); o[5] += bfhi(p.z); o[6] += bflo(p.w); o[7] += bfhi(p.w); }
                    u32x4 w; w.x = pk2(o[0], o[1]); w.y = pk2(o[2], o[3]); w.z = pk2(o[4], o[5]); w.w = pk2(o[6], o[7]);
                    *(u32x4*)op = w; }
                asm volatile("" ::: "memory"); }
    }
};
struct EpiResid {
    static constexpr bool PERM = false;
    const float* base; float* out; const float* gate;
    __device__ __forceinline__ void operator()(const f32x4 (&acc)[2][2][4][2], const Unit& u, int wr, int wc, int fr, int fq) const {
        const int row0 = u.pm * BM + wr * 64 + fr, col0 = u.pn * BM + wc * 32 + 4 * fq;
        const float* gp = gate + (size_t)((u.pm * BM) / T) * 6144 + col0;
        f32x4 gv[2][2];
#pragma unroll
        for (int bj = 0; bj < 2; ++bj)
#pragma unroll
            for (int n = 0; n < 2; ++n) gv[bj][n] = *(const f32x4*)(gp + bj * HALF + n * 16);
#pragma unroll
        for (int ai = 0; ai < 2; ++ai)
#pragma unroll
            for (int m = 0; m < 4; ++m) { const size_t off = (size_t)(row0 + ai * HALF + m * 16) * D + col0;
#pragma unroll
                for (int bj = 0; bj < 2; ++bj)
#pragma unroll
                    for (int n = 0; n < 2; ++n) { const f32x4 bs = *(const f32x4*)(base + off + bj * HALF + n * 16);
                        *(f32x4*)(out + off + bj * HALF + n * 16) = bs + gv[bj][n] * acc[ai][bj][m][n]; }
                asm volatile("" ::: "memory"); }
    }
};
}

struct Args { const float* in[28]; float* out; unsigned char* ws; int ph_lo, ph_hi; };

struct Frame {
    LAS unsigned char* lds;
    int tid, lane, wave, G, bid;
    const float* const* in;
    unsigned char* ws; unsigned char* dob;
};
enum { I_X = 0, I_C, I_CTX, I_CCTX, I_N1W, I_N2W, I_WMOD, I_BMOD, I_WIN, I_MU, I_W0, I_WUP, I_A0, I_AUP, I_GUP, I_KK, I_KA, I_RK, I_LNW, I_LNB, I_HGLB, I_HGNW, I_PA, I_PB, I_WOUT, I_FC1, I_FC2, I_FNW };

__device__ __forceinline__ void transpose_item(const float* W, int N, bf16_t* WT, int ldk, LAS float* scr, int item, int lane) {
    const int nblk = N / 32, kb = item / nblk, nb = item % nblk, k0 = 64 * kb, n0 = 32 * nb;
#pragma unroll 8
    for (int i = 0; i < 32; ++i) { const int kk = 2 * i + (lane >> 5); scr[kk * 33 + (lane & 31)] = W[(size_t)(k0 + kk) * N + n0 + (lane & 31)]; }
    asm volatile("s_waitcnt lgkmcnt(0)" ::: "memory");
    const int c = lane & 7;
#pragma unroll
    for (int j = 0; j < 4; ++j) { const int n = (lane >> 3) + 8 * j; const LAS float* s = scr + (8 * c) * 33 + n;
        u32x4 o; o.x = pk2(s[0 * 33], s[1 * 33]); o.y = pk2(s[2 * 33], s[3 * 33]); o.z = pk2(s[4 * 33], s[5 * 33]); o.w = pk2(s[6 * 33], s[7 * 33]);
        *(u32x4*)(WT + (size_t)(n0 + n) * ldk + k0 + 8 * c) = o; }
    asm volatile("s_waitcnt lgkmcnt(0)" ::: "memory");
}

__device__ __forceinline__ void p0_prologue(const Frame& F) {
    float* MOD = (float*)(F.ws + WS_MOD);
    if (F.bid < 96) {
        LAS float* act = (LAS float*)F.lds;
        LAS float* red = act + 9 * 1024;
        for (int i = F.tid; i < 9 * 1024; i += 512) { const float v = (i < 8 * 1024) ? F.in[I_C][i] : F.in[I_CCTX][i - 8 * 1024]; act[i] = v * sigmoidf_(v); }
        __syncthreads();
        const float* wm = F.in[I_WMOD];
        const int n = F.bid * 64 + F.lane;
        float a[9];
#pragma unroll
        for (int r = 0; r < 9; ++r) a[r] = 0.f;
        const int kb = F.wave * 128;
#pragma unroll 4
        for (int k = kb; k < kb + 128; ++k) { const float w = wm[(size_t)k * 6144 + n];
#pragma unroll
            for (int r = 0; r < 9; ++r) a[r] += act[r * 1024 + k] * w; }
#pragma unroll
        for (int r = 0; r < 9; ++r) red[(F.wave * 9 + r) * 64 + F.lane] = a[r];
        __syncthreads();
        for (int i = F.tid; i < 9 * 64; i += 512) { const int r = i >> 6, l = i & 63; float s = 0.f;
#pragma unroll
            for (int w = 0; w < 8; ++w) s += red[(w * 9 + r) * 64 + l];
            MOD[r * 6144 + F.bid * 64 + l] = s + F.in[I_BMOD][F.bid * 64 + l]; }
        __syncthreads();
    }
    LAS float* scr = (LAS float*)(F.lds + 48 * 1024) + F.wave * (64 * 33);
    const int gw = F.bid * 8 + F.wave, NGW = F.G * 8;
    constexpr int I_IN = 16 * (NIN / 32), I_SQ = 16 * 32, I_F1 = 16 * (FF / 32), I_F2 = 64 * 32, I_GU = 2 * 32;
    constexpr int NITEMS = I_IN + 3 * I_SQ + I_F1 + I_F2 + I_GU;
    for (int it = gw; it < NITEMS; it += NGW) {
        int r = it;
        if (r < I_IN) { transpose_item(F.in[I_WIN], NIN, (bf16_t*)(F.dob + DO_WIN), D, scr, r, F.lane); continue; } r -= I_IN;
        if (r < I_SQ) { transpose_item(F.in[I_PA], D, (bf16_t*)(F.dob + DO_PA), D, scr, r, F.lane); continue; } r -= I_SQ;
        if (r < I_SQ) { transpose_item(F.in[I_PB], D, (bf16_t*)(F.dob + DO_PB), D, scr, r, F.lane); continue; } r -= I_SQ;
        if (r < I_SQ) { transpose_item(F.in[I_WOUT], D, (bf16_t*)(F.dob + DO_WO), D, scr, r, F.lane); continue; } r -= I_SQ;
        if (r < I_F1) { transpose_item(F.in[I_FC1], FF, (bf16_t*)(F.dob + DO_FC1), D, scr, r, F.lane); continue; } r -= I_F1;
        if (r < I_F2) { transpose_item(F.in[I_FC2], D, (bf16_t*)(F.dob + DO_FC2), FF, scr, r, F.lane); continue; } r -= I_F2;
        transpose_item(F.in[I_GUP], D, (bf16_t*)(F.dob + DO_GUP), 256, scr, r, F.lane);
    }
    { bf16_t* gu = (bf16_t*)(F.dob + DO_GUP);
      for (int i = F.bid * 512 + F.tid; i < 1024 * 16; i += F.G * 512) { const int n = i >> 4, ch = i & 15; *(u32x4*)(gu + (size_t)n * 256 + 128 + ch * 8) = (u32x4){0u, 0u, 0u, 0u}; } }
}

__device__ __forceinline__ void modnorm_row(const float* xrow, const float* nw, const float* sh, const float* sc, bf16_t* orow, int lane) {
    f32x4 v[4]; float s = 0.f;
#pragma unroll
    for (int j = 0; j < 4; ++j) { v[j] = *(const f32x4*)(xrow + 4 * lane + 256 * j); s += (v[j].x * v[j].x + v[j].y * v[j].y) + (v[j].z * v[j].z + v[j].w * v[j].w); }
    const float rs = 1.0f / sqrtf(wave_sum(s) * (1.f / D) + RMS_EPS);
#pragma unroll
    for (int j = 0; j < 4; ++j) { const int c = 4 * lane + 256 * j;
        const f32x4 w = *(const f32x4*)(nw + c), a = *(const f32x4*)(sc + c), b = *(const f32x4*)(sh + c);
        const f32x4 y = (v[j] * rs * w) * (1.0f + a) + b;
        u32x2 o; o.x = pk2(y.x, y.y); o.y = pk2(y.z, y.w); *(u32x2*)(orow + c) = o; }
}

__device__ __forceinline__ void unpack8(const u32x4 w, float (&f)[8]) { f[0] = bflo(w.x); f[1] = bfhi(w.x); f[2] = bflo(w.y); f[3] = bfhi(w.y); f[4] = bflo(w.z); f[5] = bfhi(w.z); f[6] = bflo(w.w); f[7] = bfhi(w.w); }
__device__ __forceinline__ void p3_shift(const Frame& F) {
    const bf16_t* ZR = (const bf16_t*)(F.ws + WS_R1); bf16_t* ZS = (bf16_t*)(F.ws + WS_ZRS); bf16_t* XG = (bf16_t*)(F.ws + WS_XGS);
    const float* mu = F.in[I_MU];
    constexpr int CH = NZR / 8;
    const size_t total = (size_t)MR * CH;
    for (size_t i = (size_t)F.bid * 512 + F.tid; i < total; i += (size_t)F.G * 512) {
        const int row = (int)(i / CH), ch = (int)(i % CH), c0 = ch * 8;
        const bf16_t* p = ZR + (size_t)row * NZR + c0;
        float z[8], a[8], o[8];
        unpack8(*(const u32x4*)p, z);
        float m0[8], m1[8];
        { const f32x4 t0 = *(const f32x4*)(mu + c0), t1 = *(const f32x4*)(mu + c0 + 4); m0[0] = t0.x; m0[1] = t0.y; m0[2] = t0.z; m0[3] = t0.w; m0[4] = t1.x; m0[5] = t1.y; m0[6] = t1.z; m0[7] = t1.w; }
        { const f32x4 t0 = *(const f32x4*)(mu + NZR + c0), t1 = *(const f32x4*)(mu + NZR + c0 + 4); m1[0] = t0.x; m1[1] = t0.y; m1[2] = t0.z; m1[3] = t0.w; m1[4] = t1.x; m1[5] = t1.y; m1[6] = t1.z; m1[7] = t1.w; }
        if (row < ML) {
            const int t = row & (T - 1), gc = t & 63, gr = t >> 6;
            float m2[8], m3[8];
            { const f32x4 t0 = *(const f32x4*)(mu + 2 * NZR + c0), t1 = *(const f32x4*)(mu + 2 * NZR + c0 + 4); m2[0] = t0.x; m2[1] = t0.y; m2[2] = t0.z; m2[3] = t0.w; m2[4] = t1.x; m2[5] = t1.y; m2[6] = t1.z; m2[7] = t1.w; }
            { const f32x4 t0 = *(const f32x4*)(mu + 3 * NZR + c0), t1 = *(const f32x4*)(mu + 3 * NZR + c0 + 4); m3[0] = t0.x; m3[1] = t0.y; m3[2] = t0.z; m3[3] = t0.w; m3[4] = t1.x; m3[5] = t1.y; m3[6] = t1.z; m3[7] = t1.w; }
#pragma unroll
            for (int j = 0; j < 8; ++j) o[j] = z[j];
            if (gc > 0) unpack8(*(const u32x4*)(p - NZR), a); else {
#pragma unroll
                for (int j = 0; j < 8; ++j) a[j] = 0.f; }
#pragma unroll
            for (int j = 0; j < 8; ++j) o[j] += m0[j] * (a[j] - z[j]);
            if (gc < 63) unpack8(*(const u32x4*)(p + NZR), a); else {
#pragma unroll
                for (int j = 0; j < 8; ++j) a[j] = 0.f; }
#pragma unroll
            for (int j = 0; j < 8; ++j) o[j] += m1[j] * (a[j] - z[j]);
            if (gr > 0) unpack8(*(const u32x4*)(p - (size_t)64 * NZR), a); else {
#pragma unroll
                for (int j = 0; j < 8; ++j) a[j] = 0.f; }
#pragma unroll
            for (int j = 0; j < 8; ++j) o[j] += m2[j] * (a[j] - z[j]);
            if (gr < 63) unpack8(*(const u32x4*)(p + (size_t)64 * NZR), a); else {
#pragma unroll
                for (int j = 0; j < 8; ++j) a[j] = 0.f; }
#pragma unroll
            for (int j = 0; j < 8; ++j) o[j] += m3[j] * (a[j] - z[j]);
            if (c0 >= 3200) {
                u32x4 w; w.x = pk2(sigmoidf_(o[0]), sigmoidf_(o[1])); w.y = pk2(sigmoidf_(o[2]), sigmoidf_(o[3])); w.z = pk2(sigmoidf_(o[4]), sigmoidf_(o[5])); w.w = pk2(sigmoidf_(o[6]), sigmoidf_(o[7]));
                *(u32x4*)(XG + (size_t)row * 256 + (c0 - 3200)) = w;
                *(u32x4*)(XG + (size_t)row * 256 + 128 + (c0 - 3200)) = (u32x4){0u, 0u, 0u, 0u};
            }
        } else {
            const int tc = (row - ML) & (TC - 1);
#pragma unroll
            for (int j = 0; j < 8; ++j) o[j] = z[j];
            if (tc > 0) unpack8(*(const u32x4*)(p - NZR), a); else {
#pragma unroll
                for (int j = 0; j < 8; ++j) a[j] = 0.f; }
#pragma unroll
            for (int j = 0; j < 8; ++j) o[j] += m0[j] * (a[j] - z[j]);
            if (tc < TC - 1) unpack8(*(const u32x4*)(p + NZR), a); else {
#pragma unroll
                for (int j = 0; j < 8; ++j) a[j] = 0.f; }
#pragma unroll
            for (int j = 0; j < 8; ++j) o[j] += m1[j] * (a[j] - z[j]);
        }
        u32x4 w; w.x = pk2(o[0], o[1]); w.y = pk2(o[2], o[3]); w.z = pk2(o[4], o[5]); w.w = pk2(o[6], o[7]);
        *(u32x4*)(ZS + (size_t)row * NZR + c0) = w;
    }
}

constexpr int RC = 32;
__device__ __forceinline__ void p4_rwkv_scan(const Frame& F) {
    const bf16_t* ZS = (const bf16_t*)(F.ws + WS_ZRS);
    float* BON = (float*)(F.ws + WS_BON);
    LAS float* WUP = (LAS float*)F.lds;
    LAS float* AUP = WUP + 4096;
    LAS float* PRM = AUP + 4096;
    LAS float* TW = PRM + 512;
    LAS float* XA = TW + RC * 65;
    LAS float* SV = XA + RC * 65;
    LAS float* YB = SV + RC * 384;
    const int tid = F.tid, lane = F.lane, w8 = F.wave;
    for (int cid = F.bid; cid < 256; cid += F.G) {
        const int b = cid >> 5, h = (cid >> 1) & 15, d = cid & 1;
        bf16_t* Yd = (bf16_t*)(F.ws + (d ? WS_YB : WS_YF));
        __syncthreads();
        for (int i = tid; i < 4096; i += 512) { const int j = i >> 6, k = i & 63;
            WUP[i] = F.in[I_WUP][((size_t)(d * 64 + j)) * 1024 + h * 64 + k]; AUP[i] = F.in[I_AUP][((size_t)(d * 64 + j)) * 1024 + h * 64 + k]; }
        if (tid < 64) { PRM[tid] = F.in[I_W0][d * 1024 + h * 64 + tid]; PRM[64 + tid] = F.in[I_A0][d * 1024 + h * 64 + tid];
            PRM[128 + tid] = F.in[I_KK][h * 64 + tid]; PRM[192 + tid] = F.in[I_KA][h * 64 + tid]; PRM[256 + tid] = F.in[I_RK][h * 64 + tid]; }
        float S0[4] = {0.f, 0.f, 0.f, 0.f}, S1[4] = {0.f, 0.f, 0.f, 0.f};
        const int tl = tid >> 4, q16 = tid & 15;
        const int rp = lane >> 4, q = lane & 15, v0 = 8 * w8 + 2 * rp;
        const int sidx = d ? (RC - 1 - tl) : tl;
        int prev_row0 = -1;
        constexpr int NCH = (TC + T) / RC;
        for (int ci = 0; ci <= NCH; ++ci) {
            int row0 = 0; bool isctx = false;
            u32x2 gr_, gk_, gv_, gw_, ga_;
            if (ci < NCH) {
                isctx = ci < TC / RC; const int cj = isctx ? ci : ci - TC / RC, nch = isctx ? TC / RC : T / RC;
                const int pos = d ? (nch - 1 - cj) : cj;
                row0 = (isctx ? ML + b * TC : b * T) + pos * RC;
                const bf16_t* rp_ = ZS + (size_t)(row0 + tl) * NZR;
                gr_ = *(const u32x2*)(rp_ + h * 64 + 4 * q16); gk_ = *(const u32x2*)(rp_ + 1024 + h * 64 + 4 * q16); gv_ = *(const u32x2*)(rp_ + 2048 + h * 64 + 4 * q16);
                gw_ = *(const u32x2*)(rp_ + 3072 + 4 * q16); ga_ = *(const u32x2*)(rp_ + 3136 + 4 * q16);
                LAS float* tw = TW + tl * 65 + 4 * q16; LAS float* xa = XA + tl * 65 + 4 * q16;
                tw[0] = tanhf(bflo(gw_.x)); tw[1] = tanhf(bfhi(gw_.x)); tw[2] = tanhf(bflo(gw_.y)); tw[3] = tanhf(bfhi(gw_.y));
                xa[0] = bflo(ga_.x); xa[1] = bfhi(ga_.x); xa[2] = bflo(ga_.y); xa[3] = bfhi(ga_.y);
            }
            __syncthreads();
            if (prev_row0 >= 0) {
                const f32x4 y = *(const LAS f32x4*)(YB + sidx * 64 + 4 * q16);
                u32x2 o; o.x = pk2(y.x, y.y); o.y = pk2(y.z, y.w);
                *(u32x2*)(Yd + (size_t)(prev_row0 + tl) * D + h * 64 + 4 * q16) = o;
            }
            if (ci == NCH) break;
            {
                float zw[4], za[4];
#pragma unroll
                for (int i = 0; i < 4; ++i) { zw[i] = PRM[4 * q16 + i]; za[i] = PRM[64 + 4 * q16 + i]; }
#pragma unroll 8
                for (int j = 0; j < 64; ++j) { const float t = TW[tl * 65 + j], x = XA[tl * 65 + j];
                    const f32x4 wv = *(const LAS f32x4*)(WUP + j * 64 + 4 * q16), av = *(const LAS f32x4*)(AUP + j * 64 + 4 * q16);
                    zw[0] += t * wv.x; zw[1] += t * wv.y; zw[2] += t * wv.z; zw[3] += t * wv.w;
                    za[0] += x * av.x; za[1] += x * av.y; za[2] += x * av.z; za[3] += x * av.w; }
                const float kr[4] = {bflo(gk_.x), bfhi(gk_.x), bflo(gk_.y), bfhi(gk_.y)};
                const float rr[4] = {bflo(gr_.x), bfhi(gr_.x), bflo(gr_.y), bfhi(gr_.y)};
                const float vv[4] = {bflo(gv_.x), bfhi(gv_.x), bflo(gv_.y), bfhi(gv_.y)};
                float kkv[4], ss = 0.f;
#pragma unroll
                for (int i = 0; i < 4; ++i) { kkv[i] = kr[i] * PRM[128 + 4 * q16 + i]; ss += kkv[i] * kkv[i]; }
                ss = sum16(ss);
                const float inv = 1.0f / fmaxf(sqrtf(ss), 1e-12f);
                f32x4 okk, ow, ob, okd, orr, ov; float bon = 0.f;
#pragma unroll
                for (int i = 0; i < 4; ++i) {
                    const float kk = kkv[i] * inv;
                    const float sw = sigmoidf_(zw[i]);
                    const float dec = __expf(-0.6065306597126334f * sw);
                    const float a = sigmoidf_(za[i]);
                    const float kd = kr[i] * (1.0f + (a - 1.0f) * PRM[192 + 4 * q16 + i]);
                    bon += rr[i] * kd * PRM[256 + 4 * q16 + i];
                    okk[i] = kk; ow[i] = dec; ob[i] = kk * a; okd[i] = kd; orr[i] = rr[i]; ov[i] = vv[i];
                }
                bon = sum16(bon);
                if (!isctx && q16 == 0) BON[((size_t)d * ML + row0 + tl) * 16 + h] = bon;
                LAS float* sv = SV + sidx * 384 + 4 * q16;
                *(LAS f32x4*)(sv) = okk; *(LAS f32x4*)(sv + 64) = ow; *(LAS f32x4*)(sv + 128) = ob; *(LAS f32x4*)(sv + 192) = okd; *(LAS f32x4*)(sv + 256) = orr; *(LAS f32x4*)(sv + 320) = ov;
            }
            __syncthreads();
#pragma unroll 2
            for (int s = 0; s < RC; ++s) {
                const LAS float* base = SV + s * 384;
                const f32x4 kk4 = *(const LAS f32x4*)(base + 4 * q), w4 = *(const LAS f32x4*)(base + 64 + 4 * q), b4 = *(const LAS f32x4*)(base + 128 + 4 * q),
                            k4 = *(const LAS f32x4*)(base + 192 + 4 * q), r4 = *(const LAS f32x4*)(base + 256 + 4 * q);
                const f32x2 vv = *(const LAS f32x2*)(base + 320 + v0);
                float p0 = (S0[0] * kk4.x + S0[1] * kk4.y) + (S0[2] * kk4.z + S0[3] * kk4.w);
                float p1 = (S1[0] * kk4.x + S1[1] * kk4.y) + (S1[2] * kk4.z + S1[3] * kk4.w);
                p0 = sum16(p0); p1 = sum16(p1);
                const float sa0 = -p0, sa1 = -p1;
#pragma unroll
                for (int j = 0; j < 4; ++j) { S0[j] = S0[j] * w4[j] + (sa0 * b4[j] + vv.x * k4[j]); S1[j] = S1[j] * w4[j] + (sa1 * b4[j] + vv.y * k4[j]); }
                float y0 = (S0[0] * r4.x + S0[1] * r4.y) + (S0[2] * r4.z + S0[3] * r4.w);
                float y1 = (S1[0] * r4.x + S1[1] * r4.y) + (S1[2] * r4.z + S1[3] * r4.w);
                y0 = sum16(y0); y1 = sum16(y1);
                if (q == 0) *(LAS f32x2*)(YB + s * 64 + v0) = (f32x2){y0, y1};
            }
            prev_row0 = isctx ? -1 : row0;
        }
    }
}

__device__ __forceinline__ void p5_rwkv_norm(const Frame& F) {
    bf16_t* YF = (bf16_t*)(F.ws + WS_YF); const bf16_t* YBk = (const bf16_t*)(F.ws + WS_YB); const bf16_t* ZS = (const bf16_t*)(F.ws + WS_ZRS);
    const float* BON = (const float*)(F.ws + WS_BON);
    const float* lnw = F.in[I_LNW]; const float* lnb = F.in[I_LNB];
    const size_t total = (size_t)ML * 256;
    for (size_t i = (size_t)F.bid * 512 + F.tid; i < total; i += (size_t)F.G * 512) {
        const int row = (int)(i >> 8), c = ((int)i & 255) * 4, h = c >> 6;
        const u32x2 a = *(const u32x2*)(YF + (size_t)row * D + c), b = *(const u32x2*)(YBk + (size_t)row * D + c);
        float y[4] = {bflo(a.x) + bflo(b.x), bfhi(a.x) + bfhi(b.x), bflo(a.y) + bflo(b.y), bfhi(a.y) + bfhi(b.y)};
        const float mean = sum16((y[0] + y[1]) + (y[2] + y[3])) * (1.f / 64.f);
        float q = 0.f;
#pragma unroll
        for (int j = 0; j < 4; ++j) { y[j] -= mean; q += y[j] * y[j]; }
        const float rstd = 1.0f / sqrtf(sum16(q) * (1.f / 64.f) + GN_EPS);
        const float bon = BON[(size_t)row * 16 + h] + BON[((size_t)ML + row) * 16 + h];
        const u32x2 vw = *(const u32x2*)(ZS + (size_t)row * NZR + 2048 + c);
        const float v[4] = {bflo(vw.x), bfhi(vw.x), bflo(vw.y), bfhi(vw.y)};
        const f32x4 lw = *(const f32x4*)(lnw + c), lb = *(const f32x4*)(lnb + c);
        float o[4];
#pragma unroll
        for (int j = 0; j < 4; ++j) o[j] = y[j] * rstd * lw[j] + lb[j] + bon * v[j];
        u32x2 w; w.x = pk2(o[0], o[1]); w.y = pk2(o[2], o[3]);
        *(u32x2*)(YF + (size_t)row * D + c) = w;
    }
}

__device__ __forceinline__ void p8_hgrn_scan(const Frame& F) {
    const bf16_t* ZH = (const bf16_t*)(F.ws + WS_ZH);
    LAS float* SV = (LAS float*)F.lds;
    LAS float* OB = SV + RC * 448;
    const int tid = F.tid, lane = F.lane, w8 = F.wave;
    const float* hglb = F.in[I_HGLB];
    for (int cid = F.bid; cid < 256; cid += F.G) {
        const int b = cid >> 5, hh = (cid >> 2) & 7, d = (cid >> 1) & 1, vh = cid & 1;
        bf16_t* Od = (bf16_t*)(F.ws + (d ? WS_OB : WS_OF));
        float S[8][2];
#pragma unroll
        for (int j = 0; j < 8; ++j) { S[j][0] = 0.f; S[j][1] = 0.f; }
        const int tl = tid >> 4, c16 = tid & 15;
        const int sidx = d ? (RC - 1 - tl) : tl;
        const int ko = lane & 15, vp = w8 * 4 + (lane >> 4);
        float lbv[8];
#pragma unroll
        for (int j = 0; j < 8; ++j) { const int ch = hh * 128 + 8 * c16 + j; lbv[j] = sigmoidf_(hglb[ch] - hglb[1024 + ch]); }
        int prev_row0 = -1;
        constexpr int NCH = (TC + T) / RC;
        __syncthreads();
        for (int ci = 0; ci <= NCH; ++ci) {
            int row0 = 0; bool isctx = false;
            u32x4 gq, gf; u32x2 gi;
            if (ci < NCH) {
                isctx = ci < TC / RC; const int cj = isctx ? ci : ci - TC / RC, nch = isctx ? TC / RC : T / RC;
                const int pos = d ? (nch - 1 - cj) : cj;
                row0 = (isctx ? ML + b * TC : b * T) + pos * RC;
                const bf16_t* rp_ = ZH + (size_t)(row0 + tl) * NZH;
                gq = *(const u32x4*)(rp_ + hh * 128 + 8 * c16);
                gf = *(const u32x4*)(rp_ + (d ? 2048 : 1024) + hh * 128 + 8 * c16);
                gi = *(const u32x2*)(rp_ + 3072 + hh * 128 + vh * 64 + 4 * c16);
            }
            __syncthreads();
            if (prev_row0 >= 0) {
                const f32x4 y = *(const LAS f32x4*)(OB + sidx * 64 + 4 * c16);
                u32x2 o; o.x = pk2(y.x, y.y); o.y = pk2(y.z, y.w);
                *(u32x2*)(Od + (size_t)(prev_row0 + tl) * D + hh * 128 + vh * 64 + 4 * c16) = o;
            }
            if (ci == NCH) break;
            {
                float qv[8], fz[8]; unpack8(gq, qv); unpack8(gf, fz);
                LAS float* sv = SV + sidx * 448 + 8 * c16;
                f32x4 f0, f1, k0, k1;
#pragma unroll
                for (int j = 0; j < 4; ++j) { const float fa = lbv[j] + (1.0f - lbv[j]) * sigmoidf_(fz[j]), fb = lbv[4 + j] + (1.0f - lbv[4 + j]) * sigmoidf_(fz[4 + j]);
                    f0[j] = fa; f1[j] = fb; k0[j] = 1.0f - fa; k1[j] = 1.0f - fb; }
                *(LAS f32x4*)(sv) = f0; *(LAS f32x4*)(sv + 4) = f1; *(LAS f32x4*)(sv + 128) = k0; *(LAS f32x4*)(sv + 132) = k1;
                *(LAS f32x4*)(sv + 256) = (f32x4){qv[0], qv[1], qv[2], qv[3]}; *(LAS f32x4*)(sv + 260) = (f32x4){qv[4], qv[5], qv[6], qv[7]};
                *(LAS f32x4*)(SV + sidx * 448 + 384 + 4 * c16) = (f32x4){bflo(gi.x), bfhi(gi.x), bflo(gi.y), bfhi(gi.y)};
            }
            __syncthreads();
#pragma unroll 2
            for (int s = 0; s < RC; ++s) {
                const LAS float* base = SV + s * 448;
                const f32x4 fA = *(const LAS f32x4*)(base + 8 * ko), fB = *(const LAS f32x4*)(base + 8 * ko + 4);
                const f32x4 kA = *(const LAS f32x4*)(base + 128 + 8 * ko), kB = *(const LAS f32x4*)(base + 128 + 8 * ko + 4);
                const f32x4 qA = *(const LAS f32x4*)(base + 256 + 8 * ko), qB = *(const LAS f32x4*)(base + 256 + 8 * ko + 4);
                const f32x2 iv = *(const LAS f32x2*)(base + 384 + 2 * vp);
                float o0 = 0.f, o1 = 0.f;
#pragma unroll
                for (int j = 0; j < 4; ++j) {
                    S[j][0] = fA[j] * S[j][0] + kA[j] * iv.x; S[j][1] = fA[j] * S[j][1] + kA[j] * iv.y;
                    S[4 + j][0] = fB[j] * S[4 + j][0] + kB[j] * iv.x; S[4 + j][1] = fB[j] * S[4 + j][1] + kB[j] * iv.y;
                    o0 += S[j][0] * qA[j] + S[4 + j][0] * qB[j]; o1 += S[j][1] * qA[j] + S[4 + j][1] * qB[j];
                }
                o0 = sum16(o0); o1 = sum16(o1);
                if (ko == 0) *(LAS f32x2*)(OB + s * 64 + 2 * vp) = (f32x2){o0, o1};
            }
            prev_row0 = isctx ? -1 : row0;
        }
    }
}

__device__ __forceinline__ void p10_hgrn_read(const Frame& F) {
    bf16_t* OF = (bf16_t*)(F.ws + WS_OF); const bf16_t* OBk = (const bf16_t*)(F.ws + WS_OB); const bf16_t* ZG = (const bf16_t*)(F.ws + WS_ZG);
    const float* nw = F.in[I_HGNW];
    const size_t total = (size_t)ML * 256;
    for (size_t i = (size_t)F.bid * 512 + F.tid; i < total; i += (size_t)F.G * 512) {
        const int row = (int)(i >> 8), c = ((int)i & 255) * 4;
        const u32x2 a = *(const u32x2*)(OF + (size_t)row * D + c), b = *(const u32x2*)(OBk + (size_t)row * D + c);
        const float o[4] = {bflo(a.x) + bflo(b.x), bfhi(a.x) + bfhi(b.x), bflo(a.y) + bflo(b.y), bfhi(a.y) + bfhi(b.y)};
        const float ms = sum32((o[0] * o[0] + o[1] * o[1]) + (o[2] * o[2] + o[3] * o[3])) * (1.f / 128.f);
        const float rs = 1.0f / sqrtf(ms + RMS_EPS);
        const u32x2 gw = *(const u32x2*)(ZG + (size_t)row * NZG + c);
        const float g[4] = {bflo(gw.x), bfhi(gw.x), bflo(gw.y), bfhi(gw.y)};
        const f32x4 w = *(const f32x4*)(nw + c);
        float y[4];
#pragma unroll
        for (int j = 0; j < 4; ++j) y[j] = o[j] * rs * w[j] * (g[j] * sigmoidf_(g[j]));
        u32x2 ww; ww.x = pk2(y[0], y[1]); ww.y = pk2(y[2], y[3]);
        *(u32x2*)(OF + (size_t)row * D + c) = ww;
    }
}

template <bool COOP>
__device__ __forceinline__ void mk_body(const Args& args) {
    extern __shared__ __attribute__((aligned(16))) unsigned char lds_raw[];
    Frame F;
    F.lds = (LAS unsigned char*)lds_raw;
    F.tid = threadIdx.x; F.lane = F.tid & 63; F.wave = __builtin_amdgcn_readfirstlane(F.tid >> 6);
    F.G = gridDim.x; F.bid = blockIdx.x;
    F.in = args.in; F.ws = args.ws; F.dob = (unsigned char*)args.out;
    const int lo = args.ph_lo, hi = args.ph_hi;
    const float* MOD = (const float*)(F.ws + WS_MOD);
    const int gw = F.bid * 8 + F.wave, NGW = F.G * 8;
#define IN(k) (lo <= (k) && (k) < hi)
#define SEAM(k) do { if (COOP && IN(k) && IN((k) + 1)) cg::this_grid().sync(); } while (0)

    if (IN(0)) { p0_prologue(F); } SEAM(0);
    if (IN(1)) {
        bf16_t* H = (bf16_t*)(F.dob + DO_H);
        for (int m = gw; m < MR; m += NGW) {
            const bool lat = m < ML; const int b = lat ? (m >> 12) : 8;
            const float* xr = lat ? F.in[I_X] + (size_t)m * D : F.in[I_CTX] + (size_t)(m - ML) * D;
            modnorm_row(xr, F.in[I_N1W], MOD + b * 6144, MOD + b * 6144 + 1024, H + (size_t)m * D, F.lane);
        }
    } SEAM(1);
    if (IN(2)) {
        pg8::Sched S; S.init(F.dob + DO_H, F.dob + DO_WIN, nullptr, nullptr, MR, NZR, D, F.G, F.bid, 1);
        pg8::EpiBf16 E{(bf16_t*)(F.ws + WS_R1), NZR};
        pg8::gemm_phase(F.lds, D, S, E);
    } SEAM(2);
    if (IN(3)) { p3_shift(F); } SEAM(3);
    if (IN(4)) { p4_rwkv_scan(F); } SEAM(4);
    if (IN(5)) { p5_rwkv_norm(F); } SEAM(5);
    if (IN(6)) {
        pg8::Sched S; S.init(F.ws + WS_XGS, F.dob + DO_GUP, nullptr, nullptr, ML, D, 256, F.G, F.bid, 1);
        pg8::EpiMulBf16 E{(const bf16_t*)(F.ws + WS_YF), (bf16_t*)(F.ws + WS_YRW), D};
        pg8::gemm_phase(F.lds, 256, S, E);
    } SEAM(6);
    if (IN(7)) {
        pg8::Sched S; S.init(F.dob + DO_H, F.dob + DO_WIN + (size_t)NZR * D * 2, nullptr, nullptr, MR, NZH, D, F.G, F.bid, 1);
        pg8::EpiBf16 E{(bf16_t*)(F.ws + WS_ZH), NZH};
        pg8::gemm_phase(F.lds, D, S, E);
    } SEAM(7);
    if (IN(8)) { p8_hgrn_scan(F); } SEAM(8);
    if (IN(9)) {
        pg8::Sched S; S.init(F.dob + DO_H, F.dob + DO_WIN + (size_t)(NZR + NZH) * D * 2, nullptr, nullptr, ML, NZG, D, F.G, F.bid, 1);
        pg8::EpiBf16 E{(bf16_t*)(F.ws + WS_ZG), NZG};
        pg8::gemm_phase(F.lds, D, S, E);
    } SEAM(9);
    if (IN(10)) { p10_hgrn_read(F); } SEAM(10);
    if (IN(11)) {
        pg8::Sched S; S.init(F.ws + WS_YRW, F.dob + DO_PA, F.ws + WS_OF, F.dob + DO_PB, ML, D, D, F.G, F.bid, 2);
        pg8::EpiMerge E{(const bf16_t*)(F.ws + WS_ZG), (bf16_t*)(F.ws + WS_MRG)};
        pg8::gemm_phase(F.lds, D, S, E);
    } SEAM(11);
    if (IN(12)) {
        pg8::Sched S; S.init(F.ws + WS_MRG, F.dob + DO_WO, nullptr, nullptr, ML, D, D, F.G, F.bid, 1);
        pg8::EpiResid E{F.in[I_X], (float*)(F.ws + WS_X1), MOD + 2048};
        pg8::gemm_phase(F.lds, D, S, E);
    } SEAM(12);
    if (IN(13)) {
        const float* X1 = (const float*)(F.ws + WS_X1); bf16_t* H2 = (bf16_t*)(F.ws + WS_H2);
        for (int m = gw; m < ML; m += NGW) { const int b = m >> 12;
            modnorm_row(X1 + (size_t)m * D, F.in[I_N2W], MOD + b * 6144 + 3072, MOD + b * 6144 + 4096, H2 + (size_t)m * D, F.lane); }
    } SEAM(13);
    if (IN(14)) {
        pg8::Sched S; S.init(F.ws + WS_H2, F.dob + DO_FC1, nullptr, nullptr, ML, FF, D, F.G, F.bid, 1);
        pg8::EpiSqRelu E{(bf16_t*)(F.ws + WS_U), FF};
        pg8::gemm_phase(F.lds, D, S, E);
    } SEAM(14);
    if (IN(15)) {
        pg8::Sched S; S.init(F.ws + WS_U, F.dob + DO_FC2, nullptr, nullptr, ML, D, FF, F.G, F.bid, 1);
        pg8::EpiResid E{(const float*)(F.ws + WS_X1), (float*)(F.ws + WS_X1), MOD + 5120};
        pg8::gemm_phase(F.lds, FF, S, E);
    } SEAM(15);
    if (IN(16)) {
        const float* X2 = (const float*)(F.ws + WS_X1); const float* fw = F.in[I_FNW];
        for (int m = gw; m < ML; m += NGW) {
            const float* xr = X2 + (size_t)m * D; float* orow = args.out + (size_t)m * D;
            f32x4 v[4]; float s = 0.f;
#pragma unroll
            for (int j = 0; j < 4; ++j) { v[j] = *(const f32x4*)(xr + 4 * F.lane + 256 * j); s += (v[j].x * v[j].x + v[j].y * v[j].y) + (v[j].z * v[j].z + v[j].w * v[j].w); }
            const float rs = 1.0f / sqrtf(wave_sum(s) * (1.f / D) + RMS_EPS);
#pragma unroll
            for (int j = 0; j < 4; ++j) { const int c = 4 * F.lane + 256 * j; *(f32x4*)(orow + c) = v[j] * rs * *(const f32x4*)(fw + c); }
        }
    }
#undef IN
#undef SEAM
}

__global__ void __launch_bounds__(512, 2) mk_multi(Args args) { mk_body<false>(args); }
__global__ void __launch_bounds__(512, 2) mk_one(Args args) { mk_body<true>(args); }

extern "C" void kernel_launch(void* const* d_in, const int* in_sizes, int n_in, void* d_out, int out_size, void* d_ws, size_t ws_size, hipStream_t stream) {
    static int grid = 0;
    if (grid == 0) {
        if (n_in != 28 || out_size != ML * D || ws_size < WS_END) { fprintf(stderr, "kernel_launch: unexpected problem (n_in %d, out %d, ws %zu)\n", n_in, out_size, ws_size); grid = -1; return; }
        int dev = 0, cus = 0;
        if (hipGetDevice(&dev) != hipSuccess || hipDeviceGetAttribute(&cus, hipDeviceAttributeMultiprocessorCount, dev) != hipSuccess) { grid = -1; return; }
        (void)hipFuncSetAttribute((const void*)mk_multi, hipFuncAttributeMaxDynamicSharedMemorySize, LDS_BYTES);
        (void)hipFuncSetAttribute((const void*)mk_one, hipFuncAttributeMaxDynamicSharedMemorySize, LDS_BYTES);
        int per_cu = 0;
        (void)hipOccupancyMaxActiveBlocksPerMultiprocessor(&per_cu, (const void*)mk_one, 512, LDS_BYTES);
        (void)hipGetLastError();
        grid = cus;
        if (per_cu < 1) fprintf(stderr, "kernel_launch: occupancy query reports %d blocks per CU\n", per_cu);
    }
    if (grid < 0) return;
    Args a{};
    for (int i = 0; i < 28; ++i) a.in[i] = (const float*)d_in[i];
    a.out = (float*)d_out; a.ws = (unsigned char*)d_ws;
#if MK_ONE_LAUNCH
    a.ph_lo = 0; a.ph_hi = NPHASE;
    void* kargs[] = {&a};
    hipError_t e = hipLaunchCooperativeKernel((const void*)mk_one, dim3(grid), dim3(512), kargs, LDS_BYTES, stream);
    if (e != hipSuccess) fprintf(stderr, "cooperative launch failed: %s\n", hipGetErrorString(e));
#else
    for (int p = 0; p < NPHASE; ++p) { a.ph_lo = p; a.ph_hi = p + 1; hipLaunchKernelGGL(mk_multi, dim3(grid), dim3(512), LDS_BYTES, stream, a); }
#endif
}
```

```cpp
#include <hip/hip_runtime.h>
#include <hip/hip_cooperative_groups.h>
#include <cstdio>
#include <cstdint>
namespace cg = cooperative_groups;

#ifndef MK_ONE_LAUNCH
#define MK_ONE_LAUNCH 1
#endif
#ifndef MK_REPMASK
#define MK_REPMASK 0x0u
#endif

#define LAS __attribute__((address_space(3)))
typedef unsigned short bf16_t;
typedef short bf16x8 __attribute__((ext_vector_type(8)));
typedef float f32x4 __attribute__((ext_vector_type(4)));
typedef float f32x2 __attribute__((ext_vector_type(2)));
typedef unsigned u32x4 __attribute__((ext_vector_type(4)));
typedef unsigned u32x2 __attribute__((ext_vector_type(2)));

constexpr int D = 1024, NB = 8, T = 4096, TC = 256, GW = 64;
constexpr int ML = NB * T;
constexpr int MC = NB * TC;
constexpr int MR = ML + MC;
constexpr int NZR = 3328, NZH = 4096, NZG = 3072, NIN = 10496, FF = 4096;
constexpr float RMS_EPS = 1e-6f, GN_EPS = 64e-5f;

constexpr size_t MiB = 1u << 20;
constexpr size_t WS_CTL = 0, WS_MOD = 1 * MiB;
constexpr size_t WS_R1 = 2 * MiB;
constexpr size_t WS_YF = 2 * MiB, WS_YB = 66 * MiB, WS_YRW = 130 * MiB;
constexpr size_t WS_OF = 2 * MiB, WS_OB = 66 * MiB;
constexpr size_t WS_X1 = 2 * MiB;
constexpr size_t WS_H2 = 130 * MiB;
constexpr size_t WS_ZRS = 223 * MiB;
constexpr size_t WS_XGS = 444 * MiB;
constexpr size_t WS_BON = 460 * MiB;
constexpr size_t WS_ZH = 194 * MiB;
constexpr size_t WS_ZG = 194 * MiB;
constexpr size_t WS_MRG = 386 * MiB;
constexpr size_t WS_U = 194 * MiB;
constexpr size_t WS_END = 466 * MiB;
constexpr size_t DO_H = 0;
constexpr size_t DO_WIN = 68 * MiB;
constexpr size_t DO_PA = DO_WIN + (size_t)NIN * D * 2;
constexpr size_t DO_PB = DO_PA + 2 * MiB, DO_WO = DO_PB + 2 * MiB, DO_FC1 = DO_WO + 2 * MiB, DO_FC2 = DO_FC1 + 8 * MiB, DO_GUP = DO_FC2 + 8 * MiB;
constexpr size_t DO_END = DO_GUP + (size_t)1024 * 256 * 2;
static_assert(DO_END <= 128 * MiB, "d_out scratch overflow");

constexpr int LDS_BYTES = 152 * 1024;
constexpr int NPHASE = 17;

__device__ __forceinline__ unsigned f2bf(float f) { unsigned u = __builtin_bit_cast(unsigned, f); return (u + 0x7fffu + ((u >> 16) & 1u)) >> 16; }
__device__ __forceinline__ unsigned pk2(float lo, float hi) { return f2bf(lo) | (f2bf(hi) << 16); }
__device__ __forceinline__ float bflo(unsigned w) { return __builtin_bit_cast(float, w << 16); }
__device__ __forceinline__ float bfhi(unsigned w) { return __builtin_bit_cast(float, w & 0xffff0000u); }
__device__ __forceinline__ float sigmoidf_(float x) { return 1.0f / (1.0f + __expf(-x)); }
__device__ __forceinline__ float wave_sum(float v) {
#pragma unroll
    for (int o = 1; o < 64; o <<= 1) v += __shfl_xor(v, o);
    return v;
}
template <int CTRL> __device__ __forceinline__ float dpp_mov(float v) { return __builtin_bit_cast(float, __builtin_amdgcn_update_dpp(0, __builtin_bit_cast(int, v), CTRL, 0xf, 0xf, true)); }
__device__ __forceinline__ float sum16(float v) { v += dpp_mov<0xB1>(v); v += dpp_mov<0x4E>(v); v += dpp_mov<0x141>(v); v += dpp_mov<0x140>(v); return v; }
__device__ __forceinline__ float sum32(float v) { v = sum16(v); v += __shfl_xor(v, 16); return v; }

namespace pg8 {
constexpr int BM = 256, BK = 64, HALF = 128, HTB = HALF * BK * 2, STAGE_BYTES = 8 * HTB, NXCD = 8, WGM = 8;
__host__ __device__ __forceinline__ int lds_byte(int r, int c) { const int st = (r >> 4) * 2 + (c >> 5), rr = r & 15, cc = c & 31, ob = rr * 64 + cc * 2; return st * 1024 + (ob ^ (((ob >> 9) & 1) << 5)); }
__host__ __device__ __forceinline__ void stage_rc(int b, int& R, int& C) { const int st = b / 1024, sb = b % 1024, swz = sb ^ (((sb >> 9) & 1) << 5); R = (st >> 1) * 16 + swz / 64; C = (st & 1) * 32 + (swz % 64) / 2; }
__host__ __device__ __forceinline__ int perm32(int rho) { const int n = rho >> 4, i = rho & 15; return 8 * (i >> 2) + 4 * n + (i & 3); }

struct Unit { int pm, pn, sel; };
struct Sched {
    const char* A0; const char* B0; const char* A1; const char* B1;
    int nM, nN, nwg, G, c, nsel; size_t tstep;
    __device__ void init(const void* a0, const void* b0, const void* a1, const void* b1, int M, int N, int K, int G_, int c_, int nsel_) {
        A0 = (const char*)a0; B0 = (const char*)b0; A1 = (const char*)a1; B1 = (const char*)b1; nM = M / BM; nN = N / BM; nwg = nM * nN; G = G_; c = c_; nsel = nsel_; tstep = (size_t)BM * K * 2; }
    __device__ bool next(int i, Unit& u) const {
        const int j = (nsel == 2) ? (i >> 1) : i;
        const long L = (long)j * G + c; if (L >= nwg) return false;
        int wgid = (int)L; { const int q = nwg / NXCD, r = nwg % NXCD, xcd = wgid % NXCD, off = wgid / NXCD; wgid = (xcd < r ? xcd * (q + 1) : r * (q + 1) + (xcd - r) * q) + off; }
        const int nig = WGM * nN, gid = wgid / nig, fm = gid * WGM, gsz = (nM - fm) < WGM ? (nM - fm) : WGM;
        u.pm = fm + ((wgid % nig) % gsz); u.pn = (wgid % nig) / gsz; u.sel = (nsel == 2) ? (i & 1) : 0; return true;
    }
    __device__ __forceinline__ const char* abase(const Unit& u) const { return (u.sel ? A1 : A0) + (size_t)u.pm * tstep; }
    __device__ __forceinline__ const char* bbase(const Unit& u) const { return (u.sel ? B1 : B0) + (size_t)u.pn * tstep; }
};

template <class Epi>
__device__ __forceinline__ void gemm_phase(LAS unsigned char* lds, const int K, const Sched& S, const Epi& E) {
    const int tid = threadIdx.x, wid = __builtin_amdgcn_readfirstlane(tid >> 6), lane = tid & 63, wr = wid >> 2, wc = wid & 3, fr = lane & 15, fq = lane >> 4;
    const int nt = K / BK;
    unsigned voffA[2], voffB[2];
#pragma unroll
    for (int i = 0; i < 2; ++i) { int R, C; stage_rc(tid * 16 + i * 8192, R, C); const int Rb = Epi::PERM ? ((R & ~31) + perm32(R & 31)) : R;
        voffA[i] = (unsigned)(R * K + C) * 2u; voffB[i] = (unsigned)(Rb * K + C) * 2u; }
    const size_t kstep = (size_t)(BK * 2);
    const size_t hstep = (size_t)HALF * K * 2;
    const unsigned ldsw = (unsigned)wid * 1024u;
    const int aoff = lds_byte(wr * 64 + fr, fq * 8), boff = lds_byte(wc * 32 + fr, fq * 8);
#define PG8_SA(b, h) (((b) * 2 + (h)) * HTB)
#define PG8_SB(b, h) ((4 + (b) * 2 + (h)) * HTB)
#define PG8_STAGE(bufoff, gbase, voff) do { _Pragma("unroll") for (int _i = 0; _i < 2; ++_i) \
        __builtin_amdgcn_global_load_lds((const unsigned*)((const char*)(gbase) + (voff)[_i]), (LAS unsigned*)(lds + (bufoff) + ldsw + _i * 8192), 16, 0, 0); } while (0)
#define PG8_LDA(dst, b, h) do { _Pragma("unroll") for (int m = 0; m < 4; ++m) _Pragma("unroll") for (int k = 0; k < 2; ++k) dst[m][k] = *(const LAS bf16x8*)(lds + PG8_SA(b, h) + aoff + m * 2048 + k * 1024); } while (0)
#define PG8_LDB(dst, b, h) do { _Pragma("unroll") for (int n = 0; n < 2; ++n) _Pragma("unroll") for (int k = 0; k < 2; ++k) dst[n][k] = *(const LAS bf16x8*)(lds + PG8_SB(b, h) + boff + n * 2048 + k * 1024); } while (0)
#define PG8_MMA(ai, bj, At, Bt) do { __builtin_amdgcn_s_setprio(1); _Pragma("unroll") for (int m = 0; m < 4; ++m) _Pragma("unroll") for (int n = 0; n < 2; ++n) _Pragma("unroll") for (int k = 0; k < 2; ++k) \
        acc[ai][bj][m][n] = __builtin_amdgcn_mfma_f32_16x16x32_bf16(Bt[n][k], At[m][k], acc[ai][bj][m][n], 0, 0, 0); __builtin_amdgcn_s_setprio(0); } while (0)
#define PG8_WAIT_V(n) asm volatile("s_waitcnt vmcnt(" #n ")" ::: "memory")
#define PG8_WAIT_L(n) asm volatile("s_waitcnt lgkmcnt(" #n ")" ::: "memory")
#define PG8_BAR __builtin_amdgcn_s_barrier()
#define PG8_SCHED __builtin_amdgcn_sched_barrier(0)
    Unit cur, nxt; int ui = 0;
    if (!S.next(0, cur)) return;
    f32x4 acc[2][2][4][2];
#pragma unroll
    for (int a = 0; a < 2; ++a)
#pragma unroll
        for (int b = 0; b < 2; ++b)
#pragma unroll
            for (int m = 0; m < 4; ++m)
#pragma unroll
                for (int n = 0; n < 2; ++n) acc[a][b][m][n] = (f32x4){0.f, 0.f, 0.f, 0.f};
    bf16x8 At[4][2], B0[2][2], B1[2][2];
    const char* cA = S.abase(cur); const char* cB = S.bbase(cur);
    PG8_STAGE(PG8_SB(0, 0), cB, voffB); PG8_STAGE(PG8_SB(0, 1), cB + hstep, voffB); PG8_STAGE(PG8_SA(0, 0), cA, voffA); PG8_STAGE(PG8_SA(0, 1), cA + hstep, voffA);
    if (wr == 1) PG8_BAR;
    PG8_WAIT_V(2); PG8_BAR;
    PG8_STAGE(PG8_SB(1, 0), cB + kstep, voffB); PG8_STAGE(PG8_SA(1, 0), cA + kstep, voffA); PG8_STAGE(PG8_SB(1, 1), cB + hstep + kstep, voffB);
    PG8_WAIT_V(6); PG8_BAR;
    for (;;) {
        const bool has_next = S.next(ui + 1, nxt);
        const char* nA = has_next ? S.abase(nxt) : cA; const char* nB = has_next ? S.bbase(nxt) : cB;
        for (int t = 0; t < nt; t += 2) {
            const bool last = (t == nt - 2);
            const char* a1 = cA + (size_t)(t + 1) * kstep;
            const char* a2 = last ? nA : cA + (size_t)(t + 2) * kstep; const char* b2 = last ? nB : cB + (size_t)(t + 2) * kstep;
            const char* a3 = a2 + kstep; const char* b3 = b2 + kstep;
            PG8_LDB(B0, 0, 0); PG8_LDB(B1, 0, 1); PG8_SCHED; PG8_LDA(At, 0, 0); PG8_STAGE(PG8_SA(1, 1), a1 + hstep, voffA);
            PG8_WAIT_V(8); PG8_WAIT_L(0); PG8_BAR; PG8_MMA(0, 0, At, B0); PG8_MMA(0, 1, At, B1); PG8_BAR; PG8_SCHED;
            PG8_LDA(At, 0, 1); PG8_STAGE(PG8_SB(0, 0), b2, voffB); PG8_STAGE(PG8_SB(0, 1), b2 + hstep, voffB); PG8_STAGE(PG8_SA(0, 0), a2, voffA);
            PG8_WAIT_V(8); PG8_WAIT_L(0); PG8_BAR; PG8_MMA(1, 0, At, B0); PG8_MMA(1, 1, At, B1); PG8_BAR; PG8_SCHED;
            PG8_LDB(B0, 1, 0); PG8_LDB(B1, 1, 1); PG8_SCHED; PG8_LDA(At, 1, 0); PG8_STAGE(PG8_SA(0, 1), a2 + hstep, voffA);
            PG8_WAIT_V(8); PG8_WAIT_L(0); PG8_BAR; PG8_MMA(0, 0, At, B0); PG8_MMA(0, 1, At, B1); PG8_BAR; PG8_SCHED;
            PG8_LDA(At, 1, 1); PG8_STAGE(PG8_SB(1, 0), b3, voffB); PG8_STAGE(PG8_SB(1, 1), b3 + hstep, voffB); PG8_STAGE(PG8_SA(1, 0), a3, voffA);
            PG8_WAIT_V(8); PG8_WAIT_L(0); PG8_BAR; PG8_MMA(1, 0, At, B0); PG8_MMA(1, 1, At, B1); PG8_BAR; PG8_SCHED;
        }
        if (wr == 0) PG8_BAR;
        E(acc, cur, wr, wc, fr, fq);
        if (!has_next) break;
#pragma unroll
        for (int a = 0; a < 2; ++a)
#pragma unroll
            for (int b = 0; b < 2; ++b)
#pragma unroll
                for (int m = 0; m < 4; ++m)
#pragma unroll
                    for (int n = 0; n < 2; ++n) acc[a][b][m][n] = (f32x4){0.f, 0.f, 0.f, 0.f};
        cur = nxt; cA = nA; cB = nB; ++ui;
        if (wr == 1) PG8_BAR;
    }
    PG8_WAIT_V(0);
    PG8_BAR;
#undef PG8_SA
#undef PG8_SB
#undef PG8_STAGE
#undef PG8_LDA
#undef PG8_LDB
#undef PG8_MMA
#undef PG8_WAIT_V
#undef PG8_WAIT_L
#undef PG8_BAR
#undef PG8_SCHED
}

struct EpiBf16 {
    static constexpr bool PERM = true;
    bf16_t* O; int ldc;
    __device__ __forceinline__ void operator()(const f32x4 (&acc)[2][2][4][2], const Unit& u, int wr, int wc, int fr, int fq) const {
        const int row0 = u.pm * BM + wr * 64 + fr, col0 = u.pn * BM + wc * 32 + 8 * fq;
#pragma unroll
        for (int ai = 0; ai < 2; ++ai)
#pragma unroll
            for (int m = 0; m < 4; ++m) { bf16_t* rowp = O + (size_t)(row0 + ai * HALF + m * 16) * ldc + col0;
#pragma unroll
                for (int bj = 0; bj < 2; ++bj) { const f32x4 v0 = acc[ai][bj][m][0], v1 = acc[ai][bj][m][1];
                    u32x4 w; w.x = pk2(v0[0], v0[1]); w.y = pk2(v0[2], v0[3]); w.z = pk2(v1[0], v1[1]); w.w = pk2(v1[2], v1[3]);
                    *(u32x4*)(rowp + bj * HALF) = w; } }
    }
};
struct EpiSqRelu {
    static constexpr bool PERM = true;
    bf16_t* O; int ldc;
    __device__ __forceinline__ void operator()(const f32x4 (&acc)[2][2][4][2], const Unit& u, int wr, int wc, int fr, int fq) const {
        const int row0 = u.pm * BM + wr * 64 + fr, col0 = u.pn * BM + wc * 32 + 8 * fq;
#pragma unroll
        for (int ai = 0; ai < 2; ++ai)
#pragma unroll
            for (int m = 0; m < 4; ++m) { bf16_t* rowp = O + (size_t)(row0 + ai * HALF + m * 16) * ldc + col0;
#pragma unroll
                for (int bj = 0; bj < 2; ++bj) { f32x4 v0 = acc[ai][bj][m][0], v1 = acc[ai][bj][m][1];
#pragma unroll
                    for (int j = 0; j < 4; ++j) { const float a = fmaxf(v0[j], 0.f), b = fmaxf(v1[j], 0.f); v0[j] = a * a; v1[j] = b * b; }
                    u32x4 w; w.x = pk2(v0[0], v0[1]); w.y = pk2(v0[2], v0[3]); w.z = pk2(v1[0], v1[1]); w.w = pk2(v1[2], v1[3]);
                    *(u32x4*)(rowp + bj * HALF) = w; } }
    }
};
struct EpiMulBf16 {
    static constexpr bool PERM = true;
    const bf16_t* Y; bf16_t* O; int ldc;
    __device__ __forceinline__ void operator()(const f32x4 (&acc)[2][2][4][2], const Unit& u, int wr, int wc, int fr, int fq) const {
        const int row0 = u.pm * BM + wr * 64 + fr, col0 = u.pn * BM + wc * 32 + 8 * fq;
#pragma unroll
        for (int ai = 0; ai < 2; ++ai)
#pragma unroll
            for (int m = 0; m < 4; ++m) { const size_t off = (size_t)(row0 + ai * HALF + m * 16) * ldc + col0;
#pragma unroll
                for (int bj = 0; bj < 2; ++bj) { const f32x4 v0 = acc[ai][bj][m][0], v1 = acc[ai][bj][m][1];
                    const u32x4 y = *(const u32x4*)(Y + off + bj * HALF);
                    u32x4 w; w.x = pk2(v0[0] * bflo(y.x), v0[1] * bfhi(y.x)); w.y = pk2(v0[2] * bflo(y.y), v0[3] * bfhi(y.y));
                    w.z = pk2(v1[0] * bflo(y.z), v1[1] * bfhi(y.z)); w.w = pk2(v1[2] * bflo(y.w), v1[3] * bfhi(y.w));
                    *(u32x4*)(O + off + bj * HALF) = w; }
                asm volatile("" ::: "memory"); }
    }
};
struct EpiMerge {
    static constexpr bool PERM = true;
    const bf16_t* ZG; bf16_t* O;
    __device__ __forceinline__ void operator()(const f32x4 (&acc)[2][2][4][2], const Unit& u, int wr, int wc, int fr, int fq) const {
        const int row0 = u.pm * BM + wr * 64 + fr, col0 = u.pn * BM + wc * 32 + 8 * fq;
        const int goff = u.sel ? 2048 : 1024;
#pragma unroll
        for (int ai = 0; ai < 2; ++ai)
#pragma unroll
            for (int m = 0; m < 4; ++m) { const size_t r = (size_t)(row0 + ai * HALF + m * 16);
#pragma unroll
                for (int bj = 0; bj < 2; ++bj) { const f32x4 v0 = acc[ai][bj][m][0], v1 = acc[ai][bj][m][1];
                    const u32x4 g = *(const u32x4*)(ZG + r * NZG + goff + col0 + bj * HALF);
                    float o[8];
                    o[0] = v0[0] * sigmoidf_(bflo(g.x)); o[1] = v0[1] * sigmoidf_(bfhi(g.x)); o[2] = v0[2] * sigmoidf_(bflo(g.y)); o[3] = v0[3] * sigmoidf_(bfhi(g.y));
                    o[4] = v1[0] * sigmoidf_(bflo(g.z)); o[5] = v1[1] * sigmoidf_(bfhi(g.z)); o[6] = v1[2] * sigmoidf_(bflo(g.w)); o[7] = v1[3] * sigmoidf_(bfhi(g.w));
                    bf16_t* op = O + r * D + col0 + bj * HALF;
                    if (u.sel) { const u32x4 p = *(const u32x4*)op;
                        o[0] += bflo(p.x); o[1] += bfhi(p.x); o[2] += bflo(p.y); o[3] += bfhi(p.y); o[4] += bflo(p.z); o[5] += bfhi(p.z); o[6] += bflo(p.w); o[7] += bfhi(p.w); }
                    u32x4 w; w.x = pk2(o[0], o[1]); w.y = pk2(o[2], o[3]); w.z = pk2(o[4], o[5]); w.w = pk2(o[6], o[7]);
                    *(u32x4*)op = w; }
                asm volatile("" ::: "memory"); }
    }
};
struct EpiResid {
    static constexpr bool PERM = false;
    const float* base; float* out; const float* gate;
    __device__ __forceinline__ void operator()(const f32x4 (&acc)[2][2][4][2], const Unit& u, int wr, int wc, int fr, int fq) const {
        const int row0 = u.pm * BM + wr * 64 + fr, col0 = u.pn * BM + wc * 32 + 4 * fq;
        const float* gp = gate + (size_t)((u.pm * BM) / T) * 6144 + col0;
        f32x4 gv[2][2];
#pragma unroll
        for (int bj = 0; bj < 2; ++bj)
#pragma unroll
            for (int n = 0; n < 2; ++n) gv[bj][n] = *(const f32x4*)(gp + bj * HALF + n * 16);
#pragma unroll
        for (int ai = 0; ai < 2; ++ai)
#pragma unroll
            for (int m = 0; m < 4; ++m) { const size_t off = (size_t)(row0 + ai * HALF + m * 16) * D + col0;
#pragma unroll
                for (int bj = 0; bj < 2; ++bj)
#pragma unroll
                    for (int n = 0; n < 2; ++n) { const f32x4 bs = *(const f32x4*)(base + off + bj * HALF + n * 16);
                        *(f32x4*)(out + off + bj * HALF + n * 16) = bs + gv[bj][n] * acc[ai][bj][m][n]; }
                asm volatile("" ::: "memory"); }
    }
};
}

struct Args { const float* in[28]; float* out; unsigned char* ws; int ph_lo, ph_hi; };

struct Frame {
    LAS unsigned char* lds;
    int tid, lane, wave, G, bid;
    const float* const* in;
    unsigned char* ws; unsigned char* dob;
};
enum { I_X = 0, I_C, I_CTX, I_CCTX, I_N1W, I_N2W, I_WMOD, I_BMOD, I_WIN, I_MU, I_W0, I_WUP, I_A0, I_AUP, I_GUP, I_KK, I_KA, I_RK, I_LNW, I_LNB, I_HGLB, I_HGNW, I_PA, I_PB, I_WOUT, I_FC1, I_FC2, I_FNW };

__device__ __forceinline__ void transpose_item(const float* W, int N, bf16_t* WT, int ldk, LAS float* scr, int item, int lane) {
    const int nblk = N / 32, kb = item / nblk, nb = item % nblk, k0 = 64 * kb, n0 = 32 * nb;
#pragma unroll 8
    for (int i = 0; i < 32; ++i) { const int kk = 2 * i + (lane >> 5); scr[kk * 33 + (lane & 31)] = W[(size_t)(k0 + kk) * N + n0 + (lane & 31)]; }
    asm volatile("s_waitcnt lgkmcnt(0)" ::: "memory");
    const int c = lane & 7;
#pragma unroll
    for (int j = 0; j < 4; ++j) { const int n = (lane >> 3) + 8 * j; const LAS float* s = scr + (8 * c) * 33 + n;
        u32x4 o; o.x = pk2(s[0 * 33], s[1 * 33]); o.y = pk2(s[2 * 33], s[3 * 33]); o.z = pk2(s[4 * 33], s[5 * 33]); o.w = pk2(s[6 * 33], s[7 * 33]);
        *(u32x4*)(WT + (size_t)(n0 + n) * ldk + k0 + 8 * c) = o; }
    asm volatile("s_waitcnt lgkmcnt(0)" ::: "memory");
}

__device__ __forceinline__ void p0_prologue(const Frame& F) {
    float* MOD = (float*)(F.ws + WS_MOD);
    if (F.bid < 96) {
        LAS float* act = (LAS float*)F.lds;
        LAS float* red = act + 9 * 1024;
        for (int i = F.tid; i < 9 * 1024; i += 512) { const float v = (i < 8 * 1024) ? F.in[I_C][i] : F.in[I_CCTX][i - 8 * 1024]; act[i] = v * sigmoidf_(v); }
        __syncthreads();
        const float* wm = F.in[I_WMOD];
        const int n = F.bid * 64 + F.lane;
        float a[9];
#pragma unroll
        for (int r = 0; r < 9; ++r) a[r] = 0.f;
        const int kb = F.wave * 128;
#pragma unroll 4
        for (int k = kb; k < kb + 128; ++k) { const float w = wm[(size_t)k * 6144 + n];
#pragma unroll
            for (int r = 0; r < 9; ++r) a[r] += act[r * 1024 + k] * w; }
#pragma unroll
        for (int r = 0; r < 9; ++r) red[(F.wave * 9 + r) * 64 + F.lane] = a[r];
        __syncthreads();
        for (int i = F.tid; i < 9 * 64; i += 512) { const int r = i >> 6, l = i & 63; float s = 0.f;
#pragma unroll
            for (int w = 0; w < 8; ++w) s += red[(w * 9 + r) * 64 + l];
            MOD[r * 6144 + F.bid * 64 + l] = s + F.in[I_BMOD][F.bid * 64 + l]; }
        __syncthreads();
    }
    LAS float* scr = (LAS float*)(F.lds + 48 * 1024) + F.wave * (64 * 33);
    const int gw = F.bid * 8 + F.wave, NGW = F.G * 8;
    constexpr int I_IN = 16 * (NIN / 32), I_SQ = 16 * 32, I_F1 = 16 * (FF / 32), I_F2 = 64 * 32, I_GU = 2 * 32;
    constexpr int NITEMS = I_IN + 3 * I_SQ + I_F1 + I_F2 + I_GU;
    for (int it = gw; it < NITEMS; it += NGW) {
        int r = it;
        if (r < I_IN) { transpose_item(F.in[I_WIN], NIN, (bf16_t*)(F.dob + DO_WIN), D, scr, r, F.lane); continue; } r -= I_IN;
        if (r < I_SQ) { transpose_item(F.in[I_PA], D, (bf16_t*)(F.dob + DO_PA), D, scr, r, F.lane); continue; } r -= I_SQ;
        if (r < I_SQ) { transpose_item(F.in[I_PB], D, (bf16_t*)(F.dob + DO_PB), D, scr, r, F.lane); continue; } r -= I_SQ;
        if (r < I_SQ) { transpose_item(F.in[I_WOUT], D, (bf16_t*)(F.dob + DO_WO), D, scr, r, F.lane); continue; } r -= I_SQ;
        if (r < I_F1) { transpose_item(F.in[I_FC1], FF, (bf16_t*)(F.dob + DO_FC1), D, scr, r, F.lane); continue; } r -= I_F1;
        if (r < I_F2) { transpose_item(F.in[I_FC2], D, (bf16_t*)(F.dob + DO_FC2), FF, scr, r, F.lane); continue; } r -= I_F2;
        transpose_item(F.in[I_GUP], D, (bf16_t*)(F.dob + DO_GUP), 256, scr, r, F.lane);
    }
    { bf16_t* gu = (bf16_t*)(F.dob + DO_GUP);
      for (int i = F.bid * 512 + F.tid; i < 1024 * 16; i += F.G * 512) { const int n = i >> 4, ch = i & 15; *(u32x4*)(gu + (size_t)n * 256 + 128 + ch * 8) = (u32x4){0u, 0u, 0u, 0u}; } }
}

__device__ __forceinline__ void modnorm_row(const float* xrow, const float* nw, const float* sh, const float* sc, bf16_t* orow, int lane) {
    f32x4 v[4]; float s = 0.f;
#pragma unroll
    for (int j = 0; j < 4; ++j) { v[j] = *(const f32x4*)(xrow + 4 * lane + 256 * j); s += (v[j].x * v[j].x + v[j].y * v[j].y) + (v[j].z * v[j].z + v[j].w * v[j].w); }
    const float rs = 1.0f / sqrtf(wave_sum(s) * (1.f / D) + RMS_EPS);
#pragma unroll
    for (int j = 0; j < 4; ++j) { const int c = 4 * lane + 256 * j;
        const f32x4 w = *(const f32x4*)(nw + c), a = *(const f32x4*)(sc + c), b = *(const f32x4*)(sh + c);
        const f32x4 y = (v[j] * rs * w) * (1.0f + a) + b;
        u32x2 o; o.x = pk2(y.x, y.y); o.y = pk2(y.z, y.w); *(u32x2*)(orow + c) = o; }
}

__device__ __forceinline__ void unpack8(const u32x4 w, float (&f)[8]) { f[0] = bflo(w.x); f[1] = bfhi(w.x); f[2] = bflo(w.y); f[3] = bfhi(w.y); f[4] = bflo(w.z); f[5] = bfhi(w.z); f[6] = bflo(w.w); f[7] = bfhi(w.w); }
__device__ __forceinline__ void p3_shift(const Frame& F) {
    const bf16_t* ZR = (const bf16_t*)(F.ws + WS_R1); bf16_t* ZS = (bf16_t*)(F.ws + WS_ZRS); bf16_t* XG = (bf16_t*)(F.ws + WS_XGS);
    const float* mu = F.in[I_MU];
    constexpr int CH = NZR / 8;
    const size_t total = (size_t)MR * CH;
    for (size_t i = (size_t)F.bid * 512 + F.tid; i < total; i += (size_t)F.G * 512) {
        const int row = (int)(i / CH), ch = (int)(i % CH), c0 = ch * 8;
        const bf16_t* p = ZR + (size_t)row * NZR + c0;
        float z[8], a[8], o[8];
        unpack8(*(const u32x4*)p, z);
        float m0[8], m1[8];
        { const f32x4 t0 = *(const f32x4*)(mu + c0), t1 = *(const f32x4*)(mu + c0 + 4); m0[0] = t0.x; m0[1] = t0.y; m0[2] = t0.z; m0[3] = t0.w; m0[4] = t1.x; m0[5] = t1.y; m0[6] = t1.z; m0[7] = t1.w; }
        { const f32x4 t0 = *(const f32x4*)(mu + NZR + c0), t1 = *(const f32x4*)(mu + NZR + c0 + 4); m1[0] = t0.x; m1[1] = t0.y; m1[2] = t0.z; m1[3] = t0.w; m1[4] = t1.x; m1[5] = t1.y; m1[6] = t1.z; m1[7] = t1.w; }
        if (row < ML) {
            const int t = row & (T - 1), gc = t & 63, gr = t >> 6;
            float m2[8], m3[8];
            { const f32x4 t0 = *(const f32x4*)(mu + 2 * NZR + c0), t1 = *(const f32x4*)(mu + 2 * NZR + c0 + 4); m2[0] = t0.x; m2[1] = t0.y; m2[2] = t0.z; m2[3] = t0.w; m2[4] = t1.x; m2[5] = t1.y; m2[6] = t1.z; m2[7] = t1.w; }
            { const f32x4 t0 = *(const f32x4*)(mu + 3 * NZR + c0), t1 = *(const f32x4*)(mu + 3 * NZR + c0 + 4); m3[0] = t0.x; m3[1] = t0.y; m3[2] = t0.z; m3[3] = t0.w; m3[4] = t1.x; m3[5] = t1.y; m3[6] = t1.z; m3[7] = t1.w; }
#pragma unroll
            for (int j = 0; j < 8; ++j) o[j] = z[j];
            if (gc > 0) unpack8(*(const u32x4*)(p - NZR), a); else {
#pragma unroll
                for (int j = 0; j < 8; ++j) a[j] = 0.f; }
#pragma unroll
            for (int j = 0; j < 8; ++j) o[j] += m0[j] * (a[j] - z[j]);
            if (gc < 63) unpack8(*(const u32x4*)(p + NZR), a); else {
#pragma unroll
                for (int j = 0; j < 8; ++j) a[j] = 0.f; }
#pragma unroll
            for (int j = 0; j < 8; ++j) o[j] += m1[j] * (a[j] - z[j]);
            if (gr > 0) unpack8(*(const u32x4*)(p - (size_t)64 * NZR), a); else {
#pragma unroll
                for (int j = 0; j < 8; ++j) a[j] = 0.f; }
#pragma unroll
            for (int j = 0; j < 8; ++j) o[j] += m2[j] * (a[j] - z[j]);
            if (gr < 63) unpack8(*(const u32x4*)(p + (size_t)64 * NZR), a); else {
#pragma unroll
                for (int j = 0; j < 8; ++j) a[j] = 0.f; }
#pragma unroll
            for (int j = 0; j < 8; ++j) o[j] += m3[j] * (a[j] - z[j]);
            if (c0 >= 3200) {
                u32x4 w; w.x = pk2(sigmoidf_(o[0]), sigmoidf_(o[1])); w.y = pk2(sigmoidf_(o[2]), sigmoidf_(o[3])); w.z = pk2(sigmoidf_(o[4]), sigmoidf_(o[5])); w.w = pk2(sigmoidf_(o[6]), sigmoidf_(o[7]));
                *(u32x4*)(XG + (size_t)row * 256 + (c0 - 3200)) = w;
                *(u32x4*)(XG + (size_t)row * 256 + 128 + (c0 - 3200)) = (u32x4){0u, 0u, 0u, 0u};
            }
        } else {
            const int tc = (row - ML) & (TC - 1);
#pragma unroll
            for (int j = 0; j < 8; ++j) o[j] = z[j];
            if (tc > 0) unpack8(*(const u32x4*)(p - NZR), a); else {
#pragma unroll
                for (int j = 0; j < 8; ++j) a[j] = 0.f; }
#pragma unroll
            for (int j = 0; j < 8; ++j) o[j] += m0[j] * (a[j] - z[j]);
            if (tc < TC - 1) unpack8(*(const u32x4*)(p + NZR), a); else {
#pragma unroll
                for (int j = 0; j < 8; ++j) a[j] = 0.f; }
#pragma unroll
            for (int j = 0; j < 8; ++j) o[j] += m1[j] * (a[j] - z[j]);
        }
        u32x4 w; w.x = pk2(o[0], o[1]); w.y = pk2(o[2], o[3]); w.z = pk2(o[4], o[5]); w.w = pk2(o[6], o[7]);
        *(u32x4*)(ZS + (size_t)row * NZR + c0) = w;
    }
}

constexpr int RC = 32;
__device__ __forceinline__ void p4_rwkv_scan(const Frame& F) {
    const bf16_t* ZS = (const bf16_t*)(F.ws + WS_ZRS);
    float* BON = (float*)(F.ws + WS_BON);
    LAS float* WUP = (LAS float*)F.lds;
    LAS float* AUP = WUP + 4096;
    LAS float* PRM = AUP + 4096;
    LAS float* TW = PRM + 512;
    LAS float* XA = TW + RC * 65;
    LAS float* SV = XA + RC * 65;
    LAS float* YB = SV + RC * 384;
    const int tid = F.tid, lane = F.lane, w8 = F.wave;
    for (int cid = F.bid; cid < 256; cid += F.G) {
        const int b = cid >> 5, h = (cid >> 1) & 15, d = cid & 1;
        bf16_t* Yd = (bf16_t*)(F.ws + (d ? WS_YB : WS_YF));
        __syncthreads();
        for (int i = tid; i < 4096; i += 512) { const int j = i >> 6, k = i & 63;
            WUP[i] = F.in[I_WUP][((size_t)(d * 64 + j)) * 1024 + h * 64 + k]; AUP[i] = F.in[I_AUP][((size_t)(d * 64 + j)) * 1024 + h * 64 + k]; }
        if (tid < 64) { PRM[tid] = F.in[I_W0][d * 1024 + h * 64 + tid]; PRM[64 + tid] = F.in[I_A0][d * 1024 + h * 64 + tid];
            PRM[128 + tid] = F.in[I_KK][h * 64 + tid]; PRM[192 + tid] = F.in[I_KA][h * 64 + tid]; PRM[256 + tid] = F.in[I_RK][h * 64 + tid]; }
        float S0[4] = {0.f, 0.f, 0.f, 0.f}, S1[4] = {0.f, 0.f, 0.f, 0.f};
        const int tl = tid >> 4, q16 = tid & 15;
        const int rp = lane >> 4, q = lane & 15, v0 = 8 * w8 + 2 * rp;
        const int sidx = d ? (RC - 1 - tl) : tl;
        int prev_row0 = -1;
        constexpr int NCH = (TC + T) / RC;
        for (int ci = 0; ci <= NCH; ++ci) {
            int row0 = 0; bool isctx = false;
            u32x2 gr_, gk_, gv_, gw_, ga_;
            if (ci < NCH) {
                isctx = ci < TC / RC; const int cj = isctx ? ci : ci - TC / RC, nch = isctx ? TC / RC : T / RC;
                const int pos = d ? (nch - 1 - cj) : cj;
                row0 = (isctx ? ML + b * TC : b * T) + pos * RC;
                const bf16_t* rp_ = ZS + (size_t)(row0 + tl) * NZR;
                gr_ = *(const u32x2*)(rp_ + h * 64 + 4 * q16); gk_ = *(const u32x2*)(rp_ + 1024 + h * 64 + 4 * q16); gv_ = *(const u32x2*)(rp_ + 2048 + h * 64 + 4 * q16);
                gw_ = *(const u32x2*)(rp_ + 3072 + 4 * q16); ga_ = *(const u32x2*)(rp_ + 3136 + 4 * q16);
                LAS float* tw = TW + tl * 65 + 4 * q16; LAS float* xa = XA + tl * 65 + 4 * q16;
                tw[0] = tanhf(bflo(gw_.x)); tw[1] = tanhf(bfhi(gw_.x)); tw[2] = tanhf(bflo(gw_.y)); tw[3] = tanhf(bfhi(gw_.y));
                xa[0] = bflo(ga_.x); xa[1] = bfhi(ga_.x); xa[2] = bflo(ga_.y); xa[3] = bfhi(ga_.y);
            }
            __syncthreads();
            if (prev_row0 >= 0) {
                const f32x4 y = *(const LAS f32x4*)(YB + sidx * 64 + 4 * q16);
                u32x2 o; o.x = pk2(y.x, y.y); o.y = pk2(y.z, y.w);
                *(u32x2*)(Yd + (size_t)(prev_row0 + tl) * D + h * 64 + 4 * q16) = o;
            }
            if (ci == NCH) break;
            {
                float zw[4], za[4];
#pragma unroll
                for (int i = 0; i < 4; ++i) { zw[i] = PRM[4 * q16 + i]; za[i] = PRM[64 + 4 * q16 + i]; }
#pragma unroll 8
                for (int j = 0; j < 64; ++j) { const float t = TW[tl * 65 + j], x = XA[tl * 65 + j];
                    const f32x4 wv = *(const LAS f32x4*)(WUP + j * 64 + 4 * q16), av = *(const LAS f32x4*)(AUP + j * 64 + 4 * q16);
                    zw[0] += t * wv.x; zw[1] += t * wv.y; zw[2] += t * wv.z; zw[3] += t * wv.w;
                    za[0] += x * av.x; za[1] += x * av.y; za[2] += x * av.z; za[3] += x * av.w; }
                const float kr[4] = {bflo(gk_.x), bfhi(gk_.x), bflo(gk_.y), bfhi(gk_.y)};
                const float rr[4] = {bflo(gr_.x), bfhi(gr_.x), bflo(gr_.y), bfhi(gr_.y)};
                const float vv[4] = {bflo(gv_.x), bfhi(gv_.x), bflo(gv_.y), bfhi(gv_.y)};
                float kkv[4], ss = 0.f;
#pragma unroll
                for (int i = 0; i < 4; ++i) { kkv[i] = kr[i] * PRM[128 + 4 * q16 + i]; ss += kkv[i] * kkv[i]; }
                ss = sum16(ss);
                const float inv = 1.0f / fmaxf(sqrtf(ss), 1e-12f);
                f32x4 okk, ow, ob, okd, orr, ov; float bon = 0.f;
#pragma unroll
                for (int i = 0; i < 4; ++i) {
                    const float kk = kkv[i] * inv;
                    const float sw = sigmoidf_(zw[i]);
                    const float dec = __expf(-0.6065306597126334f * sw);
                    const float a = sigmoidf_(za[i]);
                    const float kd = kr[i] * (1.0f + (a - 1.0f) * PRM[192 + 4 * q16 + i]);
                    bon += rr[i] * kd * PRM[256 + 4 * q16 + i];
                    okk[i] = kk; ow[i] = dec; ob[i] = kk * a; okd[i] = kd; orr[i] = rr[i]; ov[i] = vv[i];
                }
                bon = sum16(bon);
                if (!isctx && q16 == 0) BON[((size_t)d * ML + row0 + tl) * 16 + h] = bon;
                LAS float* sv = SV + sidx * 384 + 4 * q16;
                *(LAS f32x4*)(sv) = okk; *(LAS f32x4*)(sv + 64) = ow; *(LAS f32x4*)(sv + 128) = ob; *(LAS f32x4*)(sv + 192) = okd; *(LAS f32x4*)(sv + 256) = orr; *(LAS f32x4*)(sv + 320) = ov;
            }
            __syncthreads();
#pragma unroll 2
            for (int s = 0; s < RC; ++s) {
                const LAS float* base = SV + s * 384;
                const f32x4 kk4 = *(const LAS f32x4*)(base + 4 * q), w4 = *(const LAS f32x4*)(base + 64 + 4 * q), b4 = *(const LAS f32x4*)(base + 128 + 4 * q),
                            k4 = *(const LAS f32x4*)(base + 192 + 4 * q), r4 = *(const LAS f32x4*)(base + 256 + 4 * q);
                const f32x2 vv = *(const LAS f32x2*)(base + 320 + v0);
                float p0 = (S0[0] * kk4.x + S0[1] * kk4.y) + (S0[2] * kk4.z + S0[3] * kk4.w);
                float p1 = (S1[0] * kk4.x + S1[1] * kk4.y) + (S1[2] * kk4.z + S1[3] * kk4.w);
                p0 = sum16(p0); p1 = sum16(p1);
                const float sa0 = -p0, sa1 = -p1;
#pragma unroll
                for (int j = 0; j < 4; ++j) { S0[j] = S0[j] * w4[j] + (sa0 * b4[j] + vv.x * k4[j]); S1[j] = S1[j] * w4[j] + (sa1 * b4[j] + vv.y * k4[j]); }
                float y0 = (S0[0] * r4.x + S0[1] * r4.y) + (S0[2] * r4.z + S0[3] * r4.w);
                float y1 = (S1[0] * r4.x + S1[1] * r4.y) + (S1[2] * r4.z + S1[3] * r4.w);
                y0 = sum16(y0); y1 = sum16(y1);
                if (q == 0) *(LAS f32x2*)(YB + s * 64 + v0) = (f32x2){y0, y1};
            }
            prev_row0 = isctx ? -1 : row0;
        }
    }
}

__device__ __forceinline__ void p5_rwkv_norm(const Frame& F) {
    bf16_t* YF = (bf16_t*)(F.ws + WS_YF); const bf16_t* YBk = (const bf16_t*)(F.ws + WS_YB); const bf16_t* ZS = (const bf16_t*)(F.ws + WS_ZRS);
    const float* BON = (const float*)(F.ws + WS_BON);
    const float* lnw = F.in[I_LNW]; const float* lnb = F.in[I_LNB];
    const size_t total = (size_t)ML * 256;
    for (size_t i = (size_t)F.bid * 512 + F.tid; i < total; i += (size_t)F.G * 512) {
        const int row = (int)(i >> 8), c = ((int)i & 255) * 4, h = c >> 6;
        const u32x2 a = *(const u32x2*)(YF + (size_t)row * D + c), b = *(const u32x2*)(YBk + (size_t)row * D + c);
        float y[4] = {bflo(a.x) + bflo(b.x), bfhi(a.x) + bfhi(b.x), bflo(a.y) + bflo(b.y), bfhi(a.y) + bfhi(b.y)};
        const float mean = sum16((y[0] + y[1]) + (y[2] + y[3])) * (1.f / 64.f);
        float q = 0.f;
#pragma unroll
        for (int j = 0; j < 4; ++j) { y[j] -= mean; q += y[j] * y[j]; }
        const float rstd = 1.0f / sqrtf(sum16(q) * (1.f / 64.f) + GN_EPS);
        const float bon = BON[(size_t)row * 16 + h] + BON[((size_t)ML + row) * 16 + h];
        const u32x2 vw = *(const u32x2*)(ZS + (size_t)row * NZR + 2048 + c);
        const float v[4] = {bflo(vw.x), bfhi(vw.x), bflo(vw.y), bfhi(vw.y)};
        const f32x4 lw = *(const f32x4*)(lnw + c), lb = *(const f32x4*)(lnb + c);
        float o[4];
#pragma unroll
        for (int j = 0; j < 4; ++j) o[j] = y[j] * rstd * lw[j] + lb[j] + bon * v[j];
        u32x2 w; w.x = pk2(o[0], o[1]); w.y = pk2(o[2], o[3]);
        *(u32x2*)(YF + (size_t)row * D + c) = w;
    }
}

constexpr int HC = 64;
constexpr int H_RAWQ = 0, H_RAWF = 16384, H_RAWI = 32768;
constexpr int H_PL = 0;
constexpr int H_TOT = 40960;
constexpr int H_DEC = H_TOT + 2048;
constexpr int H_QIN = H_DEC + 1024, H_KIN = H_QIN + 17408, H_QB = H_KIN + 17408;
constexpr int H_KINT = H_QB + 17408;
constexpr int H_VT = H_KINT + 18432;
constexpr int H_ST = H_VT + 9216;
constexpr int H_OL = H_ST + 17408;
constexpr int H_END = H_OL + 9216;
static_assert(H_END <= LDS_BYTES, "HGRN2 LDS overflow");
__device__ __forceinline__ void p8_hgrn_scan(const Frame& F) {
    const bf16_t* ZH = (const bf16_t*)(F.ws + WS_ZH);
    LAS unsigned char* L = F.lds;
    const int tid = F.tid, lane = F.lane, w8 = F.wave;
    const float* hglb = F.in[I_HGLB];
    const int fr = lane & 15, fq = lane >> 4;
    for (int cid = F.bid; cid < 256; cid += F.G) {
        const int b = cid >> 5, hh = (cid >> 2) & 7, d = (cid >> 1) & 1, vh = cid & 1;
        bf16_t* Od = (bf16_t*)(F.ws + (d ? WS_OB : WS_OF));
        const int k1 = tid & 127, seg = tid >> 7;
        const float lbk = sigmoidf_(hglb[hh * 128 + k1] - hglb[1024 + hh * 128 + k1]);
        f32x4 Sreg[4];
#pragma unroll
        for (int i = 0; i < 4; ++i) Sreg[i] = (f32x4){0.f, 0.f, 0.f, 0.f};
        __syncthreads();
        for (int i = tid; i < 17408 / 4; i += 512) ((LAS unsigned*)(L + H_ST))[i] = 0u;
        constexpr int NCH = (TC + T) / HC;
        u32x4 pq0, pq1, pf0, pf1, pi0;
        auto chunk_row0 = [&](int ci) { const bool isctx = ci < TC / HC; const int cj = isctx ? ci : ci - TC / HC, nch = isctx ? TC / HC : T / HC;
            const int pos = d ? (nch - 1 - cj) : cj; return (isctx ? ML + b * TC : b * T) + pos * HC; };
#define H_PREFETCH(ci_) do { const int r0_ = chunk_row0(ci_); \
            { const int st = tid >> 4, kc = tid & 15; const bf16_t* g0 = ZH + (size_t)(r0_ + (d ? HC - 1 - st : st)) * NZH + hh * 128 + 8 * kc; \
              const bf16_t* g1 = ZH + (size_t)(r0_ + (d ? HC - 1 - (st + 32) : (st + 32))) * NZH + hh * 128 + 8 * kc; \
              pq0 = *(const u32x4*)g0; pq1 = *(const u32x4*)g1; pf0 = *(const u32x4*)(g0 + (d ? 2048 : 1024)); pf1 = *(const u32x4*)(g1 + (d ? 2048 : 1024)); } \
            { const int st = tid >> 3, vc = tid & 7; pi0 = *(const u32x4*)(ZH + (size_t)(r0_ + (d ? HC - 1 - st : st)) * NZH + 3072 + hh * 128 + vh * 64 + 8 * vc); } } while (0)
        H_PREFETCH(0);
        for (int ci = 0; ci < NCH; ++ci) {
            const bool isctx = ci < TC / HC;
            const int row0 = chunk_row0(ci);
            { const int st = tid >> 4, kc = tid & 15;
              *(LAS u32x4*)(L + H_RAWQ + (st * 128 + 8 * kc) * 2) = pq0; *(LAS u32x4*)(L + H_RAWQ + ((st + 32) * 128 + 8 * kc) * 2) = pq1;
              *(LAS u32x4*)(L + H_RAWF + (st * 128 + 8 * kc) * 2) = pf0; *(LAS u32x4*)(L + H_RAWF + ((st + 32) * 128 + 8 * kc) * 2) = pf1; }
            { const int st = tid >> 3, vc = tid & 7; *(LAS u32x4*)(L + H_RAWI + (st * 64 + 8 * vc) * 2) = pi0; }
            if (ci + 1 < NCH) H_PREFETCH(ci + 1);
            __syncthreads();
            float cc[16], kfv[16], qv[16];
            { float c = 0.f;
#pragma unroll
              for (int j = 0; j < 16; ++j) { const int st = 16 * seg + j;
                  const float fz = __builtin_bit_cast(float, (unsigned)(*(const LAS bf16_t*)(L + H_RAWF + (st * 128 + k1) * 2)) << 16);
                  qv[j] = __builtin_bit_cast(float, (unsigned)(*(const LAS bf16_t*)(L + H_RAWQ + (st * 128 + k1) * 2)) << 16);
                  const float f = lbk + (1.0f - lbk) * sigmoidf_(fz);
                  c += __logf(f); cc[j] = c; kfv[j] = 1.0f - f; }
              ((LAS float*)(L + H_TOT))[seg * 128 + k1] = c; }
            __syncthreads();
            { const LAS float* TOT = (const LAS float*)(L + H_TOT);
              const float t0 = TOT[k1], t1 = TOT[128 + k1], t2 = TOT[256 + k1], t3 = TOT[384 + k1];
              const float off = (seg > 0 ? t0 : 0.f) + (seg > 1 ? t1 : 0.f) + (seg > 2 ? t2 : 0.f);
              const float bref = t0 + t1, blast = (t0 + t1) + (t2 + t3);
              unsigned kp[8];
#pragma unroll
              for (int j = 0; j < 16; ++j) { const int st = 16 * seg + j; const float bb = cc[j] + off;
                  const float eq = __expf(bb - bref), ek = __expf(bref - bb), eb = __expf(bb);
                  const unsigned qin = f2bf(qv[j] * eq), kin = f2bf(kfv[j] * ek), qb = f2bf(qv[j] * eb);
                  *(LAS bf16_t*)(L + H_QIN + (st * 136 + k1) * 2) = (bf16_t)qin; *(LAS bf16_t*)(L + H_KIN + (st * 136 + k1) * 2) = (bf16_t)kin; *(LAS bf16_t*)(L + H_QB + (st * 136 + k1) * 2) = (bf16_t)qb;
                  if (j & 1) kp[j >> 1] |= kin << 16; else kp[j >> 1] = kin; }
              *(LAS u32x4*)(L + H_KINT + (k1 * 72 + 16 * seg) * 2) = (u32x4){kp[0], kp[1], kp[2], kp[3]};
              *(LAS u32x4*)(L + H_KINT + (k1 * 72 + 16 * seg + 8) * 2) = (u32x4){kp[4], kp[5], kp[6], kp[7]};
              if (seg == 0) { ((LAS float*)(L + H_DEC))[k1] = __expf(blast); ((LAS float*)(L + H_DEC))[128 + k1] = __expf(blast - bref); } }
            { const int v = tid & 63, s8 = tid >> 6; unsigned vp[4];
#pragma unroll
              for (int j = 0; j < 8; ++j) { const unsigned x = *(const LAS bf16_t*)(L + H_RAWI + ((8 * s8 + j) * 64 + v) * 2); if (j & 1) vp[j >> 1] |= x << 16; else vp[j >> 1] = x; }
              *(LAS u32x4*)(L + H_VT + (v * 72 + 8 * s8) * 2) = (u32x4){vp[0], vp[1], vp[2], vp[3]}; }
            __syncthreads();
            if (!isctx) {
                const int tt = w8 >> 1;
#pragma unroll
                for (int u = 0; u < 2; ++u) { const int stl = 2 * (w8 & 1) + u; f32x4 acc = (f32x4){0.f, 0.f, 0.f, 0.f};
                    if (stl <= tt) {
#pragma unroll
                        for (int ks = 0; ks < 4; ++ks) { const bf16x8 a = *(const LAS bf16x8*)(L + H_QIN + ((16 * tt + fr) * 136 + 32 * ks + 8 * fq) * 2);
                            const bf16x8 bq = *(const LAS bf16x8*)(L + H_KIN + ((16 * stl + fr) * 136 + 32 * ks + 8 * fq) * 2);
                            acc = __builtin_amdgcn_mfma_f32_16x16x32_bf16(a, bq, acc, 0, 0, 0); } }
#pragma unroll
                    for (int r = 0; r < 4; ++r) { const int t = 16 * tt + 4 * fq + r, s = 16 * stl + fr; const float pv = (s <= t && stl <= tt) ? acc[r] : 0.f;
                        *(LAS bf16_t*)(L + H_PL + (t * 72 + s) * 2) = (bf16_t)f2bf(pv); } }
            }
            __syncthreads();
            if (!isctx) {
                const int tt = w8 >> 1;
#pragma unroll
                for (int u = 0; u < 2; ++u) { const int vt = 2 * (w8 & 1) + u; f32x4 acc = (f32x4){0.f, 0.f, 0.f, 0.f};
#pragma unroll
                    for (int ks = 0; ks < 2; ++ks) { const bf16x8 a = *(const LAS bf16x8*)(L + H_PL + ((16 * tt + fr) * 72 + 32 * ks + 8 * fq) * 2);
                        const bf16x8 bv = *(const LAS bf16x8*)(L + H_VT + ((16 * vt + fr) * 72 + 32 * ks + 8 * fq) * 2);
                        acc = __builtin_amdgcn_mfma_f32_16x16x32_bf16(a, bv, acc, 0, 0, 0); }
#pragma unroll
                    for (int ks = 0; ks < 4; ++ks) { const bf16x8 a = *(const LAS bf16x8*)(L + H_QB + ((16 * tt + fr) * 136 + 32 * ks + 8 * fq) * 2);
                        const bf16x8 bs = *(const LAS bf16x8*)(L + H_ST + ((16 * vt + fr) * 136 + 32 * ks + 8 * fq) * 2);
                        acc = __builtin_amdgcn_mfma_f32_16x16x32_bf16(a, bs, acc, 0, 0, 0); }
#pragma unroll
                    for (int r = 0; r < 4; ++r) *(LAS bf16_t*)(L + H_OL + ((16 * tt + 4 * fq + r) * 72 + 16 * vt + fr) * 2) = (bf16_t)f2bf(acc[r]); }
            }
            { const LAS float* DEC = (const LAS float*)(L + H_DEC);
              const f32x4 dk = *(const LAS f32x4*)(DEC + 16 * w8 + 4 * fq), e2 = *(const LAS f32x4*)(DEC + 128 + 16 * w8 + 4 * fq);
#pragma unroll
              for (int vt = 0; vt < 4; ++vt) { f32x4 acc = (f32x4){0.f, 0.f, 0.f, 0.f};
#pragma unroll
                  for (int ks = 0; ks < 2; ++ks) { const bf16x8 a = *(const LAS bf16x8*)(L + H_KINT + ((16 * w8 + fr) * 72 + 32 * ks + 8 * fq) * 2);
                      const bf16x8 bv = *(const LAS bf16x8*)(L + H_VT + ((16 * vt + fr) * 72 + 32 * ks + 8 * fq) * 2);
                      acc = __builtin_amdgcn_mfma_f32_16x16x32_bf16(a, bv, acc, 0, 0, 0); }
                  Sreg[vt] = dk * Sreg[vt] + e2 * acc; } }
            __syncthreads();
#pragma unroll
            for (int vt = 0; vt < 4; ++vt) { u32x2 o; o.x = pk2(Sreg[vt][0], Sreg[vt][1]); o.y = pk2(Sreg[vt][2], Sreg[vt][3]);
                *(LAS u32x2*)(L + H_ST + ((16 * vt + fr) * 136 + 16 * w8 + 4 * fq) * 2) = o; }
            if (!isctx) { const int st = tid >> 3, vc = tid & 7;
                const u32x4 o = *(const LAS u32x4*)(L + H_OL + (st * 72 + 8 * vc) * 2);
                *(u32x4*)(Od + (size_t)(row0 + (d ? HC - 1 - st : st)) * D + hh * 128 + vh * 64 + 8 * vc) = o; }
        }
#undef H_PREFETCH
        __syncthreads();
    }
}

__device__ __forceinline__ void p10_hgrn_read(const Frame& F) {
    bf16_t* OF = (bf16_t*)(F.ws + WS_OF); const bf16_t* OBk = (const bf16_t*)(F.ws + WS_OB); const bf16_t* ZG = (const bf16_t*)(F.ws + WS_ZG);
    const float* nw = F.in[I_HGNW];
    const size_t total = (size_t)ML * 256;
    for (size_t i = (size_t)F.bid * 512 + F.tid; i < total; i += (size_t)F.G * 512) {
        const int row = (int)(i >> 8), c = ((int)i & 255) * 4;
        const u32x2 a = *(const u32x2*)(OF + (size_t)row * D + c), b = *(const u32x2*)(OBk + (size_t)row * D + c);
        const float o[4] = {bflo(a.x) + bflo(b.x), bfhi(a.x) + bfhi(b.x), bflo(a.y) + bflo(b.y), bfhi(a.y) + bfhi(b.y)};
        const float ms = sum32((o[0] * o[0] + o[1] * o[1]) + (o[2] * o[2] + o[3] * o[3])) * (1.f / 128.f);
        const float rs = 1.0f / sqrtf(ms + RMS_EPS);
        const u32x2 gw = *(const u32x2*)(ZG + (size_t)row * NZG + c);
        const float g[4] = {bflo(gw.x), bfhi(gw.x), bflo(gw.y), bfhi(gw.y)};
        const f32x4 w = *(const f32x4*)(nw + c);
        float y[4];
#pragma unroll
        for (int j = 0; j < 4; ++j) y[j] = o[j] * rs * w[j] * (g[j] * sigmoidf_(g[j]));
        u32x2 ww; ww.x = pk2(y[0], y[1]); ww.y = pk2(y[2], y[3]);
        *(u32x2*)(OF + (size_t)row * D + c) = ww;
    }
}

template <bool COOP>
__device__ __forceinline__ void mk_body(const Args& args) {
    extern __shared__ __attribute__((aligned(16))) unsigned char lds_raw[];
    Frame F;
    F.lds = (LAS unsigned char*)lds_raw;
    F.tid = threadIdx.x; F.lane = F.tid & 63; F.wave = __builtin_amdgcn_readfirstlane(F.tid >> 6);
    F.G = gridDim.x; F.bid = blockIdx.x;
    F.in = args.in; F.ws = args.ws; F.dob = (unsigned char*)args.out;
    const int lo = args.ph_lo, hi = args.ph_hi;
    const float* MOD = (const float*)(F.ws + WS_MOD);
    const int gw = F.bid * 8 + F.wave, NGW = F.G * 8;
#define IN(k) (lo <= (k) && (k) < hi)
#define SEAM(k) do { if (COOP && IN(k) && IN((k) + 1)) cg::this_grid().sync(); } while (0)

    if (IN(0)) { p0_prologue(F); }
#if (MK_REPMASK >> 0) & 1
    if (COOP) cg::this_grid().sync();
    if (IN(0)) { p0_prologue(F); }
#endif
    SEAM(0);
    if (IN(1)) {
        bf16_t* H = (bf16_t*)(F.dob + DO_H);
        for (int m = gw; m < MR; m += NGW) {
            const bool lat = m < ML; const int b = lat ? (m >> 12) : 8;
            const float* xr = lat ? F.in[I_X] + (size_t)m * D : F.in[I_CTX] + (size_t)(m - ML) * D;
            modnorm_row(xr, F.in[I_N1W], MOD + b * 6144, MOD + b * 6144 + 1024, H + (size_t)m * D, F.lane);
        }
    }
#if (MK_REPMASK >> 1) & 1
    if (COOP) cg::this_grid().sync();
    if (IN(1)) {
        bf16_t* H = (bf16_t*)(F.dob + DO_H);
        for (int m = gw; m < MR; m += NGW) {
            const bool lat = m < ML; const int b = lat ? (m >> 12) : 8;
            const float* xr = lat ? F.in[I_X] + (size_t)m * D : F.in[I_CTX] + (size_t)(m - ML) * D;
            modnorm_row(xr, F.in[I_N1W], MOD + b * 6144, MOD + b * 6144 + 1024, H + (size_t)m * D, F.lane);
        }
    }
#endif
    SEAM(1);
    if (IN(2)) {
        pg8::Sched S; S.init(F.dob + DO_H, F.dob + DO_WIN, nullptr, nullptr, MR, NZR, D, F.G, F.bid, 1);
        pg8::EpiBf16 E{(bf16_t*)(F.ws + WS_R1), NZR};
        pg8::gemm_phase(F.lds, D, S, E);
    }
#if (MK_REPMASK >> 2) & 1
    if (COOP) cg::this_grid().sync();
    if (IN(2)) {
        pg8::Sched S; S.init(F.dob + DO_H, F.dob + DO_WIN, nullptr, nullptr, MR, NZR, D, F.G, F.bid, 1);
        pg8::EpiBf16 E{(bf16_t*)(F.ws + WS_R1), NZR};
        pg8::gemm_phase(F.lds, D, S, E);
    }
#endif
    SEAM(2);
    if (IN(3)) { p3_shift(F); }
#if (MK_REPMASK >> 3) & 1
    if (COOP) cg::this_grid().sync();
    if (IN(3)) { p3_shift(F); }
#endif
    SEAM(3);
    if (IN(4)) { p4_rwkv_scan(F); }
#if (MK_REPMASK >> 4) & 1
    if (COOP) cg::this_grid().sync();
    if (IN(4)) { p4_rwkv_scan(F); }
#endif
    SEAM(4);
    if (IN(5)) { p5_rwkv_norm(F); }
#if (MK_REPMASK >> 5) & 1
    if (COOP) cg::this_grid().sync();
    if (IN(5)) { p5_rwkv_norm(F); }
#endif
    SEAM(5);
    if (IN(6)) {
        pg8::Sched S; S.init(F.ws + WS_XGS, F.dob + DO_GUP, nullptr, nullptr, ML, D, 256, F.G, F.bid, 1);
        pg8::EpiMulBf16 E{(const bf16_t*)(F.ws + WS_YF), (bf16_t*)(F.ws + WS_YRW), D};
        pg8::gemm_phase(F.lds, 256, S, E);
    }
#if (MK_REPMASK >> 6) & 1
    if (COOP) cg::this_grid().sync();
    if (IN(6)) {
        pg8::Sched S; S.init(F.ws + WS_XGS, F.dob + DO_GUP, nullptr, nullptr, ML, D, 256, F.G, F.bid, 1);
        pg8::EpiMulBf16 E{(const bf16_t*)(F.ws + WS_YF), (bf16_t*)(F.ws + WS_YRW), D};
        pg8::gemm_phase(F.lds, 256, S, E);
    }
#endif
    SEAM(6);
    if (IN(7)) {
        pg8::Sched S; S.init(F.dob + DO_H, F.dob + DO_WIN + (size_t)NZR * D * 2, nullptr, nullptr, MR, NZH, D, F.G, F.bid, 1);
        pg8::EpiBf16 E{(bf16_t*)(F.ws + WS_ZH), NZH};
        pg8::gemm_phase(F.lds, D, S, E);
    }
#if (MK_REPMASK >> 7) & 1
    if (COOP) cg::this_grid().sync();
    if (IN(7)) {
        pg8::Sched S; S.init(F.dob + DO_H, F.dob + DO_WIN + (size_t)NZR * D * 2, nullptr, nullptr, MR, NZH, D, F.G, F.bid, 1);
        pg8::EpiBf16 E{(bf16_t*)(F.ws + WS_ZH), NZH};
        pg8::gemm_phase(F.lds, D, S, E);
    }
#endif
    SEAM(7);
    if (IN(8)) { p8_hgrn_scan(F); }
#if (MK_REPMASK >> 8) & 1
    if (COOP) cg::this_grid().sync();
    if (IN(8)) { p8_hgrn_scan(F); }
#endif
    SEAM(8);
    if (IN(9)) {
        pg8::Sched S; S.init(F.dob + DO_H, F.dob + DO_WIN + (size_t)(NZR + NZH) * D * 2, nullptr, nullptr, ML, NZG, D, F.G, F.bid, 1);
        pg8::EpiBf16 E{(bf16_t*)(F.ws + WS_ZG), NZG};
        pg8::gemm_phase(F.lds, D, S, E);
    }
#if (MK_REPMASK >> 9) & 1
    if (COOP) cg::this_grid().sync();
    if (IN(9)) {
        pg8::Sched S; S.init(F.dob + DO_H, F.dob + DO_WIN + (size_t)(NZR + NZH) * D * 2, nullptr, nullptr, ML, NZG, D, F.G, F.bid, 1);
        pg8::EpiBf16 E{(bf16_t*)(F.ws + WS_ZG), NZG};
        pg8::gemm_phase(F.lds, D, S, E);
    }
#endif
    SEAM(9);
    if (IN(10)) { p10_hgrn_read(F); }
#if (MK_REPMASK >> 10) & 1
    if (COOP) cg::this_grid().sync();
    if (IN(10)) { p10_hgrn_read(F); }
#endif
    SEAM(10);
    if (IN(11)) {
        pg8::Sched S; S.init(F.ws + WS_YRW, F.dob + DO_PA, F.ws + WS_OF, F.dob + DO_PB, ML, D, D, F.G, F.bid, 2);
        pg8::EpiMerge E{(const bf16_t*)(F.ws + WS_ZG), (bf16_t*)(F.ws + WS_MRG)};
        pg8::gemm_phase(F.lds, D, S, E);
    }
#if (MK_REPMASK >> 11) & 1
    if (COOP) cg::this_grid().sync();
    if (IN(11)) {
        pg8::Sched S; S.init(F.ws + WS_YRW, F.dob + DO_PA, F.ws + WS_OF, F.dob + DO_PB, ML, D, D, F.G, F.bid, 2);
        pg8::EpiMerge E{(const bf16_t*)(F.ws + WS_ZG), (bf16_t*)(F.ws + WS_MRG)};
        pg8::gemm_phase(F.lds, D, S, E);
    }
#endif
    SEAM(11);
    if (IN(12)) {
        pg8::Sched S; S.init(F.ws + WS_MRG, F.dob + DO_WO, nullptr, nullptr, ML, D, D, F.G, F.bid, 1);
        pg8::EpiResid E{F.in[I_X], (float*)(F.ws + WS_X1), MOD + 2048};
        pg8::gemm_phase(F.lds, D, S, E);
    }
#if (MK_REPMASK >> 12) & 1
    if (COOP) cg::this_grid().sync();
    if (IN(12)) {
        pg8::Sched S; S.init(F.ws + WS_MRG, F.dob + DO_WO, nullptr, nullptr, ML, D, D, F.G, F.bid, 1);
        pg8::EpiResid E{F.in[I_X], (float*)(F.ws + WS_X1), MOD + 2048};
        pg8::gemm_phase(F.lds, D, S, E);
    }
#endif
    SEAM(12);
    if (IN(13)) {
        const float* X1 = (const float*)(F.ws + WS_X1); bf16_t* H2 = (bf16_t*)(F.ws + WS_H2);
        for (int m = gw; m < ML; m += NGW) { const int b = m >> 12;
            modnorm_row(X1 + (size_t)m * D, F.in[I_N2W], MOD + b * 6144 + 3072, MOD + b * 6144 + 4096, H2 + (size_t)m * D, F.lane); }
    }
#if (MK_REPMASK >> 13) & 1
    if (COOP) cg::this_grid().sync();
    if (IN(13)) {
        const float* X1 = (const float*)(F.ws + WS_X1); bf16_t* H2 = (bf16_t*)(F.ws + WS_H2);
        for (int m = gw; m < ML; m += NGW) { const int b = m >> 12;
            modnorm_row(X1 + (size_t)m * D, F.in[I_N2W], MOD + b * 6144 + 3072, MOD + b * 6144 + 4096, H2 + (size_t)m * D, F.lane); }
    }
#endif
    SEAM(13);
    if (IN(14)) {
        pg8::Sched S; S.init(F.ws + WS_H2, F.dob + DO_FC1, nullptr, nullptr, ML, FF, D, F.G, F.bid, 1);
        pg8::EpiSqRelu E{(bf16_t*)(F.ws + WS_U), FF};
        pg8::gemm_phase(F.lds, D, S, E);
    }
#if (MK_REPMASK >> 14) & 1
    if (COOP) cg::this_grid().sync();
    if (IN(14)) {
        pg8::Sched S; S.init(F.ws + WS_H2, F.dob + DO_FC1, nullptr, nullptr, ML, FF, D, F.G, F.bid, 1);
        pg8::EpiSqRelu E{(bf16_t*)(F.ws + WS_U), FF};
        pg8::gemm_phase(F.lds, D, S, E);
    }
#endif
    SEAM(14);
    if (IN(15)) {
        pg8::Sched S; S.init(F.ws + WS_U, F.dob + DO_FC2, nullptr, nullptr, ML, D, FF, F.G, F.bid, 1);
        pg8::EpiResid E{(const float*)(F.ws + WS_X1), (float*)(F.ws + WS_X1), MOD + 5120};
        pg8::gemm_phase(F.lds, FF, S, E);
    }
#if (MK_REPMASK >> 15) & 1
    if (COOP) cg::this_grid().sync();
    if (IN(15)) {
        pg8::Sched S; S.init(F.ws + WS_U, F.dob + DO_FC2, nullptr, nullptr, ML, D, FF, F.G, F.bid, 1);
        pg8::EpiResid E{(const float*)(F.ws + WS_X1), (float*)(F.ws + WS_X1), MOD + 5120};
        pg8::gemm_phase(F.lds, FF, S, E);
    }
#endif
    SEAM(15);
    if (IN(16)) {
        const float* X2 = (const float*)(F.ws + WS_X1); const float* fw = F.in[I_FNW];
        for (int m = gw; m < ML; m += NGW) {
            const float* xr = X2 + (size_t)m * D; float* orow = args.out + (size_t)m * D;
            f32x4 v[4]; float s = 0.f;
#pragma unroll
            for (int j = 0; j < 4; ++j) { v[j] = *(const f32x4*)(xr + 4 * F.lane + 256 * j); s += (v[j].x * v[j].x + v[j].y * v[j].y) + (v[j].z * v[j].z + v[j].w * v[j].w); }
            const float rs = 1.0f / sqrtf(wave_sum(s) * (1.f / D) + RMS_EPS);
#pragma unroll
            for (int j = 0; j < 4; ++j) { const int c = 4 * F.lane + 256 * j; *(f32x4*)(orow + c) = v[j] * rs * *(const f32x4*)(fw + c); }
        }
    }
#if (MK_REPMASK >> 16) & 1
    if (COOP) cg::this_grid().sync();
    if (IN(16)) {
        const float* X2 = (const float*)(F.ws + WS_X1); const float* fw = F.in[I_FNW];
        for (int m = gw; m < ML; m += NGW) {
            const float* xr = X2 + (size_t)m * D; float* orow = args.out + (size_t)m * D;
            f32x4 v[4]; float s = 0.f;
#pragma unroll
            for (int j = 0; j < 4; ++j) { v[j] = *(const f32x4*)(xr + 4 * F.lane + 256 * j); s += (v[j].x * v[j].x + v[j].y * v[j].y) + (v[j].z * v[j].z + v[j].w * v[j].w); }
            const float rs = 1.0f / sqrtf(wave_sum(s) * (1.f / D) + RMS_EPS);
#pragma unroll
            for (int j = 0; j < 4; ++j) { const int c = 4 * F.lane + 256 * j; *(f32x4*)(orow + c) = v[j] * rs * *(const f32x4*)(fw + c); }
        }
    }
#endif

#undef IN
#undef SEAM
}

__global__ void __launch_bounds__(512, 2) mk_multi(Args args) { mk_body<false>(args); }
__global__ void __launch_bounds__(512, 2) mk_one(Args args) { mk_body<true>(args); }

extern "C" void kernel_launch(void* const* d_in, const int* in_sizes, int n_in, void* d_out, int out_size, void* d_ws, size_t ws_size, hipStream_t stream) {
    static int grid = 0;
    if (grid == 0) {
        if (n_in != 28 || out_size != ML * D || ws_size < WS_END) { fprintf(stderr, "kernel_launch: unexpected problem (n_in %d, out %d, ws %zu)\n", n_in, out_size, ws_size); grid = -1; return; }
        int dev = 0, cus = 0;
        if (hipGetDevice(&dev) != hipSuccess || hipDeviceGetAttribute(&cus, hipDeviceAttributeMultiprocessorCount, dev) != hipSuccess) { grid = -1; return; }
        (void)hipFuncSetAttribute((const void*)mk_multi, hipFuncAttributeMaxDynamicSharedMemorySize, LDS_BYTES);
        (void)hipFuncSetAttribute((const void*)mk_one, hipFuncAttributeMaxDynamicSharedMemorySize, LDS_BYTES);
        int per_cu = 0;
        (void)hipOccupancyMaxActiveBlocksPerMultiprocessor(&per_cu, (const void*)mk_one, 512, LDS_BYTES);
        (void)hipGetLastError();
        grid = cus;
        if (per_cu < 1) fprintf(stderr, "kernel_launch: occupancy query reports %d blocks per CU\n", per_cu);
    }
    if (grid < 0) return;
    Args a{};
    for (int i = 0; i < 28; ++i) a.in[i] = (const float*)d_in[i];
    a.out = (float*)d_out; a.ws = (unsigned char*)d_ws;
#if MK_ONE_LAUNCH
    a.ph_lo = 0; a.ph_hi = NPHASE;
    void* kargs[] = {&a};
    hipError_t e = hipLaunchCooperativeKernel((const void*)mk_one, dim3(grid), dim3(512), kargs, LDS_BYTES, stream);
    if (e != hipSuccess) fprintf(stderr, "cooperative launch failed: %s\n", hipGetErrorString(e));
#else
    for (int p = 0; p < NPHASE; ++p) { a.ph_lo = p; a.ph_hi = p + 1; hipLaunchKernelGGL(mk_multi, dim3(grid), dim3(512), LDS_BYTES, stream, a); }
#endif
}
```

```cpp
#include <hip/hip_runtime.h>
#include <hip/hip_cooperative_groups.h>
#include <cstdio>
#include <cstdint>
namespace cg = cooperative_groups;

#ifndef MK_ONE_LAUNCH
#define MK_ONE_LAUNCH 1
#endif
#ifndef MK_REPMASK
#define MK_REPMASK 0x0u
#endif

#define LAS __attribute__((address_space(3)))
typedef unsigned short bf16_t;
typedef short bf16x8 __attribute__((ext_vector_type(8)));
typedef float f32x4 __attribute__((ext_vector_type(4)));
typedef float f32x2 __attribute__((ext_vector_type(2)));
typedef unsigned u32x4 __attribute__((ext_vector_type(4)));
typedef unsigned u32x2 __attribute__((ext_vector_type(2)));

constexpr int D = 1024, NB = 8, T = 4096, TC = 256, GW = 64;
constexpr int ML = NB * T;
constexpr int MC = NB * TC;
constexpr int MR = ML + MC;
constexpr int NZR = 3328, NZH = 4096, NZG = 3072, NIN = 10496, FF = 4096;
constexpr float RMS_EPS = 1e-6f, GN_EPS = 64e-5f;

constexpr size_t MiB = 1u << 20;
constexpr size_t WS_CTL = 0, WS_MOD = 1 * MiB;
constexpr size_t WS_R1 = 2 * MiB;
constexpr size_t WS_YF = 2 * MiB, WS_YB = 66 * MiB, WS_YRW = 130 * MiB;
constexpr size_t WS_OF = 2 * MiB, WS_OB = 66 * MiB;
constexpr size_t WS_X1 = 2 * MiB;
constexpr size_t WS_H2 = 130 * MiB;
constexpr size_t WS_ZRS = 223 * MiB;
constexpr size_t WS_XGS = 444 * MiB;
constexpr size_t WS_BON = 460 * MiB;
constexpr size_t WS_ZH = 194 * MiB;
constexpr size_t WS_ZG = 194 * MiB;
constexpr size_t WS_MRG = 386 * MiB;
constexpr size_t WS_U = 194 * MiB;
constexpr size_t WS_RN = 464 * MiB;
constexpr size_t WS_END = 468 * MiB;
constexpr size_t DO_H = 0;
constexpr size_t DO_WIN = 68 * MiB;
constexpr size_t DO_PA = DO_WIN + (size_t)NIN * D * 2;
constexpr size_t DO_PB = DO_PA + 2 * MiB, DO_WO = DO_PB + 2 * MiB, DO_FC1 = DO_WO + 2 * MiB, DO_FC2 = DO_FC1 + 8 * MiB, DO_GUP = DO_FC2 + 8 * MiB;
constexpr size_t DO_END = DO_GUP + (size_t)1024 * 256 * 2;
static_assert(DO_END <= 128 * MiB, "d_out scratch overflow");

constexpr int LDS_BYTES = 152 * 1024;
constexpr int NPHASE = 17;

__device__ __forceinline__ unsigned f2bf(float f) { unsigned u = __builtin_bit_cast(unsigned, f); return (u + 0x7fffu + ((u >> 16) & 1u)) >> 16; }
__device__ __forceinline__ unsigned pk2(float lo, float hi) { return f2bf(lo) | (f2bf(hi) << 16); }
__device__ __forceinline__ float bflo(unsigned w) { return __builtin_bit_cast(float, w << 16); }
__device__ __forceinline__ float bfhi(unsigned w) { return __builtin_bit_cast(float, w & 0xffff0000u); }
__device__ __forceinline__ float sigmoidf_(float x) { return 1.0f / (1.0f + __expf(-x)); }
__device__ __forceinline__ float wave_sum(float v) {
#pragma unroll
    for (int o = 1; o < 64; o <<= 1) v += __shfl_xor(v, o);
    return v;
}
template <int CTRL> __device__ __forceinline__ float dpp_mov(float v) { return __builtin_bit_cast(float, __builtin_amdgcn_update_dpp(0, __builtin_bit_cast(int, v), CTRL, 0xf, 0xf, true)); }
__device__ __forceinline__ float sum16(float v) { v += dpp_mov<0xB1>(v); v += dpp_mov<0x4E>(v); v += dpp_mov<0x141>(v); v += dpp_mov<0x140>(v); return v; }
__device__ __forceinline__ float sum32(float v) { v = sum16(v); v += __shfl_xor(v, 16); return v; }


#define XB_TMO      128
#define XB_XCNT(j)  (256  + 64 * (j))
#define XB_XSUB(j)  (1280 + 64 * (j))
#define XB_XGEN(j)  (2304 + 64 * (j))
#define XB_TOP      3328
#define XB_TOPGEN   3392
#define XCD_BAR_WORDS 3456
#define XB_SPIN_CAP (1u << 18)
__device__ __forceinline__ unsigned xb_ld(unsigned* p)              { return __hip_atomic_load(p, __ATOMIC_RELAXED, __HIP_MEMORY_SCOPE_AGENT); }
__device__ __forceinline__ unsigned xb_add(unsigned* p, unsigned v) { return __hip_atomic_fetch_add(p, v, __ATOMIC_RELAXED, __HIP_MEMORY_SCOPE_AGENT); }
__device__ __forceinline__ unsigned xb_xcc_id() { return (unsigned)__builtin_amdgcn_s_getreg((3 << 11) | 20) & 0xFu; }
#define XB_SPIN(cond, bar) do { unsigned _sp = 0; while (cond) { __builtin_amdgcn_s_sleep(1); \
    if ((++_sp & 255u) == 0u) { if (xb_ld(&(bar)[XB_TMO])) break; if (_sp > XB_SPIN_CAP) { atomicAdd(&(bar)[XB_TMO], 1u); break; } } } } while (0)
struct XcdBarrier { unsigned* bar; unsigned x; volatile LAS unsigned* st; };
__device__ __forceinline__ XcdBarrier xcd_barrier_post(unsigned* bar, volatile LAS unsigned* st) {
    XcdBarrier b; b.bar = bar; b.x = xb_xcc_id(); b.st = st;
    if (threadIdx.x == 0) (void)xb_add(&bar[XB_XCNT(b.x)], 1u);
    return b;
}
__device__ __forceinline__ void xcd_barrier_complete(unsigned* bar, unsigned x, unsigned& nloc, unsigned& nx) {
    const unsigned G = gridDim.x * gridDim.y * gridDim.z;
    unsigned sum, cnt, mine, sp = 0u;
    for (;;) {
        sum = 0u; cnt = 0u; mine = 0u;
#pragma unroll
        for (unsigned j = 0; j < 16; ++j) { const unsigned c = xb_ld(&bar[XB_XCNT(j)]); sum += c; cnt += (c > 0u) ? 1u : 0u; mine = (j == x) ? c : mine; }
        if (sum == G) break;
        __builtin_amdgcn_s_sleep(1);
        if ((++sp & 255u) == 0u) { if (xb_ld(&bar[XB_TMO])) break; if (sp > XB_SPIN_CAP) { atomicAdd(&bar[XB_TMO], 1u); break; } }
    }
    nloc = mine > 0u ? mine : 1u; nx = cnt > 0u ? cnt : 1u;
}
__device__ __forceinline__ void xcd_barrier(const XcdBarrier& b) {
    asm volatile("s_waitcnt vmcnt(0)" ::: "memory");
    __syncthreads();
    if (threadIdx.x == 0) {
        unsigned* bar = b.bar;
        __builtin_amdgcn_s_waitcnt(0);
        unsigned nloc = b.st[0], nx = b.st[1];
        if (nloc == 0u) { xcd_barrier_complete(bar, b.x, nloc, nx); b.st[0] = nloc; b.st[1] = nx; }
        const unsigned old = xb_add(&bar[XB_XSUB(b.x)], 1u);
        const unsigned gen = old / nloc;
        if (old + 1u == (gen + 1u) * nloc) {
            __builtin_amdgcn_fence(__ATOMIC_RELEASE, "agent");
            asm volatile("s_waitcnt vmcnt(0)" ::: "memory");
            const unsigned og = xb_add(&bar[XB_TOP], 1u);
            const unsigned tg = og / nx;
            if (og + 1u == (tg + 1u) * nx) xb_add(&bar[XB_TOPGEN], 1u);
            else XB_SPIN(xb_ld(&bar[XB_TOPGEN]) == tg, bar);
            __builtin_amdgcn_fence(__ATOMIC_ACQUIRE, "agent");
            xb_add(&bar[XB_XGEN(b.x)], 1u);
            asm volatile("s_waitcnt vmcnt(0)" ::: "memory");
        } else {
            XB_SPIN(xb_ld(&bar[XB_XGEN(b.x)]) == gen, bar);
            __builtin_amdgcn_fence(__ATOMIC_ACQUIRE, "agent");
            asm volatile("s_waitcnt vmcnt(0)" ::: "memory");
        }
    }
    __syncthreads();
}

namespace pg8 {
constexpr int BM = 256, BK = 64, HALF = 128, HTB = HALF * BK * 2, STAGE_BYTES = 8 * HTB, NXCD = 8, WGM = 8;
__host__ __device__ __forceinline__ int lds_byte(int r, int c) { const int st = (r >> 4) * 2 + (c >> 5), rr = r & 15, cc = c & 31, ob = rr * 64 + cc * 2; return st * 1024 + (ob ^ (((ob >> 9) & 1) << 5)); }
__host__ __device__ __forceinline__ void stage_rc(int b, int& R, int& C) { const int st = b / 1024, sb = b % 1024, swz = sb ^ (((sb >> 9) & 1) << 5); R = (st >> 1) * 16 + swz / 64; C = (st & 1) * 32 + (swz % 64) / 2; }
__host__ __device__ __forceinline__ int perm32(int rho) { const int n = rho >> 4, i = rho & 15; return 8 * (i >> 2) + 4 * n + (i & 3); }

struct Unit { int pm, pn, sel; };
struct Sched {
    const char* A0; const char* B0; const char* A1; const char* B1;
    int nM, nN, nwg, G, c, nsel; size_t tstep;
    __device__ void init(const void* a0, const void* b0, const void* a1, const void* b1, int M, int N, int K, int G_, int c_, int nsel_) {
        A0 = (const char*)a0; B0 = (const char*)b0; A1 = (const char*)a1; B1 = (const char*)b1; nM = M / BM; nN = N / BM; nwg = nM * nN; G = G_; c = c_; nsel = nsel_; tstep = (size_t)BM * K * 2; }
    __device__ bool next(int i, Unit& u) const {
        const int j = (nsel == 2) ? (i >> 1) : i;
        const long L = (long)j * G + c; if (L >= nwg) return false;
        int wgid = (int)L; { const int q = nwg / NXCD, r = nwg % NXCD, xcd = wgid % NXCD, off = wgid / NXCD; wgid = (xcd < r ? xcd * (q + 1) : r * (q + 1) + (xcd - r) * q) + off; }
        const int nig = WGM * nN, gid = wgid / nig, fm = gid * WGM, gsz = (nM - fm) < WGM ? (nM - fm) : WGM;
        u.pm = fm + ((wgid % nig) % gsz); u.pn = (wgid % nig) / gsz; u.sel = (nsel == 2) ? (i & 1) : 0; return true;
    }
    __device__ __forceinline__ const char* abase(const Unit& u) const { return (u.sel ? A1 : A0) + (size_t)u.pm * tstep; }
    __device__ __forceinline__ const char* bbase(const Unit& u) const { return (u.sel ? B1 : B0) + (size_t)u.pn * tstep; }
};

template <class Epi>
__device__ __forceinline__ void gemm_phase(LAS unsigned char* lds, const int K, const Sched& S, const Epi& E) {
    const int tid = threadIdx.x, wid = __builtin_amdgcn_readfirstlane(tid >> 6), lane = tid & 63, wr = wid >> 2, wc = wid & 3, fr = lane & 15, fq = lane >> 4;
    const int nt = K / BK;
    unsigned voffA[2], voffB[2];
#pragma unroll
    for (int i = 0; i < 2; ++i) { int R, C; stage_rc(tid * 16 + i * 8192, R, C); const int Rb = Epi::PERM ? ((R & ~31) + perm32(R & 31)) : R;
        voffA[i] = (unsigned)(R * K + C) * 2u; voffB[i] = (unsigned)(Rb * K + C) * 2u; }
    const size_t kstep = (size_t)(BK * 2);
    const size_t hstep = (size_t)HALF * K * 2;
    const unsigned ldsw = (unsigned)wid * 1024u;
    const int aoff = lds_byte(wr * 64 + fr, fq * 8), boff = lds_byte(wc * 32 + fr, fq * 8);
#define PG8_SA(b, h) (((b) * 2 + (h)) * HTB)
#define PG8_SB(b, h) ((4 + (b) * 2 + (h)) * HTB)
#define PG8_STAGE(bufoff, gbase, voff) do { _Pragma("unroll") for (int _i = 0; _i < 2; ++_i) \
        __builtin_amdgcn_global_load_lds((const unsigned*)((const char*)(gbase) + (voff)[_i]), (LAS unsigned*)(lds + (bufoff) + ldsw + _i * 8192), 16, 0, 0); } while (0)
#define PG8_LDA(dst, b, h) do { _Pragma("unroll") for (int m = 0; m < 4; ++m) _Pragma("unroll") for (int k = 0; k < 2; ++k) dst[m][k] = *(const LAS bf16x8*)(lds + PG8_SA(b, h) + aoff + m * 2048 + k * 1024); } while (0)
#define PG8_LDB(dst, b, h) do { _Pragma("unroll") for (int n = 0; n < 2; ++n) _Pragma("unroll") for (int k = 0; k < 2; ++k) dst[n][k] = *(const LAS bf16x8*)(lds + PG8_SB(b, h) + boff + n * 2048 + k * 1024); } while (0)
#define PG8_MMA(ai, bj, At, Bt) do { __builtin_amdgcn_s_setprio(1); _Pragma("unroll") for (int m = 0; m < 4; ++m) _Pragma("unroll") for (int n = 0; n < 2; ++n) _Pragma("unroll") for (int k = 0; k < 2; ++k) \
        acc[ai][bj][m][n] = __builtin_amdgcn_mfma_f32_16x16x32_bf16(Bt[n][k], At[m][k], acc[ai][bj][m][n], 0, 0, 0); __builtin_amdgcn_s_setprio(0); } while (0)
#define PG8_WAIT_V(n) asm volatile("s_waitcnt vmcnt(" #n ")" ::: "memory")
#define PG8_WAIT_L(n) asm volatile("s_waitcnt lgkmcnt(" #n ")" ::: "memory")
#define PG8_BAR __builtin_amdgcn_s_barrier()
#define PG8_SCHED __builtin_amdgcn_sched_barrier(0)
    Unit cur, nxt; int ui = 0;
    if (!S.next(0, cur)) return;
    f32x4 acc[2][2][4][2];
#pragma unroll
    for (int a = 0; a < 2; ++a)
#pragma unroll
        for (int b = 0; b < 2; ++b)
#pragma unroll
            for (int m = 0; m < 4; ++m)
#pragma unroll
                for (int n = 0; n < 2; ++n) acc[a][b][m][n] = (f32x4){0.f, 0.f, 0.f, 0.f};
    bf16x8 At[4][2], B0[2][2], B1[2][2];
    const char* cA = S.abase(cur); const char* cB = S.bbase(cur);
    PG8_STAGE(PG8_SB(0, 0), cB, voffB); PG8_STAGE(PG8_SB(0, 1), cB + hstep, voffB); PG8_STAGE(PG8_SA(0, 0), cA, voffA); PG8_STAGE(PG8_SA(0, 1), cA + hstep, voffA);
    if (wr == 1) PG8_BAR;
    PG8_WAIT_V(2); PG8_BAR;
    PG8_STAGE(PG8_SB(1, 0), cB + kstep, voffB); PG8_STAGE(PG8_SA(1, 0), cA + kstep, voffA); PG8_STAGE(PG8_SB(1, 1), cB + hstep + kstep, voffB);
    PG8_WAIT_V(6); PG8_BAR;
    for (;;) {
        const bool has_next = S.next(ui + 1, nxt);
        const char* nA = has_next ? S.abase(nxt) : cA; const char* nB = has_next ? S.bbase(nxt) : cB;
        for (int t = 0; t < nt; t += 2) {
            const bool last = (t == nt - 2);
            const char* a1 = cA + (size_t)(t + 1) * kstep;
            const char* a2 = last ? nA : cA + (size_t)(t + 2) * kstep; const char* b2 = last ? nB : cB + (size_t)(t + 2) * kstep;
            const char* a3 = a2 + kstep; const char* b3 = b2 + kstep;
            PG8_LDB(B0, 0, 0); PG8_LDB(B1, 0, 1); PG8_SCHED; PG8_LDA(At, 0, 0); PG8_STAGE(PG8_SA(1, 1), a1 + hstep, voffA);
            PG8_WAIT_V(8); PG8_WAIT_L(0); PG8_BAR; PG8_MMA(0, 0, At, B0); PG8_MMA(0, 1, At, B1); PG8_BAR; PG8_SCHED;
            PG8_LDA(At, 0, 1); PG8_STAGE(PG8_SB(0, 0), b2, voffB); PG8_STAGE(PG8_SB(0, 1), b2 + hstep, voffB); PG8_STAGE(PG8_SA(0, 0), a2, voffA);
            PG8_WAIT_V(8); PG8_WAIT_L(0); PG8_BAR; PG8_MMA(1, 0, At, B0); PG8_MMA(1, 1, At, B1); PG8_BAR; PG8_SCHED;
            PG8_LDB(B0, 1, 0); PG8_LDB(B1, 1, 1); PG8_SCHED; PG8_LDA(At, 1, 0); PG8_STAGE(PG8_SA(0, 1), a2 + hstep, voffA);
            PG8_WAIT_V(8); PG8_WAIT_L(0); PG8_BAR; PG8_MMA(0, 0, At, B0); PG8_MMA(0, 1, At, B1); PG8_BAR; PG8_SCHED;
            PG8_LDA(At, 1, 1); PG8_STAGE(PG8_SB(1, 0), b3, voffB); PG8_STAGE(PG8_SB(1, 1), b3 + hstep, voffB); PG8_STAGE(PG8_SA(1, 0), a3, voffA);
            PG8_WAIT_V(8); PG8_WAIT_L(0); PG8_BAR; PG8_MMA(1, 0, At, B0); PG8_MMA(1, 1, At, B1); PG8_BAR; PG8_SCHED;
        }
        if (wr == 0) PG8_BAR;
        E(acc, cur, wr, wc, fr, fq);
        if (!has_next) break;
#pragma unroll
        for (int a = 0; a < 2; ++a)
#pragma unroll
            for (int b = 0; b < 2; ++b)
#pragma unroll
                for (int m = 0; m < 4; ++m)
#pragma unroll
                    for (int n = 0; n < 2; ++n) acc[a][b][m][n] = (f32x4){0.f, 0.f, 0.f, 0.f};
        cur = nxt; cA = nA; cB = nB; ++ui;
        if (wr == 1) PG8_BAR;
    }
    PG8_WAIT_V(0);
    PG8_BAR;
#undef PG8_SA
#undef PG8_SB
#undef PG8_STAGE
#undef PG8_LDA
#undef PG8_LDB
#undef PG8_MMA
#undef PG8_WAIT_V
#undef PG8_WAIT_L
#undef PG8_BAR
#undef PG8_SCHED
}

struct EpiBf16 {
    static constexpr bool PERM = true;
    bf16_t* O; int ldc;
    __device__ __forceinline__ void operator()(const f32x4 (&acc)[2][2][4][2], const Unit& u, int wr, int wc, int fr, int fq) const {
        const int row0 = u.pm * BM + wr * 64 + fr, col0 = u.pn * BM + wc * 32 + 8 * fq;
#pragma unroll
        for (int ai = 0; ai < 2; ++ai)
#pragma unroll
            for (int m = 0; m < 4; ++m) { bf16_t* rowp = O + (size_t)(row0 + ai * HALF + m * 16) * ldc + col0;
#pragma unroll
                for (int bj = 0; bj < 2; ++bj) { const f32x4 v0 = acc[ai][bj][m][0], v1 = acc[ai][bj][m][1];
                    u32x4 w; w.x = pk2(v0[0], v0[1]); w.y = pk2(v0[2], v0[3]); w.z = pk2(v1[0], v1[1]); w.w = pk2(v1[2], v1[3]);
                    *(u32x4*)(rowp + bj * HALF) = w; } }
    }
};
struct EpiSqRelu {
    static constexpr bool PERM = true;
    bf16_t* O; int ldc;
    __device__ __forceinline__ void operator()(const f32x4 (&acc)[2][2][4][2], const Unit& u, int wr, int wc, int fr, int fq) const {
        const int row0 = u.pm * BM + wr * 64 + fr, col0 = u.pn * BM + wc * 32 + 8 * fq;
#pragma unroll
        for (int ai = 0; ai < 2; ++ai)
#pragma unroll
            for (int m = 0; m < 4; ++m) { bf16_t* rowp = O + (size_t)(row0 + ai * HALF + m * 16) * ldc + col0;
#pragma unroll
                for (int bj = 0; bj < 2; ++bj) { f32x4 v0 = acc[ai][bj][m][0], v1 = acc[ai][bj][m][1];
#pragma unroll
                    for (int j = 0; j < 4; ++j) { const float a = fmaxf(v0[j], 0.f), b = fmaxf(v1[j], 0.f); v0[j] = a * a; v1[j] = b * b; }
                    u32x4 w; w.x = pk2(v0[0], v0[1]); w.y = pk2(v0[2], v0[3]); w.z = pk2(v1[0], v1[1]); w.w = pk2(v1[2], v1[3]);
                    *(u32x4*)(rowp + bj * HALF) = w; } }
    }
};
struct EpiMulBf16 {
    static constexpr bool PERM = true;
    const bf16_t* Y; bf16_t* O; int ldc;
    __device__ __forceinline__ void operator()(const f32x4 (&acc)[2][2][4][2], const Unit& u, int wr, int wc, int fr, int fq) const {
        const int row0 = u.pm * BM + wr * 64 + fr, col0 = u.pn * BM + wc * 32 + 8 * fq;
#pragma unroll
        for (int ai = 0; ai < 2; ++ai)
#pragma unroll
            for (int m = 0; m < 4; ++m) { const size_t off = (size_t)(row0 + ai * HALF + m * 16) * ldc + col0;
#pragma unroll
                for (int bj = 0; bj < 2; ++bj) { const f32x4 v0 = acc[ai][bj][m][0], v1 = acc[ai][bj][m][1];
                    const u32x4 y = *(const u32x4*)(Y + off + bj * HALF);
                    u32x4 w; w.x = pk2(v0[0] * bflo(y.x), v0[1] * bfhi(y.x)); w.y = pk2(v0[2] * bflo(y.y), v0[3] * bfhi(y.y));
                    w.z = pk2(v1[0] * bflo(y.z), v1[1] * bfhi(y.z)); w.w = pk2(v1[2] * bflo(y.w), v1[3] * bfhi(y.w));
                    *(u32x4*)(O + off + bj * HALF) = w; }
                asm volatile("" ::: "memory"); }
    }
};
struct EpiMerge {
    static constexpr bool PERM = true;
    const bf16_t* ZG; bf16_t* O;
    __device__ __forceinline__ void operator()(const f32x4 (&acc)[2][2][4][2], const Unit& u, int wr, int wc, int fr, int fq) const {
        const int row0 = u.pm * BM + wr * 64 + fr, col0 = u.pn * BM + wc * 32 + 8 * fq;
        const int goff = u.sel ? 2048 : 1024;
#pragma unroll
        for (int ai = 0; ai < 2; ++ai)
#pragma unroll
            for (int m = 0; m < 4; ++m) { const size_t r = (size_t)(row0 + ai * HALF + m * 16);
#pragma unroll
                for (int bj = 0; bj < 2; ++bj) { const f32x4 v0 = acc[ai][bj][m][0], v1 = acc[ai][bj][m][1];
                    const u32x4 g = *(const u32x4*)(ZG + r * NZG + goff + col0 + bj * HALF);
                    float o[8];
                    o[0] = v0[0] * sigmoidf_(bflo(g.x)); o[1] = v0[1] * sigmoidf_(bfhi(g.x)); o[2] = v0[2] * sigmoidf_(bflo(g.y)); o[3] = v0[3] * sigmoidf_(bfhi(g.y));
                    o[4] = v1[0] * sigmoidf_(bflo(g.z)); o[5] = v1[1] * sigmoidf_(bfhi(g.z)); o[6] = v1[2] * sigmoidf_(bflo(g.w)); o[7] = v1[3] * sigmoidf_(bfhi(g.w));
                    bf16_t* op = O + r * D + col0 + bj * HALF;
                    if (u.sel) { const u32x4 p = *(const u32x4*)op;
                        o[0] += bflo(p.x); o[1] += bfhi(p.x); o[2] += bflo(p.y); o[3] += bfhi(p.y); o[4] += bflo(p.z); o[5] += bfhi(p.z); o[6] += bflo(p.w); o[7] += bfhi(p.w); }
                    u32x4 w; w.x = pk2(o[0], o[1]); w.y = pk2(o[2], o[3]); w.z = pk2(o[4], o[5]); w.w = pk2(o[6], o[7]);
                    *(u32x4*)op = w; }
                asm volatile("" ::: "memory"); }
    }
};
struct EpiResid {
    static constexpr bool PERM = false;
    const float* base; float* out; const float* gate;
    __device__ __forceinline__ void operator()(const f32x4 (&acc)[2][2][4][2], const Unit& u, int wr, int wc, int fr, int fq) const {
        const int row0 = u.pm * BM + wr * 64 + fr, col0 = u.pn * BM + wc * 32 + 4 * fq;
        const float* gp = gate + (size_t)((u.pm * BM) / T) * 6144 + col0;
        f32x4 gv[2][2];
#pragma unroll
        for (int bj = 0; bj < 2; ++bj)
#pragma unroll
            for (int n = 0; n < 2; ++n) gv[bj][n] = *(const f32x4*)(gp + bj * HALF + n * 16);
#pragma unroll
        for (int ai = 0; ai < 2; ++ai)
#pragma unroll
            for (int m = 0; m < 4; ++m) { const size_t off = (size_t)(row0 + ai * HALF + m * 16) * D + col0;
#pragma unroll
                for (int bj = 0; bj < 2; ++bj)
#pragma unroll
                    for (int n = 0; n < 2; ++n) { const f32x4 bs = *(const f32x4*)(base + off + bj * HALF + n * 16);
                        *(f32x4*)(out + off + bj * HALF + n * 16) = bs + gv[bj][n] * acc[ai][bj][m][n]; }
                asm volatile("" ::: "memory"); }
    }
};
}

struct Args { const float* in[28]; float* out; unsigned char* ws; int ph_lo, ph_hi; };

struct Frame {
    LAS unsigned char* lds;
    int tid, lane, wave, G, bid;
    const float* const* in;
    unsigned char* ws; unsigned char* dob;
};
enum { I_X = 0, I_C, I_CTX, I_CCTX, I_N1W, I_N2W, I_WMOD, I_BMOD, I_WIN, I_MU, I_W0, I_WUP, I_A0, I_AUP, I_GUP, I_KK, I_KA, I_RK, I_LNW, I_LNB, I_HGLB, I_HGNW, I_PA, I_PB, I_WOUT, I_FC1, I_FC2, I_FNW };

__device__ __forceinline__ void transpose_item(const float* W, int N, bf16_t* WT, int ldk, LAS float* scr, int item, int lane) {
    const int nblk = N / 32, kb = item / nblk, nb = item % nblk, k0 = 64 * kb, n0 = 32 * nb;
#pragma unroll 8
    for (int i = 0; i < 32; ++i) { const int kk = 2 * i + (lane >> 5); scr[kk * 33 + (lane & 31)] = W[(size_t)(k0 + kk) * N + n0 + (lane & 31)]; }
    asm volatile("s_waitcnt lgkmcnt(0)" ::: "memory");
    const int c = lane & 7;
#pragma unroll
    for (int j = 0; j < 4; ++j) { const int n = (lane >> 3) + 8 * j; const LAS float* s = scr + (8 * c) * 33 + n;
        u32x4 o; o.x = pk2(s[0 * 33], s[1 * 33]); o.y = pk2(s[2 * 33], s[3 * 33]); o.z = pk2(s[4 * 33], s[5 * 33]); o.w = pk2(s[6 * 33], s[7 * 33]);
        *(u32x4*)(WT + (size_t)(n0 + n) * ldk + k0 + 8 * c) = o; }
    asm volatile("s_waitcnt lgkmcnt(0)" ::: "memory");
}

__device__ __forceinline__ void p0_prologue(const Frame& F) {
    float* MOD = (float*)(F.ws + WS_MOD);
    if (F.bid < 96) {
        LAS float* act = (LAS float*)F.lds;
        LAS float* red = act + 9 * 1024;
        for (int i = F.tid; i < 9 * 1024; i += 512) { const float v = (i < 8 * 1024) ? F.in[I_C][i] : F.in[I_CCTX][i - 8 * 1024]; act[i] = v * sigmoidf_(v); }
        __syncthreads();
        const float* wm = F.in[I_WMOD];
        const int n = F.bid * 64 + F.lane;
        float a[9];
#pragma unroll
        for (int r = 0; r < 9; ++r) a[r] = 0.f;
        const int kb = F.wave * 128;
#pragma unroll 4
        for (int k = kb; k < kb + 128; ++k) { const float w = wm[(size_t)k * 6144 + n];
#pragma unroll
            for (int r = 0; r < 9; ++r) a[r] += act[r * 1024 + k] * w; }
#pragma unroll
        for (int r = 0; r < 9; ++r) red[(F.wave * 9 + r) * 64 + F.lane] = a[r];
        __syncthreads();
        for (int i = F.tid; i < 9 * 64; i += 512) { const int r = i >> 6, l = i & 63; float s = 0.f;
#pragma unroll
            for (int w = 0; w < 8; ++w) s += red[(w * 9 + r) * 64 + l];
            MOD[r * 6144 + F.bid * 64 + l] = s + F.in[I_BMOD][F.bid * 64 + l]; }
        __syncthreads();
    }
    LAS float* scr = (LAS float*)(F.lds + 48 * 1024) + F.wave * (64 * 33);
    const int gw = F.bid * 8 + F.wave, NGW = F.G * 8;
    constexpr int I_IN = 16 * (NIN / 32), I_SQ = 16 * 32, I_F1 = 16 * (FF / 32), I_F2 = 64 * 32, I_GU = 2 * 32;
    constexpr int NITEMS = I_IN + 3 * I_SQ + I_F1 + I_F2 + I_GU;
    for (int it = gw; it < NITEMS; it += NGW) {
        int r = it;
        if (r < I_IN) { transpose_item(F.in[I_WIN], NIN, (bf16_t*)(F.dob + DO_WIN), D, scr, r, F.lane); continue; } r -= I_IN;
        if (r < I_SQ) { transpose_item(F.in[I_PA], D, (bf16_t*)(F.dob + DO_PA), D, scr, r, F.lane); continue; } r -= I_SQ;
        if (r < I_SQ) { transpose_item(F.in[I_PB], D, (bf16_t*)(F.dob + DO_PB), D, scr, r, F.lane); continue; } r -= I_SQ;
        if (r < I_SQ) { transpose_item(F.in[I_WOUT], D, (bf16_t*)(F.dob + DO_WO), D, scr, r, F.lane); continue; } r -= I_SQ;
        if (r < I_F1) { transpose_item(F.in[I_FC1], FF, (bf16_t*)(F.dob + DO_FC1), D, scr, r, F.lane); continue; } r -= I_F1;
        if (r < I_F2) { transpose_item(F.in[I_FC2], D, (bf16_t*)(F.dob + DO_FC2), FF, scr, r, F.lane); continue; } r -= I_F2;
        transpose_item(F.in[I_GUP], D, (bf16_t*)(F.dob + DO_GUP), 256, scr, r, F.lane);
    }
    { bf16_t* gu = (bf16_t*)(F.dob + DO_GUP);
      for (int i = F.bid * 512 + F.tid; i < 1024 * 16; i += F.G * 512) { const int n = i >> 4, ch = i & 15; *(u32x4*)(gu + (size_t)n * 256 + 128 + ch * 8) = (u32x4){0u, 0u, 0u, 0u}; } }
}

__device__ __forceinline__ void modnorm_row(const float* xrow, const float* nw, const float* sh, const float* sc, bf16_t* orow, int lane) {
    f32x4 v[4]; float s = 0.f;
#pragma unroll
    for (int j = 0; j < 4; ++j) { v[j] = *(const f32x4*)(xrow + 4 * lane + 256 * j); s += (v[j].x * v[j].x + v[j].y * v[j].y) + (v[j].z * v[j].z + v[j].w * v[j].w); }
    const float rs = 1.0f / sqrtf(wave_sum(s) * (1.f / D) + RMS_EPS);
#pragma unroll
    for (int j = 0; j < 4; ++j) { const int c = 4 * lane + 256 * j;
        const f32x4 w = *(const f32x4*)(nw + c), a = *(const f32x4*)(sc + c), b = *(const f32x4*)(sh + c);
        const f32x4 y = (v[j] * rs * w) * (1.0f + a) + b;
        u32x2 o; o.x = pk2(y.x, y.y); o.y = pk2(y.z, y.w); *(u32x2*)(orow + c) = o; }
}

__device__ __forceinline__ void unpack8(const u32x4 w, float (&f)[8]) { f[0] = bflo(w.x); f[1] = bfhi(w.x); f[2] = bflo(w.y); f[3] = bfhi(w.y); f[4] = bflo(w.z); f[5] = bfhi(w.z); f[6] = bflo(w.w); f[7] = bfhi(w.w); }
__device__ __forceinline__ void p3_shift(const Frame& F) {
    const bf16_t* ZR = (const bf16_t*)(F.ws + WS_R1); bf16_t* ZS = (bf16_t*)(F.ws + WS_ZRS); bf16_t* XG = (bf16_t*)(F.ws + WS_XGS);
    const float* mu = F.in[I_MU]; float* RN = (float*)(F.ws + WS_RN);
    constexpr int CH = NZR / 8;
    const size_t total = (size_t)MR * CH;
    for (size_t i = (size_t)F.bid * 512 + F.tid; i < total; i += (size_t)F.G * 512) {
        const int row = (int)(i / CH), ch = (int)(i % CH), c0 = ch * 8;
        const bf16_t* p = ZR + (size_t)row * NZR + c0;
        float z[8], a[8], o[8];
        unpack8(*(const u32x4*)p, z);
        float m0[8], m1[8];
        { const f32x4 t0 = *(const f32x4*)(mu + c0), t1 = *(const f32x4*)(mu + c0 + 4); m0[0] = t0.x; m0[1] = t0.y; m0[2] = t0.z; m0[3] = t0.w; m0[4] = t1.x; m0[5] = t1.y; m0[6] = t1.z; m0[7] = t1.w; }
        { const f32x4 t0 = *(const f32x4*)(mu + NZR + c0), t1 = *(const f32x4*)(mu + NZR + c0 + 4); m1[0] = t0.x; m1[1] = t0.y; m1[2] = t0.z; m1[3] = t0.w; m1[4] = t1.x; m1[5] = t1.y; m1[6] = t1.z; m1[7] = t1.w; }
        if (row < ML) {
            const int t = row & (T - 1), gc = t & 63, gr = t >> 6;
            float m2[8], m3[8];
            { const f32x4 t0 = *(const f32x4*)(mu + 2 * NZR + c0), t1 = *(const f32x4*)(mu + 2 * NZR + c0 + 4); m2[0] = t0.x; m2[1] = t0.y; m2[2] = t0.z; m2[3] = t0.w; m2[4] = t1.x; m2[5] = t1.y; m2[6] = t1.z; m2[7] = t1.w; }
            { const f32x4 t0 = *(const f32x4*)(mu + 3 * NZR + c0), t1 = *(const f32x4*)(mu + 3 * NZR + c0 + 4); m3[0] = t0.x; m3[1] = t0.y; m3[2] = t0.z; m3[3] = t0.w; m3[4] = t1.x; m3[5] = t1.y; m3[6] = t1.z; m3[7] = t1.w; }
#pragma unroll
            for (int j = 0; j < 8; ++j) o[j] = z[j];
            if (gc > 0) unpack8(*(const u32x4*)(p - NZR), a); else {
#pragma unroll
                for (int j = 0; j < 8; ++j) a[j] = 0.f; }
#pragma unroll
            for (int j = 0; j < 8; ++j) o[j] += m0[j] * (a[j] - z[j]);
            if (gc < 63) unpack8(*(const u32x4*)(p + NZR), a); else {
#pragma unroll
                for (int j = 0; j < 8; ++j) a[j] = 0.f; }
#pragma unroll
            for (int j = 0; j < 8; ++j) o[j] += m1[j] * (a[j] - z[j]);
            if (gr > 0) unpack8(*(const u32x4*)(p - (size_t)64 * NZR), a); else {
#pragma unroll
                for (int j = 0; j < 8; ++j) a[j] = 0.f; }
#pragma unroll
            for (int j = 0; j < 8; ++j) o[j] += m2[j] * (a[j] - z[j]);
            if (gr < 63) unpack8(*(const u32x4*)(p + (size_t)64 * NZR), a); else {
#pragma unroll
                for (int j = 0; j < 8; ++j) a[j] = 0.f; }
#pragma unroll
            for (int j = 0; j < 8; ++j) o[j] += m3[j] * (a[j] - z[j]);
            if (c0 >= 3200) {
                u32x4 w; w.x = pk2(sigmoidf_(o[0]), sigmoidf_(o[1])); w.y = pk2(sigmoidf_(o[2]), sigmoidf_(o[3])); w.z = pk2(sigmoidf_(o[4]), sigmoidf_(o[5])); w.w = pk2(sigmoidf_(o[6]), sigmoidf_(o[7]));
                *(u32x4*)(XG + (size_t)row * 256 + (c0 - 3200)) = w;
                *(u32x4*)(XG + (size_t)row * 256 + 128 + (c0 - 3200)) = (u32x4){0u, 0u, 0u, 0u};
            }
        } else {
            const int tc = (row - ML) & (TC - 1);
#pragma unroll
            for (int j = 0; j < 8; ++j) o[j] = z[j];
            if (tc > 0) unpack8(*(const u32x4*)(p - NZR), a); else {
#pragma unroll
                for (int j = 0; j < 8; ++j) a[j] = 0.f; }
#pragma unroll
            for (int j = 0; j < 8; ++j) o[j] += m0[j] * (a[j] - z[j]);
            if (tc < TC - 1) unpack8(*(const u32x4*)(p + NZR), a); else {
#pragma unroll
                for (int j = 0; j < 8; ++j) a[j] = 0.f; }
#pragma unroll
            for (int j = 0; j < 8; ++j) o[j] += m1[j] * (a[j] - z[j]);
        }
        if (c0 >= 3072 && c0 < 3136) {
#pragma unroll
            for (int j = 0; j < 8; ++j) o[j] = tanhf(o[j]); }
        {
            const bool isk = c0 >= 1024 && c0 < 2048; float ss = 0.f;
            if (isk) { const f32x4 k0 = *(const f32x4*)(F.in[I_KK] + c0 - 1024), k1 = *(const f32x4*)(F.in[I_KK] + c0 - 1020);
                const float t0 = o[0] * k0.x, t1 = o[1] * k0.y, t2 = o[2] * k0.z, t3 = o[3] * k0.w, t4 = o[4] * k1.x, t5 = o[5] * k1.y, t6 = o[6] * k1.z, t7 = o[7] * k1.w;
                ss = ((t0 * t0 + t1 * t1) + (t2 * t2 + t3 * t3)) + ((t4 * t4 + t5 * t5) + (t6 * t6 + t7 * t7)); }
            ss += __shfl_xor(ss, 1); ss += __shfl_xor(ss, 2); ss += __shfl_xor(ss, 4);
            if (isk && (ch & 7) == 0) RN[(size_t)row * 16 + ((c0 - 1024) >> 6)] = 1.0f / fmaxf(sqrtf(ss), 1e-12f);
        }
        u32x4 w; w.x = pk2(o[0], o[1]); w.y = pk2(o[2], o[3]); w.z = pk2(o[4], o[5]); w.w = pk2(o[6], o[7]);
        *(u32x4*)(ZS + (size_t)row * NZR + c0) = w;
    }
}

constexpr int RC = 32;
__device__ __forceinline__ void red16x2(float& a, float& b) {
    asm volatile("s_nop 1\n\t"
                 "v_add_f32_dpp %0, %0, %0 quad_perm:[1,0,3,2] row_mask:0xf bank_mask:0xf bound_ctrl:1\n\t"
                 "v_add_f32_dpp %1, %1, %1 quad_perm:[1,0,3,2] row_mask:0xf bank_mask:0xf bound_ctrl:1\n\t"
                 "s_nop 0\n\t"
                 "v_add_f32_dpp %0, %0, %0 quad_perm:[2,3,0,1] row_mask:0xf bank_mask:0xf bound_ctrl:1\n\t"
                 "v_add_f32_dpp %1, %1, %1 quad_perm:[2,3,0,1] row_mask:0xf bank_mask:0xf bound_ctrl:1\n\t"
                 "s_nop 0\n\t"
                 "v_add_f32_dpp %0, %0, %0 row_half_mirror row_mask:0xf bank_mask:0xf bound_ctrl:1\n\t"
                 "v_add_f32_dpp %1, %1, %1 row_half_mirror row_mask:0xf bank_mask:0xf bound_ctrl:1\n\t"
                 "s_nop 0\n\t"
                 "v_add_f32_dpp %0, %0, %0 row_mirror row_mask:0xf bank_mask:0xf bound_ctrl:1\n\t"
                 "v_add_f32_dpp %1, %1, %1 row_mirror row_mask:0xf bank_mask:0xf bound_ctrl:1\n\t"
                 "s_nop 0"
                 : "+v"(a), "+v"(b));
}
__device__ __forceinline__ void red16x4(float& a, float& b, float& c, float& d) {
    asm volatile("s_nop 1\n\t"
                 "v_add_f32_dpp %0, %0, %0 quad_perm:[1,0,3,2] row_mask:0xf bank_mask:0xf bound_ctrl:1\n\t"
                 "v_add_f32_dpp %1, %1, %1 quad_perm:[1,0,3,2] row_mask:0xf bank_mask:0xf bound_ctrl:1\n\t"
                 "v_add_f32_dpp %2, %2, %2 quad_perm:[1,0,3,2] row_mask:0xf bank_mask:0xf bound_ctrl:1\n\t"
                 "v_add_f32_dpp %3, %3, %3 quad_perm:[1,0,3,2] row_mask:0xf bank_mask:0xf bound_ctrl:1\n\t"
                 "v_add_f32_dpp %0, %0, %0 quad_perm:[2,3,0,1] row_mask:0xf bank_mask:0xf bound_ctrl:1\n\t"
                 "v_add_f32_dpp %1, %1, %1 quad_perm:[2,3,0,1] row_mask:0xf bank_mask:0xf bound_ctrl:1\n\t"
                 "v_add_f32_dpp %2, %2, %2 quad_perm:[2,3,0,1] row_mask:0xf bank_mask:0xf bound_ctrl:1\n\t"
                 "v_add_f32_dpp %3, %3, %3 quad_perm:[2,3,0,1] row_mask:0xf bank_mask:0xf bound_ctrl:1\n\t"
                 "v_add_f32_dpp %0, %0, %0 row_half_mirror row_mask:0xf bank_mask:0xf bound_ctrl:1\n\t"
                 "v_add_f32_dpp %1, %1, %1 row_half_mirror row_mask:0xf bank_mask:0xf bound_ctrl:1\n\t"
                 "v_add_f32_dpp %2, %2, %2 row_half_mirror row_mask:0xf bank_mask:0xf bound_ctrl:1\n\t"
                 "v_add_f32_dpp %3, %3, %3 row_half_mirror row_mask:0xf bank_mask:0xf bound_ctrl:1\n\t"
                 "v_add_f32_dpp %0, %0, %0 row_mirror row_mask:0xf bank_mask:0xf bound_ctrl:1\n\t"
                 "v_add_f32_dpp %1, %1, %1 row_mirror row_mask:0xf bank_mask:0xf bound_ctrl:1\n\t"
                 "v_add_f32_dpp %2, %2, %2 row_mirror row_mask:0xf bank_mask:0xf bound_ctrl:1\n\t"
                 "v_add_f32_dpp %3, %3, %3 row_mirror row_mask:0xf bank_mask:0xf bound_ctrl:1\n\t"
                 "s_nop 0"
                 : "+v"(a), "+v"(b), "+v"(c), "+v"(d));
}
__device__ __forceinline__ void p4_rwkv_scan(const Frame& F) {
    const bf16_t* ZS = (const bf16_t*)(F.ws + WS_ZRS);
    float* BON = (float*)(F.ws + WS_BON);
    const float* RN = (const float*)(F.ws + WS_RN);
    LAS float* PRM = (LAS float*)F.lds;
    LAS float* BONL = PRM + 320;
    LAS float* SV = PRM + 512;
    LAS float* YB = SV + RC * 384;
    const int tid = F.tid, lane = F.lane, w8 = F.wave;
    const int fr = lane & 15, fq = lane >> 4, tt = w8 >> 2, ct = w8 & 3;
    for (int cid = F.bid; cid < 256; cid += F.G) {
        const int b = cid >> 5, h = (cid >> 1) & 15, d = cid & 1;
        bf16_t* Yd = (bf16_t*)(F.ws + (d ? WS_YB : WS_YF));
        __syncthreads();
        if (tid < 64) { PRM[tid] = F.in[I_W0][d * 1024 + h * 64 + tid]; PRM[64 + tid] = F.in[I_A0][d * 1024 + h * 64 + tid];
            PRM[128 + tid] = F.in[I_KK][h * 64 + tid]; PRM[192 + tid] = F.in[I_KA][h * 64 + tid]; PRM[256 + tid] = F.in[I_RK][h * 64 + tid]; }
        if (tid < 32) BONL[tid] = 0.f;
        bf16x8 aW[2], aA[2];
#pragma unroll
        for (int ks = 0; ks < 2; ++ks)
#pragma unroll
            for (int jj = 0; jj < 8; ++jj) { const int j = 32 * ks + 8 * fq + jj; const size_t o = ((size_t)(d * 64 + j)) * 1024 + h * 64 + 16 * ct + fr;
                aW[ks][jj] = (short)f2bf(F.in[I_WUP][o]); aA[ks][jj] = (short)f2bf(F.in[I_AUP][o]); }
        float S0[4] = {0.f, 0.f, 0.f, 0.f}, S1[4] = {0.f, 0.f, 0.f, 0.f};
        const int rp = lane >> 4, q = lane & 15, v0 = 8 * w8 + 2 * rp;
        const int tokl = 16 * tt + fr;
        const int psidx = d ? (RC - 1 - tokl) : tokl;
        const int tl = tid >> 4, q16 = tid & 15;
        const int fsidx = d ? (RC - 1 - tl) : tl;
        int prev_row0 = -1;
        constexpr int NCH = (TC + T) / RC;
        auto chunk_row0 = [&](int ci) { const bool ic = ci < TC / RC; const int cj = ic ? ci : ci - TC / RC, nch = ic ? TC / RC : T / RC;
            const int pos = d ? (nch - 1 - cj) : cj; return (ic ? ML + b * TC : b * T) + pos * RC; };
        u32x4 tw0, tw1, xa0, xa1; u32x2 gr_, gk_, gv_; float rnv;
#define R_PREFETCH(ci_) do { const int r_ = chunk_row0(ci_) + tokl; const bf16_t* p_ = ZS + (size_t)r_ * NZR; \
            tw0 = *(const u32x4*)(p_ + 3072 + 8 * fq); tw1 = *(const u32x4*)(p_ + 3104 + 8 * fq); xa0 = *(const u32x4*)(p_ + 3136 + 8 * fq); xa1 = *(const u32x4*)(p_ + 3168 + 8 * fq); \
            gr_ = *(const u32x2*)(p_ + h * 64 + 16 * ct + 4 * fq); gk_ = *(const u32x2*)(p_ + 1024 + h * 64 + 16 * ct + 4 * fq); gv_ = *(const u32x2*)(p_ + 2048 + h * 64 + 16 * ct + 4 * fq); \
            rnv = RN[(size_t)r_ * 16 + h]; } while (0)
        R_PREFETCH(0);
        __syncthreads();
        for (int ci = 0; ci <= NCH; ++ci) {
            __syncthreads();
            if (prev_row0 >= 0) {
                const f32x4 y = *(const LAS f32x4*)(YB + fsidx * 64 + 4 * q16);
                u32x2 o; o.x = pk2(y.x, y.y); o.y = pk2(y.z, y.w);
                *(u32x2*)(Yd + (size_t)(prev_row0 + tl) * D + h * 64 + 4 * q16) = o;
            }
            if (ci == NCH) break;
            const bool isctx = ci < TC / RC;
            const int row0 = chunk_row0(ci);
            {
                f32x4 zw = (f32x4){0.f, 0.f, 0.f, 0.f}, za = (f32x4){0.f, 0.f, 0.f, 0.f};
                zw = __builtin_amdgcn_mfma_f32_16x16x32_bf16(aW[0], __builtin_bit_cast(bf16x8, tw0), zw, 0, 0, 0);
                zw = __builtin_amdgcn_mfma_f32_16x16x32_bf16(aW[1], __builtin_bit_cast(bf16x8, tw1), zw, 0, 0, 0);
                za = __builtin_amdgcn_mfma_f32_16x16x32_bf16(aA[0], __builtin_bit_cast(bf16x8, xa0), za, 0, 0, 0);
                za = __builtin_amdgcn_mfma_f32_16x16x32_bf16(aA[1], __builtin_bit_cast(bf16x8, xa1), za, 0, 0, 0);
                const int c = 16 * ct + 4 * fq;
                const f32x4 w0v = *(const LAS f32x4*)(PRM + c), a0v = *(const LAS f32x4*)(PRM + 64 + c), kkw = *(const LAS f32x4*)(PRM + 128 + c),
                            kav = *(const LAS f32x4*)(PRM + 192 + c), rkv = *(const LAS f32x4*)(PRM + 256 + c);
                const float kr[4] = {bflo(gk_.x), bfhi(gk_.x), bflo(gk_.y), bfhi(gk_.y)};
                const float rr[4] = {bflo(gr_.x), bfhi(gr_.x), bflo(gr_.y), bfhi(gr_.y)};
                f32x4 okk, ow, ob, okd, orr, ov; float bon = 0.f;
#pragma unroll
                for (int i = 0; i < 4; ++i) {
                    const float kk = kr[i] * kkw[i] * rnv;
                    const float sw = sigmoidf_(zw[i] + w0v[i]);
                    const float dec = __expf(-0.6065306597126334f * sw);
                    const float a = sigmoidf_(za[i] + a0v[i]);
                    const float kd = kr[i] * (1.0f + (a - 1.0f) * kav[i]);
                    bon += rr[i] * kd * rkv[i];
                    okk[i] = kk; ow[i] = dec; ob[i] = kk * a; okd[i] = kd; orr[i] = rr[i];
                }
                ov = (f32x4){bflo(gv_.x), bfhi(gv_.x), bflo(gv_.y), bfhi(gv_.y)};
                if (!isctx) atomicAdd((float*)(BONL + tokl), bon);
                LAS float* sv = SV + psidx * 384 + c;
                *(LAS f32x4*)(sv) = okk; *(LAS f32x4*)(sv + 64) = ow; *(LAS f32x4*)(sv + 128) = ob; *(LAS f32x4*)(sv + 192) = okd; *(LAS f32x4*)(sv + 256) = orr; *(LAS f32x4*)(sv + 320) = ov;
            }
            if (ci + 1 < NCH) R_PREFETCH(ci + 1);
            __syncthreads();
            if (tid < 32 && !isctx) { BON[((size_t)d * ML + row0 + tid) * 16 + h] = BONL[tid]; BONL[tid] = 0.f; }
            {
                f32x4 kkA, wA, bA, kA, rA, kkB, wB, bB, kB, rB; f32x2 vA, vB;
#define R_LOAD(P, s_) do { const LAS float* base_ = SV + (s_) * 384; kk##P = *(const LAS f32x4*)(base_ + 4 * q); w##P = *(const LAS f32x4*)(base_ + 64 + 4 * q); b##P = *(const LAS f32x4*)(base_ + 128 + 4 * q); \
                    k##P = *(const LAS f32x4*)(base_ + 192 + 4 * q); r##P = *(const LAS f32x4*)(base_ + 256 + 4 * q); v##P = *(const LAS f32x2*)(base_ + 320 + v0); } while (0)
#define R_DOT(S_, x_) ((S_[0] * x_.x + S_[1] * x_.y) + (S_[2] * x_.z + S_[3] * x_.w))
#define R_STEP(P, N, s_) do { R_LOAD(N, (s_) + 1); \
                    red16x4(p0, p1, yq0, yq1); \
                    if ((s_) > 0 && q == 0) *(LAS f32x2*)(YB + ((s_) - 1) * 64 + v0) = (f32x2){yq0, yq1}; \
                    _Pragma("unroll") for (int j = 0; j < 4; ++j) { S0[j] = S0[j] * w##P[j] + (v##P.x * k##P[j] - p0 * b##P[j]); S1[j] = S1[j] * w##P[j] + (v##P.y * k##P[j] - p1 * b##P[j]); } \
                    yq0 = R_DOT(S0, r##P); yq1 = R_DOT(S1, r##P); p0 = R_DOT(S0, kk##N); p1 = R_DOT(S1, kk##N); } while (0)
                R_LOAD(A, 0);
                float p0 = R_DOT(S0, kkA), p1 = R_DOT(S1, kkA), yq0 = 0.f, yq1 = 0.f;
#pragma unroll 1
                for (int s = 0; s < RC; s += 2) { R_STEP(A, B, s); R_STEP(B, A, s + 1); }
                red16x2(yq0, yq1);
                if (q == 0) *(LAS f32x2*)(YB + (RC - 1) * 64 + v0) = (f32x2){yq0, yq1};
#undef R_LOAD
#undef R_DOT
#undef R_STEP
            }
            prev_row0 = isctx ? -1 : row0;
        }
#undef R_PREFETCH
    }
}

__device__ __forceinline__ void p5_rwkv_norm(const Frame& F) {
    bf16_t* YF = (bf16_t*)(F.ws + WS_YF); const bf16_t* YBk = (const bf16_t*)(F.ws + WS_YB); const bf16_t* ZS = (const bf16_t*)(F.ws + WS_ZRS);
    const float* BON = (const float*)(F.ws + WS_BON);
    const float* lnw = F.in[I_LNW]; const float* lnb = F.in[I_LNB];
    const size_t total = (size_t)ML * 256;
    for (size_t i = (size_t)F.bid * 512 + F.tid; i < total; i += (size_t)F.G * 512) {
        const int row = (int)(i >> 8), c = ((int)i & 255) * 4, h = c >> 6;
        const u32x2 a = *(const u32x2*)(YF + (size_t)row * D + c), b = *(const u32x2*)(YBk + (size_t)row * D + c);
        float y[4] = {bflo(a.x) + bflo(b.x), bfhi(a.x) + bfhi(b.x), bflo(a.y) + bflo(b.y), bfhi(a.y) + bfhi(b.y)};
        const float mean = sum16((y[0] + y[1]) + (y[2] + y[3])) * (1.f / 64.f);
        float q = 0.f;
#pragma unroll
        for (int j = 0; j < 4; ++j) { y[j] -= mean; q += y[j] * y[j]; }
        const float rstd = 1.0f / sqrtf(sum16(q) * (1.f / 64.f) + GN_EPS);
        const float bon = BON[(size_t)row * 16 + h] + BON[((size_t)ML + row) * 16 + h];
        const u32x2 vw = *(const u32x2*)(ZS + (size_t)row * NZR + 2048 + c);
        const float v[4] = {bflo(vw.x), bfhi(vw.x), bflo(vw.y), bfhi(vw.y)};
        const f32x4 lw = *(const f32x4*)(lnw + c), lb = *(const f32x4*)(lnb + c);
        float o[4];
#pragma unroll
        for (int j = 0; j < 4; ++j) o[j] = y[j] * rstd * lw[j] + lb[j] + bon * v[j];
        u32x2 w; w.x = pk2(o[0], o[1]); w.y = pk2(o[2], o[3]);
        *(u32x2*)(YF + (size_t)row * D + c) = w;
    }
}

constexpr int HC = 64;
constexpr int H_RAWQ = 0, H_RAWF = 16384, H_RAWI = 32768;
constexpr int H_PL = 0;
constexpr int H_TOT = 40960;
constexpr int H_DEC = H_TOT + 2048;
constexpr int H_QIN = H_DEC + 1024, H_KIN = H_QIN + 17408, H_QB = H_KIN + 17408;
constexpr int H_KINT = H_QB + 17408;
constexpr int H_VT = H_KINT + 18432;
constexpr int H_ST = H_VT + 9216;
constexpr int H_OL = H_ST + 17408;
constexpr int H_END = H_OL + 9216;
static_assert(H_END <= LDS_BYTES - 16, "HGRN2 LDS overflow");
__device__ __forceinline__ void p8_hgrn_scan(const Frame& F) {
    const bf16_t* ZH = (const bf16_t*)(F.ws + WS_ZH);
    LAS unsigned char* L = F.lds;
    const int tid = F.tid, lane = F.lane, w8 = F.wave;
    const float* hglb = F.in[I_HGLB];
    const int fr = lane & 15, fq = lane >> 4;
    for (int cid = F.bid; cid < 256; cid += F.G) {
        const int b = cid >> 5, hh = (cid >> 2) & 7, d = (cid >> 1) & 1, vh = cid & 1;
        bf16_t* Od = (bf16_t*)(F.ws + (d ? WS_OB : WS_OF));
        const int k1 = tid & 127, seg = tid >> 7;
        const float lbk = sigmoidf_(hglb[hh * 128 + k1] - hglb[1024 + hh * 128 + k1]);
        f32x4 Sreg[4];
#pragma unroll
        for (int i = 0; i < 4; ++i) Sreg[i] = (f32x4){0.f, 0.f, 0.f, 0.f};
        __syncthreads();
        for (int i = tid; i < 17408 / 4; i += 512) ((LAS unsigned*)(L + H_ST))[i] = 0u;
        constexpr int NCH = (TC + T) / HC;
        u32x4 pq0, pq1, pf0, pf1, pi0;
        auto chunk_row0 = [&](int ci) { const bool isctx = ci < TC / HC; const int cj = isctx ? ci : ci - TC / HC, nch = isctx ? TC / HC : T / HC;
            const int pos = d ? (nch - 1 - cj) : cj; return (isctx ? ML + b * TC : b * T) + pos * HC; };
#define H_PREFETCH(ci_) do { const int r0_ = chunk_row0(ci_); \
            { const int st = tid >> 4, kc = tid & 15; const bf16_t* g0 = ZH + (size_t)(r0_ + (d ? HC - 1 - st : st)) * NZH + hh * 128 + 8 * kc; \
              const bf16_t* g1 = ZH + (size_t)(r0_ + (d ? HC - 1 - (st + 32) : (st + 32))) * NZH + hh * 128 + 8 * kc; \
              pq0 = *(const u32x4*)g0; pq1 = *(const u32x4*)g1; pf0 = *(const u32x4*)(g0 + (d ? 2048 : 1024)); pf1 = *(const u32x4*)(g1 + (d ? 2048 : 1024)); } \
            { const int st = tid >> 3, vc = tid & 7; pi0 = *(const u32x4*)(ZH + (size_t)(r0_ + (d ? HC - 1 - st : st)) * NZH + 3072 + hh * 128 + vh * 64 + 8 * vc); } } while (0)
        H_PREFETCH(0);
        for (int ci = 0; ci < NCH; ++ci) {
            const bool isctx = ci < TC / HC;
            const int row0 = chunk_row0(ci);
            { const int st = tid >> 4, kc = tid & 15;
              *(LAS u32x4*)(L + H_RAWQ + (st * 128 + 8 * kc) * 2) = pq0; *(LAS u32x4*)(L + H_RAWQ + ((st + 32) * 128 + 8 * kc) * 2) = pq1;
              *(LAS u32x4*)(L + H_RAWF + (st * 128 + 8 * kc) * 2) = pf0; *(LAS u32x4*)(L + H_RAWF + ((st + 32) * 128 + 8 * kc) * 2) = pf1; }
            { const int st = tid >> 3, vc = tid & 7; *(LAS u32x4*)(L + H_RAWI + (st * 64 + 8 * vc) * 2) = pi0; }
            if (ci + 1 < NCH) H_PREFETCH(ci + 1);
            __syncthreads();
            float cc[16], kfv[16], qv[16];
            { float c = 0.f;
#pragma unroll
              for (int j = 0; j < 16; ++j) { const int st = 16 * seg + j;
                  const float fz = __builtin_bit_cast(float, (unsigned)(*(const LAS bf16_t*)(L + H_RAWF + (st * 128 + k1) * 2)) << 16);
                  qv[j] = __builtin_bit_cast(float, (unsigned)(*(const LAS bf16_t*)(L + H_RAWQ + (st * 128 + k1) * 2)) << 16);
                  const float f = lbk + (1.0f - lbk) * sigmoidf_(fz);
                  c += __logf(f); cc[j] = c; kfv[j] = 1.0f - f; }
              ((LAS float*)(L + H_TOT))[seg * 128 + k1] = c; }
            __syncthreads();
            { const LAS float* TOT = (const LAS float*)(L + H_TOT);
              const float t0 = TOT[k1], t1 = TOT[128 + k1], t2 = TOT[256 + k1], t3 = TOT[384 + k1];
              const float off = (seg > 0 ? t0 : 0.f) + (seg > 1 ? t1 : 0.f) + (seg > 2 ? t2 : 0.f);
              const float bref = t0 + t1, blast = (t0 + t1) + (t2 + t3);
              unsigned kp[8];
#pragma unroll
              for (int j = 0; j < 16; ++j) { const int st = 16 * seg + j; const float bb = cc[j] + off;
                  const float eq = __expf(bb - bref), ek = __expf(bref - bb), eb = __expf(bb);
                  const unsigned qin = f2bf(qv[j] * eq), kin = f2bf(kfv[j] * ek), qb = f2bf(qv[j] * eb);
                  *(LAS bf16_t*)(L + H_QIN + (st * 136 + k1) * 2) = (bf16_t)qin; *(LAS bf16_t*)(L + H_KIN + (st * 136 + k1) * 2) = (bf16_t)kin; *(LAS bf16_t*)(L + H_QB + (st * 136 + k1) * 2) = (bf16_t)qb;
                  if (j & 1) kp[j >> 1] |= kin << 16; else kp[j >> 1] = kin; }
              *(LAS u32x4*)(L + H_KINT + (k1 * 72 + 16 * seg) * 2) = (u32x4){kp[0], kp[1], kp[2], kp[3]};
              *(LAS u32x4*)(L + H_KINT + (k1 * 72 + 16 * seg + 8) * 2) = (u32x4){kp[4], kp[5], kp[6], kp[7]};
              if (seg == 0) { ((LAS float*)(L + H_DEC))[k1] = __expf(blast); ((LAS float*)(L + H_DEC))[128 + k1] = __expf(blast - bref); } }
            { const int v = tid & 63, s8 = tid >> 6; unsigned vp[4];
#pragma unroll
              for (int j = 0; j < 8; ++j) { const unsigned x = *(const LAS bf16_t*)(L + H_RAWI + ((8 * s8 + j) * 64 + v) * 2); if (j & 1) vp[j >> 1] |= x << 16; else vp[j >> 1] = x; }
              *(LAS u32x4*)(L + H_VT + (v * 72 + 8 * s8) * 2) = (u32x4){vp[0], vp[1], vp[2], vp[3]}; }
            __syncthreads();
            if (!isctx) {
                const int tt = w8 >> 1;
#pragma unroll
                for (int u = 0; u < 2; ++u) { const int stl = 2 * (w8 & 1) + u; f32x4 acc = (f32x4){0.f, 0.f, 0.f, 0.f};
                    if (stl <= tt) {
#pragma unroll
                        for (int ks = 0; ks < 4; ++ks) { const bf16x8 a = *(const LAS bf16x8*)(L + H_QIN + ((16 * tt + fr) * 136 + 32 * ks + 8 * fq) * 2);
                            const bf16x8 bq = *(const LAS bf16x8*)(L + H_KIN + ((16 * stl + fr) * 136 + 32 * ks + 8 * fq) * 2);
                            acc = __builtin_amdgcn_mfma_f32_16x16x32_bf16(a, bq, acc, 0, 0, 0); } }
#pragma unroll
                    for (int r = 0; r < 4; ++r) { const int t = 16 * tt + 4 * fq + r, s = 16 * stl + fr; const float pv = (s <= t && stl <= tt) ? acc[r] : 0.f;
                        *(LAS bf16_t*)(L + H_PL + (t * 72 + s) * 2) = (bf16_t)f2bf(pv); } }
            }
            __syncthreads();
            if (!isctx) {
                const int tt = w8 >> 1;
#pragma unroll
                for (int u = 0; u < 2; ++u) { const int vt = 2 * (w8 & 1) + u; f32x4 acc = (f32x4){0.f, 0.f, 0.f, 0.f};
#pragma unroll
                    for (int ks = 0; ks < 2; ++ks) { const bf16x8 a = *(const LAS bf16x8*)(L + H_PL + ((16 * tt + fr) * 72 + 32 * ks + 8 * fq) * 2);
                        const bf16x8 bv = *(const LAS bf16x8*)(L + H_VT + ((16 * vt + fr) * 72 + 32 * ks + 8 * fq) * 2);
                        acc = __builtin_amdgcn_mfma_f32_16x16x32_bf16(a, bv, acc, 0, 0, 0); }
#pragma unroll
                    for (int ks = 0; ks < 4; ++ks) { const bf16x8 a = *(const LAS bf16x8*)(L + H_QB + ((16 * tt + fr) * 136 + 32 * ks + 8 * fq) * 2);
                        const bf16x8 bs = *(const LAS bf16x8*)(L + H_ST + ((16 * vt + fr) * 136 + 32 * ks + 8 * fq) * 2);
                        acc = __builtin_amdgcn_mfma_f32_16x16x32_bf16(a, bs, acc, 0, 0, 0); }
#pragma unroll
                    for (int r = 0; r < 4; ++r) *(LAS bf16_t*)(L + H_OL + ((16 * tt + 4 * fq + r) * 72 + 16 * vt + fr) * 2) = (bf16_t)f2bf(acc[r]); }
            }
            { const LAS float* DEC = (const LAS float*)(L + H_DEC);
              const f32x4 dk = *(const LAS f32x4*)(DEC + 16 * w8 + 4 * fq), e2 = *(const LAS f32x4*)(DEC + 128 + 16 * w8 + 4 * fq);
#pragma unroll
              for (int vt = 0; vt < 4; ++vt) { f32x4 acc = (f32x4){0.f, 0.f, 0.f, 0.f};
#pragma unroll
                  for (int ks = 0; ks < 2; ++ks) { const bf16x8 a = *(const LAS bf16x8*)(L + H_KINT + ((16 * w8 + fr) * 72 + 32 * ks + 8 * fq) * 2);
                      const bf16x8 bv = *(const LAS bf16x8*)(L + H_VT + ((16 * vt + fr) * 72 + 32 * ks + 8 * fq) * 2);
                      acc = __builtin_amdgcn_mfma_f32_16x16x32_bf16(a, bv, acc, 0, 0, 0); }
                  Sreg[vt] = dk * Sreg[vt] + e2 * acc; } }
            __syncthreads();
#pragma unroll
            for (int vt = 0; vt < 4; ++vt) { u32x2 o; o.x = pk2(Sreg[vt][0], Sreg[vt][1]); o.y = pk2(Sreg[vt][2], Sreg[vt][3]);
                *(LAS u32x2*)(L + H_ST + ((16 * vt + fr) * 136 + 16 * w8 + 4 * fq) * 2) = o; }
            if (!isctx) { const int st = tid >> 3, vc = tid & 7;
                const u32x4 o = *(const LAS u32x4*)(L + H_OL + (st * 72 + 8 * vc) * 2);
                *(u32x4*)(Od + (size_t)(row0 + (d ? HC - 1 - st : st)) * D + hh * 128 + vh * 64 + 8 * vc) = o; }
        }
#undef H_PREFETCH
        __syncthreads();
    }
}

__device__ __forceinline__ void p10_hgrn_read(const Frame& F) {
    bf16_t* OF = (bf16_t*)(F.ws + WS_OF); const bf16_t* OBk = (const bf16_t*)(F.ws + WS_OB); const bf16_t* ZG = (const bf16_t*)(F.ws + WS_ZG);
    const float* nw = F.in[I_HGNW];
    const size_t total = (size_t)ML * 256;
    for (size_t i = (size_t)F.bid * 512 + F.tid; i < total; i += (size_t)F.G * 512) {
        const int row = (int)(i >> 8), c = ((int)i & 255) * 4;
        const u32x2 a = *(const u32x2*)(OF + (size_t)row * D + c), b = *(const u32x2*)(OBk + (size_t)row * D + c);
        const float o[4] = {bflo(a.x) + bflo(b.x), bfhi(a.x) + bfhi(b.x), bflo(a.y) + bflo(b.y), bfhi(a.y) + bfhi(b.y)};
        const float ms = sum32((o[0] * o[0] + o[1] * o[1]) + (o[2] * o[2] + o[3] * o[3])) * (1.f / 128.f);
        const float rs = 1.0f / sqrtf(ms + RMS_EPS);
        const u32x2 gw = *(const u32x2*)(ZG + (size_t)row * NZG + c);
        const float g[4] = {bflo(gw.x), bfhi(gw.x), bflo(gw.y), bfhi(gw.y)};
        const f32x4 w = *(const f32x4*)(nw + c);
        float y[4];
#pragma unroll
        for (int j = 0; j < 4; ++j) y[j] = o[j] * rs * w[j] * (g[j] * sigmoidf_(g[j]));
        u32x2 ww; ww.x = pk2(y[0], y[1]); ww.y = pk2(y[2], y[3]);
        *(u32x2*)(OF + (size_t)row * D + c) = ww;
    }
}

template <bool COOP>
__device__ __forceinline__ void mk_body(const Args& args) {
    extern __shared__ __attribute__((aligned(16))) unsigned char lds_raw[];
    Frame F;
    F.lds = (LAS unsigned char*)lds_raw;
    F.tid = threadIdx.x; F.lane = F.tid & 63; F.wave = __builtin_amdgcn_readfirstlane(F.tid >> 6);
    F.G = gridDim.x; F.bid = blockIdx.x;
    F.in = args.in; F.ws = args.ws; F.dob = (unsigned char*)args.out;
    const int lo = args.ph_lo, hi = args.ph_hi;
    const float* MOD = (const float*)(F.ws + WS_MOD);
    const int gw = F.bid * 8 + F.wave, NGW = F.G * 8;
#define IN(k) (lo <= (k) && (k) < hi)
    XcdBarrier xbar; xbar.bar = (unsigned*)(F.ws + WS_CTL); xbar.x = 0; xbar.st = nullptr;
    if (COOP) {
        volatile LAS unsigned* st = (volatile LAS unsigned*)(F.lds + LDS_BYTES - 16);
        if (F.tid < 4) st[F.tid] = 0u;
        __syncthreads();
        xbar = xcd_barrier_post((unsigned*)(F.ws + WS_CTL), st);
    }
#define SEAM(k) do { if (COOP && IN(k) && IN((k) + 1)) { if ((k) == 0) cg::this_grid().sync(); else xcd_barrier(xbar); } } while (0)

    if (IN(0)) { p0_prologue(F); }
#if (MK_REPMASK >> 0) & 1
    if (COOP) cg::this_grid().sync();
    if (IN(0)) { p0_prologue(F); }
#endif
    SEAM(0);
    if (IN(1)) {
        bf16_t* H = (bf16_t*)(F.dob + DO_H);
        for (int m = gw; m < MR; m += NGW) {
            const bool lat = m < ML; const int b = lat ? (m >> 12) : 8;
            const float* xr = lat ? F.in[I_X] + (size_t)m * D : F.in[I_CTX] + (size_t)(m - ML) * D;
            modnorm_row(xr, F.in[I_N1W], MOD + b * 6144, MOD + b * 6144 + 1024, H + (size_t)m * D, F.lane);
        }
    }
#if (MK_REPMASK >> 1) & 1
    if (COOP) cg::this_grid().sync();
    if (IN(1)) {
        bf16_t* H = (bf16_t*)(F.dob + DO_H);
        for (int m = gw; m < MR; m += NGW) {
            const bool lat = m < ML; const int b = lat ? (m >> 12) : 8;
            const float* xr = lat ? F.in[I_X] + (size_t)m * D : F.in[I_CTX] + (size_t)(m - ML) * D;
            modnorm_row(xr, F.in[I_N1W], MOD + b * 6144, MOD + b * 6144 + 1024, H + (size_t)m * D, F.lane);
        }
    }
#endif
    SEAM(1);
    if (IN(2)) {
        pg8::Sched S; S.init(F.dob + DO_H, F.dob + DO_WIN, nullptr, nullptr, MR, NZR, D, F.G, F.bid, 1);
        pg8::EpiBf16 E{(bf16_t*)(F.ws + WS_R1), NZR};
        pg8::gemm_phase(F.lds, D, S, E);
    }
#if (MK_REPMASK >> 2) & 1
    if (COOP) cg::this_grid().sync();
    if (IN(2)) {
        pg8::Sched S; S.init(F.dob + DO_H, F.dob + DO_WIN, nullptr, nullptr, MR, NZR, D, F.G, F.bid, 1);
        pg8::EpiBf16 E{(bf16_t*)(F.ws + WS_R1), NZR};
        pg8::gemm_phase(F.lds, D, S, E);
    }
#endif
    SEAM(2);
    if (IN(3)) { p3_shift(F); }
#if (MK_REPMASK >> 3) & 1
    if (COOP) cg::this_grid().sync();
    if (IN(3)) { p3_shift(F); }
#endif
    SEAM(3);
    if (IN(4)) { p4_rwkv_scan(F); }
#if (MK_REPMASK >> 4) & 1
    if (COOP) cg::this_grid().sync();
    if (IN(4)) { p4_rwkv_scan(F); }
#endif
    SEAM(4);
    if (IN(5)) { p5_rwkv_norm(F); }
#if (MK_REPMASK >> 5) & 1
    if (COOP) cg::this_grid().sync();
    if (IN(5)) { p5_rwkv_norm(F); }
#endif
    SEAM(5);
    if (IN(6)) {
        pg8::Sched S; S.init(F.ws + WS_XGS, F.dob + DO_GUP, nullptr, nullptr, ML, D, 256, F.G, F.bid, 1);
        pg8::EpiMulBf16 E{(const bf16_t*)(F.ws + WS_YF), (bf16_t*)(F.ws + WS_YRW), D};
        pg8::gemm_phase(F.lds, 256, S, E);
    }
#if (MK_REPMASK >> 6) & 1
    if (COOP) cg::this_grid().sync();
    if (IN(6)) {
        pg8::Sched S; S.init(F.ws + WS_XGS, F.dob + DO_GUP, nullptr, nullptr, ML, D, 256, F.G, F.bid, 1);
        pg8::EpiMulBf16 E{(const bf16_t*)(F.ws + WS_YF), (bf16_t*)(F.ws + WS_YRW), D};
        pg8::gemm_phase(F.lds, 256, S, E);
    }
#endif
    SEAM(6);
    if (IN(7)) {
        pg8::Sched S; S.init(F.dob + DO_H, F.dob + DO_WIN + (size_t)NZR * D * 2, nullptr, nullptr, MR, NZH, D, F.G, F.bid, 1);
        pg8::EpiBf16 E{(bf16_t*)(F.ws + WS_ZH), NZH};
        pg8::gemm_phase(F.lds, D, S, E);
    }
#if (MK_REPMASK >> 7) & 1
    if (COOP) cg::this_grid().sync();
    if (IN(7)) {
        pg8::Sched S; S.init(F.dob + DO_H, F.dob + DO_WIN + (size_t)NZR * D * 2, nullptr, nullptr, MR, NZH, D, F.G, F.bid, 1);
        pg8::EpiBf16 E{(bf16_t*)(F.ws + WS_ZH), NZH};
        pg8::gemm_phase(F.lds, D, S, E);
    }
#endif
    SEAM(7);
    if (IN(8)) { p8_hgrn_scan(F); }
#if (MK_REPMASK >> 8) & 1
    if (COOP) cg::this_grid().sync();
    if (IN(8)) { p8_hgrn_scan(F); }
#endif
    SEAM(8);
    if (IN(9)) {
        pg8::Sched S; S.init(F.dob + DO_H, F.dob + DO_WIN + (size_t)(NZR + NZH) * D * 2, nullptr, nullptr, ML, NZG, D, F.G, F.bid, 1);
        pg8::EpiBf16 E{(bf16_t*)(F.ws + WS_ZG), NZG};
        pg8::gemm_phase(F.lds, D, S, E);
    }
#if (MK_REPMASK >> 9) & 1
    if (COOP) cg::this_grid().sync();
    if (IN(9)) {
        pg8::Sched S; S.init(F.dob + DO_H, F.dob + DO_WIN + (size_t)(NZR + NZH) * D * 2, nullptr, nullptr, ML, NZG, D, F.G, F.bid, 1);
        pg8::EpiBf16 E{(bf16_t*)(F.ws + WS_ZG), NZG};
        pg8::gemm_phase(F.lds, D, S, E);
    }
#endif
    SEAM(9);
    if (IN(10)) { p10_hgrn_read(F); }
#if (MK_REPMASK >> 10) & 1
    if (COOP) cg::this_grid().sync();
    if (IN(10)) { p10_hgrn_read(F); }
#endif
    SEAM(10);
    if (IN(11)) {
        pg8::Sched S; S.init(F.ws + WS_YRW, F.dob + DO_PA, F.ws + WS_OF, F.dob + DO_PB, ML, D, D, F.G, F.bid, 2);
        pg8::EpiMerge E{(const bf16_t*)(F.ws + WS_ZG), (bf16_t*)(F.ws + WS_MRG)};
        pg8::gemm_phase(F.lds, D, S, E);
    }
#if (MK_REPMASK >> 11) & 1
    if (COOP) cg::this_grid().sync();
    if (IN(11)) {
        pg8::Sched S; S.init(F.ws + WS_YRW, F.dob + DO_PA, F.ws + WS_OF, F.dob + DO_PB, ML, D, D, F.G, F.bid, 2);
        pg8::EpiMerge E{(const bf16_t*)(F.ws + WS_ZG), (bf16_t*)(F.ws + WS_MRG)};
        pg8::gemm_phase(F.lds, D, S, E);
    }
#endif
    SEAM(11);
    if (IN(12)) {
        pg8::Sched S; S.init(F.ws + WS_MRG, F.dob + DO_WO, nullptr, nullptr, ML, D, D, F.G, F.bid, 1);
        pg8::EpiResid E{F.in[I_X], (float*)(F.ws + WS_X1), MOD + 2048};
        pg8::gemm_phase(F.lds, D, S, E);
    }
#if (MK_REPMASK >> 12) & 1
    if (COOP) cg::this_grid().sync();
    if (IN(12)) {
        pg8::Sched S; S.init(F.ws + WS_MRG, F.dob + DO_WO, nullptr, nullptr, ML, D, D, F.G, F.bid, 1);
        pg8::EpiResid E{F.in[I_X], (float*)(F.ws + WS_X1), MOD + 2048};
        pg8::gemm_phase(F.lds, D, S, E);
    }
#endif
    SEAM(12);
    if (IN(13)) {
        const float* X1 = (const float*)(F.ws + WS_X1); bf16_t* H2 = (bf16_t*)(F.ws + WS_H2);
        for (int m = gw; m < ML; m += NGW) { const int b = m >> 12;
            modnorm_row(X1 + (size_t)m * D, F.in[I_N2W], MOD + b * 6144 + 3072, MOD + b * 6144 + 4096, H2 + (size_t)m * D, F.lane); }
    }
#if (MK_REPMASK >> 13) & 1
    if (COOP) cg::this_grid().sync();
    if (IN(13)) {
        const float* X1 = (const float*)(F.ws + WS_X1); bf16_t* H2 = (bf16_t*)(F.ws + WS_H2);
        for (int m = gw; m < ML; m += NGW) { const int b = m >> 12;
            modnorm_row(X1 + (size_t)m * D, F.in[I_N2W], MOD + b * 6144 + 3072, MOD + b * 6144 + 4096, H2 + (size_t)m * D, F.lane); }
    }
#endif
    SEAM(13);
    if (IN(14)) {
        pg8::Sched S; S.init(F.ws + WS_H2, F.dob + DO_FC1, nullptr, nullptr, ML, FF, D, F.G, F.bid, 1);
        pg8::EpiSqRelu E{(bf16_t*)(F.ws + WS_U), FF};
        pg8::gemm_phase(F.lds, D, S, E);
    }
#if (MK_REPMASK >> 14) & 1
    if (COOP) cg::this_grid().sync();
    if (IN(14)) {
        pg8::Sched S; S.init(F.ws + WS_H2, F.dob + DO_FC1, nullptr, nullptr, ML, FF, D, F.G, F.bid, 1);
        pg8::EpiSqRelu E{(bf16_t*)(F.ws + WS_U), FF};
        pg8::gemm_phase(F.lds, D, S, E);
    }
#endif
    SEAM(14);
    if (IN(15)) {
        pg8::Sched S; S.init(F.ws + WS_U, F.dob + DO_FC2, nullptr, nullptr, ML, D, FF, F.G, F.bid, 1);
        pg8::EpiResid E{(const float*)(F.ws + WS_X1), (float*)(F.ws + WS_X1), MOD + 5120};
        pg8::gemm_phase(F.lds, FF, S, E);
    }
#if (MK_REPMASK >> 15) & 1
    if (COOP) cg::this_grid().sync();
    if (IN(15)) {
        pg8::Sched S; S.init(F.ws + WS_U, F.dob + DO_FC2, nullptr, nullptr, ML, D, FF, F.G, F.bid, 1);
        pg8::EpiResid E{(const float*)(F.ws + WS_X1), (float*)(F.ws + WS_X1), MOD + 5120};
        pg8::gemm_phase(F.lds, FF, S, E);
    }
#endif
    SEAM(15);
    if (IN(16)) {
        const float* X2 = (const float*)(F.ws + WS_X1); const float* fw = F.in[I_FNW];
        for (int m = gw; m < ML; m += NGW) {
            const float* xr = X2 + (size_t)m * D; float* orow = args.out + (size_t)m * D;
            f32x4 v[4]; float s = 0.f;
#pragma unroll
            for (int j = 0; j < 4; ++j) { v[j] = *(const f32x4*)(xr + 4 * F.lane + 256 * j); s += (v[j].x * v[j].x + v[j].y * v[j].y) + (v[j].z * v[j].z + v[j].w * v[j].w); }
            const float rs = 1.0f / sqrtf(wave_sum(s) * (1.f / D) + RMS_EPS);
#pragma unroll
            for (int j = 0; j < 4; ++j) { const int c = 4 * F.lane + 256 * j; *(f32x4*)(orow + c) = v[j] * rs * *(const f32x4*)(fw + c); }
        }
    }
#if (MK_REPMASK >> 16) & 1
    if (COOP) cg::this_grid().sync();
    if (IN(16)) {
        const float* X2 = (const float*)(F.ws + WS_X1); const float* fw = F.in[I_FNW];
        for (int m = gw; m < ML; m += NGW) {
            const float* xr = X2 + (size_t)m * D; float* orow = args.out + (size_t)m * D;
            f32x4 v[4]; float s = 0.f;
#pragma unroll
            for (int j = 0; j < 4; ++j) { v[j] = *(const f32x4*)(xr + 4 * F.lane + 256 * j); s += (v[j].x * v[j].x + v[j].y * v[j].y) + (v[j].z * v[j].z + v[j].w * v[j].w); }
            const float rs = 1.0f / sqrtf(wave_sum(s) * (1.f / D) + RMS_EPS);
#pragma unroll
            for (int j = 0; j < 4; ++j) { const int c = 4 * F.lane + 256 * j; *(f32x4*)(orow + c) = v[j] * rs * *(const f32x4*)(fw + c); }
        }
    }
#endif

#undef IN
#undef SEAM
}

__global__ void __launch_bounds__(512, 2) mk_multi(Args args) { mk_body<false>(args); }
__global__ void __launch_bounds__(512, 2) mk_one(Args args) { mk_body<true>(args); }

extern "C" void kernel_launch(void* const* d_in, const int* in_sizes, int n_in, void* d_out, int out_size, void* d_ws, size_t ws_size, hipStream_t stream) {
    static int grid = 0;
    if (grid == 0) {
        if (n_in != 28 || out_size != ML * D || ws_size < WS_END) { fprintf(stderr, "kernel_launch: unexpected problem (n_in %d, out %d, ws %zu)\n", n_in, out_size, ws_size); grid = -1; return; }
        int dev = 0, cus = 0;
        if (hipGetDevice(&dev) != hipSuccess || hipDeviceGetAttribute(&cus, hipDeviceAttributeMultiprocessorCount, dev) != hipSuccess) { grid = -1; return; }
        (void)hipFuncSetAttribute((const void*)mk_multi, hipFuncAttributeMaxDynamicSharedMemorySize, LDS_BYTES);
        (void)hipFuncSetAttribute((const void*)mk_one, hipFuncAttributeMaxDynamicSharedMemorySize, LDS_BYTES);
        int per_cu = 0;
        (void)hipOccupancyMaxActiveBlocksPerMultiprocessor(&per_cu, (const void*)mk_one, 512, LDS_BYTES);
        (void)hipGetLastError();
        grid = cus;
        if (per_cu < 1) fprintf(stderr, "kernel_launch: occupancy query reports %d blocks per CU\n", per_cu);
    }
    if (grid < 0) return;
    (void)hipMemsetAsync((char*)d_ws + WS_CTL, 0, XCD_BAR_WORDS * 4, stream);
    Args a{};
    for (int i = 0; i < 28; ++i) a.in[i] = (const float*)d_in[i];
    a.out = (float*)d_out; a.ws = (unsigned char*)d_ws;
#if MK_ONE_LAUNCH
    a.ph_lo = 0; a.ph_hi = NPHASE;
    void* kargs[] = {&a};
    hipError_t e = hipLaunchCooperativeKernel((const void*)mk_one, dim3(grid), dim3(512), kargs, LDS_BYTES, stream);
    if (e != hipSuccess) fprintf(stderr, "cooperative launch failed: %s\n", hipGetErrorString(e));
#else
    for (int p = 0; p < NPHASE; ++p) { a.ph_lo = p; a.ph_hi = p + 1; hipLaunchKernelGGL(mk_multi, dim3(grid), dim3(512), LDS_BYTES, stream, a); }
#endif
}
```

```cpp
#include <hip/hip_runtime.h>
#include <hip/hip_cooperative_groups.h>
#include <cstdio>
#include <cstdint>
namespace cg = cooperative_groups;

#ifndef MK_ONE_LAUNCH
#define MK_ONE_LAUNCH 1
#endif
#ifndef MK_REPMASK
#define MK_REPMASK 0x0u
#endif

#define LAS __attribute__((address_space(3)))
typedef unsigned short bf16_t;
typedef short bf16x8 __attribute__((ext_vector_type(8)));
typedef float f32x4 __attribute__((ext_vector_type(4)));
typedef float f32x2 __attribute__((ext_vector_type(2)));
typedef unsigned u32x4 __attribute__((ext_vector_type(4)));
typedef unsigned u32x2 __attribute__((ext_vector_type(2)));

constexpr int D = 1024, NB = 8, T = 4096, TC = 256, GW = 64;
constexpr int ML = NB * T;
constexpr int MC = NB * TC;
constexpr int MR = ML + MC;
constexpr int NZR = 3328, NZH = 4096, NZG = 3072, NIN = 10496, FF = 4096;
constexpr float RMS_EPS = 1e-6f, GN_EPS = 64e-5f;

constexpr size_t MiB = 1u << 20;
constexpr size_t WS_CTL = 0, WS_MOD = 1 * MiB;
constexpr size_t WS_R1 = 2 * MiB;
constexpr size_t WS_YF = 2 * MiB, WS_YB = 66 * MiB, WS_YRW = 130 * MiB;
constexpr size_t WS_OF = 2 * MiB, WS_OB = 66 * MiB;
constexpr size_t WS_X1 = 2 * MiB;
constexpr size_t WS_H2 = 130 * MiB;
constexpr size_t WS_ZRS = 223 * MiB;
constexpr size_t WS_XGS = 444 * MiB;
constexpr size_t WS_BON = 460 * MiB;
constexpr size_t WS_ZH = 194 * MiB;
constexpr size_t WS_ZG = 194 * MiB;
constexpr size_t WS_MRG = 386 * MiB;
constexpr size_t WS_U = 194 * MiB;
constexpr size_t WS_RN = 464 * MiB;
constexpr size_t WS_END = 468 * MiB;
constexpr size_t DO_H = 0;
constexpr size_t DO_WIN = 68 * MiB;
constexpr size_t DO_PA = DO_WIN + (size_t)NIN * D * 2;
constexpr size_t DO_PB = DO_PA + 2 * MiB, DO_WO = DO_PB + 2 * MiB, DO_FC1 = DO_WO + 2 * MiB, DO_FC2 = DO_FC1 + 8 * MiB, DO_GUP = DO_FC2 + 8 * MiB;
constexpr size_t DO_END = DO_GUP + (size_t)1024 * 256 * 2;
static_assert(DO_END <= 128 * MiB, "d_out scratch overflow");

constexpr int LDS_BYTES = 152 * 1024;
constexpr int NPHASE = 17;

__device__ __forceinline__ unsigned f2bf(float f) { unsigned u = __builtin_bit_cast(unsigned, f); return (u + 0x7fffu + ((u >> 16) & 1u)) >> 16; }
__device__ __forceinline__ unsigned pk2(float lo, float hi) { return f2bf(lo) | (f2bf(hi) << 16); }
__device__ __forceinline__ float bflo(unsigned w) { return __builtin_bit_cast(float, w << 16); }
__device__ __forceinline__ float bfhi(unsigned w) { return __builtin_bit_cast(float, w & 0xffff0000u); }
__device__ __forceinline__ float sigmoidf_(float x) { return 1.0f / (1.0f + __expf(-x)); }
__device__ __forceinline__ float wave_sum(float v) {
#pragma unroll
    for (int o = 1; o < 64; o <<= 1) v += __shfl_xor(v, o);
    return v;
}
template <int CTRL> __device__ __forceinline__ float dpp_mov(float v) { return __builtin_bit_cast(float, __builtin_amdgcn_update_dpp(0, __builtin_bit_cast(int, v), CTRL, 0xf, 0xf, true)); }
__device__ __forceinline__ float sum16(float v) { v += dpp_mov<0xB1>(v); v += dpp_mov<0x4E>(v); v += dpp_mov<0x141>(v); v += dpp_mov<0x140>(v); return v; }
__device__ __forceinline__ float sum32(float v) { v = sum16(v); v += __shfl_xor(v, 16); return v; }


#define XB_TMO      128
#define XB_XCNT(j)  (256  + 64 * (j))
#define XB_XSUB(j)  (1280 + 64 * (j))
#define XB_XGEN(j)  (2304 + 64 * (j))
#define XB_TOP      3328
#define XB_TOPGEN   3392
#define XCD_BAR_WORDS 3456
#define XB_SPIN_CAP (1u << 18)
__device__ __forceinline__ unsigned xb_ld(unsigned* p)              { return __hip_atomic_load(p, __ATOMIC_RELAXED, __HIP_MEMORY_SCOPE_AGENT); }
__device__ __forceinline__ unsigned xb_add(unsigned* p, unsigned v) { return __hip_atomic_fetch_add(p, v, __ATOMIC_RELAXED, __HIP_MEMORY_SCOPE_AGENT); }
__device__ __forceinline__ unsigned xb_xcc_id() { return (unsigned)__builtin_amdgcn_s_getreg((3 << 11) | 20) & 0xFu; }
#define XB_SPIN(cond, bar) do { unsigned _sp = 0; while (cond) { __builtin_amdgcn_s_sleep(1); \
    if ((++_sp & 255u) == 0u) { if (xb_ld(&(bar)[XB_TMO])) break; if (_sp > XB_SPIN_CAP) { atomicAdd(&(bar)[XB_TMO], 1u); break; } } } } while (0)
struct XcdBarrier { unsigned* bar; unsigned x; volatile LAS unsigned* st; };
__device__ __forceinline__ XcdBarrier xcd_barrier_post(unsigned* bar, volatile LAS unsigned* st) {
    XcdBarrier b; b.bar = bar; b.x = xb_xcc_id(); b.st = st;
    if (threadIdx.x == 0) (void)xb_add(&bar[XB_XCNT(b.x)], 1u);
    return b;
}
__device__ __forceinline__ void xcd_barrier_complete(unsigned* bar, unsigned x, unsigned& nloc, unsigned& nx) {
    const unsigned G = gridDim.x * gridDim.y * gridDim.z;
    unsigned sum, cnt, mine, sp = 0u;
    for (;;) {
        sum = 0u; cnt = 0u; mine = 0u;
#pragma unroll
        for (unsigned j = 0; j < 16; ++j) { const unsigned c = xb_ld(&bar[XB_XCNT(j)]); sum += c; cnt += (c > 0u) ? 1u : 0u; mine = (j == x) ? c : mine; }
        if (sum == G) break;
        __builtin_amdgcn_s_sleep(1);
        if ((++sp & 255u) == 0u) { if (xb_ld(&bar[XB_TMO])) break; if (sp > XB_SPIN_CAP) { atomicAdd(&bar[XB_TMO], 1u); break; } }
    }
    nloc = mine > 0u ? mine : 1u; nx = cnt > 0u ? cnt : 1u;
}
__device__ __forceinline__ void xcd_barrier(const XcdBarrier& b) {
    asm volatile("s_waitcnt vmcnt(0)" ::: "memory");
    __syncthreads();
    if (threadIdx.x == 0) {
        unsigned* bar = b.bar;
        __builtin_amdgcn_s_waitcnt(0);
        unsigned nloc = b.st[0], nx = b.st[1];
        if (nloc == 0u) { xcd_barrier_complete(bar, b.x, nloc, nx); b.st[0] = nloc; b.st[1] = nx; }
        const unsigned old = xb_add(&bar[XB_XSUB(b.x)], 1u);
        const unsigned gen = old / nloc;
        if (old + 1u == (gen + 1u) * nloc) {
            __builtin_amdgcn_fence(__ATOMIC_RELEASE, "agent");
            asm volatile("s_waitcnt vmcnt(0)" ::: "memory");
            const unsigned og = xb_add(&bar[XB_TOP], 1u);
            const unsigned tg = og / nx;
            if (og + 1u == (tg + 1u) * nx) xb_add(&bar[XB_TOPGEN], 1u);
            else XB_SPIN(xb_ld(&bar[XB_TOPGEN]) == tg, bar);
            __builtin_amdgcn_fence(__ATOMIC_ACQUIRE, "agent");
            xb_add(&bar[XB_XGEN(b.x)], 1u);
            asm volatile("s_waitcnt vmcnt(0)" ::: "memory");
        } else {
            XB_SPIN(xb_ld(&bar[XB_XGEN(b.x)]) == gen, bar);
            __builtin_amdgcn_fence(__ATOMIC_ACQUIRE, "agent");
            asm volatile("s_waitcnt vmcnt(0)" ::: "memory");
        }
    }
    __syncthreads();
}

namespace pg8 {
constexpr int BM = 256, BK = 64, HALF = 128, HTB = HALF * BK * 2, STAGE_BYTES = 8 * HTB, NXCD = 8, WGM = 8;
__host__ __device__ __forceinline__ int lds_byte(int r, int c) { const int st = (r >> 4) * 2 + (c >> 5), rr = r & 15, cc = c & 31, ob = rr * 64 + cc * 2; return st * 1024 + (ob ^ (((ob >> 9) & 1) << 5)); }
__host__ __device__ __forceinline__ void stage_rc(int b, int& R, int& C) { const int st = b / 1024, sb = b % 1024, swz = sb ^ (((sb >> 9) & 1) << 5); R = (st >> 1) * 16 + swz / 64; C = (st & 1) * 32 + (swz % 64) / 2; }
__host__ __device__ __forceinline__ int perm32(int rho) { const int n = rho >> 4, i = rho & 15; return 8 * (i >> 2) + 4 * n + (i & 3); }

struct Unit { int pm, pn, sel; };
struct Sched {
    const char* A0; const char* B0; const char* A1; const char* B1;
    int nM, nN, nwg, G, c, nsel; size_t tstep;
    __device__ void init(const void* a0, const void* b0, const void* a1, const void* b1, int M, int N, int K, int G_, int c_, int nsel_) {
        A0 = (const char*)a0; B0 = (const char*)b0; A1 = (const char*)a1; B1 = (const char*)b1; nM = M / BM; nN = N / BM; nwg = nM * nN; G = G_; c = c_; nsel = nsel_; tstep = (size_t)BM * K * 2; }
    __device__ bool next(int i, Unit& u) const {
        const int j = (nsel == 2) ? (i >> 1) : i;
        const long L = (long)j * G + c; if (L >= nwg) return false;
        int wgid = (int)L; { const int q = nwg / NXCD, r = nwg % NXCD, xcd = wgid % NXCD, off = wgid / NXCD; wgid = (xcd < r ? xcd * (q + 1) : r * (q + 1) + (xcd - r) * q) + off; }
        const int nig = WGM * nN, gid = wgid / nig, fm = gid * WGM, gsz = (nM - fm) < WGM ? (nM - fm) : WGM;
        u.pm = fm + ((wgid % nig) % gsz); u.pn = (wgid % nig) / gsz; u.sel = (nsel == 2) ? (i & 1) : 0; return true;
    }
    __device__ __forceinline__ const char* abase(const Unit& u) const { return (u.sel ? A1 : A0) + (size_t)u.pm * tstep; }
    __device__ __forceinline__ const char* bbase(const Unit& u) const { return (u.sel ? B1 : B0) + (size_t)u.pn * tstep; }
};

template <class Epi>
__device__ __forceinline__ void gemm_phase(LAS unsigned char* lds, const int K, const Sched& S, const Epi& E) {
    const int tid = threadIdx.x, wid = __builtin_amdgcn_readfirstlane(tid >> 6), lane = tid & 63, wr = wid >> 2, wc = wid & 3, fr = lane & 15, fq = lane >> 4;
    const int nt = K / BK;
    unsigned voffA[2], voffB[2];
#pragma unroll
    for (int i = 0; i < 2; ++i) { int R, C; stage_rc(tid * 16 + i * 8192, R, C); const int Rb = Epi::PERM ? ((R & ~31) + perm32(R & 31)) : R;
        voffA[i] = (unsigned)(R * K + C) * 2u; voffB[i] = (unsigned)(Rb * K + C) * 2u; }
    const size_t kstep = (size_t)(BK * 2);
    const size_t hstep = (size_t)HALF * K * 2;
    const unsigned ldsw = (unsigned)wid * 1024u;
    const int aoff = lds_byte(wr * 64 + fr, fq * 8), boff = lds_byte(wc * 32 + fr, fq * 8);
#define PG8_SA(b, h) (((b) * 2 + (h)) * HTB)
#define PG8_SB(b, h) ((4 + (b) * 2 + (h)) * HTB)
#define PG8_STAGE(bufoff, gbase, voff) do { _Pragma("unroll") for (int _i = 0; _i < 2; ++_i) \
        __builtin_amdgcn_global_load_lds((const unsigned*)((const char*)(gbase) + (voff)[_i]), (LAS unsigned*)(lds + (bufoff) + ldsw + _i * 8192), 16, 0, 0); } while (0)
#define PG8_LDA(dst, b, h) do { _Pragma("unroll") for (int m = 0; m < 4; ++m) _Pragma("unroll") for (int k = 0; k < 2; ++k) dst[m][k] = *(const LAS bf16x8*)(lds + PG8_SA(b, h) + aoff + m * 2048 + k * 1024); } while (0)
#define PG8_LDB(dst, b, h) do { _Pragma("unroll") for (int n = 0; n < 2; ++n) _Pragma("unroll") for (int k = 0; k < 2; ++k) dst[n][k] = *(const LAS bf16x8*)(lds + PG8_SB(b, h) + boff + n * 2048 + k * 1024); } while (0)
#define PG8_MMA(ai, bj, At, Bt) do { __builtin_amdgcn_s_setprio(1); _Pragma("unroll") for (int m = 0; m < 4; ++m) _Pragma("unroll") for (int n = 0; n < 2; ++n) _Pragma("unroll") for (int k = 0; k < 2; ++k) \
        acc[ai][bj][m][n] = __builtin_amdgcn_mfma_f32_16x16x32_bf16(Bt[n][k], At[m][k], acc[ai][bj][m][n], 0, 0, 0); __builtin_amdgcn_s_setprio(0); } while (0)
#define PG8_WAIT_V(n) asm volatile("s_waitcnt vmcnt(" #n ")" ::: "memory")
#define PG8_WAIT_L(n) asm volatile("s_waitcnt lgkmcnt(" #n ")" ::: "memory")
#define PG8_BAR __builtin_amdgcn_s_barrier()
#define PG8_SCHED __builtin_amdgcn_sched_barrier(0)
    Unit cur, nxt; int ui = 0;
    if (!S.next(0, cur)) return;
    f32x4 acc[2][2][4][2];
#pragma unroll
    for (int a = 0; a < 2; ++a)
#pragma unroll
        for (int b = 0; b < 2; ++b)
#pragma unroll
            for (int m = 0; m < 4; ++m)
#pragma unroll
                for (int n = 0; n < 2; ++n) acc[a][b][m][n] = (f32x4){0.f, 0.f, 0.f, 0.f};
    bf16x8 At[4][2], B0[2][2], B1[2][2];
    const char* cA = S.abase(cur); const char* cB = S.bbase(cur);
    PG8_STAGE(PG8_SB(0, 0), cB, voffB); PG8_STAGE(PG8_SB(0, 1), cB + hstep, voffB); PG8_STAGE(PG8_SA(0, 0), cA, voffA); PG8_STAGE(PG8_SA(0, 1), cA + hstep, voffA);
    if (wr == 1) PG8_BAR;
    PG8_WAIT_V(2); PG8_BAR;
    PG8_STAGE(PG8_SB(1, 0), cB + kstep, voffB); PG8_STAGE(PG8_SA(1, 0), cA + kstep, voffA); PG8_STAGE(PG8_SB(1, 1), cB + hstep + kstep, voffB);
    PG8_WAIT_V(6); PG8_BAR;
    for (;;) {
        const bool has_next = S.next(ui + 1, nxt);
        const char* nA = has_next ? S.abase(nxt) : cA; const char* nB = has_next ? S.bbase(nxt) : cB;
        for (int t = 0; t < nt; t += 2) {
            const bool last = (t == nt - 2);
            const char* a1 = cA + (size_t)(t + 1) * kstep;
            const char* a2 = last ? nA : cA + (size_t)(t + 2) * kstep; const char* b2 = last ? nB : cB + (size_t)(t + 2) * kstep;
            const char* a3 = a2 + kstep; const char* b3 = b2 + kstep;
            PG8_LDB(B0, 0, 0); PG8_LDB(B1, 0, 1); PG8_SCHED; PG8_LDA(At, 0, 0); PG8_STAGE(PG8_SA(1, 1), a1 + hstep, voffA);
            PG8_WAIT_V(8); PG8_WAIT_L(0); PG8_BAR; PG8_MMA(0, 0, At, B0); PG8_MMA(0, 1, At, B1); PG8_BAR; PG8_SCHED;
            PG8_LDA(At, 0, 1); PG8_STAGE(PG8_SB(0, 0), b2, voffB); PG8_STAGE(PG8_SB(0, 1), b2 + hstep, voffB); PG8_STAGE(PG8_SA(0, 0), a2, voffA);
            PG8_WAIT_V(8); PG8_WAIT_L(0); PG8_BAR; PG8_MMA(1, 0, At, B0); PG8_MMA(1, 1, At, B1); PG8_BAR; PG8_SCHED;
            PG8_LDB(B0, 1, 0); PG8_LDB(B1, 1, 1); PG8_SCHED; PG8_LDA(At, 1, 0); PG8_STAGE(PG8_SA(0, 1), a2 + hstep, voffA);
            PG8_WAIT_V(8); PG8_WAIT_L(0); PG8_BAR; PG8_MMA(0, 0, At, B0); PG8_MMA(0, 1, At, B1); PG8_BAR; PG8_SCHED;
            PG8_LDA(At, 1, 1); PG8_STAGE(PG8_SB(1, 0), b3, voffB); PG8_STAGE(PG8_SB(1, 1), b3 + hstep, voffB); PG8_STAGE(PG8_SA(1, 0), a3, voffA);
            PG8_WAIT_V(8); PG8_WAIT_L(0); PG8_BAR; PG8_MMA(1, 0, At, B0); PG8_MMA(1, 1, At, B1); PG8_BAR; PG8_SCHED;
        }
        if (wr == 0) PG8_BAR;
        E(acc, cur, wr, wc, fr, fq);
        if (!has_next) break;
#pragma unroll
        for (int a = 0; a < 2; ++a)
#pragma unroll
            for (int b = 0; b < 2; ++b)
#pragma unroll
                for (int m = 0; m < 4; ++m)
#pragma unroll
                    for (int n = 0; n < 2; ++n) acc[a][b][m][n] = (f32x4){0.f, 0.f, 0.f, 0.f};
        cur = nxt; cA = nA; cB = nB; ++ui;
        if (wr == 1) PG8_BAR;
    }
    PG8_WAIT_V(0);
    PG8_BAR;
#undef PG8_SA
#undef PG8_SB
#undef PG8_STAGE
#undef PG8_LDA
#undef PG8_LDB
#undef PG8_MMA
#undef PG8_WAIT_V
#undef PG8_WAIT_L
#undef PG8_BAR
#undef PG8_SCHED
}

struct EpiBf16 {
    static constexpr bool PERM = true;
    bf16_t* O; int ldc;
    __device__ __forceinline__ void operator()(const f32x4 (&acc)[2][2][4][2], const Unit& u, int wr, int wc, int fr, int fq) const {
        const int row0 = u.pm * BM + wr * 64 + fr, col0 = u.pn * BM + wc * 32 + 8 * fq;
#pragma unroll
        for (int ai = 0; ai < 2; ++ai)
#pragma unroll
            for (int m = 0; m < 4; ++m) { bf16_t* rowp = O + (size_t)(row0 + ai * HALF + m * 16) * ldc + col0;
#pragma unroll
                for (int bj = 0; bj < 2; ++bj) { const f32x4 v0 = acc[ai][bj][m][0], v1 = acc[ai][bj][m][1];
                    u32x4 w; w.x = pk2(v0[0], v0[1]); w.y = pk2(v0[2], v0[3]); w.z = pk2(v1[0], v1[1]); w.w = pk2(v1[2], v1[3]);
                    *(u32x4*)(rowp + bj * HALF) = w; } }
    }
};
struct EpiSqRelu {
    static constexpr bool PERM = true;
    bf16_t* O; int ldc;
    __device__ __forceinline__ void operator()(const f32x4 (&acc)[2][2][4][2], const Unit& u, int wr, int wc, int fr, int fq) const {
        const int row0 = u.pm * BM + wr * 64 + fr, col0 = u.pn * BM + wc * 32 + 8 * fq;
#pragma unroll
        for (int ai = 0; ai < 2; ++ai)
#pragma unroll
            for (int m = 0; m < 4; ++m) { bf16_t* rowp = O + (size_t)(row0 + ai * HALF + m * 16) * ldc + col0;
#pragma unroll
                for (int bj = 0; bj < 2; ++bj) { f32x4 v0 = acc[ai][bj][m][0], v1 = acc[ai][bj][m][1];
#pragma unroll
                    for (int j = 0; j < 4; ++j) { const float a = fmaxf(v0[j], 0.f), b = fmaxf(v1[j], 0.f); v0[j] = a * a; v1[j] = b * b; }
                    u32x4 w; w.x = pk2(v0[0], v0[1]); w.y = pk2(v0[2], v0[3]); w.z = pk2(v1[0], v1[1]); w.w = pk2(v1[2], v1[3]);
                    *(u32x4*)(rowp + bj * HALF) = w; } }
    }
};
struct EpiMulBf16 {
    static constexpr bool PERM = true;
    const bf16_t* Y; bf16_t* O; int ldc;
    __device__ __forceinline__ void operator()(const f32x4 (&acc)[2][2][4][2], const Unit& u, int wr, int wc, int fr, int fq) const {
        const int row0 = u.pm * BM + wr * 64 + fr, col0 = u.pn * BM + wc * 32 + 8 * fq;
#pragma unroll
        for (int ai = 0; ai < 2; ++ai)
#pragma unroll
            for (int m = 0; m < 4; ++m) { const size_t off = (size_t)(row0 + ai * HALF + m * 16) * ldc + col0;
#pragma unroll
                for (int bj = 0; bj < 2; ++bj) { const f32x4 v0 = acc[ai][bj][m][0], v1 = acc[ai][bj][m][1];
                    const u32x4 y = *(const u32x4*)(Y + off + bj * HALF);
                    u32x4 w; w.x = pk2(v0[0] * bflo(y.x), v0[1] * bfhi(y.x)); w.y = pk2(v0[2] * bflo(y.y), v0[3] * bfhi(y.y));
                    w.z = pk2(v1[0] * bflo(y.z), v1[1] * bfhi(y.z)); w.w = pk2(v1[2] * bflo(y.w), v1[3] * bfhi(y.w));
                    *(u32x4*)(O + off + bj * HALF) = w; }
                asm volatile("" ::: "memory"); }
    }
};
struct EpiMerge {
    static constexpr bool PERM = true;
    const bf16_t* ZG; bf16_t* O;
    __device__ __forceinline__ void operator()(const f32x4 (&acc)[2][2][4][2], const Unit& u, int wr, int wc, int fr, int fq) const {
        const int row0 = u.pm * BM + wr * 64 + fr, col0 = u.pn * BM + wc * 32 + 8 * fq;
        const int goff = u.sel ? 2048 : 1024;
#pragma unroll
        for (int ai = 0; ai < 2; ++ai)
#pragma unroll
            for (int m = 0; m < 4; ++m) { const size_t r = (size_t)(row0 + ai * HALF + m * 16);
#pragma unroll
                for (int bj = 0; bj < 2; ++bj) { const f32x4 v0 = acc[ai][bj][m][0], v1 = acc[ai][bj][m][1];
                    const u32x4 g = *(const u32x4*)(ZG + r * NZG + goff + col0 + bj * HALF);
                    float o[8];
                    o[0] = v0[0] * sigmoidf_(bflo(g.x)); o[1] = v0[1] * sigmoidf_(bfhi(g.x)); o[2] = v0[2] * sigmoidf_(bflo(g.y)); o[3] = v0[3] * sigmoidf_(bfhi(g.y));
                    o[4] = v1[0] * sigmoidf_(bflo(g.z)); o[5] = v1[1] * sigmoidf_(bfhi(g.z)); o[6] = v1[2] * sigmoidf_(bflo(g.w)); o[7] = v1[3] * sigmoidf_(bfhi(g.w));
                    bf16_t* op = O + r * D + col0 + bj * HALF;
                    if (u.sel) { const u32x4 p = *(const u32x4*)op;
                        o[0] += bflo(p.x); o[1] += bfhi(p.x); o[2] += bflo(p.y); o[3] += bfhi(p.y); o[4] += bflo(p.z); o[5] += bfhi(p.z); o[6] += bflo(p.w); o[7] += bfhi(p.w); }
                    u32x4 w; w.x = pk2(o[0], o[1]); w.y = pk2(o[2], o[3]); w.z = pk2(o[4], o[5]); w.w = pk2(o[6], o[7]);
                    *(u32x4*)op = w; }
                asm volatile("" ::: "memory"); }
    }
};
struct EpiResid {
    static constexpr bool PERM = false;
    const float* base; float* out; const float* gate;
    __device__ __forceinline__ void operator()(const f32x4 (&acc)[2][2][4][2], const Unit& u, int wr, int wc, int fr, int fq) const {
        const int row0 = u.pm * BM + wr * 64 + fr, col0 = u.pn * BM + wc * 32 + 4 * fq;
        const float* gp = gate + (size_t)((u.pm * BM) / T) * 6144 + col0;
        f32x4 gv[2][2];
#pragma unroll
        for (int bj = 0; bj < 2; ++bj)
#pragma unroll
            for (int n = 0; n < 2; ++n) gv[bj][n] = *(const f32x4*)(gp + bj * HALF + n * 16);
#pragma unroll
        for (int ai = 0; ai < 2; ++ai)
#pragma unroll
            for (int m = 0; m < 4; ++m) { const size_t off = (size_t)(row0 + ai * HALF + m * 16) * D + col0;
#pragma unroll
                for (int bj = 0; bj < 2; ++bj)
#pragma unroll
                    for (int n = 0; n < 2; ++n) { const f32x4 bs = *(const f32x4*)(base + off + bj * HALF + n * 16);
                        *(f32x4*)(out + off + bj * HALF + n * 16) = bs + gv[bj][n] * acc[ai][bj][m][n]; }
                asm volatile("" ::: "memory"); }
    }
};
}

struct Args { const float* in[28]; float* out; unsigned char* ws; int ph_lo, ph_hi; };

struct Frame {
    LAS unsigned char* lds;
    int tid, lane, wave, G, bid;
    const float* const* in;
    unsigned char* ws; unsigned char* dob;
};
enum { I_X = 0, I_C, I_CTX, I_CCTX, I_N1W, I_N2W, I_WMOD, I_BMOD, I_WIN, I_MU, I_W0, I_WUP, I_A0, I_AUP, I_GUP, I_KK, I_KA, I_RK, I_LNW, I_LNB, I_HGLB, I_HGNW, I_PA, I_PB, I_WOUT, I_FC1, I_FC2, I_FNW };

__device__ __forceinline__ void transpose_item(const float* W, int N, bf16_t* WT, int ldk, LAS float* scr, int item, int lane) {
    const int nblk = N / 32, kb = item / nblk, nb = item % nblk, k0 = 64 * kb, n0 = 32 * nb;
#pragma unroll 8
    for (int i = 0; i < 32; ++i) { const int kk = 2 * i + (lane >> 5); scr[kk * 33 + (lane & 31)] = W[(size_t)(k0 + kk) * N + n0 + (lane & 31)]; }
    asm volatile("s_waitcnt lgkmcnt(0)" ::: "memory");
    const int c = lane & 7;
#pragma unroll
    for (int j = 0; j < 4; ++j) { const int n = (lane >> 3) + 8 * j; const LAS float* s = scr + (8 * c) * 33 + n;
        u32x4 o; o.x = pk2(s[0 * 33], s[1 * 33]); o.y = pk2(s[2 * 33], s[3 * 33]); o.z = pk2(s[4 * 33], s[5 * 33]); o.w = pk2(s[6 * 33], s[7 * 33]);
        *(u32x4*)(WT + (size_t)(n0 + n) * ldk + k0 + 8 * c) = o; }
    asm volatile("s_waitcnt lgkmcnt(0)" ::: "memory");
}

__device__ __forceinline__ void p0_prologue(const Frame& F) {
    float* MOD = (float*)(F.ws + WS_MOD);
    if (F.bid < 96) {
        LAS float* act = (LAS float*)F.lds;
        LAS float* red = act + 9 * 1024;
        for (int i = F.tid; i < 9 * 1024; i += 512) { const float v = (i < 8 * 1024) ? F.in[I_C][i] : F.in[I_CCTX][i - 8 * 1024]; act[i] = v * sigmoidf_(v); }
        __syncthreads();
        const float* wm = F.in[I_WMOD];
        const int n = F.bid * 64 + F.lane;
        float a[9];
#pragma unroll
        for (int r = 0; r < 9; ++r) a[r] = 0.f;
        const int kb = F.wave * 128;
#pragma unroll 4
        for (int k = kb; k < kb + 128; ++k) { const float w = wm[(size_t)k * 6144 + n];
#pragma unroll
            for (int r = 0; r < 9; ++r) a[r] += act[r * 1024 + k] * w; }
#pragma unroll
        for (int r = 0; r < 9; ++r) red[(F.wave * 9 + r) * 64 + F.lane] = a[r];
        __syncthreads();
        for (int i = F.tid; i < 9 * 64; i += 512) { const int r = i >> 6, l = i & 63; float s = 0.f;
#pragma unroll
            for (int w = 0; w < 8; ++w) s += red[(w * 9 + r) * 64 + l];
            MOD[r * 6144 + F.bid * 64 + l] = s + F.in[I_BMOD][F.bid * 64 + l]; }
        __syncthreads();
    }
    LAS float* scr = (LAS float*)(F.lds + 48 * 1024) + F.wave * (64 * 33);
    const int gw = F.bid * 8 + F.wave, NGW = F.G * 8;
    constexpr int I_IN = 16 * (NIN / 32), I_SQ = 16 * 32, I_F1 = 16 * (FF / 32), I_F2 = 64 * 32, I_GU = 2 * 32;
    constexpr int NITEMS = I_IN + 3 * I_SQ + I_F1 + I_F2 + I_GU;
    for (int it = gw; it < NITEMS; it += NGW) {
        int r = it;
        if (r < I_IN) { transpose_item(F.in[I_WIN], NIN, (bf16_t*)(F.dob + DO_WIN), D, scr, r, F.lane); continue; } r -= I_IN;
        if (r < I_SQ) { transpose_item(F.in[I_PA], D, (bf16_t*)(F.dob + DO_PA), D, scr, r, F.lane); continue; } r -= I_SQ;
        if (r < I_SQ) { transpose_item(F.in[I_PB], D, (bf16_t*)(F.dob + DO_PB), D, scr, r, F.lane); continue; } r -= I_SQ;
        if (r < I_SQ) { transpose_item(F.in[I_WOUT], D, (bf16_t*)(F.dob + DO_WO), D, scr, r, F.lane); continue; } r -= I_SQ;
        if (r < I_F1) { transpose_item(F.in[I_FC1], FF, (bf16_t*)(F.dob + DO_FC1), D, scr, r, F.lane); continue; } r -= I_F1;
        if (r < I_F2) { transpose_item(F.in[I_FC2], D, (bf16_t*)(F.dob + DO_FC2), FF, scr, r, F.lane); continue; } r -= I_F2;
        transpose_item(F.in[I_GUP], D, (bf16_t*)(F.dob + DO_GUP), 256, scr, r, F.lane);
    }
    { bf16_t* gu = (bf16_t*)(F.dob + DO_GUP);
      for (int i = F.bid * 512 + F.tid; i < 1024 * 16; i += F.G * 512) { const int n = i >> 4, ch = i & 15; *(u32x4*)(gu + (size_t)n * 256 + 128 + ch * 8) = (u32x4){0u, 0u, 0u, 0u}; } }
}

__device__ __forceinline__ void modnorm_row(const float* xrow, const float* nw, const float* sh, const float* sc, bf16_t* orow, int lane) {
    f32x4 v[4]; float s = 0.f;
#pragma unroll
    for (int j = 0; j < 4; ++j) { v[j] = *(const f32x4*)(xrow + 4 * lane + 256 * j); s += (v[j].x * v[j].x + v[j].y * v[j].y) + (v[j].z * v[j].z + v[j].w * v[j].w); }
    const float rs = 1.0f / sqrtf(wave_sum(s) * (1.f / D) + RMS_EPS);
#pragma unroll
    for (int j = 0; j < 4; ++j) { const int c = 4 * lane + 256 * j;
        const f32x4 w = *(const f32x4*)(nw + c), a = *(const f32x4*)(sc + c), b = *(const f32x4*)(sh + c);
        const f32x4 y = (v[j] * rs * w) * (1.0f + a) + b;
        u32x2 o; o.x = pk2(y.x, y.y); o.y = pk2(y.z, y.w); *(u32x2*)(orow + c) = o; }
}

__device__ __forceinline__ void unpack8(const u32x4 w, float (&f)[8]) { f[0] = bflo(w.x); f[1] = bfhi(w.x); f[2] = bflo(w.y); f[3] = bfhi(w.y); f[4] = bflo(w.z); f[5] = bfhi(w.z); f[6] = bflo(w.w); f[7] = bfhi(w.w); }
__device__ __forceinline__ void p3_shift(const Frame& F) {
    const bf16_t* ZR = (const bf16_t*)(F.ws + WS_R1); bf16_t* ZS = (bf16_t*)(F.ws + WS_ZRS); bf16_t* XG = (bf16_t*)(F.ws + WS_XGS);
    const float* mu = F.in[I_MU]; float* RN = (float*)(F.ws + WS_RN);
    constexpr int CH = NZR / 8;
    const size_t total = (size_t)MR * CH;
    for (size_t i = (size_t)F.bid * 512 + F.tid; i < total; i += (size_t)F.G * 512) {
        const int row = (int)(i / CH), ch = (int)(i % CH), c0 = ch * 8;
        const bf16_t* p = ZR + (size_t)row * NZR + c0;
        float z[8], a[8], o[8];
        unpack8(*(const u32x4*)p, z);
        float m0[8], m1[8];
        { const f32x4 t0 = *(const f32x4*)(mu + c0), t1 = *(const f32x4*)(mu + c0 + 4); m0[0] = t0.x; m0[1] = t0.y; m0[2] = t0.z; m0[3] = t0.w; m0[4] = t1.x; m0[5] = t1.y; m0[6] = t1.z; m0[7] = t1.w; }
        { const f32x4 t0 = *(const f32x4*)(mu + NZR + c0), t1 = *(const f32x4*)(mu + NZR + c0 + 4); m1[0] = t0.x; m1[1] = t0.y; m1[2] = t0.z; m1[3] = t0.w; m1[4] = t1.x; m1[5] = t1.y; m1[6] = t1.z; m1[7] = t1.w; }
        if (row < ML) {
            const int t = row & (T - 1), gc = t & 63, gr = t >> 6;
            float m2[8], m3[8];
            { const f32x4 t0 = *(const f32x4*)(mu + 2 * NZR + c0), t1 = *(const f32x4*)(mu + 2 * NZR + c0 + 4); m2[0] = t0.x; m2[1] = t0.y; m2[2] = t0.z; m2[3] = t0.w; m2[4] = t1.x; m2[5] = t1.y; m2[6] = t1.z; m2[7] = t1.w; }
            { const f32x4 t0 = *(const f32x4*)(mu + 3 * NZR + c0), t1 = *(const f32x4*)(mu + 3 * NZR + c0 + 4); m3[0] = t0.x; m3[1] = t0.y; m3[2] = t0.z; m3[3] = t0.w; m3[4] = t1.x; m3[5] = t1.y; m3[6] = t1.z; m3[7] = t1.w; }
#pragma unroll
            for (int j = 0; j < 8; ++j) o[j] = z[j];
            if (gc > 0) unpack8(*(const u32x4*)(p - NZR), a); else {
#pragma unroll
                for (int j = 0; j < 8; ++j) a[j] = 0.f; }
#pragma unroll
            for (int j = 0; j < 8; ++j) o[j] += m0[j] * (a[j] - z[j]);
            if (gc < 63) unpack8(*(const u32x4*)(p + NZR), a); else {
#pragma unroll
                for (int j = 0; j < 8; ++j) a[j] = 0.f; }
#pragma unroll
            for (int j = 0; j < 8; ++j) o[j] += m1[j] * (a[j] - z[j]);
            if (gr > 0) unpack8(*(const u32x4*)(p - (size_t)64 * NZR), a); else {
#pragma unroll
                for (int j = 0; j < 8; ++j) a[j] = 0.f; }
#pragma unroll
            for (int j = 0; j < 8; ++j) o[j] += m2[j] * (a[j] - z[j]);
            if (gr < 63) unpack8(*(const u32x4*)(p + (size_t)64 * NZR), a); else {
#pragma unroll
                for (int j = 0; j < 8; ++j) a[j] = 0.f; }
#pragma unroll
            for (int j = 0; j < 8; ++j) o[j] += m3[j] * (a[j] - z[j]);
            if (c0 >= 3200) {
                u32x4 w; w.x = pk2(sigmoidf_(o[0]), sigmoidf_(o[1])); w.y = pk2(sigmoidf_(o[2]), sigmoidf_(o[3])); w.z = pk2(sigmoidf_(o[4]), sigmoidf_(o[5])); w.w = pk2(sigmoidf_(o[6]), sigmoidf_(o[7]));
                *(u32x4*)(XG + (size_t)row * 256 + (c0 - 3200)) = w;
                *(u32x4*)(XG + (size_t)row * 256 + 128 + (c0 - 3200)) = (u32x4){0u, 0u, 0u, 0u};
            }
        } else {
            const int tc = (row - ML) & (TC - 1);
#pragma unroll
            for (int j = 0; j < 8; ++j) o[j] = z[j];
            if (tc > 0) unpack8(*(const u32x4*)(p - NZR), a); else {
#pragma unroll
                for (int j = 0; j < 8; ++j) a[j] = 0.f; }
#pragma unroll
            for (int j = 0; j < 8; ++j) o[j] += m0[j] * (a[j] - z[j]);
            if (tc < TC - 1) unpack8(*(const u32x4*)(p + NZR), a); else {
#pragma unroll
                for (int j = 0; j < 8; ++j) a[j] = 0.f; }
#pragma unroll
            for (int j = 0; j < 8; ++j) o[j] += m1[j] * (a[j] - z[j]);
        }
        if (c0 >= 3072 && c0 < 3136) {
#pragma unroll
            for (int j = 0; j < 8; ++j) o[j] = tanhf(o[j]); }
        {
            const bool isk = c0 >= 1024 && c0 < 2048; float ss = 0.f;
            if (isk) { const f32x4 k0 = *(const f32x4*)(F.in[I_KK] + c0 - 1024), k1 = *(const f32x4*)(F.in[I_KK] + c0 - 1020);
                const float t0 = o[0] * k0.x, t1 = o[1] * k0.y, t2 = o[2] * k0.z, t3 = o[3] * k0.w, t4 = o[4] * k1.x, t5 = o[5] * k1.y, t6 = o[6] * k1.z, t7 = o[7] * k1.w;
                ss = ((t0 * t0 + t1 * t1) + (t2 * t2 + t3 * t3)) + ((t4 * t4 + t5 * t5) + (t6 * t6 + t7 * t7)); }
            ss += __shfl_xor(ss, 1); ss += __shfl_xor(ss, 2); ss += __shfl_xor(ss, 4);
            if (isk && (ch & 7) == 0) RN[(size_t)row * 16 + ((c0 - 1024) >> 6)] = 1.0f / fmaxf(sqrtf(ss), 1e-12f);
        }
        u32x4 w; w.x = pk2(o[0], o[1]); w.y = pk2(o[2], o[3]); w.z = pk2(o[4], o[5]); w.w = pk2(o[6], o[7]);
        *(u32x4*)(ZS + (size_t)row * NZR + c0) = w;
    }
}

constexpr int RC = 32;
__device__ __forceinline__ void red16x4(float& a, float& b, float& c, float& d) {
    asm volatile("s_nop 1\n\t"
                 "v_add_f32_dpp %0, %0, %0 quad_perm:[1,0,3,2] row_mask:0xf bank_mask:0xf bound_ctrl:1\n\t"
                 "v_add_f32_dpp %1, %1, %1 quad_perm:[1,0,3,2] row_mask:0xf bank_mask:0xf bound_ctrl:1\n\t"
                 "v_add_f32_dpp %2, %2, %2 quad_perm:[1,0,3,2] row_mask:0xf bank_mask:0xf bound_ctrl:1\n\t"
                 "v_add_f32_dpp %3, %3, %3 quad_perm:[1,0,3,2] row_mask:0xf bank_mask:0xf bound_ctrl:1\n\t"
                 "v_add_f32_dpp %0, %0, %0 quad_perm:[2,3,0,1] row_mask:0xf bank_mask:0xf bound_ctrl:1\n\t"
                 "v_add_f32_dpp %1, %1, %1 quad_perm:[2,3,0,1] row_mask:0xf bank_mask:0xf bound_ctrl:1\n\t"
                 "v_add_f32_dpp %2, %2, %2 quad_perm:[2,3,0,1] row_mask:0xf bank_mask:0xf bound_ctrl:1\n\t"
                 "v_add_f32_dpp %3, %3, %3 quad_perm:[2,3,0,1] row_mask:0xf bank_mask:0xf bound_ctrl:1\n\t"
                 "v_add_f32_dpp %0, %0, %0 row_half_mirror row_mask:0xf bank_mask:0xf bound_ctrl:1\n\t"
                 "v_add_f32_dpp %1, %1, %1 row_half_mirror row_mask:0xf bank_mask:0xf bound_ctrl:1\n\t"
                 "v_add_f32_dpp %2, %2, %2 row_half_mirror row_mask:0xf bank_mask:0xf bound_ctrl:1\n\t"
                 "v_add_f32_dpp %3, %3, %3 row_half_mirror row_mask:0xf bank_mask:0xf bound_ctrl:1\n\t"
                 "v_add_f32_dpp %0, %0, %0 row_mirror row_mask:0xf bank_mask:0xf bound_ctrl:1\n\t"
                 "v_add_f32_dpp %1, %1, %1 row_mirror row_mask:0xf bank_mask:0xf bound_ctrl:1\n\t"
                 "v_add_f32_dpp %2, %2, %2 row_mirror row_mask:0xf bank_mask:0xf bound_ctrl:1\n\t"
                 "v_add_f32_dpp %3, %3, %3 row_mirror row_mask:0xf bank_mask:0xf bound_ctrl:1\n\t"
                 "s_nop 0"
                 : "+v"(a), "+v"(b), "+v"(c), "+v"(d));
}
__device__ __forceinline__ void p4_rwkv_scan(const Frame& F) {
    const bf16_t* ZS = (const bf16_t*)(F.ws + WS_ZRS);
    float* BON = (float*)(F.ws + WS_BON);
    const float* RN = (const float*)(F.ws + WS_RN);
    LAS float* PRM = (LAS float*)F.lds;
    LAS float* BONL = PRM + 384;
    LAS float* SV = PRM + 512;
    LAS float* YB = SV + 2 * RC * 384;
    const int tid = F.tid, lane = F.lane, w8 = F.wave;
    const int fr = lane & 15, fq = lane >> 4;
    constexpr int NCH = (TC + T) / RC;
    for (int cid = F.bid; cid < 256; cid += F.G) {
        const int b = cid >> 5, h = (cid >> 1) & 15, d = cid & 1;
        bf16_t* Yd = (bf16_t*)(F.ws + (d ? WS_YB : WS_YF));
        auto chunk_row0 = [&](int ci) { const bool ic = ci < TC / RC; const int cj = ic ? ci : ci - TC / RC, nch = ic ? TC / RC : T / RC;
            const int pos = d ? (nch - 1 - cj) : cj; return (ic ? ML + b * TC : b * T) + pos * RC; };
        __syncthreads();
        if (tid < 64) { PRM[tid] = F.in[I_W0][d * 1024 + h * 64 + tid]; PRM[64 + tid] = F.in[I_A0][d * 1024 + h * 64 + tid];
            PRM[128 + tid] = F.in[I_KK][h * 64 + tid]; PRM[192 + tid] = F.in[I_KA][h * 64 + tid]; PRM[256 + tid] = F.in[I_RK][h * 64 + tid]; BONL[tid] = 0.f; }
        __syncthreads();
        if (w8 < 4) {
            __builtin_amdgcn_s_setprio(2);
            const int q = lane & 15, v0 = 16 * w8 + 4 * (lane >> 4);
            f32x2 Sa[4], Sb[4];
#pragma unroll
            for (int r = 0; r < 4; ++r) { Sa[r] = (f32x2){0.f, 0.f}; Sb[r] = (f32x2){0.f, 0.f}; }
            for (int ci = -1; ci <= NCH; ++ci) {
                if (ci >= 0 && ci < NCH) {
                    const LAS float* sv = SV + (ci & 1) * (RC * 384); LAS float* yb = YB + (ci & 1) * (RC * 64);
                    f32x4 kkA, wA, bA, kA, rA, vA, kkB, wB, bB, kB, rB, vB;
#define R_LOAD(P, s_) do { const LAS float* base_ = sv + (s_) * 384; kk##P = *(const LAS f32x4*)(base_ + 4 * q); w##P = *(const LAS f32x4*)(base_ + 64 + 4 * q); b##P = *(const LAS f32x4*)(base_ + 128 + 4 * q); \
                        k##P = *(const LAS f32x4*)(base_ + 192 + 4 * q); r##P = *(const LAS f32x4*)(base_ + 256 + 4 * q); v##P = *(const LAS f32x4*)(base_ + 320 + v0); } while (0)
#define R_DOT(r_, x_) ({ const f32x2 t_ = Sa[r_] * (f32x2){x_.x, x_.y} + Sb[r_] * (f32x2){x_.z, x_.w}; t_.x + t_.y; })
#define R_STEP(P, N, s_) do { R_LOAD(N, (s_) + 1); \
                        red16x4(p[0], p[1], p[2], p[3]); red16x4(y[0], y[1], y[2], y[3]); \
                        if ((s_) > 0 && q == 0) *(LAS f32x4*)(yb + ((s_) - 1) * 64 + v0) = (f32x4){y[0], y[1], y[2], y[3]}; \
                        _Pragma("unroll") for (int r = 0; r < 4; ++r) { \
                            const f32x2 ca = (f32x2){k##P.x, k##P.y} * v##P[r] - (f32x2){b##P.x, b##P.y} * p[r]; const f32x2 cb = (f32x2){k##P.z, k##P.w} * v##P[r] - (f32x2){b##P.z, b##P.w} * p[r]; \
                            Sa[r] = Sa[r] * (f32x2){w##P.x, w##P.y} + ca; Sb[r] = Sb[r] * (f32x2){w##P.z, w##P.w} + cb; } \
                        _Pragma("unroll") for (int r = 0; r < 4; ++r) { y[r] = R_DOT(r, r##P); p[r] = R_DOT(r, kk##N); } } while (0)
                    R_LOAD(A, 0);
                    float p[4], y[4];
#pragma unroll
                    for (int r = 0; r < 4; ++r) { p[r] = R_DOT(r, kkA); y[r] = 0.f; }
#pragma unroll 1
                    for (int s = 0; s < RC; s += 2) { R_STEP(A, B, s); R_STEP(B, A, s + 1); }
                    red16x4(y[0], y[1], y[2], y[3]);
                    if (q == 0) *(LAS f32x4*)(yb + (RC - 1) * 64 + v0) = (f32x4){y[0], y[1], y[2], y[3]};
#undef R_LOAD
#undef R_DOT
#undef R_STEP
                }
                __syncthreads();
            }
            __builtin_amdgcn_s_setprio(0);
        } else {
            const int ct = w8 - 4, pt = tid - 256;
            bf16x8 aW[2], aA[2];
#pragma unroll
            for (int ks = 0; ks < 2; ++ks)
#pragma unroll
                for (int jj = 0; jj < 8; ++jj) { const int j = 32 * ks + 8 * fq + jj; const size_t o = ((size_t)(d * 64 + j)) * 1024 + h * 64 + 16 * ct + fr;
                    aW[ks][jj] = (short)f2bf(F.in[I_WUP][o]); aA[ks][jj] = (short)f2bf(F.in[I_AUP][o]); }
            const int c = 16 * ct + 4 * fq;
            const f32x4 w0v = *(const LAS f32x4*)(PRM + c), a0v = *(const LAS f32x4*)(PRM + 64 + c), kkw = *(const LAS f32x4*)(PRM + 128 + c),
                        kav = *(const LAS f32x4*)(PRM + 192 + c), rkv = *(const LAS f32x4*)(PRM + 256 + c);
            u32x4 tw0[2], tw1[2], xa0[2], xa1[2]; u32x2 gr_[2], gk_[2], gv_[2]; float rnv[2];
#define R_PREFETCH(ci_) do { _Pragma("unroll") for (int tt = 0; tt < 2; ++tt) { const int r_ = chunk_row0(ci_) + 16 * tt + fr; const bf16_t* p_ = ZS + (size_t)r_ * NZR; \
                tw0[tt] = *(const u32x4*)(p_ + 3072 + 8 * fq); tw1[tt] = *(const u32x4*)(p_ + 3104 + 8 * fq); xa0[tt] = *(const u32x4*)(p_ + 3136 + 8 * fq); xa1[tt] = *(const u32x4*)(p_ + 3168 + 8 * fq); \
                gr_[tt] = *(const u32x2*)(p_ + h * 64 + c); gk_[tt] = *(const u32x2*)(p_ + 1024 + h * 64 + c); gv_[tt] = *(const u32x2*)(p_ + 2048 + h * 64 + c); \
                rnv[tt] = RN[(size_t)r_ * 16 + h]; } } while (0)
            R_PREFETCH(0);
            for (int ci = -1; ci <= NCH; ++ci) {
                if (ci >= 1 && (ci - 1) >= TC / RC) {
                    const int tl = pt >> 3, v8 = pt & 7, sidx = d ? (RC - 1 - tl) : tl;
                    const LAS float* yp = YB + ((ci - 1) & 1) * (RC * 64) + sidx * 64 + 8 * v8;
                    const f32x4 y0 = *(const LAS f32x4*)yp, y1 = *(const LAS f32x4*)(yp + 4);
                    u32x4 o; o.x = pk2(y0.x, y0.y); o.y = pk2(y0.z, y0.w); o.z = pk2(y1.x, y1.y); o.w = pk2(y1.z, y1.w);
                    *(u32x4*)(Yd + (size_t)(chunk_row0(ci - 1) + tl) * D + h * 64 + 8 * v8) = o;
                }
                if (ci >= TC / RC && ci < NCH && pt < 32) { LAS float* bl = BONL + (ci & 1) * 32 + pt; BON[((size_t)d * ML + chunk_row0(ci) + pt) * 16 + h] = *bl; *bl = 0.f; }
                if (ci + 1 < NCH) {
                    const bool nctx = (ci + 1) < TC / RC;
                    LAS float* svb = SV + ((ci + 1) & 1) * (RC * 384);
#pragma unroll
                    for (int tt = 0; tt < 2; ++tt) {
                        f32x4 zw = (f32x4){0.f, 0.f, 0.f, 0.f}, za = (f32x4){0.f, 0.f, 0.f, 0.f};
                        zw = __builtin_amdgcn_mfma_f32_16x16x32_bf16(aW[0], __builtin_bit_cast(bf16x8, tw0[tt]), zw, 0, 0, 0);
                        zw = __builtin_amdgcn_mfma_f32_16x16x32_bf16(aW[1], __builtin_bit_cast(bf16x8, tw1[tt]), zw, 0, 0, 0);
                        za = __builtin_amdgcn_mfma_f32_16x16x32_bf16(aA[0], __builtin_bit_cast(bf16x8, xa0[tt]), za, 0, 0, 0);
                        za = __builtin_amdgcn_mfma_f32_16x16x32_bf16(aA[1], __builtin_bit_cast(bf16x8, xa1[tt]), za, 0, 0, 0);
                        const float kr[4] = {bflo(gk_[tt].x), bfhi(gk_[tt].x), bflo(gk_[tt].y), bfhi(gk_[tt].y)};
                        const float rr[4] = {bflo(gr_[tt].x), bfhi(gr_[tt].x), bflo(gr_[tt].y), bfhi(gr_[tt].y)};
                        f32x4 okk, ow, ob, okd, orr, ov; float bon = 0.f;
#pragma unroll
                        for (int i = 0; i < 4; ++i) {
                            const float kk = kr[i] * kkw[i] * rnv[tt];
                            const float sw = sigmoidf_(zw[i] + w0v[i]);
                            const float dec = __expf(-0.6065306597126334f * sw);
                            const float a = sigmoidf_(za[i] + a0v[i]);
                            const float kd = kr[i] * (1.0f + (a - 1.0f) * kav[i]);
                            bon += rr[i] * kd * rkv[i];
                            okk[i] = kk; ow[i] = dec; ob[i] = kk * a; okd[i] = kd; orr[i] = rr[i];
                        }
                        ov = (f32x4){bflo(gv_[tt].x), bfhi(gv_[tt].x), bflo(gv_[tt].y), bfhi(gv_[tt].y)};
                        const int tokl = 16 * tt + fr, psidx = d ? (RC - 1 - tokl) : tokl;
                        if (!nctx) atomicAdd((float*)(BONL + ((ci + 1) & 1) * 32 + tokl), bon);
                        LAS float* sv = svb + psidx * 384 + c;
                        *(LAS f32x4*)(sv) = okk; *(LAS f32x4*)(sv + 64) = ow; *(LAS f32x4*)(sv + 128) = ob; *(LAS f32x4*)(sv + 192) = okd; *(LAS f32x4*)(sv + 256) = orr; *(LAS f32x4*)(sv + 320) = ov;
                    }
                }
                if (ci + 2 < NCH) R_PREFETCH(ci + 2);
                __syncthreads();
            }
#undef R_PREFETCH
        }
    }
}

__device__ __forceinline__ void p5_rwkv_norm(const Frame& F) {
    bf16_t* YF = (bf16_t*)(F.ws + WS_YF); const bf16_t* YBk = (const bf16_t*)(F.ws + WS_YB); const bf16_t* ZS = (const bf16_t*)(F.ws + WS_ZRS);
    const float* BON = (const float*)(F.ws + WS_BON);
    const float* lnw = F.in[I_LNW]; const float* lnb = F.in[I_LNB];
    const size_t total = (size_t)ML * 256;
    for (size_t i = (size_t)F.bid * 512 + F.tid; i < total; i += (size_t)F.G * 512) {
        const int row = (int)(i >> 8), c = ((int)i & 255) * 4, h = c >> 6;
        const u32x2 a = *(const u32x2*)(YF + (size_t)row * D + c), b = *(const u32x2*)(YBk + (size_t)row * D + c);
        float y[4] = {bflo(a.x) + bflo(b.x), bfhi(a.x) + bfhi(b.x), bflo(a.y) + bflo(b.y), bfhi(a.y) + bfhi(b.y)};
        const float mean = sum16((y[0] + y[1]) + (y[2] + y[3])) * (1.f / 64.f);
        float q = 0.f;
#pragma unroll
        for (int j = 0; j < 4; ++j) { y[j] -= mean; q += y[j] * y[j]; }
        const float rstd = 1.0f / sqrtf(sum16(q) * (1.f / 64.f) + GN_EPS);
        const float bon = BON[(size_t)row * 16 + h] + BON[((size_t)ML + row) * 16 + h];
        const u32x2 vw = *(const u32x2*)(ZS + (size_t)row * NZR + 2048 + c);
        const float v[4] = {bflo(vw.x), bfhi(vw.x), bflo(vw.y), bfhi(vw.y)};
        const f32x4 lw = *(const f32x4*)(lnw + c), lb = *(const f32x4*)(lnb + c);
        float o[4];
#pragma unroll
        for (int j = 0; j < 4; ++j) o[j] = y[j] * rstd * lw[j] + lb[j] + bon * v[j];
        u32x2 w; w.x = pk2(o[0], o[1]); w.y = pk2(o[2], o[3]);
        *(u32x2*)(YF + (size_t)row * D + c) = w;
    }
}

constexpr int HC = 64;
constexpr int H_RAWQ = 0, H_RAWF = 16384, H_RAWI = 32768;
constexpr int H_PL = 0;
constexpr int H_TOT = 40960;
constexpr int H_DEC = H_TOT + 2048;
constexpr int H_QIN = H_DEC + 1024, H_KIN = H_QIN + 17408, H_QB = H_KIN + 17408;
constexpr int H_KINT = H_QB + 17408;
constexpr int H_VT = H_KINT + 18432;
constexpr int H_ST = H_VT + 9216;
constexpr int H_OL = H_ST + 17408;
constexpr int H_END = H_OL + 9216;
static_assert(H_END <= LDS_BYTES - 16, "HGRN2 LDS overflow");
__device__ __forceinline__ void p8_hgrn_scan(const Frame& F) {
    const bf16_t* ZH = (const bf16_t*)(F.ws + WS_ZH);
    LAS unsigned char* L = F.lds;
    const int tid = F.tid, lane = F.lane, w8 = F.wave;
    const float* hglb = F.in[I_HGLB];
    const int fr = lane & 15, fq = lane >> 4;
    for (int cid = F.bid; cid < 256; cid += F.G) {
        const int b = cid >> 5, hh = (cid >> 2) & 7, d = (cid >> 1) & 1, vh = cid & 1;
        bf16_t* Od = (bf16_t*)(F.ws + (d ? WS_OB : WS_OF));
        const int k1 = tid & 127, seg = tid >> 7;
        const float lbk = sigmoidf_(hglb[hh * 128 + k1] - hglb[1024 + hh * 128 + k1]);
        f32x4 Sreg[4];
#pragma unroll
        for (int i = 0; i < 4; ++i) Sreg[i] = (f32x4){0.f, 0.f, 0.f, 0.f};
        __syncthreads();
        for (int i = tid; i < 17408 / 4; i += 512) ((LAS unsigned*)(L + H_ST))[i] = 0u;
        constexpr int NCH = (TC + T) / HC;
        u32x4 pq0, pq1, pf0, pf1, pi0;
        auto chunk_row0 = [&](int ci) { const bool isctx = ci < TC / HC; const int cj = isctx ? ci : ci - TC / HC, nch = isctx ? TC / HC : T / HC;
            const int pos = d ? (nch - 1 - cj) : cj; return (isctx ? ML + b * TC : b * T) + pos * HC; };
#define H_PREFETCH(ci_) do { const int r0_ = chunk_row0(ci_); \
            { const int st = tid >> 4, kc = tid & 15; const bf16_t* g0 = ZH + (size_t)(r0_ + (d ? HC - 1 - st : st)) * NZH + hh * 128 + 8 * kc; \
              const bf16_t* g1 = ZH + (size_t)(r0_ + (d ? HC - 1 - (st + 32) : (st + 32))) * NZH + hh * 128 + 8 * kc; \
              pq0 = *(const u32x4*)g0; pq1 = *(const u32x4*)g1; pf0 = *(const u32x4*)(g0 + (d ? 2048 : 1024)); pf1 = *(const u32x4*)(g1 + (d ? 2048 : 1024)); } \
            { const int st = tid >> 3, vc = tid & 7; pi0 = *(const u32x4*)(ZH + (size_t)(r0_ + (d ? HC - 1 - st : st)) * NZH + 3072 + hh * 128 + vh * 64 + 8 * vc); } } while (0)
        H_PREFETCH(0);
        for (int ci = 0; ci < NCH; ++ci) {
            const bool isctx = ci < TC / HC;
            const int row0 = chunk_row0(ci);
            { const int st = tid >> 4, kc = tid & 15;
              *(LAS u32x4*)(L + H_RAWQ + (st * 128 + 8 * kc) * 2) = pq0; *(LAS u32x4*)(L + H_RAWQ + ((st + 32) * 128 + 8 * kc) * 2) = pq1;
              *(LAS u32x4*)(L + H_RAWF + (st * 128 + 8 * kc) * 2) = pf0; *(LAS u32x4*)(L + H_RAWF + ((st + 32) * 128 + 8 * kc) * 2) = pf1; }
            { const int st = tid >> 3, vc = tid & 7; *(LAS u32x4*)(L + H_RAWI + (st * 64 + 8 * vc) * 2) = pi0; }
            if (ci + 1 < NCH) H_PREFETCH(ci + 1);
            __syncthreads();
            float cc[16], kfv[16], qv[16];
            { float c = 0.f;
#pragma unroll
              for (int j = 0; j < 16; ++j) { const int st = 16 * seg + j;
                  const float fz = __builtin_bit_cast(float, (unsigned)(*(const LAS bf16_t*)(L + H_RAWF + (st * 128 + k1) * 2)) << 16);
                  qv[j] = __builtin_bit_cast(float, (unsigned)(*(const LAS bf16_t*)(L + H_RAWQ + (st * 128 + k1) * 2)) << 16);
                  const float f = lbk + (1.0f - lbk) * sigmoidf_(fz);
                  c += __logf(f); cc[j] = c; kfv[j] = 1.0f - f; }
              ((LAS float*)(L + H_TOT))[seg * 128 + k1] = c; }
            __syncthreads();
            { const LAS float* TOT = (const LAS float*)(L + H_TOT);
              const float t0 = TOT[k1], t1 = TOT[128 + k1], t2 = TOT[256 + k1], t3 = TOT[384 + k1];
              const float off = (seg > 0 ? t0 : 0.f) + (seg > 1 ? t1 : 0.f) + (seg > 2 ? t2 : 0.f);
              const float bref = t0 + t1, blast = (t0 + t1) + (t2 + t3);
              unsigned kp[8];
#pragma unroll
              for (int j = 0; j < 16; ++j) { const int st = 16 * seg + j; const float bb = cc[j] + off;
                  const float eq = __expf(bb - bref), ek = __expf(bref - bb), eb = __expf(bb);
                  const unsigned qin = f2bf(qv[j] * eq), kin = f2bf(kfv[j] * ek), qb = f2bf(qv[j] * eb);
                  *(LAS bf16_t*)(L + H_QIN + (st * 136 + k1) * 2) = (bf16_t)qin; *(LAS bf16_t*)(L + H_KIN + (st * 136 + k1) * 2) = (bf16_t)kin; *(LAS bf16_t*)(L + H_QB + (st * 136 + k1) * 2) = (bf16_t)qb;
                  if (j & 1) kp[j >> 1] |= kin << 16; else kp[j >> 1] = kin; }
              *(LAS u32x4*)(L + H_KINT + (k1 * 72 + 16 * seg) * 2) = (u32x4){kp[0], kp[1], kp[2], kp[3]};
              *(LAS u32x4*)(L + H_KINT + (k1 * 72 + 16 * seg + 8) * 2) = (u32x4){kp[4], kp[5], kp[6], kp[7]};
              if (seg == 0) { ((LAS float*)(L + H_DEC))[k1] = __expf(blast); ((LAS float*)(L + H_DEC))[128 + k1] = __expf(blast - bref); } }
            { const int v = tid & 63, s8 = tid >> 6; unsigned vp[4];
#pragma unroll
              for (int j = 0; j < 8; ++j) { const unsigned x = *(const LAS bf16_t*)(L + H_RAWI + ((8 * s8 + j) * 64 + v) * 2); if (j & 1) vp[j >> 1] |= x << 16; else vp[j >> 1] = x; }
              *(LAS u32x4*)(L + H_VT + (v * 72 + 8 * s8) * 2) = (u32x4){vp[0], vp[1], vp[2], vp[3]}; }
            __syncthreads();
            if (!isctx) {
                const int tt = w8 >> 1;
#pragma unroll
                for (int u = 0; u < 2; ++u) { const int stl = 2 * (w8 & 1) + u; f32x4 acc = (f32x4){0.f, 0.f, 0.f, 0.f};
                    if (stl <= tt) {
#pragma unroll
                        for (int ks = 0; ks < 4; ++ks) { const bf16x8 a = *(const LAS bf16x8*)(L + H_QIN + ((16 * tt + fr) * 136 + 32 * ks + 8 * fq) * 2);
                            const bf16x8 bq = *(const LAS bf16x8*)(L + H_KIN + ((16 * stl + fr) * 136 + 32 * ks + 8 * fq) * 2);
                            acc = __builtin_amdgcn_mfma_f32_16x16x32_bf16(a, bq, acc, 0, 0, 0); } }
#pragma unroll
                    for (int r = 0; r < 4; ++r) { const int t = 16 * tt + 4 * fq + r, s = 16 * stl + fr; const float pv = (s <= t && stl <= tt) ? acc[r] : 0.f;
                        *(LAS bf16_t*)(L + H_PL + (t * 72 + s) * 2) = (bf16_t)f2bf(pv); } }
            }
            __syncthreads();
            if (!isctx) {
                const int tt = w8 >> 1;
#pragma unroll
                for (int u = 0; u < 2; ++u) { const int vt = 2 * (w8 & 1) + u; f32x4 acc = (f32x4){0.f, 0.f, 0.f, 0.f};
#pragma unroll
                    for (int ks = 0; ks < 2; ++ks) { const bf16x8 a = *(const LAS bf16x8*)(L + H_PL + ((16 * tt + fr) * 72 + 32 * ks + 8 * fq) * 2);
                        const bf16x8 bv = *(const LAS bf16x8*)(L + H_VT + ((16 * vt + fr) * 72 + 32 * ks + 8 * fq) * 2);
                        acc = __builtin_amdgcn_mfma_f32_16x16x32_bf16(a, bv, acc, 0, 0, 0); }
#pragma unroll
                    for (int ks = 0; ks < 4; ++ks) { const bf16x8 a = *(const LAS bf16x8*)(L + H_QB + ((16 * tt + fr) * 136 + 32 * ks + 8 * fq) * 2);
                        const bf16x8 bs = *(const LAS bf16x8*)(L + H_ST + ((16 * vt + fr) * 136 + 32 * ks + 8 * fq) * 2);
                        acc = __builtin_amdgcn_mfma_f32_16x16x32_bf16(a, bs, acc, 0, 0, 0); }
#pragma unroll
                    for (int r = 0; r < 4; ++r) *(LAS bf16_t*)(L + H_OL + ((16 * tt + 4 * fq + r) * 72 + 16 * vt + fr) * 2) = (bf16_t)f2bf(acc[r]); }
            }
            { const LAS float* DEC = (const LAS float*)(L + H_DEC);
              const f32x4 dk = *(const LAS f32x4*)(DEC + 16 * w8 + 4 * fq), e2 = *(const LAS f32x4*)(DEC + 128 + 16 * w8 + 4 * fq);
#pragma unroll
              for (int vt = 0; vt < 4; ++vt) { f32x4 acc = (f32x4){0.f, 0.f, 0.f, 0.f};
#pragma unroll
                  for (int ks = 0; ks < 2; ++ks) { const bf16x8 a = *(const LAS bf16x8*)(L + H_KINT + ((16 * w8 + fr) * 72 + 32 * ks + 8 * fq) * 2);
                      const bf16x8 bv = *(const LAS bf16x8*)(L + H_VT + ((16 * vt + fr) * 72 + 32 * ks + 8 * fq) * 2);
                      acc = __builtin_amdgcn_mfma_f32_16x16x32_bf16(a, bv, acc, 0, 0, 0); }
                  Sreg[vt] = dk * Sreg[vt] + e2 * acc; } }
            __syncthreads();
#pragma unroll
            for (int vt = 0; vt < 4; ++vt) { u32x2 o; o.x = pk2(Sreg[vt][0], Sreg[vt][1]); o.y = pk2(Sreg[vt][2], Sreg[vt][3]);
                *(LAS u32x2*)(L + H_ST + ((16 * vt + fr) * 136 + 16 * w8 + 4 * fq) * 2) = o; }
            if (!isctx) { const int st = tid >> 3, vc = tid & 7;
                const u32x4 o = *(const LAS u32x4*)(L + H_OL + (st * 72 + 8 * vc) * 2);
                *(u32x4*)(Od + (size_t)(row0 + (d ? HC - 1 - st : st)) * D + hh * 128 + vh * 64 + 8 * vc) = o; }
        }
#undef H_PREFETCH
        __syncthreads();
    }
}

__device__ __forceinline__ void p10_hgrn_read(const Frame& F) {
    bf16_t* OF = (bf16_t*)(F.ws + WS_OF); const bf16_t* OBk = (const bf16_t*)(F.ws + WS_OB); const bf16_t* ZG = (const bf16_t*)(F.ws + WS_ZG);
    const float* nw = F.in[I_HGNW];
    const size_t total = (size_t)ML * 256;
    for (size_t i = (size_t)F.bid * 512 + F.tid; i < total; i += (size_t)F.G * 512) {
        const int row = (int)(i >> 8), c = ((int)i & 255) * 4;
        const u32x2 a = *(const u32x2*)(OF + (size_t)row * D + c), b = *(const u32x2*)(OBk + (size_t)row * D + c);
        const float o[4] = {bflo(a.x) + bflo(b.x), bfhi(a.x) + bfhi(b.x), bflo(a.y) + bflo(b.y), bfhi(a.y) + bfhi(b.y)};
        const float ms = sum32((o[0] * o[0] + o[1] * o[1]) + (o[2] * o[2] + o[3] * o[3])) * (1.f / 128.f);
        const float rs = 1.0f / sqrtf(ms + RMS_EPS);
        const u32x2 gw = *(const u32x2*)(ZG + (size_t)row * NZG + c);
        const float g[4] = {bflo(gw.x), bfhi(gw.x), bflo(gw.y), bfhi(gw.y)};
        const f32x4 w = *(const f32x4*)(nw + c);
        float y[4];
#pragma unroll
        for (int j = 0; j < 4; ++j) y[j] = o[j] * rs * w[j] * (g[j] * sigmoidf_(g[j]));
        u32x2 ww; ww.x = pk2(y[0], y[1]); ww.y = pk2(y[2], y[3]);
        *(u32x2*)(OF + (size_t)row * D + c) = ww;
    }
}

template <bool COOP>
__device__ __forceinline__ void mk_body(const Args& args) {
    extern __shared__ __attribute__((aligned(16))) unsigned char lds_raw[];
    Frame F;
    F.lds = (LAS unsigned char*)lds_raw;
    F.tid = threadIdx.x; F.lane = F.tid & 63; F.wave = __builtin_amdgcn_readfirstlane(F.tid >> 6);
    F.G = gridDim.x; F.bid = blockIdx.x;
    F.in = args.in; F.ws = args.ws; F.dob = (unsigned char*)args.out;
    const int lo = args.ph_lo, hi = args.ph_hi;
    const float* MOD = (const float*)(F.ws + WS_MOD);
    const int gw = F.bid * 8 + F.wave, NGW = F.G * 8;
#define IN(k) (lo <= (k) && (k) < hi)
    XcdBarrier xbar; xbar.bar = (unsigned*)(F.ws + WS_CTL); xbar.x = 0; xbar.st = nullptr;
    if (COOP) {
        volatile LAS unsigned* st = (volatile LAS unsigned*)(F.lds + LDS_BYTES - 16);
        if (F.tid < 4) st[F.tid] = 0u;
        __syncthreads();
        xbar = xcd_barrier_post((unsigned*)(F.ws + WS_CTL), st);
    }
#define SEAM(k) do { if (COOP && IN(k) && IN((k) + 1)) { if ((k) == 0) cg::this_grid().sync(); else xcd_barrier(xbar); } } while (0)

    if (IN(0)) { p0_prologue(F); }
#if (MK_REPMASK >> 0) & 1
    if (COOP) cg::this_grid().sync();
    if (IN(0)) { p0_prologue(F); }
#endif
    SEAM(0);
    if (IN(1)) {
        bf16_t* H = (bf16_t*)(F.dob + DO_H);
        for (int m = gw; m < MR; m += NGW) {
            const bool lat = m < ML; const int b = lat ? (m >> 12) : 8;
            const float* xr = lat ? F.in[I_X] + (size_t)m * D : F.in[I_CTX] + (size_t)(m - ML) * D;
            modnorm_row(xr, F.in[I_N1W], MOD + b * 6144, MOD + b * 6144 + 1024, H + (size_t)m * D, F.lane);
        }
    }
#if (MK_REPMASK >> 1) & 1
    if (COOP) cg::this_grid().sync();
    if (IN(1)) {
        bf16_t* H = (bf16_t*)(F.dob + DO_H);
        for (int m = gw; m < MR; m += NGW) {
            const bool lat = m < ML; const int b = lat ? (m >> 12) : 8;
            const float* xr = lat ? F.in[I_X] + (size_t)m * D : F.in[I_CTX] + (size_t)(m - ML) * D;
            modnorm_row(xr, F.in[I_N1W], MOD + b * 6144, MOD + b * 6144 + 1024, H + (size_t)m * D, F.lane);
        }
    }
#endif
    SEAM(1);
    if (IN(2)) {
        pg8::Sched S; S.init(F.dob + DO_H, F.dob + DO_WIN, nullptr, nullptr, MR, NZR, D, F.G, F.bid, 1);
        pg8::EpiBf16 E{(bf16_t*)(F.ws + WS_R1), NZR};
        pg8::gemm_phase(F.lds, D, S, E);
    }
#if (MK_REPMASK >> 2) & 1
    if (COOP) cg::this_grid().sync();
    if (IN(2)) {
        pg8::Sched S; S.init(F.dob + DO_H, F.dob + DO_WIN, nullptr, nullptr, MR, NZR, D, F.G, F.bid, 1);
        pg8::EpiBf16 E{(bf16_t*)(F.ws + WS_R1), NZR};
        pg8::gemm_phase(F.lds, D, S, E);
    }
#endif
    SEAM(2);
    if (IN(3)) { p3_shift(F); }
#if (MK_REPMASK >> 3) & 1
    if (COOP) cg::this_grid().sync();
    if (IN(3)) { p3_shift(F); }
#endif
    SEAM(3);
    if (IN(4)) { p4_rwkv_scan(F); }
#if (MK_REPMASK >> 4) & 1
    if (COOP) cg::this_grid().sync();
    if (IN(4)) { p4_rwkv_scan(F); }
#endif
    SEAM(4);
    if (IN(5)) { p5_rwkv_norm(F); }
#if (MK_REPMASK >> 5) & 1
    if (COOP) cg::this_grid().sync();
    if (IN(5)) { p5_rwkv_norm(F); }
#endif
    SEAM(5);
    if (IN(6)) {
        pg8::Sched S; S.init(F.ws + WS_XGS, F.dob + DO_GUP, nullptr, nullptr, ML, D, 256, F.G, F.bid, 1);
        pg8::EpiMulBf16 E{(const bf16_t*)(F.ws + WS_YF), (bf16_t*)(F.ws + WS_YRW), D};
        pg8::gemm_phase(F.lds, 256, S, E);
    }
#if (MK_REPMASK >> 6) & 1
    if (COOP) cg::this_grid().sync();
    if (IN(6)) {
        pg8::Sched S; S.init(F.ws + WS_XGS, F.dob + DO_GUP, nullptr, nullptr, ML, D, 256, F.G, F.bid, 1);
        pg8::EpiMulBf16 E{(const bf16_t*)(F.ws + WS_YF), (bf16_t*)(F.ws + WS_YRW), D};
        pg8::gemm_phase(F.lds, 256, S, E);
    }
#endif
    SEAM(6);
    if (IN(7)) {
        pg8::Sched S; S.init(F.dob + DO_H, F.dob + DO_WIN + (size_t)NZR * D * 2, nullptr, nullptr, MR, NZH, D, F.G, F.bid, 1);
        pg8::EpiBf16 E{(bf16_t*)(F.ws + WS_ZH), NZH};
        pg8::gemm_phase(F.lds, D, S, E);
    }
#if (MK_REPMASK >> 7) & 1
    if (COOP) cg::this_grid().sync();
    if (IN(7)) {
        pg8::Sched S; S.init(F.dob + DO_H, F.dob + DO_WIN + (size_t)NZR * D * 2, nullptr, nullptr, MR, NZH, D, F.G, F.bid, 1);
        pg8::EpiBf16 E{(bf16_t*)(F.ws + WS_ZH), NZH};
        pg8::gemm_phase(F.lds, D, S, E);
    }
#endif
    SEAM(7);
    if (IN(8)) { p8_hgrn_scan(F); }
#if (MK_REPMASK >> 8) & 1
    if (COOP) cg::this_grid().sync();
    if (IN(8)) { p8_hgrn_scan(F); }
#endif
    SEAM(8);
    if (IN(9)) {
        pg8::Sched S; S.init(F.dob + DO_H, F.dob + DO_WIN + (size_t)(NZR + NZH) * D * 2, nullptr, nullptr, ML, NZG, D, F.G, F.bid, 1);
        pg8::EpiBf16 E{(bf16_t*)(F.ws + WS_ZG), NZG};
        pg8::gemm_phase(F.lds, D, S, E);
    }
#if (MK_REPMASK >> 9) & 1
    if (COOP) cg::this_grid().sync();
    if (IN(9)) {
        pg8::Sched S; S.init(F.dob + DO_H, F.dob + DO_WIN + (size_t)(NZR + NZH) * D * 2, nullptr, nullptr, ML, NZG, D, F.G, F.bid, 1);
        pg8::EpiBf16 E{(bf16_t*)(F.ws + WS_ZG), NZG};
        pg8::gemm_phase(F.lds, D, S, E);
    }
#endif
    SEAM(9);
    if (IN(10)) { p10_hgrn_read(F); }
#if (MK_REPMASK >> 10) & 1
    if (COOP) cg::this_grid().sync();
    if (IN(10)) { p10_hgrn_read(F); }
#endif
    SEAM(10);
    if (IN(11)) {
        pg8::Sched S; S.init(F.ws + WS_YRW, F.dob + DO_PA, F.ws + WS_OF, F.dob + DO_PB, ML, D, D, F.G, F.bid, 2);
        pg8::EpiMerge E{(const bf16_t*)(F.ws + WS_ZG), (bf16_t*)(F.ws + WS_MRG)};
        pg8::gemm_phase(F.lds, D, S, E);
    }
#if (MK_REPMASK >> 11) & 1
    if (COOP) cg::this_grid().sync();
    if (IN(11)) {
        pg8::Sched S; S.init(F.ws + WS_YRW, F.dob + DO_PA, F.ws + WS_OF, F.dob + DO_PB, ML, D, D, F.G, F.bid, 2);
        pg8::EpiMerge E{(const bf16_t*)(F.ws + WS_ZG), (bf16_t*)(F.ws + WS_MRG)};
        pg8::gemm_phase(F.lds, D, S, E);
    }
#endif
    SEAM(11);
    if (IN(12)) {
        pg8::Sched S; S.init(F.ws + WS_MRG, F.dob + DO_WO, nullptr, nullptr, ML, D, D, F.G, F.bid, 1);
        pg8::EpiResid E{F.in[I_X], (float*)(F.ws + WS_X1), MOD + 2048};
        pg8::gemm_phase(F.lds, D, S, E);
    }
#if (MK_REPMASK >> 12) & 1
    if (COOP) cg::this_grid().sync();
    if (IN(12)) {
        pg8::Sched S; S.init(F.ws + WS_MRG, F.dob + DO_WO, nullptr, nullptr, ML, D, D, F.G, F.bid, 1);
        pg8::EpiResid E{F.in[I_X], (float*)(F.ws + WS_X1), MOD + 2048};
        pg8::gemm_phase(F.lds, D, S, E);
    }
#endif
    SEAM(12);
    if (IN(13)) {
        const float* X1 = (const float*)(F.ws + WS_X1); bf16_t* H2 = (bf16_t*)(F.ws + WS_H2);
        for (int m = gw; m < ML; m += NGW) { const int b = m >> 12;
            modnorm_row(X1 + (size_t)m * D, F.in[I_N2W], MOD + b * 6144 + 3072, MOD + b * 6144 + 4096, H2 + (size_t)m * D, F.lane); }
    }
#if (MK_REPMASK >> 13) & 1
    if (COOP) cg::this_grid().sync();
    if (IN(13)) {
        const float* X1 = (const float*)(F.ws + WS_X1); bf16_t* H2 = (bf16_t*)(F.ws + WS_H2);
        for (int m = gw; m < ML; m += NGW) { const int b = m >> 12;
            modnorm_row(X1 + (size_t)m * D, F.in[I_N2W], MOD + b * 6144 + 3072, MOD + b * 6144 + 4096, H2 + (size_t)m * D, F.lane); }
    }
#endif
    SEAM(13);
    if (IN(14)) {
        pg8::Sched S; S.init(F.ws + WS_H2, F.dob + DO_FC1, nullptr, nullptr, ML, FF, D, F.G, F.bid, 1);
        pg8::EpiSqRelu E{(bf16_t*)(F.ws + WS_U), FF};
        pg8::gemm_phase(F.lds, D, S, E);
    }
#if (MK_REPMASK >> 14) & 1
    if (COOP) cg::this_grid().sync();
    if (IN(14)) {
        pg8::Sched S; S.init(F.ws + WS_H2, F.dob + DO_FC1, nullptr, nullptr, ML, FF, D, F.G, F.bid, 1);
        pg8::EpiSqRelu E{(bf16_t*)(F.ws + WS_U), FF};
        pg8::gemm_phase(F.lds, D, S, E);
    }
#endif
    SEAM(14);
    if (IN(15)) {
        pg8::Sched S; S.init(F.ws + WS_U, F.dob + DO_FC2, nullptr, nullptr, ML, D, FF, F.G, F.bid, 1);
        pg8::EpiResid E{(const float*)(F.ws + WS_X1), (float*)(F.ws + WS_X1), MOD + 5120};
        pg8::gemm_phase(F.lds, FF, S, E);
    }
#if (MK_REPMASK >> 15) & 1
    if (COOP) cg::this_grid().sync();
    if (IN(15)) {
        pg8::Sched S; S.init(F.ws + WS_U, F.dob + DO_FC2, nullptr, nullptr, ML, D, FF, F.G, F.bid, 1);
        pg8::EpiResid E{(const float*)(F.ws + WS_X1), (float*)(F.ws + WS_X1), MOD + 5120};
        pg8::gemm_phase(F.lds, FF, S, E);
    }
#endif
    SEAM(15);
    if (IN(16)) {
        const float* X2 = (const float*)(F.ws + WS_X1); const float* fw = F.in[I_FNW];
        for (int m = gw; m < ML; m += NGW) {
            const float* xr = X2 + (size_t)m * D; float* orow = args.out + (size_t)m * D;
            f32x4 v[4]; float s = 0.f;
#pragma unroll
            for (int j = 0; j < 4; ++j) { v[j] = *(const f32x4*)(xr + 4 * F.lane + 256 * j); s += (v[j].x * v[j].x + v[j].y * v[j].y) + (v[j].z * v[j].z + v[j].w * v[j].w); }
            const float rs = 1.0f / sqrtf(wave_sum(s) * (1.f / D) + RMS_EPS);
#pragma unroll
            for (int j = 0; j < 4; ++j) { const int c = 4 * F.lane + 256 * j; *(f32x4*)(orow + c) = v[j] * rs * *(const f32x4*)(fw + c); }
        }
    }
#if (MK_REPMASK >> 16) & 1
    if (COOP) cg::this_grid().sync();
    if (IN(16)) {
        const float* X2 = (const float*)(F.ws + WS_X1); const float* fw = F.in[I_FNW];
        for (int m = gw; m < ML; m += NGW) {
            const float* xr = X2 + (size_t)m * D; float* orow = args.out + (size_t)m * D;
            f32x4 v[4]; float s = 0.f;
#pragma unroll
            for (int j = 0; j < 4; ++j) { v[j] = *(const f32x4*)(xr + 4 * F.lane + 256 * j); s += (v[j].x * v[j].x + v[j].y * v[j].y) + (v[j].z * v[j].z + v[j].w * v[j].w); }
            const float rs = 1.0f / sqrtf(wave_sum(s) * (1.f / D) + RMS_EPS);
#pragma unroll
            for (int j = 0; j < 4; ++j) { const int c = 4 * F.lane + 256 * j; *(f32x4*)(orow + c) = v[j] * rs * *(const f32x4*)(fw + c); }
        }
    }
#endif

#undef IN
#undef SEAM
}

__global__ void __launch_bounds__(512, 2) mk_multi(Args args) { mk_body<false>(args); }
__global__ void __launch_bounds__(512, 2) mk_one(Args args) { mk_body<true>(args); }

extern "C" void kernel_launch(void* const* d_in, const int* in_sizes, int n_in, void* d_out, int out_size, void* d_ws, size_t ws_size, hipStream_t stream) {
    static int grid = 0;
    if (grid == 0) {
        if (n_in != 28 || out_size != ML * D || ws_size < WS_END) { fprintf(stderr, "kernel_launch: unexpected problem (n_in %d, out %d, ws %zu)\n", n_in, out_size, ws_size); grid = -1; return; }
        int dev = 0, cus = 0;
        if (hipGetDevice(&dev) != hipSuccess || hipDeviceGetAttribute(&cus, hipDeviceAttributeMultiprocessorCount, dev) != hipSuccess) { grid = -1; return; }
        (void)hipFuncSetAttribute((const void*)mk_multi, hipFuncAttributeMaxDynamicSharedMemorySize, LDS_BYTES);
        (void)hipFuncSetAttribute((const void*)mk_one, hipFuncAttributeMaxDynamicSharedMemorySize, LDS_BYTES);
        int per_cu = 0;
        (void)hipOccupancyMaxActiveBlocksPerMultiprocessor(&per_cu, (const void*)mk_one, 512, LDS_BYTES);
        (void)hipGetLastError();
        grid = cus;
        if (per_cu < 1) fprintf(stderr, "kernel_launch: occupancy query reports %d blocks per CU\n", per_cu);
    }
    if (grid < 0) return;
    (void)hipMemsetAsync((char*)d_ws + WS_CTL, 0, XCD_BAR_WORDS * 4, stream);
    Args a{};
    for (int i = 0; i < 28; ++i) a.in[i] = (const float*)d_in[i];
    a.out = (float*)d_out; a.ws = (unsigned char*)d_ws;
#if MK_ONE_LAUNCH
    a.ph_lo = 0; a.ph_hi = NPHASE;
    void* kargs[] = {&a};
    hipError_t e = hipLaunchCooperativeKernel((const void*)mk_one, dim3(grid), dim3(512), kargs, LDS_BYTES, stream);
    if (e != hipSuccess) fprintf(stderr, "cooperative launch failed: %s\n", hipGetErrorString(e));
#else
    for (int p = 0; p < NPHASE; ++p) { a.ph_lo = p; a.ph_hi = p + 1; hipLaunchKernelGGL(mk_multi, dim3(grid), dim3(512), LDS_BYTES, stream, a); }
#endif
}
```

```cpp
#include <hip/hip_runtime.h>
#include <hip/hip_cooperative_groups.h>
#include <cstdio>
#include <cstdint>
namespace cg = cooperative_groups;

#ifndef MK_ONE_LAUNCH
#define MK_ONE_LAUNCH 1
#endif
#ifndef MK_REPMASK
#define MK_REPMASK 0x0u
#endif

#define LAS __attribute__((address_space(3)))
typedef unsigned short bf16_t;
typedef short bf16x8 __attribute__((ext_vector_type(8)));
typedef float f32x4 __attribute__((ext_vector_type(4)));
typedef float f32x2 __attribute__((ext_vector_type(2)));
typedef unsigned u32x4 __attribute__((ext_vector_type(4)));
typedef unsigned u32x2 __attribute__((ext_vector_type(2)));

constexpr int D = 1024, NB = 8, T = 4096, TC = 256, GW = 64;
constexpr int ML = NB * T;
constexpr int MC = NB * TC;
constexpr int MR = ML + MC;
constexpr int NZR = 3328, NZH = 4096, NZG = 3072, NIN = 10496, FF = 4096;
constexpr float RMS_EPS = 1e-6f, GN_EPS = 64e-5f;

constexpr size_t MiB = 1u << 20;
constexpr size_t WS_CTL = 0, WS_MOD = 1 * MiB;
constexpr size_t WS_R1 = 2 * MiB;
constexpr size_t WS_YF = 2 * MiB, WS_YB = 66 * MiB, WS_YRW = 130 * MiB;
constexpr size_t WS_OF = 2 * MiB, WS_OB = 66 * MiB;
constexpr size_t WS_X1 = 2 * MiB;
constexpr size_t WS_H2 = 130 * MiB;
constexpr size_t WS_ZRS = 223 * MiB;
constexpr size_t WS_XGS = 444 * MiB;
constexpr size_t WS_BON = 460 * MiB;
constexpr size_t WS_ZH = 194 * MiB;
constexpr size_t WS_ZG = 194 * MiB;
constexpr size_t WS_MRG = 386 * MiB;
constexpr size_t WS_U = 194 * MiB;
constexpr size_t WS_RN = 464 * MiB;
constexpr size_t WS_END = 468 * MiB;
constexpr size_t DO_H = 0;
constexpr size_t DO_WIN = 68 * MiB;
constexpr size_t DO_PA = DO_WIN + (size_t)NIN * D * 2;
constexpr size_t DO_PB = DO_PA + 2 * MiB, DO_WO = DO_PB + 2 * MiB, DO_FC1 = DO_WO + 2 * MiB, DO_FC2 = DO_FC1 + 8 * MiB, DO_GUP = DO_FC2 + 8 * MiB;
constexpr size_t DO_END = DO_GUP + (size_t)1024 * 256 * 2;
static_assert(DO_END <= 128 * MiB, "d_out scratch overflow");

constexpr int LDS_BYTES = 152 * 1024;
constexpr int NPHASE = 17;

__device__ __forceinline__ unsigned f2bf(float f) { unsigned u = __builtin_bit_cast(unsigned, f); return (u + 0x7fffu + ((u >> 16) & 1u)) >> 16; }
__device__ __forceinline__ unsigned pk2(float lo, float hi) { unsigned r; asm("v_cvt_pk_bf16_f32 %0, %1, %2" : "=v"(r) : "v"(lo), "v"(hi)); return r; }
__device__ __forceinline__ float bflo(unsigned w) { return __builtin_bit_cast(float, w << 16); }
__device__ __forceinline__ float bfhi(unsigned w) { return __builtin_bit_cast(float, w & 0xffff0000u); }
__device__ __forceinline__ float sigmoidf_(float x) { return 1.0f / (1.0f + __expf(-x)); }
__device__ __forceinline__ float wave_sum(float v) {
#pragma unroll
    for (int o = 1; o < 64; o <<= 1) v += __shfl_xor(v, o);
    return v;
}
template <int CTRL> __device__ __forceinline__ float dpp_mov(float v) { return __builtin_bit_cast(float, __builtin_amdgcn_update_dpp(0, __builtin_bit_cast(int, v), CTRL, 0xf, 0xf, true)); }
__device__ __forceinline__ float sum16(float v) { v += dpp_mov<0xB1>(v); v += dpp_mov<0x4E>(v); v += dpp_mov<0x141>(v); v += dpp_mov<0x140>(v); return v; }
__device__ __forceinline__ float sum32(float v) { v = sum16(v); v += __shfl_xor(v, 16); return v; }


#define XB_TMO      128
#define XB_XCNT(j)  (256  + 64 * (j))
#define XB_XSUB(j)  (1280 + 64 * (j))
#define XB_XGEN(j)  (2304 + 64 * (j))
#define XB_TOP      3328
#define XB_TOPGEN   3392
#define XCD_BAR_WORDS 3456
#define XB_SPIN_CAP (1u << 18)
__device__ __forceinline__ unsigned xb_ld(unsigned* p)              { return __hip_atomic_load(p, __ATOMIC_RELAXED, __HIP_MEMORY_SCOPE_AGENT); }
__device__ __forceinline__ unsigned xb_add(unsigned* p, unsigned v) { return __hip_atomic_fetch_add(p, v, __ATOMIC_RELAXED, __HIP_MEMORY_SCOPE_AGENT); }
__device__ __forceinline__ unsigned xb_xcc_id() { return (unsigned)__builtin_amdgcn_s_getreg((3 << 11) | 20) & 0xFu; }
#define XB_SPIN(cond, bar) do { unsigned _sp = 0; while (cond) { __builtin_amdgcn_s_sleep(1); \
    if ((++_sp & 255u) == 0u) { if (xb_ld(&(bar)[XB_TMO])) break; if (_sp > XB_SPIN_CAP) { atomicAdd(&(bar)[XB_TMO], 1u); break; } } } } while (0)
struct XcdBarrier { unsigned* bar; unsigned x; volatile LAS unsigned* st; };
__device__ __forceinline__ XcdBarrier xcd_barrier_post(unsigned* bar, volatile LAS unsigned* st) {
    XcdBarrier b; b.bar = bar; b.x = xb_xcc_id(); b.st = st;
    if (threadIdx.x == 0) (void)xb_add(&bar[XB_XCNT(b.x)], 1u);
    return b;
}
__device__ __forceinline__ void xcd_barrier_complete(unsigned* bar, unsigned x, unsigned& nloc, unsigned& nx) {
    const unsigned G = gridDim.x * gridDim.y * gridDim.z;
    unsigned sum, cnt, mine, sp = 0u;
    for (;;) {
        sum = 0u; cnt = 0u; mine = 0u;
#pragma unroll
        for (unsigned j = 0; j < 16; ++j) { const unsigned c = xb_ld(&bar[XB_XCNT(j)]); sum += c; cnt += (c > 0u) ? 1u : 0u; mine = (j == x) ? c : mine; }
        if (sum == G) break;
        __builtin_amdgcn_s_sleep(1);
        if ((++sp & 255u) == 0u) { if (xb_ld(&bar[XB_TMO])) break; if (sp > XB_SPIN_CAP) { atomicAdd(&bar[XB_TMO], 1u); break; } }
    }
    nloc = mine > 0u ? mine : 1u; nx = cnt > 0u ? cnt : 1u;
}
__device__ __forceinline__ void xcd_barrier(const XcdBarrier& b) {
    asm volatile("s_waitcnt vmcnt(0)" ::: "memory");
    __syncthreads();
    if (threadIdx.x == 0) {
        unsigned* bar = b.bar;
        __builtin_amdgcn_s_waitcnt(0);
        unsigned nloc = b.st[0], nx = b.st[1];
        if (nloc == 0u) { xcd_barrier_complete(bar, b.x, nloc, nx); b.st[0] = nloc; b.st[1] = nx; }
        const unsigned old = xb_add(&bar[XB_XSUB(b.x)], 1u);
        const unsigned gen = old / nloc;
        if (old + 1u == (gen + 1u) * nloc) {
            __builtin_amdgcn_fence(__ATOMIC_RELEASE, "agent");
            asm volatile("s_waitcnt vmcnt(0)" ::: "memory");
            const unsigned og = xb_add(&bar[XB_TOP], 1u);
            const unsigned tg = og / nx;
            if (og + 1u == (tg + 1u) * nx) xb_add(&bar[XB_TOPGEN], 1u);
            else XB_SPIN(xb_ld(&bar[XB_TOPGEN]) == tg, bar);
            __builtin_amdgcn_fence(__ATOMIC_ACQUIRE, "agent");
            xb_add(&bar[XB_XGEN(b.x)], 1u);
            asm volatile("s_waitcnt vmcnt(0)" ::: "memory");
        } else {
            XB_SPIN(xb_ld(&bar[XB_XGEN(b.x)]) == gen, bar);
            __builtin_amdgcn_fence(__ATOMIC_ACQUIRE, "agent");
            asm volatile("s_waitcnt vmcnt(0)" ::: "memory");
        }
    }
    __syncthreads();
}

namespace pg8 {
constexpr int BM = 256, BK = 64, HALF = 128, HTB = HALF * BK * 2, STAGE_BYTES = 8 * HTB, NXCD = 8, WGM = 8;
__host__ __device__ __forceinline__ int lds_byte(int r, int c) { const int st = (r >> 4) * 2 + (c >> 5), rr = r & 15, cc = c & 31, ob = rr * 64 + cc * 2; return st * 1024 + (ob ^ (((ob >> 9) & 1) << 5)); }
__host__ __device__ __forceinline__ void stage_rc(int b, int& R, int& C) { const int st = b / 1024, sb = b % 1024, swz = sb ^ (((sb >> 9) & 1) << 5); R = (st >> 1) * 16 + swz / 64; C = (st & 1) * 32 + (swz % 64) / 2; }
__host__ __device__ __forceinline__ int perm32(int rho) { const int n = rho >> 4, i = rho & 15; return 8 * (i >> 2) + 4 * n + (i & 3); }

struct Unit { int pm, pn, sel; };
struct Sched {
    const char* A0; const char* B0; const char* A1; const char* B1;
    int nM, nN, nwg, G, c, nsel; size_t tstep;
    __device__ void init(const void* a0, const void* b0, const void* a1, const void* b1, int M, int N, int K, int G_, int c_, int nsel_) {
        A0 = (const char*)a0; B0 = (const char*)b0; A1 = (const char*)a1; B1 = (const char*)b1; nM = M / BM; nN = N / BM; nwg = nM * nN; G = G_; c = c_; nsel = nsel_; tstep = (size_t)BM * K * 2; }
    __device__ bool next(int i, Unit& u) const {
        const int j = (nsel == 2) ? (i >> 1) : i;
        const long L = (long)j * G + c; if (L >= nwg) return false;
        int wgid = (int)L; { const int q = nwg / NXCD, r = nwg % NXCD, xcd = wgid % NXCD, off = wgid / NXCD; wgid = (xcd < r ? xcd * (q + 1) : r * (q + 1) + (xcd - r) * q) + off; }
        const int nig = WGM * nN, gid = wgid / nig, fm = gid * WGM, gsz = (nM - fm) < WGM ? (nM - fm) : WGM;
        u.pm = fm + ((wgid % nig) % gsz); u.pn = (wgid % nig) / gsz; u.sel = (nsel == 2) ? (i & 1) : 0; return true;
    }
    __device__ __forceinline__ const char* abase(const Unit& u) const { return (u.sel ? A1 : A0) + (size_t)u.pm * tstep; }
    __device__ __forceinline__ const char* bbase(const Unit& u) const { return (u.sel ? B1 : B0) + (size_t)u.pn * tstep; }
};

template <class Epi>
__device__ __forceinline__ void gemm_phase(LAS unsigned char* lds, const int K, const Sched& S, const Epi& E) {
    const int tid = threadIdx.x, wid = __builtin_amdgcn_readfirstlane(tid >> 6), lane = tid & 63, wr = wid >> 2, wc = wid & 3, fr = lane & 15, fq = lane >> 4;
    const int nt = K / BK;
    unsigned voffA[2], voffB[2];
#pragma unroll
    for (int i = 0; i < 2; ++i) { int R, C; stage_rc(tid * 16 + i * 8192, R, C); const int Rb = Epi::PERM ? ((R & ~31) + perm32(R & 31)) : R;
        voffA[i] = (unsigned)(R * K + C) * 2u; voffB[i] = (unsigned)(Rb * K + C) * 2u; }
    const size_t kstep = (size_t)(BK * 2);
    const size_t hstep = (size_t)HALF * K * 2;
    const unsigned ldsw = (unsigned)wid * 1024u;
    const int aoff = lds_byte(wr * 64 + fr, fq * 8), boff = lds_byte(wc * 32 + fr, fq * 8);
#define PG8_SA(b, h) (((b) * 2 + (h)) * HTB)
#define PG8_SB(b, h) ((4 + (b) * 2 + (h)) * HTB)
#define PG8_STAGE(bufoff, gbase, voff) do { _Pragma("unroll") for (int _i = 0; _i < 2; ++_i) \
        __builtin_amdgcn_global_load_lds((const unsigned*)((const char*)(gbase) + (voff)[_i]), (LAS unsigned*)(lds + (bufoff) + ldsw + _i * 8192), 16, 0, 0); } while (0)
#define PG8_LDA(dst, b, h) do { _Pragma("unroll") for (int m = 0; m < 4; ++m) _Pragma("unroll") for (int k = 0; k < 2; ++k) dst[m][k] = *(const LAS bf16x8*)(lds + PG8_SA(b, h) + aoff + m * 2048 + k * 1024); } while (0)
#define PG8_LDB(dst, b, h) do { _Pragma("unroll") for (int n = 0; n < 2; ++n) _Pragma("unroll") for (int k = 0; k < 2; ++k) dst[n][k] = *(const LAS bf16x8*)(lds + PG8_SB(b, h) + boff + n * 2048 + k * 1024); } while (0)
#define PG8_MMA(ai, bj, At, Bt) do { __builtin_amdgcn_s_setprio(1); _Pragma("unroll") for (int m = 0; m < 4; ++m) _Pragma("unroll") for (int n = 0; n < 2; ++n) _Pragma("unroll") for (int k = 0; k < 2; ++k) \
        acc[ai][bj][m][n] = __builtin_amdgcn_mfma_f32_16x16x32_bf16(Bt[n][k], At[m][k], acc[ai][bj][m][n], 0, 0, 0); __builtin_amdgcn_s_setprio(0); } while (0)
#define PG8_WAIT_V(n) asm volatile("s_waitcnt vmcnt(" #n ")" ::: "memory")
#define PG8_WAIT_L(n) asm volatile("s_waitcnt lgkmcnt(" #n ")" ::: "memory")
#define PG8_BAR __builtin_amdgcn_s_barrier()
#define PG8_SCHED __builtin_amdgcn_sched_barrier(0)
    Unit cur, nxt; int ui = 0;
    if (!S.next(0, cur)) return;
    f32x4 acc[2][2][4][2];
#pragma unroll
    for (int a = 0; a < 2; ++a)
#pragma unroll
        for (int b = 0; b < 2; ++b)
#pragma unroll
            for (int m = 0; m < 4; ++m)
#pragma unroll
                for (int n = 0; n < 2; ++n) acc[a][b][m][n] = (f32x4){0.f, 0.f, 0.f, 0.f};
    bf16x8 At[4][2], B0[2][2], B1[2][2];
    const char* cA = S.abase(cur); const char* cB = S.bbase(cur);
    PG8_STAGE(PG8_SB(0, 0), cB, voffB); PG8_STAGE(PG8_SB(0, 1), cB + hstep, voffB); PG8_STAGE(PG8_SA(0, 0), cA, voffA); PG8_STAGE(PG8_SA(0, 1), cA + hstep, voffA);
    if (wr == 1) PG8_BAR;
    PG8_WAIT_V(2); PG8_BAR;
    PG8_STAGE(PG8_SB(1, 0), cB + kstep, voffB); PG8_STAGE(PG8_SA(1, 0), cA + kstep, voffA); PG8_STAGE(PG8_SB(1, 1), cB + hstep + kstep, voffB);
    PG8_WAIT_V(6); PG8_BAR;
    for (;;) {
        const bool has_next = S.next(ui + 1, nxt);
        const char* nA = has_next ? S.abase(nxt) : cA; const char* nB = has_next ? S.bbase(nxt) : cB;
        for (int t = 0; t < nt; t += 2) {
            const bool last = (t == nt - 2);
            const char* a1 = cA + (size_t)(t + 1) * kstep;
            const char* a2 = last ? nA : cA + (size_t)(t + 2) * kstep; const char* b2 = last ? nB : cB + (size_t)(t + 2) * kstep;
            const char* a3 = a2 + kstep; const char* b3 = b2 + kstep;
            PG8_LDB(B0, 0, 0); PG8_LDB(B1, 0, 1); PG8_SCHED; PG8_LDA(At, 0, 0); PG8_STAGE(PG8_SA(1, 1), a1 + hstep, voffA);
            PG8_WAIT_V(8); PG8_WAIT_L(0); PG8_BAR; PG8_MMA(0, 0, At, B0); PG8_MMA(0, 1, At, B1); PG8_BAR; PG8_SCHED;
            PG8_LDA(At, 0, 1); PG8_STAGE(PG8_SB(0, 0), b2, voffB); PG8_STAGE(PG8_SB(0, 1), b2 + hstep, voffB); PG8_STAGE(PG8_SA(0, 0), a2, voffA);
            PG8_WAIT_V(8); PG8_WAIT_L(0); PG8_BAR; PG8_MMA(1, 0, At, B0); PG8_MMA(1, 1, At, B1); PG8_BAR; PG8_SCHED;
            PG8_LDB(B0, 1, 0); PG8_LDB(B1, 1, 1); PG8_SCHED; PG8_LDA(At, 1, 0); PG8_STAGE(PG8_SA(0, 1), a2 + hstep, voffA);
            PG8_WAIT_V(8); PG8_WAIT_L(0); PG8_BAR; PG8_MMA(0, 0, At, B0); PG8_MMA(0, 1, At, B1); PG8_BAR; PG8_SCHED;
            PG8_LDA(At, 1, 1); PG8_STAGE(PG8_SB(1, 0), b3, voffB); PG8_STAGE(PG8_SB(1, 1), b3 + hstep, voffB); PG8_STAGE(PG8_SA(1, 0), a3, voffA);
            PG8_WAIT_V(8); PG8_WAIT_L(0); PG8_BAR; PG8_MMA(1, 0, At, B0); PG8_MMA(1, 1, At, B1); PG8_BAR; PG8_SCHED;
        }
        if (wr == 0) PG8_BAR;
        E(acc, cur, wr, wc, fr, fq);
        if (!has_next) break;
#pragma unroll
        for (int a = 0; a < 2; ++a)
#pragma unroll
            for (int b = 0; b < 2; ++b)
#pragma unroll
                for (int m = 0; m < 4; ++m)
#pragma unroll
                    for (int n = 0; n < 2; ++n) acc[a][b][m][n] = (f32x4){0.f, 0.f, 0.f, 0.f};
        cur = nxt; cA = nA; cB = nB; ++ui;
        if (wr == 1) PG8_BAR;
    }
    PG8_WAIT_V(0);
    PG8_BAR;
#undef PG8_SA
#undef PG8_SB
#undef PG8_STAGE
#undef PG8_LDA
#undef PG8_LDB
#undef PG8_MMA
#undef PG8_WAIT_V
#undef PG8_WAIT_L
#undef PG8_BAR
#undef PG8_SCHED
}

struct EpiBf16 {
    static constexpr bool PERM = true;
    bf16_t* O; int ldc;
    __device__ __forceinline__ void operator()(const f32x4 (&acc)[2][2][4][2], const Unit& u, int wr, int wc, int fr, int fq) const {
        const int row0 = u.pm * BM + wr * 64 + fr, col0 = u.pn * BM + wc * 32 + 8 * fq;
#pragma unroll
        for (int ai = 0; ai < 2; ++ai)
#pragma unroll
            for (int m = 0; m < 4; ++m) { bf16_t* rowp = O + (size_t)(row0 + ai * HALF + m * 16) * ldc + col0;
#pragma unroll
                for (int bj = 0; bj < 2; ++bj) { const f32x4 v0 = acc[ai][bj][m][0], v1 = acc[ai][bj][m][1];
                    u32x4 w; w.x = pk2(v0[0], v0[1]); w.y = pk2(v0[2], v0[3]); w.z = pk2(v1[0], v1[1]); w.w = pk2(v1[2], v1[3]);
                    *(u32x4*)(rowp + bj * HALF) = w; } }
    }
};
struct EpiSqRelu {
    static constexpr bool PERM = true;
    bf16_t* O; int ldc;
    __device__ __forceinline__ void operator()(const f32x4 (&acc)[2][2][4][2], const Unit& u, int wr, int wc, int fr, int fq) const {
        const int row0 = u.pm * BM + wr * 64 + fr, col0 = u.pn * BM + wc * 32 + 8 * fq;
#pragma unroll
        for (int ai = 0; ai < 2; ++ai)
#pragma unroll
            for (int m = 0; m < 4; ++m) { bf16_t* rowp = O + (size_t)(row0 + ai * HALF + m * 16) * ldc + col0;
#pragma unroll
                for (int bj = 0; bj < 2; ++bj) { f32x4 v0 = acc[ai][bj][m][0], v1 = acc[ai][bj][m][1];
#pragma unroll
                    for (int j = 0; j < 4; ++j) { const float a = fmaxf(v0[j], 0.f), b = fmaxf(v1[j], 0.f); v0[j] = a * a; v1[j] = b * b; }
                    u32x4 w; w.x = pk2(v0[0], v0[1]); w.y = pk2(v0[2], v0[3]); w.z = pk2(v1[0], v1[1]); w.w = pk2(v1[2], v1[3]);
                    *(u32x4*)(rowp + bj * HALF) = w; } }
    }
};
struct EpiMulBf16 {
    static constexpr bool PERM = true;
    const bf16_t* Y; bf16_t* O; int ldc;
    __device__ __forceinline__ void operator()(const f32x4 (&acc)[2][2][4][2], const Unit& u, int wr, int wc, int fr, int fq) const {
        const int row0 = u.pm * BM + wr * 64 + fr, col0 = u.pn * BM + wc * 32 + 8 * fq;
#pragma unroll
        for (int ai = 0; ai < 2; ++ai)
#pragma unroll
            for (int m = 0; m < 4; ++m) { const size_t off = (size_t)(row0 + ai * HALF + m * 16) * ldc + col0;
#pragma unroll
                for (int bj = 0; bj < 2; ++bj) { const f32x4 v0 = acc[ai][bj][m][0], v1 = acc[ai][bj][m][1];
                    const u32x4 y = *(const u32x4*)(Y + off + bj * HALF);
                    u32x4 w; w.x = pk2(v0[0] * bflo(y.x), v0[1] * bfhi(y.x)); w.y = pk2(v0[2] * bflo(y.y), v0[3] * bfhi(y.y));
                    w.z = pk2(v1[0] * bflo(y.z), v1[1] * bfhi(y.z)); w.w = pk2(v1[2] * bflo(y.w), v1[3] * bfhi(y.w));
                    *(u32x4*)(O + off + bj * HALF) = w; }
                asm volatile("" ::: "memory"); }
    }
};
struct EpiMerge {
    static constexpr bool PERM = true;
    const bf16_t* ZG; bf16_t* O;
    __device__ __forceinline__ void operator()(const f32x4 (&acc)[2][2][4][2], const Unit& u, int wr, int wc, int fr, int fq) const {
        const int row0 = u.pm * BM + wr * 64 + fr, col0 = u.pn * BM + wc * 32 + 8 * fq;
        const int goff = u.sel ? 2048 : 1024;
#pragma unroll
        for (int ai = 0; ai < 2; ++ai)
#pragma unroll
            for (int m = 0; m < 4; ++m) { const size_t r = (size_t)(row0 + ai * HALF + m * 16);
#pragma unroll
                for (int bj = 0; bj < 2; ++bj) { const f32x4 v0 = acc[ai][bj][m][0], v1 = acc[ai][bj][m][1];
                    const u32x4 g = *(const u32x4*)(ZG + r * NZG + goff + col0 + bj * HALF);
                    float o[8];
                    o[0] = v0[0] * sigmoidf_(bflo(g.x)); o[1] = v0[1] * sigmoidf_(bfhi(g.x)); o[2] = v0[2] * sigmoidf_(bflo(g.y)); o[3] = v0[3] * sigmoidf_(bfhi(g.y));
                    o[4] = v1[0] * sigmoidf_(bflo(g.z)); o[5] = v1[1] * sigmoidf_(bfhi(g.z)); o[6] = v1[2] * sigmoidf_(bflo(g.w)); o[7] = v1[3] * sigmoidf_(bfhi(g.w));
                    bf16_t* op = O + r * D + col0 + bj * HALF;
                    if (u.sel) { const u32x4 p = *(const u32x4*)op;
                        o[0] += bflo(p.x); o[1] += bfhi(p.x); o[2] += bflo(p.y); o[3] += bfhi(p.y); o[4] += bflo(p.z); o[5] += bfhi(p.z); o[6] += bflo(p.w); o[7] += bfhi(p.w); }
                    u32x4 w; w.x = pk2(o[0], o[1]); w.y = pk2(o[2], o[3]); w.z = pk2(o[4], o[5]); w.w = pk2(o[6], o[7]);
                    *(u32x4*)op = w; }
                asm volatile("" ::: "memory"); }
    }
};
struct EpiResid {
    static constexpr bool PERM = false;
    const float* base; float* out; const float* gate;
    __device__ __forceinline__ void operator()(const f32x4 (&acc)[2][2][4][2], const Unit& u, int wr, int wc, int fr, int fq) const {
        const int row0 = u.pm * BM + wr * 64 + fr, col0 = u.pn * BM + wc * 32 + 4 * fq;
        const float* gp = gate + (size_t)((u.pm * BM) / T) * 6144 + col0;
        f32x4 gv[2][2];
#pragma unroll
        for (int bj = 0; bj < 2; ++bj)
#pragma unroll
            for (int n = 0; n < 2; ++n) gv[bj][n] = *(const f32x4*)(gp + bj * HALF + n * 16);
#pragma unroll
        for (int ai = 0; ai < 2; ++ai)
#pragma unroll
            for (int m = 0; m < 4; ++m) { const size_t off = (size_t)(row0 + ai * HALF + m * 16) * D + col0;
#pragma unroll
                for (int bj = 0; bj < 2; ++bj)
#pragma unroll
                    for (int n = 0; n < 2; ++n) { const f32x4 bs = *(const f32x4*)(base + off + bj * HALF + n * 16);
                        *(f32x4*)(out + off + bj * HALF + n * 16) = bs + gv[bj][n] * acc[ai][bj][m][n]; }
                asm volatile("" ::: "memory"); }
    }
};
}

struct Args { const float* in[28]; float* out; unsigned char* ws; int ph_lo, ph_hi; };

struct Frame {
    LAS unsigned char* lds;
    int tid, lane, wave, G, bid;
    const float* const* in;
    unsigned char* ws; unsigned char* dob;
};
enum { I_X = 0, I_C, I_CTX, I_CCTX, I_N1W, I_N2W, I_WMOD, I_BMOD, I_WIN, I_MU, I_W0, I_WUP, I_A0, I_AUP, I_GUP, I_KK, I_KA, I_RK, I_LNW, I_LNB, I_HGLB, I_HGNW, I_PA, I_PB, I_WOUT, I_FC1, I_FC2, I_FNW };

__device__ __forceinline__ void transpose_item(const float* W, int N, bf16_t* WT, int ldk, LAS float* scr, int item, int lane) {
    const int nblk = N / 32, kb = item / nblk, nb = item % nblk, k0 = 64 * kb, n0 = 32 * nb;
#pragma unroll 8
    for (int i = 0; i < 32; ++i) { const int kk = 2 * i + (lane >> 5); scr[kk * 33 + (lane & 31)] = W[(size_t)(k0 + kk) * N + n0 + (lane & 31)]; }
    asm volatile("s_waitcnt lgkmcnt(0)" ::: "memory");
    const int c = lane & 7;
#pragma unroll
    for (int j = 0; j < 4; ++j) { const int n = (lane >> 3) + 8 * j; const LAS float* s = scr + (8 * c) * 33 + n;
        u32x4 o; o.x = pk2(s[0 * 33], s[1 * 33]); o.y = pk2(s[2 * 33], s[3 * 33]); o.z = pk2(s[4 * 33], s[5 * 33]); o.w = pk2(s[6 * 33], s[7 * 33]);
        *(u32x4*)(WT + (size_t)(n0 + n) * ldk + k0 + 8 * c) = o; }
    asm volatile("s_waitcnt lgkmcnt(0)" ::: "memory");
}

__device__ __forceinline__ void p0_prologue(const Frame& F) {
    float* MOD = (float*)(F.ws + WS_MOD);
    if (F.bid < 96) {
        LAS float* act = (LAS float*)F.lds;
        LAS float* red = act + 9 * 1024;
        for (int i = F.tid; i < 9 * 1024; i += 512) { const float v = (i < 8 * 1024) ? F.in[I_C][i] : F.in[I_CCTX][i - 8 * 1024]; act[i] = v * sigmoidf_(v); }
        __syncthreads();
        const float* wm = F.in[I_WMOD];
        const int n = F.bid * 64 + F.lane;
        float a[9];
#pragma unroll
        for (int r = 0; r < 9; ++r) a[r] = 0.f;
        const int kb = F.wave * 128;
#pragma unroll 4
        for (int k = kb; k < kb + 128; ++k) { const float w = wm[(size_t)k * 6144 + n];
#pragma unroll
            for (int r = 0; r < 9; ++r) a[r] += act[r * 1024 + k] * w; }
#pragma unroll
        for (int r = 0; r < 9; ++r) red[(F.wave * 9 + r) * 64 + F.lane] = a[r];
        __syncthreads();
        for (int i = F.tid; i < 9 * 64; i += 512) { const int r = i >> 6, l = i & 63; float s = 0.f;
#pragma unroll
            for (int w = 0; w < 8; ++w) s += red[(w * 9 + r) * 64 + l];
            MOD[r * 6144 + F.bid * 64 + l] = s + F.in[I_BMOD][F.bid * 64 + l]; }
        __syncthreads();
    }
    LAS float* scr = (LAS float*)(F.lds + 48 * 1024) + F.wave * (64 * 33);
    const int gw = F.bid * 8 + F.wave, NGW = F.G * 8;
    constexpr int I_IN = 16 * (NIN / 32), I_SQ = 16 * 32, I_F1 = 16 * (FF / 32), I_F2 = 64 * 32, I_GU = 2 * 32;
    constexpr int NITEMS = I_IN + 3 * I_SQ + I_F1 + I_F2 + I_GU;
    for (int it = gw; it < NITEMS; it += NGW) {
        int r = it;
        if (r < I_IN) { transpose_item(F.in[I_WIN], NIN, (bf16_t*)(F.dob + DO_WIN), D, scr, r, F.lane); continue; } r -= I_IN;
        if (r < I_SQ) { transpose_item(F.in[I_PA], D, (bf16_t*)(F.dob + DO_PA), D, scr, r, F.lane); continue; } r -= I_SQ;
        if (r < I_SQ) { transpose_item(F.in[I_PB], D, (bf16_t*)(F.dob + DO_PB), D, scr, r, F.lane); continue; } r -= I_SQ;
        if (r < I_SQ) { transpose_item(F.in[I_WOUT], D, (bf16_t*)(F.dob + DO_WO), D, scr, r, F.lane); continue; } r -= I_SQ;
        if (r < I_F1) { transpose_item(F.in[I_FC1], FF, (bf16_t*)(F.dob + DO_FC1), D, scr, r, F.lane); continue; } r -= I_F1;
        if (r < I_F2) { transpose_item(F.in[I_FC2], D, (bf16_t*)(F.dob + DO_FC2), FF, scr, r, F.lane); continue; } r -= I_F2;
        transpose_item(F.in[I_GUP], D, (bf16_t*)(F.dob + DO_GUP), 256, scr, r, F.lane);
    }
    { bf16_t* gu = (bf16_t*)(F.dob + DO_GUP);
      for (int i = F.bid * 512 + F.tid; i < 1024 * 16; i += F.G * 512) { const int n = i >> 4, ch = i & 15; *(u32x4*)(gu + (size_t)n * 256 + 128 + ch * 8) = (u32x4){0u, 0u, 0u, 0u}; } }
}

__device__ __forceinline__ void modnorm_row(const float* xrow, const float* nw, const float* sh, const float* sc, bf16_t* orow, int lane) {
    f32x4 v[4]; float s = 0.f;
#pragma unroll
    for (int j = 0; j < 4; ++j) { v[j] = *(const f32x4*)(xrow + 4 * lane + 256 * j); s += (v[j].x * v[j].x + v[j].y * v[j].y) + (v[j].z * v[j].z + v[j].w * v[j].w); }
    const float rs = 1.0f / sqrtf(wave_sum(s) * (1.f / D) + RMS_EPS);
#pragma unroll
    for (int j = 0; j < 4; ++j) { const int c = 4 * lane + 256 * j;
        const f32x4 w = *(const f32x4*)(nw + c), a = *(const f32x4*)(sc + c), b = *(const f32x4*)(sh + c);
        const f32x4 y = (v[j] * rs * w) * (1.0f + a) + b;
        u32x2 o; o.x = pk2(y.x, y.y); o.y = pk2(y.z, y.w); *(u32x2*)(orow + c) = o; }
}

__device__ __forceinline__ void unpack8(const u32x4 w, float (&f)[8]) { f[0] = bflo(w.x); f[1] = bfhi(w.x); f[2] = bflo(w.y); f[3] = bfhi(w.y); f[4] = bflo(w.z); f[5] = bfhi(w.z); f[6] = bflo(w.w); f[7] = bfhi(w.w); }
__device__ __forceinline__ void p3_shift(const Frame& F) {
    const bf16_t* ZR = (const bf16_t*)(F.ws + WS_R1); bf16_t* ZS = (bf16_t*)(F.ws + WS_ZRS); bf16_t* XG = (bf16_t*)(F.ws + WS_XGS);
    const float* mu = F.in[I_MU]; float* RN = (float*)(F.ws + WS_RN);
    constexpr int CH = NZR / 8;
    const size_t total = (size_t)MR * CH;
    for (size_t i = (size_t)F.bid * 512 + F.tid; i < total; i += (size_t)F.G * 512) {
        const int row = (int)(i / CH), ch = (int)(i % CH), c0 = ch * 8;
        const bf16_t* p = ZR + (size_t)row * NZR + c0;
        float z[8], a[8], o[8];
        unpack8(*(const u32x4*)p, z);
        float m0[8], m1[8];
        { const f32x4 t0 = *(const f32x4*)(mu + c0), t1 = *(const f32x4*)(mu + c0 + 4); m0[0] = t0.x; m0[1] = t0.y; m0[2] = t0.z; m0[3] = t0.w; m0[4] = t1.x; m0[5] = t1.y; m0[6] = t1.z; m0[7] = t1.w; }
        { const f32x4 t0 = *(const f32x4*)(mu + NZR + c0), t1 = *(const f32x4*)(mu + NZR + c0 + 4); m1[0] = t0.x; m1[1] = t0.y; m1[2] = t0.z; m1[3] = t0.w; m1[4] = t1.x; m1[5] = t1.y; m1[6] = t1.z; m1[7] = t1.w; }
        if (row < ML) {
            const int t = row & (T - 1), gc = t & 63, gr = t >> 6;
            float m2[8], m3[8];
            { const f32x4 t0 = *(const f32x4*)(mu + 2 * NZR + c0), t1 = *(const f32x4*)(mu + 2 * NZR + c0 + 4); m2[0] = t0.x; m2[1] = t0.y; m2[2] = t0.z; m2[3] = t0.w; m2[4] = t1.x; m2[5] = t1.y; m2[6] = t1.z; m2[7] = t1.w; }
            { const f32x4 t0 = *(const f32x4*)(mu + 3 * NZR + c0), t1 = *(const f32x4*)(mu + 3 * NZR + c0 + 4); m3[0] = t0.x; m3[1] = t0.y; m3[2] = t0.z; m3[3] = t0.w; m3[4] = t1.x; m3[5] = t1.y; m3[6] = t1.z; m3[7] = t1.w; }
#pragma unroll
            for (int j = 0; j < 8; ++j) o[j] = z[j];
            if (gc > 0) unpack8(*(const u32x4*)(p - NZR), a); else {
#pragma unroll
                for (int j = 0; j < 8; ++j) a[j] = 0.f; }
#pragma unroll
            for (int j = 0; j < 8; ++j) o[j] += m0[j] * (a[j] - z[j]);
            if (gc < 63) unpack8(*(const u32x4*)(p + NZR), a); else {
#pragma unroll
                for (int j = 0; j < 8; ++j) a[j] = 0.f; }
#pragma unroll
            for (int j = 0; j < 8; ++j) o[j] += m1[j] * (a[j] - z[j]);
            if (gr > 0) unpack8(*(const u32x4*)(p - (size_t)64 * NZR), a); else {
#pragma unroll
                for (int j = 0; j < 8; ++j) a[j] = 0.f; }
#pragma unroll
            for (int j = 0; j < 8; ++j) o[j] += m2[j] * (a[j] - z[j]);
            if (gr < 63) unpack8(*(const u32x4*)(p + (size_t)64 * NZR), a); else {
#pragma unroll
                for (int j = 0; j < 8; ++j) a[j] = 0.f; }
#pragma unroll
            for (int j = 0; j < 8; ++j) o[j] += m3[j] * (a[j] - z[j]);
            if (c0 >= 3200) {
                u32x4 w; w.x = pk2(sigmoidf_(o[0]), sigmoidf_(o[1])); w.y = pk2(sigmoidf_(o[2]), sigmoidf_(o[3])); w.z = pk2(sigmoidf_(o[4]), sigmoidf_(o[5])); w.w = pk2(sigmoidf_(o[6]), sigmoidf_(o[7]));
                *(u32x4*)(XG + (size_t)row * 256 + (c0 - 3200)) = w;
                *(u32x4*)(XG + (size_t)row * 256 + 128 + (c0 - 3200)) = (u32x4){0u, 0u, 0u, 0u};
            }
        } else {
            const int tc = (row - ML) & (TC - 1);
#pragma unroll
            for (int j = 0; j < 8; ++j) o[j] = z[j];
            if (tc > 0) unpack8(*(const u32x4*)(p - NZR), a); else {
#pragma unroll
                for (int j = 0; j < 8; ++j) a[j] = 0.f; }
#pragma unroll
            for (int j = 0; j < 8; ++j) o[j] += m0[j] * (a[j] - z[j]);
            if (tc < TC - 1) unpack8(*(const u32x4*)(p + NZR), a); else {
#pragma unroll
                for (int j = 0; j < 8; ++j) a[j] = 0.f; }
#pragma unroll
            for (int j = 0; j < 8; ++j) o[j] += m1[j] * (a[j] - z[j]);
        }
        if (c0 >= 3072 && c0 < 3136) {
#pragma unroll
            for (int j = 0; j < 8; ++j) o[j] = tanhf(o[j]); }
        {
            const bool isk = c0 >= 1024 && c0 < 2048; float ss = 0.f;
            if (isk) { const f32x4 k0 = *(const f32x4*)(F.in[I_KK] + c0 - 1024), k1 = *(const f32x4*)(F.in[I_KK] + c0 - 1020);
                const float t0 = o[0] * k0.x, t1 = o[1] * k0.y, t2 = o[2] * k0.z, t3 = o[3] * k0.w, t4 = o[4] * k1.x, t5 = o[5] * k1.y, t6 = o[6] * k1.z, t7 = o[7] * k1.w;
                ss = ((t0 * t0 + t1 * t1) + (t2 * t2 + t3 * t3)) + ((t4 * t4 + t5 * t5) + (t6 * t6 + t7 * t7)); }
            ss += __shfl_xor(ss, 1); ss += __shfl_xor(ss, 2); ss += __shfl_xor(ss, 4);
            if (isk && (ch & 7) == 0) RN[(size_t)row * 16 + ((c0 - 1024) >> 6)] = 1.0f / fmaxf(sqrtf(ss), 1e-12f);
        }
        u32x4 w; w.x = pk2(o[0], o[1]); w.y = pk2(o[2], o[3]); w.z = pk2(o[4], o[5]); w.w = pk2(o[6], o[7]);
        *(u32x4*)(ZS + (size_t)row * NZR + c0) = w;
    }
}

constexpr int QC = 16, NSLOT = 4, NPREP = 6;
constexpr int Q_P2T = 0, Q_BKT = 4608, Q_UV = 9728, Q_HY = 14848, Q_CO = 23040, Q_WC = 25088, Q_SLOT = 25344;
constexpr int Q_SLOTS = 0, Q_GLG = NSLOT * Q_SLOT, Q_Y0 = Q_GLG + 4096, Q_UF = Q_Y0 + 8192, Q_SL = Q_UF + 8192, Q_PRM = Q_SL + 9216, Q_FLG = Q_PRM + 1280, Q_AF = Q_FLG + 64, Q_END = Q_AF + 16384;
static_assert(Q_END <= LDS_BYTES - 16, "RWKV LDS overflow");
__device__ __forceinline__ void q_wait_ge(volatile LAS unsigned* p, unsigned need) { while ((unsigned)__builtin_amdgcn_readfirstlane((int)*p) < need) __builtin_amdgcn_s_sleep(1); asm volatile("" ::: "memory"); }
__device__ __forceinline__ void q_publish(volatile LAS unsigned* p, unsigned val, int lane) { asm volatile("s_waitcnt lgkmcnt(0)" ::: "memory"); if (lane == 0) *p = val; asm volatile("" ::: "memory"); }
template <int N> __device__ __forceinline__ float dpp_shr_one(float v) {
    return __builtin_bit_cast(float, __builtin_amdgcn_update_dpp(0x3f800000, __builtin_bit_cast(int, v), 0x110 + N, 0xf, 0xf, false)); }
__device__ __forceinline__ void p4_rwkv_scan(const Frame& F) {
    const bf16_t* ZS = (const bf16_t*)(F.ws + WS_ZRS);
    float* BON = (float*)(F.ws + WS_BON);
    const float* RN = (const float*)(F.ws + WS_RN);
    LAS unsigned char* L = F.lds;
    LAS float* PRM = (LAS float*)(L + Q_PRM);
    volatile LAS unsigned* FLG = (volatile LAS unsigned*)(L + Q_FLG);
    const int tid = F.tid, lane = F.lane, w8 = F.wave;
    const int fr = lane & 15, fq = lane >> 4;
    constexpr int NCH = (TC + T) / QC, NCTX = TC / QC;
    for (int cid = F.bid; cid < 256; cid += F.G) {
        const int b = cid >> 5, h = (cid >> 1) & 15, d = cid & 1;
        bf16_t* Yd = (bf16_t*)(F.ws + (d ? WS_YB : WS_YF));
        auto chunk_row0 = [&](int ci) { const bool ic = ci < NCTX; const int cj = ic ? ci : ci - NCTX, nch = ic ? NCTX : T / QC;
            const int pos = d ? (nch - 1 - cj) : cj; return (ic ? ML + b * TC : b * T) + pos * QC; };
        __syncthreads();
        if (tid < 64) { PRM[tid] = F.in[I_W0][d * 1024 + h * 64 + tid]; PRM[64 + tid] = F.in[I_A0][d * 1024 + h * 64 + tid];
            PRM[128 + tid] = F.in[I_KK][h * 64 + tid]; PRM[192 + tid] = F.in[I_KA][h * 64 + tid]; PRM[256 + tid] = F.in[I_RK][h * 64 + tid]; }
        if (tid < 16) FLG[tid] = 0u;
        for (int it = tid; it < 1024; it += 512) {
            const int l_ = it & 63, f_ = it >> 6, ks_ = f_ & 1, ct_ = (f_ >> 1) & 3, m_ = f_ >> 3; const float* src = m_ ? F.in[I_AUP] : F.in[I_WUP];
            unsigned wv[4];
#pragma unroll
            for (int jj = 0; jj < 8; jj += 2) { const size_t o = ((size_t)(d * 64 + 32 * ks_ + 8 * (l_ >> 4) + jj)) * 1024 + h * 64 + 16 * ct_ + (l_ & 15); wv[jj >> 1] = pk2(src[o], src[o + 1024]); }
            *(LAS u32x4*)(L + Q_AF + it * 16) = (u32x4){wv[0], wv[1], wv[2], wv[3]};
        }
        __syncthreads();
        if (w8 == 0) {
            __builtin_amdgcn_s_setprio(2);
            f32x4 acc[4][4];
#pragma unroll
            for (int i = 0; i < 4; ++i)
#pragma unroll
                for (int j = 0; j < 4; ++j) acc[i][j] = (f32x4){0.f, 0.f, 0.f, 0.f};
            for (int ci = 0; ci < NCH; ++ci) {
                LAS unsigned char* SLT = L + (ci & (NSLOT - 1)) * Q_SLOT;
#pragma unroll
                for (int kt = 0; kt < 4; ++kt)
#pragma unroll
                    for (int vt = 0; vt < 4; ++vt) { u32x2 o; o.x = pk2(acc[kt][vt][0], acc[kt][vt][1]); o.y = pk2(acc[kt][vt][2], acc[kt][vt][3]);
                        *(LAS u32x2*)(L + Q_SL + ((16 * vt + fr) * 72 + 16 * kt + 4 * fq) * 2) = o; }
                q_wait_ge(FLG + (ci & (NSLOT - 1)), (unsigned)ci + 1u);
                if (ci >= 2) q_wait_ge(FLG + 6, (unsigned)ci - 1u);
                asm volatile("s_waitcnt lgkmcnt(0)" ::: "memory");
                LAS float* GLG = (LAS float*)(L + Q_GLG); LAS float* Y0B = (LAS float*)(L + Q_Y0 + (ci & 1) * 4096);
                {
                    bf16x8 af[2][2];
#pragma unroll
                    for (int tt = 0; tt < 2; ++tt)
#pragma unroll
                        for (int ks = 0; ks < 2; ++ks) af[tt][ks] = *(const LAS bf16x8*)(SLT + Q_P2T + ((16 * tt + fr) * 72 + 32 * ks + 8 * fq) * 2);
#pragma unroll 1
                    for (int vt = 0; vt < 4; ++vt) {
                        const bf16x8 b0 = *(const LAS bf16x8*)(L + Q_SL + ((16 * vt + fr) * 72 + 8 * fq) * 2), b1 = *(const LAS bf16x8*)(L + Q_SL + ((16 * vt + fr) * 72 + 32 + 8 * fq) * 2);
                        f32x4 g = (f32x4){0.f, 0.f, 0.f, 0.f}, y = (f32x4){0.f, 0.f, 0.f, 0.f};
                        g = __builtin_amdgcn_mfma_f32_16x16x32_bf16(af[0][0], b0, g, 0, 0, 0); g = __builtin_amdgcn_mfma_f32_16x16x32_bf16(af[0][1], b1, g, 0, 0, 0);
                        y = __builtin_amdgcn_mfma_f32_16x16x32_bf16(af[1][0], b0, y, 0, 0, 0); y = __builtin_amdgcn_mfma_f32_16x16x32_bf16(af[1][1], b1, y, 0, 0, 0);
#pragma unroll
                        for (int r = 0; r < 4; ++r) { GLG[(4 * fq + r) * 64 + 16 * vt + fr] = g[r]; Y0B[(4 * fq + r) * 64 + 16 * vt + fr] = y[r]; }
                    }
                }
                asm volatile("s_waitcnt lgkmcnt(0)" ::: "memory");
                {
                    const LAS float* HY = (const LAS float*)(SLT + Q_HY); const LAS float* CN = (const LAS float*)(SLT + Q_CO);
                    float u[16];
#pragma unroll
                    for (int t = 0; t < 16; ++t) {
                        float a = GLG[t * 64 + lane] + HY[t * 64 + lane];
#pragma unroll
                        for (int i4 = 0; i4 < (t + 3) / 4; ++i4) { const f32x4 c4 = *(const LAS f32x4*)(CN + t * 16 + 4 * i4);
#pragma unroll
                            for (int j = 0; j < 4; ++j) if (4 * i4 + j < t) a += u[4 * i4 + j] * c4[j]; }
                        u[t] = -a;
                        asm volatile("" ::: "memory");
                    }
                    LAS float* UF = (LAS float*)(L + Q_UF + (ci & 1) * 4096);
#pragma unroll
                    for (int t = 0; t < 16; ++t) UF[t * 64 + lane] = u[t];
                    u32x4 o0, o1; o0.x = pk2(u[0], u[1]); o0.y = pk2(u[2], u[3]); o0.z = pk2(u[4], u[5]); o0.w = pk2(u[6], u[7]);
                    o1.x = pk2(u[8], u[9]); o1.y = pk2(u[10], u[11]); o1.z = pk2(u[12], u[13]); o1.w = pk2(u[14], u[15]);
                    *(LAS u32x4*)(SLT + Q_UV + (lane * 40) * 2) = o0; *(LAS u32x4*)(SLT + Q_UV + (lane * 40 + 8) * 2) = o1;
                }
                q_publish(FLG + 4, (unsigned)ci + 1u, lane);
                {
                    bf16x8 bu[4];
#pragma unroll
                    for (int vt = 0; vt < 4; ++vt) bu[vt] = *(const LAS bf16x8*)(SLT + Q_UV + ((16 * vt + fr) * 40 + 8 * fq) * 2);
#pragma unroll
                    for (int kt = 0; kt < 4; ++kt) {
                        const bf16x8 ak = *(const LAS bf16x8*)(SLT + Q_BKT + ((16 * kt + fr) * 40 + 8 * fq) * 2);
                        const f32x4 wc = *(const LAS f32x4*)(SLT + Q_WC + (16 * kt + 4 * fq) * 4);
#pragma unroll
                        for (int vt = 0; vt < 4; ++vt) acc[kt][vt] = __builtin_amdgcn_mfma_f32_16x16x32_bf16(ak, bu[vt], acc[kt][vt] * wc, 0, 0, 0);
                    }
                }
                q_publish(FLG + 5, (unsigned)ci + 1u, lane);
            }
            __builtin_amdgcn_s_setprio(0);
        } else if (w8 == 1) {
            for (int ci = 0; ci < NCH; ++ci) {
                q_wait_ge(FLG + 4, (unsigned)ci + 1u);
                if (ci >= NCTX) {
                    const LAS unsigned char* SLT = L + (ci & (NSLOT - 1)) * Q_SLOT;
                    const LAS float* HY = (const LAS float*)(SLT + Q_HY); const LAS float* CT2 = (const LAS float*)(SLT + Q_CO + 1024);
                    const LAS float* Y0B = (const LAS float*)(L + Q_Y0 + (ci & 1) * 4096); const LAS float* UF = (const LAS float*)(L + Q_UF + (ci & 1) * 4096);
                    float u[16];
#pragma unroll
                    for (int t = 0; t < 16; ++t) u[t] = UF[t * 64 + lane];
                    const int row0 = chunk_row0(ci);
#pragma unroll
                    for (int t = 0; t < 16; ++t) {
                        float y = Y0B[t * 64 + lane] + HY[(16 + t) * 64 + lane];
#pragma unroll
                        for (int i4 = 0; i4 < (t + 4) / 4; ++i4) { const f32x4 c4 = *(const LAS f32x4*)(CT2 + t * 16 + 4 * i4);
#pragma unroll
                            for (int j = 0; j < 4; ++j) if (4 * i4 + j <= t) y += u[4 * i4 + j] * c4[j]; }
                        Yd[(size_t)(row0 + (d ? QC - 1 - t : t)) * D + h * 64 + lane] = (bf16_t)f2bf(y);
                        asm volatile("" ::: "memory");
                    }
                }
                q_publish(FLG + 6, (unsigned)ci + 1u, lane);
            }
        } else {
            const int pw = w8 - 2;
            for (int ci = pw; ci < NCH; ci += NPREP) {
                const bool isctx = ci < NCTX;
                const int row = chunk_row0(ci) + (d ? QC - 1 - fr : fr);
                const bf16_t* p_ = ZS + (size_t)row * NZR;
                LAS unsigned char* SLT = L + (ci & (NSLOT - 1)) * Q_SLOT;
                const u32x4 tw0 = *(const u32x4*)(p_ + 3072 + 8 * fq), tw1 = *(const u32x4*)(p_ + 3104 + 8 * fq), xa0 = *(const u32x4*)(p_ + 3136 + 8 * fq), xa1 = *(const u32x4*)(p_ + 3168 + 8 * fq);
                const float rnv = RN[(size_t)row * 16 + h];
                if (ci >= NSLOT) { q_wait_ge(FLG + 5, (unsigned)(ci - NSLOT) + 1u); q_wait_ge(FLG + 6, (unsigned)(ci - NSLOT) + 1u); }
                f32x4 gN = (f32x4){0.f, 0.f, 0.f, 0.f}, gT1 = gN, gT2 = gN, gT3 = gN; float bon = 0.f;
#pragma unroll 1
                for (int ks = 0; ks < 2; ++ks) {
                    unsigned fal[4], fbe[4], fka[4], frh[4];
#pragma unroll
                    for (int u = 0; u < 2; ++u) {
                        const int ct = 2 * ks + u, c = 16 * ct + 4 * fq;
                        const u32x2 gr_ = *(const u32x2*)(p_ + h * 64 + c), gk_ = *(const u32x2*)(p_ + 1024 + h * 64 + c), gv_ = *(const u32x2*)(p_ + 2048 + h * 64 + c);
                        f32x4 zw = (f32x4){0.f, 0.f, 0.f, 0.f}, za = (f32x4){0.f, 0.f, 0.f, 0.f};
                        { const LAS bf16x8* af = (const LAS bf16x8*)(L + Q_AF) + lane;
                          zw = __builtin_amdgcn_mfma_f32_16x16x32_bf16(af[(2 * ct) * 64], __builtin_bit_cast(bf16x8, tw0), zw, 0, 0, 0);
                          zw = __builtin_amdgcn_mfma_f32_16x16x32_bf16(af[(2 * ct + 1) * 64], __builtin_bit_cast(bf16x8, tw1), zw, 0, 0, 0);
                          za = __builtin_amdgcn_mfma_f32_16x16x32_bf16(af[(8 + 2 * ct) * 64], __builtin_bit_cast(bf16x8, xa0), za, 0, 0, 0);
                          za = __builtin_amdgcn_mfma_f32_16x16x32_bf16(af[(8 + 2 * ct + 1) * 64], __builtin_bit_cast(bf16x8, xa1), za, 0, 0, 0); }
                        const f32x4 w0v = *(const LAS f32x4*)(PRM + c), a0v = *(const LAS f32x4*)(PRM + 64 + c), kkw = *(const LAS f32x4*)(PRM + 128 + c),
                                    kav = *(const LAS f32x4*)(PRM + 192 + c), rkv = *(const LAS f32x4*)(PRM + 256 + c);
                        const float kr[4] = {bflo(gk_.x), bfhi(gk_.x), bflo(gk_.y), bfhi(gk_.y)};
                        const float rr[4] = {bflo(gr_.x), bfhi(gr_.x), bflo(gr_.y), bfhi(gr_.y)};
                        float al[4], be[4], ka[4], rh[4], bw[4], kw[4]; f32x4 wcv;
#pragma unroll
                        for (int i = 0; i < 4; ++i) {
                            const float kk = kr[i] * kkw[i] * rnv;
                            const float sw = sigmoidf_(zw[i] + w0v[i]);
                            const float dec = __expf(-0.6065306597126334f * sw);
                            const float a = sigmoidf_(za[i] + a0v[i]);
                            const float kd = kr[i] * (1.0f + (a - 1.0f) * kav[i]);
                            bon += rr[i] * kd * rkv[i];
                            float W = dec;
                            W *= dpp_shr_one<1>(W); W *= dpp_shr_one<2>(W); W *= dpp_shr_one<4>(W); W *= dpp_shr_one<8>(W);
                            const float Wp = dpp_shr_one<1>(W);
                            const float WC = __shfl(W, (lane & 48) | 15);
                            const float iW = 1.0f / W;
                            al[i] = Wp * kk; be[i] = kk * a * iW; ka[i] = kd * iW; rh[i] = W * rr[i]; bw[i] = be[i] * WC; kw[i] = ka[i] * WC; wcv[i] = WC;
                        }
                        fal[2 * u] = pk2(al[0], al[1]); fal[2 * u + 1] = pk2(al[2], al[3]); fbe[2 * u] = pk2(be[0], be[1]); fbe[2 * u + 1] = pk2(be[2], be[3]);
                        fka[2 * u] = pk2(ka[0], ka[1]); fka[2 * u + 1] = pk2(ka[2], ka[3]); frh[2 * u] = pk2(rh[0], rh[1]); frh[2 * u + 1] = pk2(rh[2], rh[3]);
                        *(LAS u32x2*)(SLT + Q_P2T + (fr * 72 + c) * 2) = (u32x2){fal[2 * u], fal[2 * u + 1]};
                        *(LAS u32x2*)(SLT + Q_P2T + ((16 + fr) * 72 + c) * 2) = (u32x2){frh[2 * u], frh[2 * u + 1]};
                        const float vv[4] = {bflo(gv_.x), bfhi(gv_.x), bflo(gv_.y), bfhi(gv_.y)};
#pragma unroll
                        for (int i = 0; i < 4; ++i) {
                            *(LAS bf16_t*)(SLT + Q_BKT + ((c + i) * 40 + fr) * 2) = (bf16_t)f2bf(bw[i]);
                            *(LAS bf16_t*)(SLT + Q_BKT + ((c + i) * 40 + 16 + fr) * 2) = (bf16_t)f2bf(kw[i]);
                            *(LAS bf16_t*)(SLT + Q_UV + ((c + i) * 40 + 16 + fr) * 2) = (bf16_t)f2bf(vv[i]); }
                        if (fr == 0) *(LAS f32x4*)(SLT + Q_WC + c * 4) = wcv;
                    }
                    const bf16x8 xal = __builtin_bit_cast(bf16x8, (u32x4){fal[0], fal[1], fal[2], fal[3]}), xbe = __builtin_bit_cast(bf16x8, (u32x4){fbe[0], fbe[1], fbe[2], fbe[3]});
                    const bf16x8 xka = __builtin_bit_cast(bf16x8, (u32x4){fka[0], fka[1], fka[2], fka[3]}), xrh = __builtin_bit_cast(bf16x8, (u32x4){frh[0], frh[1], frh[2], frh[3]});
                    gN = __builtin_amdgcn_mfma_f32_16x16x32_bf16(xbe, xal, gN, 0, 0, 0);
                    gT2 = __builtin_amdgcn_mfma_f32_16x16x32_bf16(xbe, xrh, gT2, 0, 0, 0);
                    gT1 = __builtin_amdgcn_mfma_f32_16x16x32_bf16(xka, xal, gT1, 0, 0, 0);
                    gT3 = __builtin_amdgcn_mfma_f32_16x16x32_bf16(xka, xrh, gT3, 0, 0, 0);
                }
                bon += __shfl_xor(bon, 16); bon += __shfl_xor(bon, 32);
                if (!isctx && fq == 0) BON[((size_t)d * ML + row) * 16 + h] = bon;
#pragma unroll
                for (int r = 0; r < 4; ++r) { const int i = 4 * fq + r; if (!(i < fr)) { gN[r] = 0.f; gT1[r] = 0.f; } if (!(i <= fr)) { gT2[r] = 0.f; gT3[r] = 0.f; } }
                *(LAS f32x4*)(SLT + Q_CO + (fr * 16 + 4 * fq) * 4) = gN; *(LAS f32x4*)(SLT + Q_CO + 1024 + (fr * 16 + 4 * fq) * 4) = gT2;
                asm volatile("s_waitcnt lgkmcnt(0)" ::: "memory");
                {
                    const bf16x8 a1 = __builtin_bit_cast(bf16x8, (u32x4){pk2(gT1[0], gT1[1]), pk2(gT1[2], gT1[3]), 0u, 0u});
                    const bf16x8 a3 = __builtin_bit_cast(bf16x8, (u32x4){pk2(gT3[0], gT3[1]), pk2(gT3[2], gT3[3]), 0u, 0u});
                    LAS float* HY = (LAS float*)(SLT + Q_HY);
#pragma unroll
                    for (int vt = 0; vt < 4; ++vt) {
                        const u32x2 vv = *(const LAS u32x2*)(SLT + Q_UV + ((16 * vt + fr) * 40 + 16 + 4 * fq) * 2);
                        const bf16x8 bv = __builtin_bit_cast(bf16x8, (u32x4){vv.x, vv.y, 0u, 0u});
                        f32x4 hh = (f32x4){0.f, 0.f, 0.f, 0.f}, yv = hh;
                        hh = __builtin_amdgcn_mfma_f32_16x16x32_bf16(a1, bv, hh, 0, 0, 0); yv = __builtin_amdgcn_mfma_f32_16x16x32_bf16(a3, bv, yv, 0, 0, 0);
#pragma unroll
                        for (int r = 0; r < 4; ++r) { HY[(4 * fq + r) * 64 + 16 * vt + fr] = hh[r]; HY[(16 + 4 * fq + r) * 64 + 16 * vt + fr] = yv[r]; }
                    }
                }
                q_publish(FLG + (ci & (NSLOT - 1)), (unsigned)ci + 1u, lane);
            }
        }
        __syncthreads();
    }
}

__device__ __forceinline__ void p5_rwkv_norm(const Frame& F) {
    bf16_t* YF = (bf16_t*)(F.ws + WS_YF); const bf16_t* YBk = (const bf16_t*)(F.ws + WS_YB); const bf16_t* ZS = (const bf16_t*)(F.ws + WS_ZRS);
    const float* BON = (const float*)(F.ws + WS_BON);
    const float* lnw = F.in[I_LNW]; const float* lnb = F.in[I_LNB];
    const size_t total = (size_t)ML * 256;
    for (size_t i = (size_t)F.bid * 512 + F.tid; i < total; i += (size_t)F.G * 512) {
        const int row = (int)(i >> 8), c = ((int)i & 255) * 4, h = c >> 6;
        const u32x2 a = *(const u32x2*)(YF + (size_t)row * D + c), b = *(const u32x2*)(YBk + (size_t)row * D + c);
        float y[4] = {bflo(a.x) + bflo(b.x), bfhi(a.x) + bfhi(b.x), bflo(a.y) + bflo(b.y), bfhi(a.y) + bfhi(b.y)};
        const float mean = sum16((y[0] + y[1]) + (y[2] + y[3])) * (1.f / 64.f);
        float q = 0.f;
#pragma unroll
        for (int j = 0; j < 4; ++j) { y[j] -= mean; q += y[j] * y[j]; }
        const float rstd = 1.0f / sqrtf(sum16(q) * (1.f / 64.f) + GN_EPS);
        const float bon = BON[(size_t)row * 16 + h] + BON[((size_t)ML + row) * 16 + h];
        const u32x2 vw = *(const u32x2*)(ZS + (size_t)row * NZR + 2048 + c);
        const float v[4] = {bflo(vw.x), bfhi(vw.x), bflo(vw.y), bfhi(vw.y)};
        const f32x4 lw = *(const f32x4*)(lnw + c), lb = *(const f32x4*)(lnb + c);
        float o[4];
#pragma unroll
        for (int j = 0; j < 4; ++j) o[j] = y[j] * rstd * lw[j] + lb[j] + bon * v[j];
        u32x2 w; w.x = pk2(o[0], o[1]); w.y = pk2(o[2], o[3]);
        *(u32x2*)(YF + (size_t)row * D + c) = w;
    }
}

constexpr int HC = 64;
constexpr int H_RAWQ = 0, H_RAWF = 16384, H_RAWI = 32768;
constexpr int H_PL = 0;
constexpr int H_TOT = 40960;
constexpr int H_DEC = H_TOT + 2048;
constexpr int H_QIN = H_DEC + 1024, H_KIN = H_QIN + 17408, H_QB = H_KIN + 17408;
constexpr int H_KINT = H_QB + 17408;
constexpr int H_VT = H_KINT + 18432;
constexpr int H_ST = H_VT + 9216;
constexpr int H_OL = H_ST + 17408;
constexpr int H_END = H_OL + 9216;
static_assert(H_END <= LDS_BYTES - 16, "HGRN2 LDS overflow");
__device__ __forceinline__ void p8_hgrn_scan(const Frame& F) {
    const bf16_t* ZH = (const bf16_t*)(F.ws + WS_ZH);
    LAS unsigned char* L = F.lds;
    const int tid = F.tid, lane = F.lane, w8 = F.wave;
    const float* hglb = F.in[I_HGLB];
    const int fr = lane & 15, fq = lane >> 4;
    for (int cid = F.bid; cid < 256; cid += F.G) {
        const int b = cid >> 5, hh = (cid >> 2) & 7, d = (cid >> 1) & 1, vh = cid & 1;
        bf16_t* Od = (bf16_t*)(F.ws + (d ? WS_OB : WS_OF));
        const int k1 = tid & 127, seg = tid >> 7;
        const float lbk = sigmoidf_(hglb[hh * 128 + k1] - hglb[1024 + hh * 128 + k1]);
        f32x4 Sreg[4];
#pragma unroll
        for (int i = 0; i < 4; ++i) Sreg[i] = (f32x4){0.f, 0.f, 0.f, 0.f};
        __syncthreads();
        for (int i = tid; i < 17408 / 4; i += 512) ((LAS unsigned*)(L + H_ST))[i] = 0u;
        constexpr int NCH = (TC + T) / HC;
        u32x4 pq0, pq1, pf0, pf1, pi0;
        auto chunk_row0 = [&](int ci) { const bool isctx = ci < TC / HC; const int cj = isctx ? ci : ci - TC / HC, nch = isctx ? TC / HC : T / HC;
            const int pos = d ? (nch - 1 - cj) : cj; return (isctx ? ML + b * TC : b * T) + pos * HC; };
#define H_PREFETCH(ci_) do { const int r0_ = chunk_row0(ci_); \
            { const int st = tid >> 4, kc = tid & 15; const bf16_t* g0 = ZH + (size_t)(r0_ + (d ? HC - 1 - st : st)) * NZH + hh * 128 + 8 * kc; \
              const bf16_t* g1 = ZH + (size_t)(r0_ + (d ? HC - 1 - (st + 32) : (st + 32))) * NZH + hh * 128 + 8 * kc; \
              pq0 = *(const u32x4*)g0; pq1 = *(const u32x4*)g1; pf0 = *(const u32x4*)(g0 + (d ? 2048 : 1024)); pf1 = *(const u32x4*)(g1 + (d ? 2048 : 1024)); } \
            { const int st = tid >> 3, vc = tid & 7; pi0 = *(const u32x4*)(ZH + (size_t)(r0_ + (d ? HC - 1 - st : st)) * NZH + 3072 + hh * 128 + vh * 64 + 8 * vc); } } while (0)
        H_PREFETCH(0);
        for (int ci = 0; ci < NCH; ++ci) {
            const bool isctx = ci < TC / HC;
            const int row0 = chunk_row0(ci);
            { const int st = tid >> 4, kc = tid & 15;
              *(LAS u32x4*)(L + H_RAWQ + (st * 128 + 8 * kc) * 2) = pq0; *(LAS u32x4*)(L + H_RAWQ + ((st + 32) * 128 + 8 * kc) * 2) = pq1;
              *(LAS u32x4*)(L + H_RAWF + (st * 128 + 8 * kc) * 2) = pf0; *(LAS u32x4*)(L + H_RAWF + ((st + 32) * 128 + 8 * kc) * 2) = pf1; }
            { const int st = tid >> 3, vc = tid & 7; *(LAS u32x4*)(L + H_RAWI + (st * 64 + 8 * vc) * 2) = pi0; }
            if (ci + 1 < NCH) H_PREFETCH(ci + 1);
            __syncthreads();
            float cc[16], kfv[16], qv[16];
            { float c = 0.f;
#pragma unroll
              for (int j = 0; j < 16; ++j) { const int st = 16 * seg + j;
                  const float fz = __builtin_bit_cast(float, (unsigned)(*(const LAS bf16_t*)(L + H_RAWF + (st * 128 + k1) * 2)) << 16);
                  qv[j] = __builtin_bit_cast(float, (unsigned)(*(const LAS bf16_t*)(L + H_RAWQ + (st * 128 + k1) * 2)) << 16);
                  const float f = lbk + (1.0f - lbk) * sigmoidf_(fz);
                  c += __logf(f); cc[j] = c; kfv[j] = 1.0f - f; }
              ((LAS float*)(L + H_TOT))[seg * 128 + k1] = c; }
            __syncthreads();
            { const LAS float* TOT = (const LAS float*)(L + H_TOT);
              const float t0 = TOT[k1], t1 = TOT[128 + k1], t2 = TOT[256 + k1], t3 = TOT[384 + k1];
              const float off = (seg > 0 ? t0 : 0.f) + (seg > 1 ? t1 : 0.f) + (seg > 2 ? t2 : 0.f);
              const float bref = t0 + t1, blast = (t0 + t1) + (t2 + t3);
              unsigned kp[8];
#pragma unroll
              for (int j = 0; j < 16; ++j) { const int st = 16 * seg + j; const float bb = cc[j] + off;
                  const float eq = __expf(bb - bref), ek = __expf(bref - bb), eb = __expf(bb);
                  const unsigned qin = f2bf(qv[j] * eq), kin = f2bf(kfv[j] * ek), qb = f2bf(qv[j] * eb);
                  *(LAS bf16_t*)(L + H_QIN + (st * 136 + k1) * 2) = (bf16_t)qin; *(LAS bf16_t*)(L + H_KIN + (st * 136 + k1) * 2) = (bf16_t)kin; *(LAS bf16_t*)(L + H_QB + (st * 136 + k1) * 2) = (bf16_t)qb;
                  if (j & 1) kp[j >> 1] |= kin << 16; else kp[j >> 1] = kin; }
              *(LAS u32x4*)(L + H_KINT + (k1 * 72 + 16 * seg) * 2) = (u32x4){kp[0], kp[1], kp[2], kp[3]};
              *(LAS u32x4*)(L + H_KINT + (k1 * 72 + 16 * seg + 8) * 2) = (u32x4){kp[4], kp[5], kp[6], kp[7]};
              if (seg == 0) { ((LAS float*)(L + H_DEC))[k1] = __expf(blast); ((LAS float*)(L + H_DEC))[128 + k1] = __expf(blast - bref); } }
            { const int v = tid & 63, s8 = tid >> 6; unsigned vp[4];
#pragma unroll
              for (int j = 0; j < 8; ++j) { const unsigned x = *(const LAS bf16_t*)(L + H_RAWI + ((8 * s8 + j) * 64 + v) * 2); if (j & 1) vp[j >> 1] |= x << 16; else vp[j >> 1] = x; }
              *(LAS u32x4*)(L + H_VT + (v * 72 + 8 * s8) * 2) = (u32x4){vp[0], vp[1], vp[2], vp[3]}; }
            __syncthreads();
            if (!isctx) {
                const int tt = w8 >> 1;
#pragma unroll
                for (int u = 0; u < 2; ++u) { const int stl = 2 * (w8 & 1) + u; f32x4 acc = (f32x4){0.f, 0.f, 0.f, 0.f};
                    if (stl <= tt) {
#pragma unroll
                        for (int ks = 0; ks < 4; ++ks) { const bf16x8 a = *(const LAS bf16x8*)(L + H_QIN + ((16 * tt + fr) * 136 + 32 * ks + 8 * fq) * 2);
                            const bf16x8 bq = *(const LAS bf16x8*)(L + H_KIN + ((16 * stl + fr) * 136 + 32 * ks + 8 * fq) * 2);
                            acc = __builtin_amdgcn_mfma_f32_16x16x32_bf16(a, bq, acc, 0, 0, 0); } }
#pragma unroll
                    for (int r = 0; r < 4; ++r) { const int t = 16 * tt + 4 * fq + r, s = 16 * stl + fr; const float pv = (s <= t && stl <= tt) ? acc[r] : 0.f;
                        *(LAS bf16_t*)(L + H_PL + (t * 72 + s) * 2) = (bf16_t)f2bf(pv); } }
            }
            __syncthreads();
            if (!isctx) {
                const int tt = w8 >> 1;
#pragma unroll
                for (int u = 0; u < 2; ++u) { const int vt = 2 * (w8 & 1) + u; f32x4 acc = (f32x4){0.f, 0.f, 0.f, 0.f};
#pragma unroll
                    for (int ks = 0; ks < 2; ++ks) { const bf16x8 a = *(const LAS bf16x8*)(L + H_PL + ((16 * tt + fr) * 72 + 32 * ks + 8 * fq) * 2);
                        const bf16x8 bv = *(const LAS bf16x8*)(L + H_VT + ((16 * vt + fr) * 72 + 32 * ks + 8 * fq) * 2);
                        acc = __builtin_amdgcn_mfma_f32_16x16x32_bf16(a, bv, acc, 0, 0, 0); }
#pragma unroll
                    for (int ks = 0; ks < 4; ++ks) { const bf16x8 a = *(const LAS bf16x8*)(L + H_QB + ((16 * tt + fr) * 136 + 32 * ks + 8 * fq) * 2);
                        const bf16x8 bs = *(const LAS bf16x8*)(L + H_ST + ((16 * vt + fr) * 136 + 32 * ks + 8 * fq) * 2);
                        acc = __builtin_amdgcn_mfma_f32_16x16x32_bf16(a, bs, acc, 0, 0, 0); }
#pragma unroll
                    for (int r = 0; r < 4; ++r) *(LAS bf16_t*)(L + H_OL + ((16 * tt + 4 * fq + r) * 72 + 16 * vt + fr) * 2) = (bf16_t)f2bf(acc[r]); }
            }
            { const LAS float* DEC = (const LAS float*)(L + H_DEC);
              const f32x4 dk = *(const LAS f32x4*)(DEC + 16 * w8 + 4 * fq), e2 = *(const LAS f32x4*)(DEC + 128 + 16 * w8 + 4 * fq);
#pragma unroll
              for (int vt = 0; vt < 4; ++vt) { f32x4 acc = (f32x4){0.f, 0.f, 0.f, 0.f};
#pragma unroll
                  for (int ks = 0; ks < 2; ++ks) { const bf16x8 a = *(const LAS bf16x8*)(L + H_KINT + ((16 * w8 + fr) * 72 + 32 * ks + 8 * fq) * 2);
                      const bf16x8 bv = *(const LAS bf16x8*)(L + H_VT + ((16 * vt + fr) * 72 + 32 * ks + 8 * fq) * 2);
                      acc = __builtin_amdgcn_mfma_f32_16x16x32_bf16(a, bv, acc, 0, 0, 0); }
                  Sreg[vt] = dk * Sreg[vt] + e2 * acc; } }
            __syncthreads();
#pragma unroll
            for (int vt = 0; vt < 4; ++vt) { u32x2 o; o.x = pk2(Sreg[vt][0], Sreg[vt][1]); o.y = pk2(Sreg[vt][2], Sreg[vt][3]);
                *(LAS u32x2*)(L + H_ST + ((16 * vt + fr) * 136 + 16 * w8 + 4 * fq) * 2) = o; }
            if (!isctx) { const int st = tid >> 3, vc = tid & 7;
                const u32x4 o = *(const LAS u32x4*)(L + H_OL + (st * 72 + 8 * vc) * 2);
                *(u32x4*)(Od + (size_t)(row0 + (d ? HC - 1 - st : st)) * D + hh * 128 + vh * 64 + 8 * vc) = o; }
        }
#undef H_PREFETCH
        __syncthreads();
    }
}

__device__ __forceinline__ void p10_hgrn_read(const Frame& F) {
    bf16_t* OF = (bf16_t*)(F.ws + WS_OF); const bf16_t* OBk = (const bf16_t*)(F.ws + WS_OB); const bf16_t* ZG = (const bf16_t*)(F.ws + WS_ZG);
    const float* nw = F.in[I_HGNW];
    const size_t total = (size_t)ML * 256;
    for (size_t i = (size_t)F.bid * 512 + F.tid; i < total; i += (size_t)F.G * 512) {
        const int row = (int)(i >> 8), c = ((int)i & 255) * 4;
        const u32x2 a = *(const u32x2*)(OF + (size_t)row * D + c), b = *(const u32x2*)(OBk + (size_t)row * D + c);
        const float o[4] = {bflo(a.x) + bflo(b.x), bfhi(a.x) + bfhi(b.x), bflo(a.y) + bflo(b.y), bfhi(a.y) + bfhi(b.y)};
        const float ms = sum32((o[0] * o[0] + o[1] * o[1]) + (o[2] * o[2] + o[3] * o[3])) * (1.f / 128.f);
        const float rs = 1.0f / sqrtf(ms + RMS_EPS);
        const u32x2 gw = *(const u32x2*)(ZG + (size_t)row * NZG + c);
        const float g[4] = {bflo(gw.x), bfhi(gw.x), bflo(gw.y), bfhi(gw.y)};
        const f32x4 w = *(const f32x4*)(nw + c);
        float y[4];
#pragma unroll
        for (int j = 0; j < 4; ++j) y[j] = o[j] * rs * w[j] * (g[j] * sigmoidf_(g[j]));
        u32x2 ww; ww.x = pk2(y[0], y[1]); ww.y = pk2(y[2], y[3]);
        *(u32x2*)(OF + (size_t)row * D + c) = ww;
    }
}

template <bool COOP>
__device__ __forceinline__ void mk_body(const Args& args) {
    extern __shared__ __attribute__((aligned(16))) unsigned char lds_raw[];
    Frame F;
    F.lds = (LAS unsigned char*)lds_raw;
    F.tid = threadIdx.x; F.lane = F.tid & 63; F.wave = __builtin_amdgcn_readfirstlane(F.tid >> 6);
    F.G = gridDim.x; F.bid = blockIdx.x;
    F.in = args.in; F.ws = args.ws; F.dob = (unsigned char*)args.out;
    const int lo = args.ph_lo, hi = args.ph_hi;
    const float* MOD = (const float*)(F.ws + WS_MOD);
    const int gw = F.bid * 8 + F.wave, NGW = F.G * 8;
#define IN(k) (lo <= (k) && (k) < hi)
    XcdBarrier xbar; xbar.bar = (unsigned*)(F.ws + WS_CTL); xbar.x = 0; xbar.st = nullptr;
    if (COOP) {
        volatile LAS unsigned* st = (volatile LAS unsigned*)(F.lds + LDS_BYTES - 16);
        if (F.tid < 4) st[F.tid] = 0u;
        __syncthreads();
        xbar = xcd_barrier_post((unsigned*)(F.ws + WS_CTL), st);
    }
#define SEAM(k) do { if (COOP && IN(k) && IN((k) + 1)) { if ((k) == 0) cg::this_grid().sync(); else xcd_barrier(xbar); } } while (0)

    if (IN(0)) { p0_prologue(F); }
#if (MK_REPMASK >> 0) & 1
    if (COOP) cg::this_grid().sync();
    if (IN(0)) { p0_prologue(F); }
#endif
    SEAM(0);
    if (IN(1)) {
        bf16_t* H = (bf16_t*)(F.dob + DO_H);
        for (int m = gw; m < MR; m += NGW) {
            const bool lat = m < ML; const int b = lat ? (m >> 12) : 8;
            const float* xr = lat ? F.in[I_X] + (size_t)m * D : F.in[I_CTX] + (size_t)(m - ML) * D;
            modnorm_row(xr, F.in[I_N1W], MOD + b * 6144, MOD + b * 6144 + 1024, H + (size_t)m * D, F.lane);
        }
    }
#if (MK_REPMASK >> 1) & 1
    if (COOP) cg::this_grid().sync();
    if (IN(1)) {
        bf16_t* H = (bf16_t*)(F.dob + DO_H);
        for (int m = gw; m < MR; m += NGW) {
            const bool lat = m < ML; const int b = lat ? (m >> 12) : 8;
            const float* xr = lat ? F.in[I_X] + (size_t)m * D : F.in[I_CTX] + (size_t)(m - ML) * D;
            modnorm_row(xr, F.in[I_N1W], MOD + b * 6144, MOD + b * 6144 + 1024, H + (size_t)m * D, F.lane);
        }
    }
#endif
    SEAM(1);
    if (IN(2)) {
        pg8::Sched S; S.init(F.dob + DO_H, F.dob + DO_WIN, nullptr, nullptr, MR, NZR, D, F.G, F.bid, 1);
        pg8::EpiBf16 E{(bf16_t*)(F.ws + WS_R1), NZR};
        pg8::gemm_phase(F.lds, D, S, E);
    }
#if (MK_REPMASK >> 2) & 1
    if (COOP) cg::this_grid().sync();
    if (IN(2)) {
        pg8::Sched S; S.init(F.dob + DO_H, F.dob + DO_WIN, nullptr, nullptr, MR, NZR, D, F.G, F.bid, 1);
        pg8::EpiBf16 E{(bf16_t*)(F.ws + WS_R1), NZR};
        pg8::gemm_phase(F.lds, D, S, E);
    }
#endif
    SEAM(2);
    if (IN(3)) { p3_shift(F); }
#if (MK_REPMASK >> 3) & 1
    if (COOP) cg::this_grid().sync();
    if (IN(3)) { p3_shift(F); }
#endif
    SEAM(3);
    if (IN(4)) { p4_rwkv_scan(F); }
#if (MK_REPMASK >> 4) & 1
    if (COOP) cg::this_grid().sync();
    if (IN(4)) { p4_rwkv_scan(F); }
#endif
    SEAM(4);
    if (IN(5)) { p5_rwkv_norm(F); }
#if (MK_REPMASK >> 5) & 1
    if (COOP) cg::this_grid().sync();
    if (IN(5)) { p5_rwkv_norm(F); }
#endif
    SEAM(5);
    if (IN(6)) {
        pg8::Sched S; S.init(F.ws + WS_XGS, F.dob + DO_GUP, nullptr, nullptr, ML, D, 256, F.G, F.bid, 1);
        pg8::EpiMulBf16 E{(const bf16_t*)(F.ws + WS_YF), (bf16_t*)(F.ws + WS_YRW), D};
        pg8::gemm_phase(F.lds, 256, S, E);
    }
#if (MK_REPMASK >> 6) & 1
    if (COOP) cg::this_grid().sync();
    if (IN(6)) {
        pg8::Sched S; S.init(F.ws + WS_XGS, F.dob + DO_GUP, nullptr, nullptr, ML, D, 256, F.G, F.bid, 1);
        pg8::EpiMulBf16 E{(const bf16_t*)(F.ws + WS_YF), (bf16_t*)(F.ws + WS_YRW), D};
        pg8::gemm_phase(F.lds, 256, S, E);
    }
#endif
    SEAM(6);
    if (IN(7)) {
        pg8::Sched S; S.init(F.dob + DO_H, F.dob + DO_WIN + (size_t)NZR * D * 2, nullptr, nullptr, MR, NZH, D, F.G, F.bid, 1);
        pg8::EpiBf16 E{(bf16_t*)(F.ws + WS_ZH), NZH};
        pg8::gemm_phase(F.lds, D, S, E);
    }
#if (MK_REPMASK >> 7) & 1
    if (COOP) cg::this_grid().sync();
    if (IN(7)) {
        pg8::Sched S; S.init(F.dob + DO_H, F.dob + DO_WIN + (size_t)NZR * D * 2, nullptr, nullptr, MR, NZH, D, F.G, F.bid, 1);
        pg8::EpiBf16 E{(bf16_t*)(F.ws + WS_ZH), NZH};
        pg8::gemm_phase(F.lds, D, S, E);
    }
#endif
    SEAM(7);
    if (IN(8)) { p8_hgrn_scan(F); }
#if (MK_REPMASK >> 8) & 1
    if (COOP) cg::this_grid().sync();
    if (IN(8)) { p8_hgrn_scan(F); }
#endif
    SEAM(8);
    if (IN(9)) {
        pg8::Sched S; S.init(F.dob + DO_H, F.dob + DO_WIN + (size_t)(NZR + NZH) * D * 2, nullptr, nullptr, ML, NZG, D, F.G, F.bid, 1);
        pg8::EpiBf16 E{(bf16_t*)(F.ws + WS_ZG), NZG};
        pg8::gemm_phase(F.lds, D, S, E);
    }
#if (MK_REPMASK >> 9) & 1
    if (COOP) cg::this_grid().sync();
    if (IN(9)) {
        pg8::Sched S; S.init(F.dob + DO_H, F.dob + DO_WIN + (size_t)(NZR + NZH) * D * 2, nullptr, nullptr, ML, NZG, D, F.G, F.bid, 1);
        pg8::EpiBf16 E{(bf16_t*)(F.ws + WS_ZG), NZG};
        pg8::gemm_phase(F.lds, D, S, E);
    }
#endif
    SEAM(9);
    if (IN(10)) { p10_hgrn_read(F); }
#if (MK_REPMASK >> 10) & 1
    if (COOP) cg::this_grid().sync();
    if (IN(10)) { p10_hgrn_read(F); }
#endif
    SEAM(10);
    if (IN(11)) {
        pg8::Sched S; S.init(F.ws + WS_YRW, F.dob + DO_PA, F.ws + WS_OF, F.dob + DO_PB, ML, D, D, F.G, F.bid, 2);
        pg8::EpiMerge E{(const bf16_t*)(F.ws + WS_ZG), (bf16_t*)(F.ws + WS_MRG)};
        pg8::gemm_phase(F.lds, D, S, E);
    }
#if (MK_REPMASK >> 11) & 1
    if (COOP) cg::this_grid().sync();
    if (IN(11)) {
        pg8::Sched S; S.init(F.ws + WS_YRW, F.dob + DO_PA, F.ws + WS_OF, F.dob + DO_PB, ML, D, D, F.G, F.bid, 2);
        pg8::EpiMerge E{(const bf16_t*)(F.ws + WS_ZG), (bf16_t*)(F.ws + WS_MRG)};
        pg8::gemm_phase(F.lds, D, S, E);
    }
#endif
    SEAM(11);
    if (IN(12)) {
        pg8::Sched S; S.init(F.ws + WS_MRG, F.dob + DO_WO, nullptr, nullptr, ML, D, D, F.G, F.bid, 1);
        pg8::EpiResid E{F.in[I_X], (float*)(F.ws + WS_X1), MOD + 2048};
        pg8::gemm_phase(F.lds, D, S, E);
    }
#if (MK_REPMASK >> 12) & 1
    if (COOP) cg::this_grid().sync();
    if (IN(12)) {
        pg8::Sched S; S.init(F.ws + WS_MRG, F.dob + DO_WO, nullptr, nullptr, ML, D, D, F.G, F.bid, 1);
        pg8::EpiResid E{F.in[I_X], (float*)(F.ws + WS_X1), MOD + 2048};
        pg8::gemm_phase(F.lds, D, S, E);
    }
#endif
    SEAM(12);
    if (IN(13)) {
        const float* X1 = (const float*)(F.ws + WS_X1); bf16_t* H2 = (bf16_t*)(F.ws + WS_H2);
        for (int m = gw; m < ML; m += NGW) { const int b = m >> 12;
            modnorm_row(X1 + (size_t)m * D, F.in[I_N2W], MOD + b * 6144 + 3072, MOD + b * 6144 + 4096, H2 + (size_t)m * D, F.lane); }
    }
#if (MK_REPMASK >> 13) & 1
    if (COOP) cg::this_grid().sync();
    if (IN(13)) {
        const float* X1 = (const float*)(F.ws + WS_X1); bf16_t* H2 = (bf16_t*)(F.ws + WS_H2);
        for (int m = gw; m < ML; m += NGW) { const int b = m >> 12;
            modnorm_row(X1 + (size_t)m * D, F.in[I_N2W], MOD + b * 6144 + 3072, MOD + b * 6144 + 4096, H2 + (size_t)m * D, F.lane); }
    }
#endif
    SEAM(13);
    if (IN(14)) {
        pg8::Sched S; S.init(F.ws + WS_H2, F.dob + DO_FC1, nullptr, nullptr, ML, FF, D, F.G, F.bid, 1);
        pg8::EpiSqRelu E{(bf16_t*)(F.ws + WS_U), FF};
        pg8::gemm_phase(F.lds, D, S, E);
    }
#if (MK_REPMASK >> 14) & 1
    if (COOP) cg::this_grid().sync();
    if (IN(14)) {
        pg8::Sched S; S.init(F.ws + WS_H2, F.dob + DO_FC1, nullptr, nullptr, ML, FF, D, F.G, F.bid, 1);
        pg8::EpiSqRelu E{(bf16_t*)(F.ws + WS_U), FF};
        pg8::gemm_phase(F.lds, D, S, E);
    }
#endif
    SEAM(14);
    if (IN(15)) {
        pg8::Sched S; S.init(F.ws + WS_U, F.dob + DO_FC2, nullptr, nullptr, ML, D, FF, F.G, F.bid, 1);
        pg8::EpiResid E{(const float*)(F.ws + WS_X1), (float*)(F.ws + WS_X1), MOD + 5120};
        pg8::gemm_phase(F.lds, FF, S, E);
    }
#if (MK_REPMASK >> 15) & 1
    if (COOP) cg::this_grid().sync();
    if (IN(15)) {
        pg8::Sched S; S.init(F.ws + WS_U, F.dob + DO_FC2, nullptr, nullptr, ML, D, FF, F.G, F.bid, 1);
        pg8::EpiResid E{(const float*)(F.ws + WS_X1), (float*)(F.ws + WS_X1), MOD + 5120};
        pg8::gemm_phase(F.lds, FF, S, E);
    }
#endif
    SEAM(15);
    if (IN(16)) {
        const float* X2 = (const float*)(F.ws + WS_X1); const float* fw = F.in[I_FNW];
        for (int m = gw; m < ML; m += NGW) {
            const float* xr = X2 + (size_t)m * D; float* orow = args.out + (size_t)m * D;
            f32x4 v[4]; float s = 0.f;
#pragma unroll
            for (int j = 0; j < 4; ++j) { v[j] = *(const f32x4*)(xr + 4 * F.lane + 256 * j); s += (v[j].x * v[j].x + v[j].y * v[j].y) + (v[j].z * v[j].z + v[j].w * v[j].w); }
            const float rs = 1.0f / sqrtf(wave_sum(s) * (1.f / D) + RMS_EPS);
#pragma unroll
            for (int j = 0; j < 4; ++j) { const int c = 4 * F.lane + 256 * j; *(f32x4*)(orow + c) = v[j] * rs * *(const f32x4*)(fw + c); }
        }
    }
#if (MK_REPMASK >> 16) & 1
    if (COOP) cg::this_grid().sync();
    if (IN(16)) {
        const float* X2 = (const float*)(F.ws + WS_X1); const float* fw = F.in[I_FNW];
        for (int m = gw; m < ML; m += NGW) {
            const float* xr = X2 + (size_t)m * D; float* orow = args.out + (size_t)m * D;
            f32x4 v[4]; float s = 0.f;
#pragma unroll
            for (int j = 0; j < 4; ++j) { v[j] = *(const f32x4*)(xr + 4 * F.lane + 256 * j); s += (v[j].x * v[j].x + v[j].y * v[j].y) + (v[j].z * v[j].z + v[j].w * v[j].w); }
            const float rs = 1.0f / sqrtf(wave_sum(s) * (1.f / D) + RMS_EPS);
#pragma unroll
            for (int j = 0; j < 4; ++j) { const int c = 4 * F.lane + 256 * j; *(f32x4*)(orow + c) = v[j] * rs * *(const f32x4*)(fw + c); }
        }
    }
#endif

#undef IN
#undef SEAM
}

__global__ void __launch_bounds__(512, 2) mk_multi(Args args) { mk_body<false>(args); }
__global__ void __launch_bounds__(512, 2) mk_one(Args args) { mk_body<true>(args); }

extern "C" void kernel_launch(void* const* d_in, const int* in_sizes, int n_in, void* d_out, int out_size, void* d_ws, size_t ws_size, hipStream_t stream) {
    static int grid = 0;
    if (grid == 0) {
        if (n_in != 28 || out_size != ML * D || ws_size < WS_END) { fprintf(stderr, "kernel_launch: unexpected problem (n_in %d, out %d, ws %zu)\n", n_in, out_size, ws_size); grid = -1; return; }
        int dev = 0, cus = 0;
        if (hipGetDevice(&dev) != hipSuccess || hipDeviceGetAttribute(&cus, hipDeviceAttributeMultiprocessorCount, dev) != hipSuccess) { grid = -1; return; }
        (void)hipFuncSetAttribute((const void*)mk_multi, hipFuncAttributeMaxDynamicSharedMemorySize, LDS_BYTES);
        (void)hipFuncSetAttribute((const void*)mk_one, hipFuncAttributeMaxDynamicSharedMemorySize, LDS_BYTES);
        int per_cu = 0;
        (void)hipOccupancyMaxActiveBlocksPerMultiprocessor(&per_cu, (const void*)mk_one, 512, LDS_BYTES);
        (void)hipGetLastError();
        grid = cus;
        if (per_cu < 1) fprintf(stderr, "kernel_launch: occupancy query reports %d blocks per CU\n", per_cu);
    }
    if (grid < 0) return;
    (void)hipMemsetAsync((char*)d_ws + WS_CTL, 0, XCD_BAR_WORDS * 4, stream);
    Args a{};
    for (int i = 0; i < 28; ++i) a.in[i] = (const float*)d_in[i];
    a.out = (float*)d_out; a.ws = (unsigned char*)d_ws;
#if MK_ONE_LAUNCH
    a.ph_lo = 0; a.ph_hi = NPHASE;
    void* kargs[] = {&a};
    hipError_t e = hipLaunchCooperativeKernel((const void*)mk_one, dim3(grid), dim3(512), kargs, LDS_BYTES, stream);
    if (e != hipSuccess) fprintf(stderr, "cooperative launch failed: %s\n", hipGetErrorString(e));
#else
    for (int p = 0; p < NPHASE; ++p) { a.ph_lo = p; a.ph_hi = p + 1; hipLaunchKernelGGL(mk_multi, dim3(grid), dim3(512), LDS_BYTES, stream, a); }
#endif
}
```

```cpp
#include <hip/hip_runtime.h>
#include <hip/hip_cooperative_groups.h>
#include <cstdio>
#include <cstdint>
namespace cg = cooperative_groups;

#ifndef MK_ONE_LAUNCH
#define MK_ONE_LAUNCH 1
#endif
#ifndef MK_REPMASK
#define MK_REPMASK 0x0u
#endif

#define LAS __attribute__((address_space(3)))
typedef unsigned short bf16_t;
typedef short bf16x8 __attribute__((ext_vector_type(8)));
typedef float f32x4 __attribute__((ext_vector_type(4)));
typedef float f32x2 __attribute__((ext_vector_type(2)));
typedef unsigned u32x4 __attribute__((ext_vector_type(4)));
typedef unsigned u32x2 __attribute__((ext_vector_type(2)));

constexpr int D = 1024, NB = 8, T = 4096, TC = 256, GW = 64;
constexpr int ML = NB * T;
constexpr int MC = NB * TC;
constexpr int MR = ML + MC;
constexpr int NZR = 3328, NZH = 4096, NZG = 3072, NIN = 10496, FF = 4096;
constexpr float RMS_EPS = 1e-6f, GN_EPS = 64e-5f;

constexpr size_t MiB = 1u << 20;
constexpr size_t WS_CTL = 0, WS_MOD = 1 * MiB;
constexpr size_t WS_R1 = 2 * MiB;
constexpr size_t WS_YF = 2 * MiB, WS_YB = 66 * MiB, WS_YRW = 130 * MiB;
constexpr size_t WS_OF = 2 * MiB, WS_OB = 66 * MiB;
constexpr size_t WS_X1 = 2 * MiB;
constexpr size_t WS_H2 = 130 * MiB;
constexpr size_t WS_ZRS = 223 * MiB;
constexpr size_t WS_XGS = 444 * MiB;
constexpr size_t WS_BON = 460 * MiB;
constexpr size_t WS_ZH = 194 * MiB;
constexpr size_t WS_ZG = 194 * MiB;
constexpr size_t WS_MRG = 386 * MiB;
constexpr size_t WS_U = 194 * MiB;
constexpr size_t WS_RN = 464 * MiB;
constexpr size_t WS_END = 468 * MiB;
constexpr size_t DO_H = 0;
constexpr size_t DO_WIN = 68 * MiB;
constexpr size_t DO_PA = DO_WIN + (size_t)NIN * D * 2;
constexpr size_t DO_PB = DO_PA + 2 * MiB, DO_WO = DO_PB + 2 * MiB, DO_FC1 = DO_WO + 2 * MiB, DO_FC2 = DO_FC1 + 8 * MiB, DO_GUP = DO_FC2 + 8 * MiB;
constexpr size_t DO_END = DO_GUP + (size_t)1024 * 256 * 2;
static_assert(DO_END <= 128 * MiB, "d_out scratch overflow");

constexpr int LDS_BYTES = 152 * 1024;
constexpr int NPHASE = 17;

__device__ __forceinline__ unsigned f2bf(float f) { return (unsigned)__builtin_bit_cast(unsigned short, (__bf16)f); }
typedef __bf16 bf16x2_t __attribute__((ext_vector_type(2)));
__device__ __forceinline__ unsigned pk2(float lo, float hi) { const f32x2 v = {lo, hi}; return __builtin_bit_cast(unsigned, __builtin_convertvector(v, bf16x2_t)); }
__device__ __forceinline__ float bflo(unsigned w) { return __builtin_bit_cast(float, w << 16); }
__device__ __forceinline__ float bfhi(unsigned w) { return __builtin_bit_cast(float, w & 0xffff0000u); }
__device__ __forceinline__ float sigmoidf_(float x) { return 1.0f / (1.0f + __expf(-x)); }
__device__ __forceinline__ float wave_sum(float v) {
#pragma unroll
    for (int o = 1; o < 64; o <<= 1) v += __shfl_xor(v, o);
    return v;
}
template <int CTRL> __device__ __forceinline__ float dpp_mov(float v) { return __builtin_bit_cast(float, __builtin_amdgcn_update_dpp(0, __builtin_bit_cast(int, v), CTRL, 0xf, 0xf, true)); }
__device__ __forceinline__ float sum16(float v) { v += dpp_mov<0xB1>(v); v += dpp_mov<0x4E>(v); v += dpp_mov<0x141>(v); v += dpp_mov<0x140>(v); return v; }
__device__ __forceinline__ float sum32(float v) { v = sum16(v); v += __shfl_xor(v, 16); return v; }


#define XB_TMO      128
#define XB_XCNT(j)  (256  + 64 * (j))
#define XB_XSUB(j)  (1280 + 64 * (j))
#define XB_XGEN(j)  (2304 + 64 * (j))
#define XB_TOP      3328
#define XB_TOPGEN   3392
#define XCD_BAR_WORDS 3456
#define XB_SPIN_CAP (1u << 18)
__device__ __forceinline__ unsigned xb_ld(unsigned* p)              { return __hip_atomic_load(p, __ATOMIC_RELAXED, __HIP_MEMORY_SCOPE_AGENT); }
__device__ __forceinline__ unsigned xb_add(unsigned* p, unsigned v) { return __hip_atomic_fetch_add(p, v, __ATOMIC_RELAXED, __HIP_MEMORY_SCOPE_AGENT); }
__device__ __forceinline__ unsigned xb_xcc_id() { return (unsigned)__builtin_amdgcn_s_getreg((3 << 11) | 20) & 0xFu; }
#define XB_SPIN(cond, bar) do { unsigned _sp = 0; while (cond) { __builtin_amdgcn_s_sleep(1); \
    if ((++_sp & 255u) == 0u) { if (xb_ld(&(bar)[XB_TMO])) break; if (_sp > XB_SPIN_CAP) { atomicAdd(&(bar)[XB_TMO], 1u); break; } } } } while (0)
struct XcdBarrier { unsigned* bar; unsigned x; volatile LAS unsigned* st; };
__device__ __forceinline__ XcdBarrier xcd_barrier_post(unsigned* bar, volatile LAS unsigned* st) {
    XcdBarrier b; b.bar = bar; b.x = xb_xcc_id(); b.st = st;
    if (threadIdx.x == 0) (void)xb_add(&bar[XB_XCNT(b.x)], 1u);
    return b;
}
__device__ __forceinline__ void xcd_barrier_complete(unsigned* bar, unsigned x, unsigned& nloc, unsigned& nx) {
    const unsigned G = gridDim.x * gridDim.y * gridDim.z;
    unsigned sum, cnt, mine, sp = 0u;
    for (;;) {
        sum = 0u; cnt = 0u; mine = 0u;
#pragma unroll
        for (unsigned j = 0; j < 16; ++j) { const unsigned c = xb_ld(&bar[XB_XCNT(j)]); sum += c; cnt += (c > 0u) ? 1u : 0u; mine = (j == x) ? c : mine; }
        if (sum == G) break;
        __builtin_amdgcn_s_sleep(1);
        if ((++sp & 255u) == 0u) { if (xb_ld(&bar[XB_TMO])) break; if (sp > XB_SPIN_CAP) { atomicAdd(&bar[XB_TMO], 1u); break; } }
    }
    nloc = mine > 0u ? mine : 1u; nx = cnt > 0u ? cnt : 1u;
}
__device__ __forceinline__ void xcd_barrier(const XcdBarrier& b) {
    asm volatile("s_waitcnt vmcnt(0)" ::: "memory");
    __syncthreads();
    if (threadIdx.x == 0) {
        unsigned* bar = b.bar;
        __builtin_amdgcn_s_waitcnt(0);
        unsigned nloc = b.st[0], nx = b.st[1];
        if (nloc == 0u) { xcd_barrier_complete(bar, b.x, nloc, nx); b.st[0] = nloc; b.st[1] = nx; }
        const unsigned old = xb_add(&bar[XB_XSUB(b.x)], 1u);
        const unsigned gen = old / nloc;
        if (old + 1u == (gen + 1u) * nloc) {
            __builtin_amdgcn_fence(__ATOMIC_RELEASE, "agent");
            asm volatile("s_waitcnt vmcnt(0)" ::: "memory");
            const unsigned og = xb_add(&bar[XB_TOP], 1u);
            const unsigned tg = og / nx;
            if (og + 1u == (tg + 1u) * nx) xb_add(&bar[XB_TOPGEN], 1u);
            else XB_SPIN(xb_ld(&bar[XB_TOPGEN]) == tg, bar);
            __builtin_amdgcn_fence(__ATOMIC_ACQUIRE, "agent");
            xb_add(&bar[XB_XGEN(b.x)], 1u);
            asm volatile("s_waitcnt vmcnt(0)" ::: "memory");
        } else {
            XB_SPIN(xb_ld(&bar[XB_XGEN(b.x)]) == gen, bar);
            __builtin_amdgcn_fence(__ATOMIC_ACQUIRE, "agent");
            asm volatile("s_waitcnt vmcnt(0)" ::: "memory");
        }
    }
    __syncthreads();
}

namespace pg8 {
constexpr int BM = 256, BK = 64, HALF = 128, HTB = HALF * BK * 2, STAGE_BYTES = 8 * HTB, NXCD = 8, WGM = 8;
__host__ __device__ __forceinline__ int lds_byte(int r, int c) { const int st = (r >> 4) * 2 + (c >> 5), rr = r & 15, cc = c & 31, ob = rr * 64 + cc * 2; return st * 1024 + (ob ^ (((ob >> 9) & 1) << 5)); }
__host__ __device__ __forceinline__ void stage_rc(int b, int& R, int& C) { const int st = b / 1024, sb = b % 1024, swz = sb ^ (((sb >> 9) & 1) << 5); R = (st >> 1) * 16 + swz / 64; C = (st & 1) * 32 + (swz % 64) / 2; }
__host__ __device__ __forceinline__ int perm32(int rho) { const int n = rho >> 4, i = rho & 15; return 8 * (i >> 2) + 4 * n + (i & 3); }

struct Unit { int pm, pn, sel; };
struct Sched {
    const char* A0; const char* B0; const char* A1; const char* B1;
    int nM, nN, nwg, G, c, nsel; size_t tstep;
    __device__ void init(const void* a0, const void* b0, const void* a1, const void* b1, int M, int N, int K, int G_, int c_, int nsel_) {
        A0 = (const char*)a0; B0 = (const char*)b0; A1 = (const char*)a1; B1 = (const char*)b1; nM = M / BM; nN = N / BM; nwg = nM * nN; G = G_; c = c_; nsel = nsel_; tstep = (size_t)BM * K * 2; }
    __device__ bool next(int i, Unit& u) const {
        const int j = (nsel == 2) ? (i >> 1) : i;
        const long L = (long)j * G + c; if (L >= nwg) return false;
        int wgid = (int)L; { const int q = nwg / NXCD, r = nwg % NXCD, xcd = wgid % NXCD, off = wgid / NXCD; wgid = (xcd < r ? xcd * (q + 1) : r * (q + 1) + (xcd - r) * q) + off; }
        const int nig = WGM * nN, gid = wgid / nig, fm = gid * WGM, gsz = (nM - fm) < WGM ? (nM - fm) : WGM;
        u.pm = fm + ((wgid % nig) % gsz); u.pn = (wgid % nig) / gsz; u.sel = (nsel == 2) ? (i & 1) : 0; return true;
    }
    __device__ __forceinline__ const char* abase(const Unit& u) const { return (u.sel ? A1 : A0) + (size_t)u.pm * tstep; }
    __device__ __forceinline__ const char* bbase(const Unit& u) const { return (u.sel ? B1 : B0) + (size_t)u.pn * tstep; }
};

template <class Epi>
__device__ __forceinline__ void gemm_phase(LAS unsigned char* lds, const int K, const Sched& S, const Epi& E) {
    const int tid = threadIdx.x, wid = __builtin_amdgcn_readfirstlane(tid >> 6), lane = tid & 63, wr = wid >> 2, wc = wid & 3, fr = lane & 15, fq = lane >> 4;
    const int nt = K / BK;
    unsigned voffA[2], voffB[2];
#pragma unroll
    for (int i = 0; i < 2; ++i) { int R, C; stage_rc(tid * 16 + i * 8192, R, C); const int Rb = Epi::PERM ? ((R & ~31) + perm32(R & 31)) : R;
        voffA[i] = (unsigned)(R * K + C) * 2u; voffB[i] = (unsigned)(Rb * K + C) * 2u; }
    const size_t kstep = (size_t)(BK * 2);
    const size_t hstep = (size_t)HALF * K * 2;
    const unsigned ldsw = (unsigned)wid * 1024u;
    const int aoff = lds_byte(wr * 64 + fr, fq * 8), boff = lds_byte(wc * 32 + fr, fq * 8);
#define PG8_SA(b, h) (((b) * 2 + (h)) * HTB)
#define PG8_SB(b, h) ((4 + (b) * 2 + (h)) * HTB)
#define PG8_STAGE(bufoff, gbase, voff) do { _Pragma("unroll") for (int _i = 0; _i < 2; ++_i) \
        __builtin_amdgcn_global_load_lds((const unsigned*)((const char*)(gbase) + (voff)[_i]), (LAS unsigned*)(lds + (bufoff) + ldsw + _i * 8192), 16, 0, 0); } while (0)
#define PG8_LDA(dst, b, h) do { _Pragma("unroll") for (int m = 0; m < 4; ++m) _Pragma("unroll") for (int k = 0; k < 2; ++k) dst[m][k] = *(const LAS bf16x8*)(lds + PG8_SA(b, h) + aoff + m * 2048 + k * 1024); } while (0)
#define PG8_LDB(dst, b, h) do { _Pragma("unroll") for (int n = 0; n < 2; ++n) _Pragma("unroll") for (int k = 0; k < 2; ++k) dst[n][k] = *(const LAS bf16x8*)(lds + PG8_SB(b, h) + boff + n * 2048 + k * 1024); } while (0)
#define PG8_MMA(ai, bj, At, Bt) do { __builtin_amdgcn_s_setprio(1); _Pragma("unroll") for (int m = 0; m < 4; ++m) _Pragma("unroll") for (int n = 0; n < 2; ++n) _Pragma("unroll") for (int k = 0; k < 2; ++k) \
        acc[ai][bj][m][n] = __builtin_amdgcn_mfma_f32_16x16x32_bf16(Bt[n][k], At[m][k], acc[ai][bj][m][n], 0, 0, 0); __builtin_amdgcn_s_setprio(0); } while (0)
#define PG8_WAIT_V(n) asm volatile("s_waitcnt vmcnt(" #n ")" ::: "memory")
#define PG8_WAIT_L(n) asm volatile("s_waitcnt lgkmcnt(" #n ")" ::: "memory")
#define PG8_BAR __builtin_amdgcn_s_barrier()
#define PG8_SCHED __builtin_amdgcn_sched_barrier(0)
    Unit cur, nxt; int ui = 0;
    if (!S.next(0, cur)) return;
    f32x4 acc[2][2][4][2];
#pragma unroll
    for (int a = 0; a < 2; ++a)
#pragma unroll
        for (int b = 0; b < 2; ++b)
#pragma unroll
            for (int m = 0; m < 4; ++m)
#pragma unroll
                for (int n = 0; n < 2; ++n) acc[a][b][m][n] = (f32x4){0.f, 0.f, 0.f, 0.f};
    bf16x8 At[4][2], B0[2][2], B1[2][2];
    const char* cA = S.abase(cur); const char* cB = S.bbase(cur);
    PG8_STAGE(PG8_SB(0, 0), cB, voffB); PG8_STAGE(PG8_SB(0, 1), cB + hstep, voffB); PG8_STAGE(PG8_SA(0, 0), cA, voffA); PG8_STAGE(PG8_SA(0, 1), cA + hstep, voffA);
    if (wr == 1) PG8_BAR;
    PG8_WAIT_V(2); PG8_BAR;
    PG8_STAGE(PG8_SB(1, 0), cB + kstep, voffB); PG8_STAGE(PG8_SA(1, 0), cA + kstep, voffA); PG8_STAGE(PG8_SB(1, 1), cB + hstep + kstep, voffB);
    PG8_WAIT_V(6); PG8_BAR;
    for (;;) {
        const bool has_next = S.next(ui + 1, nxt);
        const char* nA = has_next ? S.abase(nxt) : cA; const char* nB = has_next ? S.bbase(nxt) : cB;
        for (int t = 0; t < nt; t += 2) {
            const bool last = (t == nt - 2);
            const char* a1 = cA + (size_t)(t + 1) * kstep;
            const char* a2 = last ? nA : cA + (size_t)(t + 2) * kstep; const char* b2 = last ? nB : cB + (size_t)(t + 2) * kstep;
            const char* a3 = a2 + kstep; const char* b3 = b2 + kstep;
            PG8_LDB(B0, 0, 0); PG8_LDB(B1, 0, 1); PG8_SCHED; PG8_LDA(At, 0, 0); PG8_STAGE(PG8_SA(1, 1), a1 + hstep, voffA);
            PG8_WAIT_V(8); PG8_WAIT_L(0); PG8_BAR; PG8_MMA(0, 0, At, B0); PG8_MMA(0, 1, At, B1); PG8_BAR; PG8_SCHED;
            PG8_LDA(At, 0, 1); PG8_STAGE(PG8_SB(0, 0), b2, voffB); PG8_STAGE(PG8_SB(0, 1), b2 + hstep, voffB); PG8_STAGE(PG8_SA(0, 0), a2, voffA);
            PG8_WAIT_V(8); PG8_WAIT_L(0); PG8_BAR; PG8_MMA(1, 0, At, B0); PG8_MMA(1, 1, At, B1); PG8_BAR; PG8_SCHED;
            PG8_LDB(B0, 1, 0); PG8_LDB(B1, 1, 1); PG8_SCHED; PG8_LDA(At, 1, 0); PG8_STAGE(PG8_SA(0, 1), a2 + hstep, voffA);
            PG8_WAIT_V(8); PG8_WAIT_L(0); PG8_BAR; PG8_MMA(0, 0, At, B0); PG8_MMA(0, 1, At, B1); PG8_BAR; PG8_SCHED;
            PG8_LDA(At, 1, 1); PG8_STAGE(PG8_SB(1, 0), b3, voffB); PG8_STAGE(PG8_SB(1, 1), b3 + hstep, voffB); PG8_STAGE(PG8_SA(1, 0), a3, voffA);
            PG8_WAIT_V(8); PG8_WAIT_L(0); PG8_BAR; PG8_MMA(1, 0, At, B0); PG8_MMA(1, 1, At, B1); PG8_BAR; PG8_SCHED;
        }
        if (wr == 0) PG8_BAR;
        E(acc, cur, wr, wc, fr, fq);
        if (!has_next) break;
#pragma unroll
        for (int a = 0; a < 2; ++a)
#pragma unroll
            for (int b = 0; b < 2; ++b)
#pragma unroll
                for (int m = 0; m < 4; ++m)
#pragma unroll
                    for (int n = 0; n < 2; ++n) acc[a][b][m][n] = (f32x4){0.f, 0.f, 0.f, 0.f};
        cur = nxt; cA = nA; cB = nB; ++ui;
        if (wr == 1) PG8_BAR;
    }
    PG8_WAIT_V(0);
    PG8_BAR;
#undef PG8_SA
#undef PG8_SB
#undef PG8_STAGE
#undef PG8_LDA
#undef PG8_LDB
#undef PG8_MMA
#undef PG8_WAIT_V
#undef PG8_WAIT_L
#undef PG8_BAR
#undef PG8_SCHED
}

struct EpiBf16 {
    static constexpr bool PERM = true;
    bf16_t* O; int ldc;
    __device__ __forceinline__ void operator()(const f32x4 (&acc)[2][2][4][2], const Unit& u, int wr, int wc, int fr, int fq) const {
        const int row0 = u.pm * BM + wr * 64 + fr, col0 = u.pn * BM + wc * 32 + 8 * fq;
#pragma unroll
        for (int ai = 0; ai < 2; ++ai)
#pragma unroll
            for (int m = 0; m < 4; ++m) { bf16_t* rowp = O + (size_t)(row0 + ai * HALF + m * 16) * ldc + col0;
#pragma unroll
                for (int bj = 0; bj < 2; ++bj) { const f32x4 v0 = acc[ai][bj][m][0], v1 = acc[ai][bj][m][1];
                    u32x4 w; w.x = pk2(v0[0], v0[1]); w.y = pk2(v0[2], v0[3]); w.z = pk2(v1[0], v1[1]); w.w = pk2(v1[2], v1[3]);
                    *(u32x4*)(rowp + bj * HALF) = w; } }
    }
};
struct EpiSqRelu {
    static constexpr bool PERM = true;
    bf16_t* O; int ldc;
    __device__ __forceinline__ void operator()(const f32x4 (&acc)[2][2][4][2], const Unit& u, int wr, int wc, int fr, int fq) const {
        const int row0 = u.pm * BM + wr * 64 + fr, col0 = u.pn * BM + wc * 32 + 8 * fq;
#pragma unroll
        for (int ai = 0; ai < 2; ++ai)
#pragma unroll
            for (int m = 0; m < 4; ++m) { bf16_t* rowp = O + (size_t)(row0 + ai * HALF + m * 16) * ldc + col0;
#pragma unroll
                for (int bj = 0; bj < 2; ++bj) { f32x4 v0 = acc[ai][bj][m][0], v1 = acc[ai][bj][m][1];
#pragma unroll
                    for (int j = 0; j < 4; ++j) { const float a = fmaxf(v0[j], 0.f), b = fmaxf(v1[j], 0.f); v0[j] = a * a; v1[j] = b * b; }
                    u32x4 w; w.x = pk2(v0[0], v0[1]); w.y = pk2(v0[2], v0[3]); w.z = pk2(v1[0], v1[1]); w.w = pk2(v1[2], v1[3]);
                    *(u32x4*)(rowp + bj * HALF) = w; } }
    }
};
struct EpiMulBf16 {
    static constexpr bool PERM = true;
    const bf16_t* Y; bf16_t* O; int ldc;
    __device__ __forceinline__ void operator()(const f32x4 (&acc)[2][2][4][2], const Unit& u, int wr, int wc, int fr, int fq) const {
        const int row0 = u.pm * BM + wr * 64 + fr, col0 = u.pn * BM + wc * 32 + 8 * fq;
#pragma unroll
        for (int ai = 0; ai < 2; ++ai)
#pragma unroll
            for (int m = 0; m < 4; ++m) { const size_t off = (size_t)(row0 + ai * HALF + m * 16) * ldc + col0;
#pragma unroll
                for (int bj = 0; bj < 2; ++bj) { const f32x4 v0 = acc[ai][bj][m][0], v1 = acc[ai][bj][m][1];
                    const u32x4 y = *(const u32x4*)(Y + off + bj * HALF);
                    u32x4 w; w.x = pk2(v0[0] * bflo(y.x), v0[1] * bfhi(y.x)); w.y = pk2(v0[2] * bflo(y.y), v0[3] * bfhi(y.y));
                    w.z = pk2(v1[0] * bflo(y.z), v1[1] * bfhi(y.z)); w.w = pk2(v1[2] * bflo(y.w), v1[3] * bfhi(y.w));
                    *(u32x4*)(O + off + bj * HALF) = w; }
                asm volatile("" ::: "memory"); }
    }
};
struct EpiMerge {
    static constexpr bool PERM = true;
    const bf16_t* ZG; bf16_t* O;
    __device__ __forceinline__ void operator()(const f32x4 (&acc)[2][2][4][2], const Unit& u, int wr, int wc, int fr, int fq) const {
        const int row0 = u.pm * BM + wr * 64 + fr, col0 = u.pn * BM + wc * 32 + 8 * fq;
        const int goff = u.sel ? 2048 : 1024;
#pragma unroll
        for (int ai = 0; ai < 2; ++ai)
#pragma unroll
            for (int m = 0; m < 4; ++m) { const size_t r = (size_t)(row0 + ai * HALF + m * 16);
#pragma unroll
                for (int bj = 0; bj < 2; ++bj) { const f32x4 v0 = acc[ai][bj][m][0], v1 = acc[ai][bj][m][1];
                    const u32x4 g = *(const u32x4*)(ZG + r * NZG + goff + col0 + bj * HALF);
                    float o[8];
                    o[0] = v0[0] * sigmoidf_(bflo(g.x)); o[1] = v0[1] * sigmoidf_(bfhi(g.x)); o[2] = v0[2] * sigmoidf_(bflo(g.y)); o[3] = v0[3] * sigmoidf_(bfhi(g.y));
                    o[4] = v1[0] * sigmoidf_(bflo(g.z)); o[5] = v1[1] * sigmoidf_(bfhi(g.z)); o[6] = v1[2] * sigmoidf_(bflo(g.w)); o[7] = v1[3] * sigmoidf_(bfhi(g.w));
                    bf16_t* op = O + r * D + col0 + bj * HALF;
                    if (u.sel) { const u32x4 p = *(const u32x4*)op;
                        o[0] += bflo(p.x); o[1] += bfhi(p.x); o[2] += bflo(p.y); o[3] += bfhi(p.y); o[4] += bflo(p.z); o[5] += bfhi(p.z); o[6] += bflo(p.w); o[7] += bfhi(p.w); }
                    u32x4 w; w.x = pk2(o[0], o[1]); w.y = pk2(o[2], o[3]); w.z = pk2(o[4], o[5]); w.w = pk2(o[6], o[7]);
                    *(u32x4*)op = w; }
                asm volatile("" ::: "memory"); }
    }
};
struct EpiResid {
    static constexpr bool PERM = false;
    const float* base; float* out; const float* gate;
    __device__ __forceinline__ void operator()(const f32x4 (&acc)[2][2][4][2], const Unit& u, int wr, int wc, int fr, int fq) const {
        const int row0 = u.pm * BM + wr * 64 + fr, col0 = u.pn * BM + wc * 32 + 4 * fq;
        const float* gp = gate + (size_t)((u.pm * BM) / T) * 6144 + col0;
        f32x4 gv[2][2];
#pragma unroll
        for (int bj = 0; bj < 2; ++bj)
#pragma unroll
            for (int n = 0; n < 2; ++n) gv[bj][n] = *(const f32x4*)(gp + bj * HALF + n * 16);
#pragma unroll
        for (int ai = 0; ai < 2; ++ai)
#pragma unroll
            for (int m = 0; m < 4; ++m) { const size_t off = (size_t)(row0 + ai * HALF + m * 16) * D + col0;
#pragma unroll
                for (int bj = 0; bj < 2; ++bj)
#pragma unroll
                    for (int n = 0; n < 2; ++n) { const f32x4 bs = *(const f32x4*)(base + off + bj * HALF + n * 16);
                        *(f32x4*)(out + off + bj * HALF + n * 16) = bs + gv[bj][n] * acc[ai][bj][m][n]; }
                asm volatile("" ::: "memory"); }
    }
};
}

struct Args { const float* in[28]; float* out; unsigned char* ws; int ph_lo, ph_hi; };

struct Frame {
    LAS unsigned char* lds;
    int tid, lane, wave, G, bid;
    const float* const* in;
    unsigned char* ws; unsigned char* dob;
};
enum { I_X = 0, I_C, I_CTX, I_CCTX, I_N1W, I_N2W, I_WMOD, I_BMOD, I_WIN, I_MU, I_W0, I_WUP, I_A0, I_AUP, I_GUP, I_KK, I_KA, I_RK, I_LNW, I_LNB, I_HGLB, I_HGNW, I_PA, I_PB, I_WOUT, I_FC1, I_FC2, I_FNW };

__device__ __forceinline__ void transpose_item(const float* W, int N, bf16_t* WT, int ldk, LAS float* scr, int item, int lane) {
    const int nblk = N / 32, kb = item / nblk, nb = item % nblk, k0 = 64 * kb, n0 = 32 * nb;
#pragma unroll 8
    for (int i = 0; i < 32; ++i) { const int kk = 2 * i + (lane >> 5); scr[kk * 33 + (lane & 31)] = W[(size_t)(k0 + kk) * N + n0 + (lane & 31)]; }
    asm volatile("s_waitcnt lgkmcnt(0)" ::: "memory");
    const int c = lane & 7;
#pragma unroll
    for (int j = 0; j < 4; ++j) { const int n = (lane >> 3) + 8 * j; const LAS float* s = scr + (8 * c) * 33 + n;
        u32x4 o; o.x = pk2(s[0 * 33], s[1 * 33]); o.y = pk2(s[2 * 33], s[3 * 33]); o.z = pk2(s[4 * 33], s[5 * 33]); o.w = pk2(s[6 * 33], s[7 * 33]);
        *(u32x4*)(WT + (size_t)(n0 + n) * ldk + k0 + 8 * c) = o; }
    asm volatile("s_waitcnt lgkmcnt(0)" ::: "memory");
}

__device__ __forceinline__ void p0_prologue(const Frame& F) {
    float* MOD = (float*)(F.ws + WS_MOD);
    if (F.bid < 96) {
        LAS float* act = (LAS float*)F.lds;
        LAS float* red = act + 9 * 1024;
        for (int i = F.tid; i < 9 * 1024; i += 512) { const float v = (i < 8 * 1024) ? F.in[I_C][i] : F.in[I_CCTX][i - 8 * 1024]; act[i] = v * sigmoidf_(v); }
        __syncthreads();
        const float* wm = F.in[I_WMOD];
        const int n = F.bid * 64 + F.lane;
        float a[9];
#pragma unroll
        for (int r = 0; r < 9; ++r) a[r] = 0.f;
        const int kb = F.wave * 128;
#pragma unroll 4
        for (int k = kb; k < kb + 128; ++k) { const float w = wm[(size_t)k * 6144 + n];
#pragma unroll
            for (int r = 0; r < 9; ++r) a[r] += act[r * 1024 + k] * w; }
#pragma unroll
        for (int r = 0; r < 9; ++r) red[(F.wave * 9 + r) * 64 + F.lane] = a[r];
        __syncthreads();
        for (int i = F.tid; i < 9 * 64; i += 512) { const int r = i >> 6, l = i & 63; float s = 0.f;
#pragma unroll
            for (int w = 0; w < 8; ++w) s += red[(w * 9 + r) * 64 + l];
            MOD[r * 6144 + F.bid * 64 + l] = s + F.in[I_BMOD][F.bid * 64 + l]; }
        __syncthreads();
    }
    LAS float* scr = (LAS float*)(F.lds + 48 * 1024) + F.wave * (64 * 33);
    const int gw = F.bid * 8 + F.wave, NGW = F.G * 8;
    constexpr int I_IN = 16 * (NIN / 32), I_SQ = 16 * 32, I_F1 = 16 * (FF / 32), I_F2 = 64 * 32, I_GU = 2 * 32;
    constexpr int NITEMS = I_IN + 3 * I_SQ + I_F1 + I_F2 + I_GU;
    for (int it = gw; it < NITEMS; it += NGW) {
        int r = it;
        if (r < I_IN) { transpose_item(F.in[I_WIN], NIN, (bf16_t*)(F.dob + DO_WIN), D, scr, r, F.lane); continue; } r -= I_IN;
        if (r < I_SQ) { transpose_item(F.in[I_PA], D, (bf16_t*)(F.dob + DO_PA), D, scr, r, F.lane); continue; } r -= I_SQ;
        if (r < I_SQ) { transpose_item(F.in[I_PB], D, (bf16_t*)(F.dob + DO_PB), D, scr, r, F.lane); continue; } r -= I_SQ;
        if (r < I_SQ) { transpose_item(F.in[I_WOUT], D, (bf16_t*)(F.dob + DO_WO), D, scr, r, F.lane); continue; } r -= I_SQ;
        if (r < I_F1) { transpose_item(F.in[I_FC1], FF, (bf16_t*)(F.dob + DO_FC1), D, scr, r, F.lane); continue; } r -= I_F1;
        if (r < I_F2) { transpose_item(F.in[I_FC2], D, (bf16_t*)(F.dob + DO_FC2), FF, scr, r, F.lane); continue; } r -= I_F2;
        transpose_item(F.in[I_GUP], D, (bf16_t*)(F.dob + DO_GUP), 256, scr, r, F.lane);
    }
    { bf16_t* gu = (bf16_t*)(F.dob + DO_GUP);
      for (int i = F.bid * 512 + F.tid; i < 1024 * 16; i += F.G * 512) { const int n = i >> 4, ch = i & 15; *(u32x4*)(gu + (size_t)n * 256 + 128 + ch * 8) = (u32x4){0u, 0u, 0u, 0u}; } }
}

__device__ __forceinline__ void modnorm_row(const float* xrow, const float* nw, const float* sh, const float* sc, bf16_t* orow, int lane) {
    f32x4 v[4]; float s = 0.f;
#pragma unroll
    for (int j = 0; j < 4; ++j) { v[j] = *(const f32x4*)(xrow + 4 * lane + 256 * j); s += (v[j].x * v[j].x + v[j].y * v[j].y) + (v[j].z * v[j].z + v[j].w * v[j].w); }
    const float rs = 1.0f / sqrtf(wave_sum(s) * (1.f / D) + RMS_EPS);
#pragma unroll
    for (int j = 0; j < 4; ++j) { const int c = 4 * lane + 256 * j;
        const f32x4 w = *(const f32x4*)(nw + c), a = *(const f32x4*)(sc + c), b = *(const f32x4*)(sh + c);
        const f32x4 y = (v[j] * rs * w) * (1.0f + a) + b;
        u32x2 o; o.x = pk2(y.x, y.y); o.y = pk2(y.z, y.w); *(u32x2*)(orow + c) = o; }
}

__device__ __forceinline__ void unpack8(const u32x4 w, float (&f)[8]) { f[0] = bflo(w.x); f[1] = bfhi(w.x); f[2] = bflo(w.y); f[3] = bfhi(w.y); f[4] = bflo(w.z); f[5] = bfhi(w.z); f[6] = bflo(w.w); f[7] = bfhi(w.w); }
__device__ __forceinline__ void p3_shift(const Frame& F) {
    const bf16_t* ZR = (const bf16_t*)(F.ws + WS_R1); bf16_t* ZS = (bf16_t*)(F.ws + WS_ZRS); bf16_t* XG = (bf16_t*)(F.ws + WS_XGS);
    const float* mu = F.in[I_MU]; float* RN = (float*)(F.ws + WS_RN);
    constexpr int CH = NZR / 8;
    const size_t total = (size_t)MR * CH;
    for (size_t i = (size_t)F.bid * 512 + F.tid; i < total; i += (size_t)F.G * 512) {
        const int row = (int)(i / CH), ch = (int)(i % CH), c0 = ch * 8;
        const bf16_t* p = ZR + (size_t)row * NZR + c0;
        float z[8], a[8], o[8];
        unpack8(*(const u32x4*)p, z);
        float m0[8], m1[8];
        { const f32x4 t0 = *(const f32x4*)(mu + c0), t1 = *(const f32x4*)(mu + c0 + 4); m0[0] = t0.x; m0[1] = t0.y; m0[2] = t0.z; m0[3] = t0.w; m0[4] = t1.x; m0[5] = t1.y; m0[6] = t1.z; m0[7] = t1.w; }
        { const f32x4 t0 = *(const f32x4*)(mu + NZR + c0), t1 = *(const f32x4*)(mu + NZR + c0 + 4); m1[0] = t0.x; m1[1] = t0.y; m1[2] = t0.z; m1[3] = t0.w; m1[4] = t1.x; m1[5] = t1.y; m1[6] = t1.z; m1[7] = t1.w; }
        if (row < ML) {
            const int t = row & (T - 1), gc = t & 63, gr = t >> 6;
            float m2[8], m3[8];
            { const f32x4 t0 = *(const f32x4*)(mu + 2 * NZR + c0), t1 = *(const f32x4*)(mu + 2 * NZR + c0 + 4); m2[0] = t0.x; m2[1] = t0.y; m2[2] = t0.z; m2[3] = t0.w; m2[4] = t1.x; m2[5] = t1.y; m2[6] = t1.z; m2[7] = t1.w; }
            { const f32x4 t0 = *(const f32x4*)(mu + 3 * NZR + c0), t1 = *(const f32x4*)(mu + 3 * NZR + c0 + 4); m3[0] = t0.x; m3[1] = t0.y; m3[2] = t0.z; m3[3] = t0.w; m3[4] = t1.x; m3[5] = t1.y; m3[6] = t1.z; m3[7] = t1.w; }
#pragma unroll
            for (int j = 0; j < 8; ++j) o[j] = z[j];
            if (gc > 0) unpack8(*(const u32x4*)(p - NZR), a); else {
#pragma unroll
                for (int j = 0; j < 8; ++j) a[j] = 0.f; }
#pragma unroll
            for (int j = 0; j < 8; ++j) o[j] += m0[j] * (a[j] - z[j]);
            if (gc < 63) unpack8(*(const u32x4*)(p + NZR), a); else {
#pragma unroll
                for (int j = 0; j < 8; ++j) a[j] = 0.f; }
#pragma unroll
            for (int j = 0; j < 8; ++j) o[j] += m1[j] * (a[j] - z[j]);
            if (gr > 0) unpack8(*(const u32x4*)(p - (size_t)64 * NZR), a); else {
#pragma unroll
                for (int j = 0; j < 8; ++j) a[j] = 0.f; }
#pragma unroll
            for (int j = 0; j < 8; ++j) o[j] += m2[j] * (a[j] - z[j]);
            if (gr < 63) unpack8(*(const u32x4*)(p + (size_t)64 * NZR), a); else {
#pragma unroll
                for (int j = 0; j < 8; ++j) a[j] = 0.f; }
#pragma unroll
            for (int j = 0; j < 8; ++j) o[j] += m3[j] * (a[j] - z[j]);
            if (c0 >= 3200) {
                u32x4 w; w.x = pk2(sigmoidf_(o[0]), sigmoidf_(o[1])); w.y = pk2(sigmoidf_(o[2]), sigmoidf_(o[3])); w.z = pk2(sigmoidf_(o[4]), sigmoidf_(o[5])); w.w = pk2(sigmoidf_(o[6]), sigmoidf_(o[7]));
                *(u32x4*)(XG + (size_t)row * 256 + (c0 - 3200)) = w;
                *(u32x4*)(XG + (size_t)row * 256 + 128 + (c0 - 3200)) = (u32x4){0u, 0u, 0u, 0u};
            }
        } else {
            const int tc = (row - ML) & (TC - 1);
#pragma unroll
            for (int j = 0; j < 8; ++j) o[j] = z[j];
            if (tc > 0) unpack8(*(const u32x4*)(p - NZR), a); else {
#pragma unroll
                for (int j = 0; j < 8; ++j) a[j] = 0.f; }
#pragma unroll
            for (int j = 0; j < 8; ++j) o[j] += m0[j] * (a[j] - z[j]);
            if (tc < TC - 1) unpack8(*(const u32x4*)(p + NZR), a); else {
#pragma unroll
                for (int j = 0; j < 8; ++j) a[j] = 0.f; }
#pragma unroll
            for (int j = 0; j < 8; ++j) o[j] += m1[j] * (a[j] - z[j]);
        }
        if (c0 >= 3072 && c0 < 3136) {
#pragma unroll
            for (int j = 0; j < 8; ++j) o[j] = tanhf(o[j]); }
        {
            const bool isk = c0 >= 1024 && c0 < 2048; float ss = 0.f;
            if (isk) { const f32x4 k0 = *(const f32x4*)(F.in[I_KK] + c0 - 1024), k1 = *(const f32x4*)(F.in[I_KK] + c0 - 1020);
                const float t0 = o[0] * k0.x, t1 = o[1] * k0.y, t2 = o[2] * k0.z, t3 = o[3] * k0.w, t4 = o[4] * k1.x, t5 = o[5] * k1.y, t6 = o[6] * k1.z, t7 = o[7] * k1.w;
                ss = ((t0 * t0 + t1 * t1) + (t2 * t2 + t3 * t3)) + ((t4 * t4 + t5 * t5) + (t6 * t6 + t7 * t7)); }
            ss += __shfl_xor(ss, 1); ss += __shfl_xor(ss, 2); ss += __shfl_xor(ss, 4);
            if (isk && (ch & 7) == 0) RN[(size_t)row * 16 + ((c0 - 1024) >> 6)] = 1.0f / fmaxf(sqrtf(ss), 1e-12f);
        }
        u32x4 w; w.x = pk2(o[0], o[1]); w.y = pk2(o[2], o[3]); w.z = pk2(o[4], o[5]); w.w = pk2(o[6], o[7]);
        *(u32x4*)(ZS + (size_t)row * NZR + c0) = w;
    }
}

constexpr int QC = 16, NSLOT = 5, NPREP = 6;
constexpr int Q_P2T = 0, Q_BKT = 4608, Q_VV = 9728, Q_HY = 11776, Q_CO = 19968, Q_WC = 20992, Q_SLOT = 21248;
constexpr int Q_YC = NSLOT * Q_SLOT, Q_SL = Q_YC + 8192, Q_PRM = Q_SL + 9216, Q_FLG = Q_PRM + 1280, Q_AF = Q_FLG + 64, Q_END = Q_AF + 16384;
static_assert(Q_END <= LDS_BYTES - 16, "RWKV LDS overflow");
__device__ __forceinline__ void q_wait_ge(volatile LAS unsigned* p, unsigned need) { while ((unsigned)__builtin_amdgcn_readfirstlane((int)*p) < need) __builtin_amdgcn_s_sleep(1); asm volatile("" ::: "memory"); }
__device__ __forceinline__ void q_publish(volatile LAS unsigned* p, unsigned val, int lane) { asm volatile("s_waitcnt lgkmcnt(0)" ::: "memory"); if (lane == 0) *p = val; asm volatile("" ::: "memory"); }
template <int N> __device__ __forceinline__ float dpp_shr_one(float v) {
    return __builtin_bit_cast(float, __builtin_amdgcn_update_dpp(0x3f800000, __builtin_bit_cast(int, v), 0x110 + N, 0xf, 0xf, false)); }
__device__ __forceinline__ bf16x8 qfrag(const f32x4 c) { return __builtin_bit_cast(bf16x8, (u32x4){pk2(c[0], c[1]), pk2(c[2], c[3]), 0u, 0u}); }
__device__ __forceinline__ f32x4 qmm(const f32x4 x, const f32x4 y) { return __builtin_amdgcn_mfma_f32_16x16x32_bf16(qfrag(x), qfrag(y), (f32x4){0.f, 0.f, 0.f, 0.f}, 0, 0, 0); }
__device__ __forceinline__ void p4_rwkv_scan(const Frame& F) {
    const bf16_t* ZS = (const bf16_t*)(F.ws + WS_ZRS);
    float* BON = (float*)(F.ws + WS_BON);
    const float* RN = (const float*)(F.ws + WS_RN);
    LAS unsigned char* L = F.lds;
    LAS float* PRM = (LAS float*)(L + Q_PRM);
    volatile LAS unsigned* FLG = (volatile LAS unsigned*)(L + Q_FLG);
    const int tid = F.tid, lane = F.lane, w8 = F.wave;
    const int fr = lane & 15, fq = lane >> 4;
    constexpr int NCH = (TC + T) / QC, NCTX = TC / QC;
    for (int cid = F.bid; cid < 256; cid += F.G) {
        const int b = cid >> 5, h = (cid >> 1) & 15, d = cid & 1;
        bf16_t* Yd = (bf16_t*)(F.ws + (d ? WS_YB : WS_YF));
        auto chunk_row0 = [&](int ci) { const bool ic = ci < NCTX; const int cj = ic ? ci : ci - NCTX, nch = ic ? NCTX : T / QC;
            const int pos = d ? (nch - 1 - cj) : cj; return (ic ? ML + b * TC : b * T) + pos * QC; };
        __syncthreads();
        if (tid < 64) { PRM[tid] = F.in[I_W0][d * 1024 + h * 64 + tid]; PRM[64 + tid] = F.in[I_A0][d * 1024 + h * 64 + tid];
            PRM[128 + tid] = F.in[I_KK][h * 64 + tid]; PRM[192 + tid] = F.in[I_KA][h * 64 + tid]; PRM[256 + tid] = F.in[I_RK][h * 64 + tid]; }
        if (tid < 16) FLG[tid] = 0u;
        for (int it = tid; it < 1024; it += 512) {
            const int l_ = it & 63, f_ = it >> 6, ks_ = f_ & 1, ct_ = (f_ >> 1) & 3, m_ = f_ >> 3; const float* src = m_ ? F.in[I_AUP] : F.in[I_WUP];
            unsigned wv[4];
#pragma unroll
            for (int jj = 0; jj < 8; jj += 2) { const size_t o = ((size_t)(d * 64 + 32 * ks_ + 8 * (l_ >> 4) + jj)) * 1024 + h * 64 + 16 * ct_ + (l_ & 15); wv[jj >> 1] = pk2(src[o], src[o + 1024]); }
            *(LAS u32x4*)(L + Q_AF + it * 16) = (u32x4){wv[0], wv[1], wv[2], wv[3]};
        }
        __syncthreads();
        if (w8 == 0) {
            __builtin_amdgcn_s_setprio(2);
            f32x4 acc[4][4];
#pragma unroll
            for (int i = 0; i < 4; ++i)
#pragma unroll
                for (int j = 0; j < 4; ++j) acc[i][j] = (f32x4){0.f, 0.f, 0.f, 0.f};
            int slot = 0;
            for (int ci = 0; ci < NCH; ++ci) {
                LAS unsigned char* SLT = L + slot * Q_SLOT;
#pragma unroll
                for (int kt = 0; kt < 4; ++kt)
#pragma unroll
                    for (int vt = 0; vt < 4; ++vt) { u32x2 o; o.x = pk2(acc[kt][vt][0], acc[kt][vt][1]); o.y = pk2(acc[kt][vt][2], acc[kt][vt][3]);
                        *(LAS u32x2*)(L + Q_SL + ((16 * vt + fr) * 72 + 16 * kt + 4 * fq) * 2) = o; }
                q_wait_ge(FLG + slot, (unsigned)ci + 1u);
                if (ci >= 2) q_wait_ge(FLG + 10, (unsigned)ci - 1u);
                asm volatile("s_waitcnt lgkmcnt(0)" ::: "memory");
                f32x4 u[4];
                {
                    bf16x8 af[2][2];
#pragma unroll
                    for (int tt = 0; tt < 2; ++tt)
#pragma unroll
                        for (int ks = 0; ks < 2; ++ks) af[tt][ks] = *(const LAS bf16x8*)(SLT + Q_P2T + ((16 * tt + fr) * 72 + 32 * ks + 8 * fq) * 2);
                    const u32x4 co = *(const LAS u32x4*)(SLT + Q_CO + lane * 16);
                    const bf16x8 fminv = __builtin_bit_cast(bf16x8, (u32x4){co.x, co.y, 0u, 0u}), ft2 = __builtin_bit_cast(bf16x8, (u32x4){co.z, co.w, 0u, 0u});
                    LAS f32x4* YC = (LAS f32x4*)(L + Q_YC + (ci & 1) * 4096);
#pragma unroll
                    for (int vt = 0; vt < 4; ++vt) {
                        const bf16x8 b0 = *(const LAS bf16x8*)(L + Q_SL + ((16 * vt + fr) * 72 + 8 * fq) * 2), b1 = *(const LAS bf16x8*)(L + Q_SL + ((16 * vt + fr) * 72 + 32 + 8 * fq) * 2);
                        const f32x4 hh = *(const LAS f32x4*)(SLT + Q_HY + (vt * 64 + lane) * 16), yv = *(const LAS f32x4*)(SLT + Q_HY + 4096 + (vt * 64 + lane) * 16);
                        f32x4 g = hh, y = yv;
                        g = __builtin_amdgcn_mfma_f32_16x16x32_bf16(af[0][0], b0, g, 0, 0, 0); g = __builtin_amdgcn_mfma_f32_16x16x32_bf16(af[0][1], b1, g, 0, 0, 0);
                        y = __builtin_amdgcn_mfma_f32_16x16x32_bf16(af[1][0], b0, y, 0, 0, 0); y = __builtin_amdgcn_mfma_f32_16x16x32_bf16(af[1][1], b1, y, 0, 0, 0);
                        u[vt] = __builtin_amdgcn_mfma_f32_16x16x32_bf16(fminv, qfrag(g), (f32x4){0.f, 0.f, 0.f, 0.f}, 0, 0, 0);
                        y = __builtin_amdgcn_mfma_f32_16x16x32_bf16(ft2, qfrag(u[vt]), y, 0, 0, 0);
                        YC[vt * 64 + lane] = y;
                    }
                }
                q_publish(FLG + 8, (unsigned)ci + 1u, lane);
                {
                    bf16x8 bu[4];
#pragma unroll
                    for (int vt = 0; vt < 4; ++vt) { const u32x2 vv = *(const LAS u32x2*)(SLT + Q_VV + ((16 * vt + fr) * 16 + 4 * fq) * 2);
                        bu[vt] = __builtin_bit_cast(bf16x8, (u32x4){pk2(u[vt][0], u[vt][1]), pk2(u[vt][2], u[vt][3]), vv.x, vv.y}); }
#pragma unroll
                    for (int kt = 0; kt < 4; ++kt) {
                        const bf16x8 ak = *(const LAS bf16x8*)(SLT + Q_BKT + ((16 * kt + fr) * 40 + 8 * fq) * 2);
                        const f32x4 wc = *(const LAS f32x4*)(SLT + Q_WC + (16 * kt + 4 * fq) * 4);
#pragma unroll
                        for (int vt = 0; vt < 4; ++vt) acc[kt][vt] = __builtin_amdgcn_mfma_f32_16x16x32_bf16(ak, bu[vt], acc[kt][vt] * wc, 0, 0, 0);
                    }
                }
                q_publish(FLG + 9, (unsigned)ci + 1u, lane);
                slot = (slot + 1 == NSLOT) ? 0 : slot + 1;
            }
            __builtin_amdgcn_s_setprio(0);
        } else if (w8 == 1) {
            for (int ci = 0; ci < NCH; ++ci) {
                q_wait_ge(FLG + 8, (unsigned)ci + 1u);
                if (ci >= NCTX) {
                    const LAS f32x4* YC = (const LAS f32x4*)(L + Q_YC + (ci & 1) * 4096);
                    const int row0 = chunk_row0(ci);
#pragma unroll
                    for (int vt = 0; vt < 4; ++vt) { const f32x4 y = YC[vt * 64 + lane];
#pragma unroll
                        for (int r = 0; r < 4; ++r) { const int t = 4 * fq + r; Yd[(size_t)(row0 + (d ? QC - 1 - t : t)) * D + h * 64 + 16 * vt + fr] = (bf16_t)f2bf(y[r]); } }
                }
                q_publish(FLG + 10, (unsigned)ci + 1u, lane);
            }
        } else {
            const int pw = w8 - 2;
            u32x4 tw0, tw1, xa0, xa1; u32x2 gr0, gk0, gv0, gr1, gk1, gv1, gr2, gk2, gv2, gr3, gk3, gv3; float rnv = 0.f;
#define Q_PREFETCH(ci_) do { const int r_ = chunk_row0(ci_) + (d ? QC - 1 - fr : fr); const bf16_t* p_ = ZS + (size_t)r_ * NZR; const bf16_t* q_ = p_ + h * 64 + 4 * fq; \
                tw0 = *(const u32x4*)(p_ + 3072 + 8 * fq); tw1 = *(const u32x4*)(p_ + 3104 + 8 * fq); xa0 = *(const u32x4*)(p_ + 3136 + 8 * fq); xa1 = *(const u32x4*)(p_ + 3168 + 8 * fq); \
                gr0 = *(const u32x2*)(q_); gk0 = *(const u32x2*)(q_ + 1024); gv0 = *(const u32x2*)(q_ + 2048); gr1 = *(const u32x2*)(q_ + 16); gk1 = *(const u32x2*)(q_ + 1040); gv1 = *(const u32x2*)(q_ + 2064); \
                gr2 = *(const u32x2*)(q_ + 32); gk2 = *(const u32x2*)(q_ + 1056); gv2 = *(const u32x2*)(q_ + 2080); gr3 = *(const u32x2*)(q_ + 48); gk3 = *(const u32x2*)(q_ + 1072); gv3 = *(const u32x2*)(q_ + 2096); \
                rnv = RN[(size_t)r_ * 16 + h]; } while (0)
            if (pw < NCH) Q_PREFETCH(pw);
            int slot = pw % NSLOT;
            for (int ci = pw; ci < NCH; ci += NPREP) {
                const bool isctx = ci < NCTX;
                const int row = chunk_row0(ci) + (d ? QC - 1 - fr : fr);
                LAS unsigned char* SLT = L + slot * Q_SLOT;
                if (ci >= NSLOT) { q_wait_ge(FLG + 9, (unsigned)(ci - NSLOT) + 1u); q_wait_ge(FLG + 10, (unsigned)(ci - NSLOT) + 1u); }
                f32x4 gN = (f32x4){0.f, 0.f, 0.f, 0.f}, gNT = gN, gT1 = gN, gT2 = gN, gT3 = gN; float bon = 0.f;
                unsigned fal[4], fbe[4], fka[4], frh[4];
                LAS unsigned char* pP2T = SLT + Q_P2T + (fr * 72 + 4 * fq) * 2;
                LAS unsigned char* pBKT = SLT + Q_BKT + (4 * fq * 40 + 8 * (fr >> 2) + (fr & 3)) * 2;
                LAS unsigned char* pVV = SLT + Q_VV + (4 * fq * 16 + fr) * 2;
                LAS unsigned char* pWC = SLT + Q_WC + 16 * fq;
                const LAS float* pPRM = PRM + 4 * fq;
#define Q_GROUP(ct, u_, GR, GK, GV) do { \
                    f32x4 zw = (f32x4){0.f, 0.f, 0.f, 0.f}, za = (f32x4){0.f, 0.f, 0.f, 0.f}; \
                    { const LAS bf16x8* af = (const LAS bf16x8*)(L + Q_AF) + lane; \
                      zw = __builtin_amdgcn_mfma_f32_16x16x32_bf16(af[(2 * (ct)) * 64], __builtin_bit_cast(bf16x8, tw0), zw, 0, 0, 0); \
                      zw = __builtin_amdgcn_mfma_f32_16x16x32_bf16(af[(2 * (ct) + 1) * 64], __builtin_bit_cast(bf16x8, tw1), zw, 0, 0, 0); \
                      za = __builtin_amdgcn_mfma_f32_16x16x32_bf16(af[(8 + 2 * (ct)) * 64], __builtin_bit_cast(bf16x8, xa0), za, 0, 0, 0); \
                      za = __builtin_amdgcn_mfma_f32_16x16x32_bf16(af[(8 + 2 * (ct) + 1) * 64], __builtin_bit_cast(bf16x8, xa1), za, 0, 0, 0); } \
                    const f32x4 w0v = *(const LAS f32x4*)(pPRM + 16 * (ct)), a0v = *(const LAS f32x4*)(pPRM + 64 + 16 * (ct)), kkw = *(const LAS f32x4*)(pPRM + 128 + 16 * (ct)), \
                                kav = *(const LAS f32x4*)(pPRM + 192 + 16 * (ct)), rkv = *(const LAS f32x4*)(pPRM + 256 + 16 * (ct)); \
                    const float kr[4] = {bflo(GK.x), bfhi(GK.x), bflo(GK.y), bfhi(GK.y)}; \
                    const float rr[4] = {bflo(GR.x), bfhi(GR.x), bflo(GR.y), bfhi(GR.y)}; \
                    const float vv[4] = {bflo(GV.x), bfhi(GV.x), bflo(GV.y), bfhi(GV.y)}; \
                    float al[4], be[4], ka[4], rh[4], bw[4], kw[4]; f32x4 wcv; \
                    _Pragma("unroll") for (int i = 0; i < 4; ++i) { \
                        const float kk = kr[i] * kkw[i] * rnv; \
                        const float sw = sigmoidf_(zw[i] + w0v[i]); \
                        const float dec = __expf(-0.6065306597126334f * sw); \
                        const float a = sigmoidf_(za[i] + a0v[i]); \
                        const float kd = kr[i] * (1.0f + (a - 1.0f) * kav[i]); \
                        bon += rr[i] * kd * rkv[i]; \
                        float W = dec; \
                        W *= dpp_shr_one<1>(W); W *= dpp_shr_one<2>(W); W *= dpp_shr_one<4>(W); W *= dpp_shr_one<8>(W); \
                        const float Wp = dpp_shr_one<1>(W); \
                        const float WC = __shfl(W, (lane & 48) | 15); \
                        const float iW = 1.0f / W; \
                        al[i] = Wp * kk; be[i] = kk * a * iW; ka[i] = kd * iW; rh[i] = W * rr[i]; bw[i] = be[i] * WC; kw[i] = ka[i] * WC; wcv[i] = WC; } \
                    fal[2 * (u_)] = pk2(al[0], al[1]); fal[2 * (u_) + 1] = pk2(al[2], al[3]); fbe[2 * (u_)] = pk2(be[0], be[1]); fbe[2 * (u_) + 1] = pk2(be[2], be[3]); \
                    fka[2 * (u_)] = pk2(ka[0], ka[1]); fka[2 * (u_) + 1] = pk2(ka[2], ka[3]); frh[2 * (u_)] = pk2(rh[0], rh[1]); frh[2 * (u_) + 1] = pk2(rh[2], rh[3]); \
                    *(LAS u32x2*)(pP2T + 32 * (ct)) = (u32x2){fal[2 * (u_)], fal[2 * (u_) + 1]}; \
                    *(LAS u32x2*)(pP2T + 16 * 72 * 2 + 32 * (ct)) = (u32x2){frh[2 * (u_)], frh[2 * (u_) + 1]}; \
                    _Pragma("unroll") for (int i = 0; i < 4; ++i) { \
                        *(LAS bf16_t*)(pBKT + (16 * (ct) + i) * 80) = (bf16_t)f2bf(bw[i]); \
                        *(LAS bf16_t*)(pBKT + (16 * (ct) + i) * 80 + 8) = (bf16_t)f2bf(kw[i]); \
                        *(LAS bf16_t*)(pVV + (16 * (ct) + i) * 32) = (bf16_t)f2bf(vv[i]); } \
                    if (fr == 0) *(LAS f32x4*)(pWC + 64 * (ct)) = wcv; } while (0)
#define Q_GRAM() do { \
                    const bf16x8 xal = __builtin_bit_cast(bf16x8, (u32x4){fal[0], fal[1], fal[2], fal[3]}), xbe = __builtin_bit_cast(bf16x8, (u32x4){fbe[0], fbe[1], fbe[2], fbe[3]}); \
                    const bf16x8 xka = __builtin_bit_cast(bf16x8, (u32x4){fka[0], fka[1], fka[2], fka[3]}), xrh = __builtin_bit_cast(bf16x8, (u32x4){frh[0], frh[1], frh[2], frh[3]}); \
                    gN = __builtin_amdgcn_mfma_f32_16x16x32_bf16(xbe, xal, gN, 0, 0, 0);        \
                    gNT = __builtin_amdgcn_mfma_f32_16x16x32_bf16(xal, xbe, gNT, 0, 0, 0);      \
                    gT2 = __builtin_amdgcn_mfma_f32_16x16x32_bf16(xbe, xrh, gT2, 0, 0, 0);      \
                    gT1 = __builtin_amdgcn_mfma_f32_16x16x32_bf16(xka, xal, gT1, 0, 0, 0);      \
                    gT3 = __builtin_amdgcn_mfma_f32_16x16x32_bf16(xka, xrh, gT3, 0, 0, 0);      } while (0)
                Q_GROUP(0, 0, gr0, gk0, gv0); __builtin_amdgcn_sched_barrier(0); Q_GROUP(1, 1, gr1, gk1, gv1); __builtin_amdgcn_sched_barrier(0); Q_GRAM();
                __builtin_amdgcn_sched_barrier(0);
                Q_GROUP(2, 0, gr2, gk2, gv2); __builtin_amdgcn_sched_barrier(0); Q_GROUP(3, 1, gr3, gk3, gv3); __builtin_amdgcn_sched_barrier(0); Q_GRAM();
                __builtin_amdgcn_sched_barrier(0);
#undef Q_GROUP
#undef Q_GRAM
                bon += __shfl_xor(bon, 16); bon += __shfl_xor(bon, 32);
                if (!isctx && fq == 0) BON[((size_t)d * ML + row) * 16 + h] = bon;
                if (ci + NPREP < NCH) Q_PREFETCH(ci + NPREP);
                f32x4 idn;
#pragma unroll
                for (int r = 0; r < 4; ++r) { const int i = 4 * fq + r; if (!(i < fr)) { gN[r] = 0.f; gT1[r] = 0.f; } if (!(i <= fr)) { gT2[r] = 0.f; gT3[r] = 0.f; } if (!(i > fr)) gNT[r] = 0.f; idn[r] = (i == fr) ? 1.f : 0.f; }
                f32x4 minv;
                { const f32x4 n2 = qmm(gNT, gN), n2t = qmm(gN, gNT);
                  const f32x4 n4 = qmm(n2t, n2), n4t = qmm(n2, n2t);
                  const f32x4 n8t = qmm(n4, n4t);
                  const f32x4 r1 = qmm(idn + n2t, idn - gN);
                  const f32x4 r2 = qmm(idn + n4t, r1);
                  minv = qmm(idn + n8t, r2); }
                *(LAS u32x4*)(SLT + Q_CO + lane * 16) = (u32x4){pk2(-minv[0], -minv[1]), pk2(-minv[2], -minv[3]), pk2(gT2[0], gT2[1]), pk2(gT2[2], gT2[3])};
                asm volatile("s_waitcnt lgkmcnt(0)" ::: "memory");
                {
                    const bf16x8 a1 = qfrag(gT1), a3 = qfrag(gT3);
                    const LAS unsigned char* pVVr = SLT + Q_VV + (fr * 16 + 4 * fq) * 2; LAS unsigned char* pHY = SLT + Q_HY + lane * 16;
#pragma unroll
                    for (int vt = 0; vt < 4; ++vt) {
                        const u32x2 vv = *(const LAS u32x2*)(pVVr + vt * 512);
                        const bf16x8 bv = __builtin_bit_cast(bf16x8, (u32x4){vv.x, vv.y, 0u, 0u});
                        f32x4 hh = (f32x4){0.f, 0.f, 0.f, 0.f}, yv = hh;
                        hh = __builtin_amdgcn_mfma_f32_16x16x32_bf16(a1, bv, hh, 0, 0, 0); yv = __builtin_amdgcn_mfma_f32_16x16x32_bf16(a3, bv, yv, 0, 0, 0);
                        *(LAS f32x4*)(pHY + vt * 1024) = hh; *(LAS f32x4*)(pHY + 4096 + vt * 1024) = yv;
                    }
                }
                q_publish(FLG + slot, (unsigned)ci + 1u, lane);
                slot = (slot + NPREP) % NSLOT;
            }
#undef Q_PREFETCH
        }
        __syncthreads();
    }
}

__device__ __forceinline__ void p5_rwkv_norm(const Frame& F) {
    bf16_t* YF = (bf16_t*)(F.ws + WS_YF); const bf16_t* YBk = (const bf16_t*)(F.ws + WS_YB); const bf16_t* ZS = (const bf16_t*)(F.ws + WS_ZRS);
    const float* BON = (const float*)(F.ws + WS_BON);
    const float* lnw = F.in[I_LNW]; const float* lnb = F.in[I_LNB];
    const size_t total = (size_t)ML * 256;
    for (size_t i = (size_t)F.bid * 512 + F.tid; i < total; i += (size_t)F.G * 512) {
        const int row = (int)(i >> 8), c = ((int)i & 255) * 4, h = c >> 6;
        const u32x2 a = *(const u32x2*)(YF + (size_t)row * D + c), b = *(const u32x2*)(YBk + (size_t)row * D + c);
        float y[4] = {bflo(a.x) + bflo(b.x), bfhi(a.x) + bfhi(b.x), bflo(a.y) + bflo(b.y), bfhi(a.y) + bfhi(b.y)};
        const float mean = sum16((y[0] + y[1]) + (y[2] + y[3])) * (1.f / 64.f);
        float q = 0.f;
#pragma unroll
        for (int j = 0; j < 4; ++j) { y[j] -= mean; q += y[j] * y[j]; }
        const float rstd = 1.0f / sqrtf(sum16(q) * (1.f / 64.f) + GN_EPS);
        const float bon = BON[(size_t)row * 16 + h] + BON[((size_t)ML + row) * 16 + h];
        const u32x2 vw = *(const u32x2*)(ZS + (size_t)row * NZR + 2048 + c);
        const float v[4] = {bflo(vw.x), bfhi(vw.x), bflo(vw.y), bfhi(vw.y)};
        const f32x4 lw = *(const f32x4*)(lnw + c), lb = *(const f32x4*)(lnb + c);
        float o[4];
#pragma unroll
        for (int j = 0; j < 4; ++j) o[j] = y[j] * rstd * lw[j] + lb[j] + bon * v[j];
        u32x2 w; w.x = pk2(o[0], o[1]); w.y = pk2(o[2], o[3]);
        *(u32x2*)(YF + (size_t)row * D + c) = w;
    }
}

constexpr int HC = 64;
constexpr int H_RAWQ = 0, H_RAWF = 16384, H_RAWI = 32768;
constexpr int H_PL = 0;
constexpr int H_TOT = 40960;
constexpr int H_DEC = H_TOT + 2048;
constexpr int H_QIN = H_DEC + 1024, H_KIN = H_QIN + 17408, H_QB = H_KIN + 17408;
constexpr int H_KINT = H_QB + 17408;
constexpr int H_VT = H_KINT + 18432;
constexpr int H_ST = H_VT + 9216;
constexpr int H_OL = H_ST + 17408;
constexpr int H_END = H_OL + 9216;
static_assert(H_END <= LDS_BYTES - 16, "HGRN2 LDS overflow");
__device__ __forceinline__ void p8_hgrn_scan(const Frame& F) {
    const bf16_t* ZH = (const bf16_t*)(F.ws + WS_ZH);
    LAS unsigned char* L = F.lds;
    const int tid = F.tid, lane = F.lane, w8 = F.wave;
    const float* hglb = F.in[I_HGLB];
    const int fr = lane & 15, fq = lane >> 4;
    for (int cid = F.bid; cid < 256; cid += F.G) {
        const int b = cid >> 5, hh = (cid >> 2) & 7, d = (cid >> 1) & 1, vh = cid & 1;
        bf16_t* Od = (bf16_t*)(F.ws + (d ? WS_OB : WS_OF));
        const int k1 = tid & 127, seg = tid >> 7;
        const float lbk = sigmoidf_(hglb[hh * 128 + k1] - hglb[1024 + hh * 128 + k1]);
        f32x4 Sreg[4];
#pragma unroll
        for (int i = 0; i < 4; ++i) Sreg[i] = (f32x4){0.f, 0.f, 0.f, 0.f};
        __syncthreads();
        for (int i = tid; i < 17408 / 4; i += 512) ((LAS unsigned*)(L + H_ST))[i] = 0u;
        constexpr int NCH = (TC + T) / HC;
        u32x4 pq0, pq1, pf0, pf1, pi0;
        auto chunk_row0 = [&](int ci) { const bool isctx = ci < TC / HC; const int cj = isctx ? ci : ci - TC / HC, nch = isctx ? TC / HC : T / HC;
            const int pos = d ? (nch - 1 - cj) : cj; return (isctx ? ML + b * TC : b * T) + pos * HC; };
#define H_PREFETCH(ci_) do { const int r0_ = chunk_row0(ci_); \
            { const int st = tid >> 4, kc = tid & 15; const bf16_t* g0 = ZH + (size_t)(r0_ + (d ? HC - 1 - st : st)) * NZH + hh * 128 + 8 * kc; \
              const bf16_t* g1 = ZH + (size_t)(r0_ + (d ? HC - 1 - (st + 32) : (st + 32))) * NZH + hh * 128 + 8 * kc; \
              pq0 = *(const u32x4*)g0; pq1 = *(const u32x4*)g1; pf0 = *(const u32x4*)(g0 + (d ? 2048 : 1024)); pf1 = *(const u32x4*)(g1 + (d ? 2048 : 1024)); } \
            { const int st = tid >> 3, vc = tid & 7; pi0 = *(const u32x4*)(ZH + (size_t)(r0_ + (d ? HC - 1 - st : st)) * NZH + 3072 + hh * 128 + vh * 64 + 8 * vc); } } while (0)
        H_PREFETCH(0);
        for (int ci = 0; ci < NCH; ++ci) {
            const bool isctx = ci < TC / HC;
            const int row0 = chunk_row0(ci);
            { const int st = tid >> 4, kc = tid & 15;
              *(LAS u32x4*)(L + H_RAWQ + (st * 128 + 8 * kc) * 2) = pq0; *(LAS u32x4*)(L + H_RAWQ + ((st + 32) * 128 + 8 * kc) * 2) = pq1;
              *(LAS u32x4*)(L + H_RAWF + (st * 128 + 8 * kc) * 2) = pf0; *(LAS u32x4*)(L + H_RAWF + ((st + 32) * 128 + 8 * kc) * 2) = pf1; }
            { const int st = tid >> 3, vc = tid & 7; *(LAS u32x4*)(L + H_RAWI + (st * 64 + 8 * vc) * 2) = pi0; }
            if (ci + 1 < NCH) H_PREFETCH(ci + 1);
            __syncthreads();
            float cc[16], kfv[16], qv[16];
            { float c = 0.f;
#pragma unroll
              for (int j = 0; j < 16; ++j) { const int st = 16 * seg + j;
                  const float fz = __builtin_bit_cast(float, (unsigned)(*(const LAS bf16_t*)(L + H_RAWF + (st * 128 + k1) * 2)) << 16);
                  qv[j] = __builtin_bit_cast(float, (unsigned)(*(const LAS bf16_t*)(L + H_RAWQ + (st * 128 + k1) * 2)) << 16);
                  const float f = lbk + (1.0f - lbk) * sigmoidf_(fz);
                  c += __logf(f); cc[j] = c; kfv[j] = 1.0f - f; }
              ((LAS float*)(L + H_TOT))[seg * 128 + k1] = c; }
            __syncthreads();
            { const LAS float* TOT = (const LAS float*)(L + H_TOT);
              const float t0 = TOT[k1], t1 = TOT[128 + k1], t2 = TOT[256 + k1], t3 = TOT[384 + k1];
              const float off = (seg > 0 ? t0 : 0.f) + (seg > 1 ? t1 : 0.f) + (seg > 2 ? t2 : 0.f);
              const float bref = t0 + t1, blast = (t0 + t1) + (t2 + t3);
              unsigned kp[8];
#pragma unroll
              for (int j = 0; j < 16; ++j) { const int st = 16 * seg + j; const float bb = cc[j] + off;
                  const float eq = __expf(bb - bref), ek = __expf(bref - bb), eb = __expf(bb);
                  const unsigned qin = f2bf(qv[j] * eq), kin = f2bf(kfv[j] * ek), qb = f2bf(qv[j] * eb);
                  *(LAS bf16_t*)(L + H_QIN + (st * 136 + k1) * 2) = (bf16_t)qin; *(LAS bf16_t*)(L + H_KIN + (st * 136 + k1) * 2) = (bf16_t)kin; *(LAS bf16_t*)(L + H_QB + (st * 136 + k1) * 2) = (bf16_t)qb;
                  if (j & 1) kp[j >> 1] |= kin << 16; else kp[j >> 1] = kin; }
              *(LAS u32x4*)(L + H_KINT + (k1 * 72 + 16 * seg) * 2) = (u32x4){kp[0], kp[1], kp[2], kp[3]};
              *(LAS u32x4*)(L + H_KINT + (k1 * 72 + 16 * seg + 8) * 2) = (u32x4){kp[4], kp[5], kp[6], kp[7]};
              if (seg == 0) { ((LAS float*)(L + H_DEC))[k1] = __expf(blast); ((LAS float*)(L + H_DEC))[128 + k1] = __expf(blast - bref); } }
            { const int v = tid & 63, s8 = tid >> 6; unsigned vp[4];
#pragma unroll
              for (int j = 0; j < 8; ++j) { const unsigned x = *(const LAS bf16_t*)(L + H_RAWI + ((8 * s8 + j) * 64 + v) * 2); if (j & 1) vp[j >> 1] |= x << 16; else vp[j >> 1] = x; }
              *(LAS u32x4*)(L + H_VT + (v * 72 + 8 * s8) * 2) = (u32x4){vp[0], vp[1], vp[2], vp[3]}; }
            __syncthreads();
            if (!isctx) {
                const int tt = w8 >> 1;
#pragma unroll
                for (int u = 0; u < 2; ++u) { const int stl = 2 * (w8 & 1) + u; f32x4 acc = (f32x4){0.f, 0.f, 0.f, 0.f};
                    if (stl <= tt) {
#pragma unroll
                        for (int ks = 0; ks < 4; ++ks) { const bf16x8 a = *(const LAS bf16x8*)(L + H_QIN + ((16 * tt + fr) * 136 + 32 * ks + 8 * fq) * 2);
                            const bf16x8 bq = *(const LAS bf16x8*)(L + H_KIN + ((16 * stl + fr) * 136 + 32 * ks + 8 * fq) * 2);
                            acc = __builtin_amdgcn_mfma_f32_16x16x32_bf16(a, bq, acc, 0, 0, 0); } }
#pragma unroll
                    for (int r = 0; r < 4; ++r) { const int t = 16 * tt + 4 * fq + r, s = 16 * stl + fr; const float pv = (s <= t && stl <= tt) ? acc[r] : 0.f;
                        *(LAS bf16_t*)(L + H_PL + (t * 72 + s) * 2) = (bf16_t)f2bf(pv); } }
            }
            __syncthreads();
            if (!isctx) {
                const int tt = w8 >> 1;
#pragma unroll
                for (int u = 0; u < 2; ++u) { const int vt = 2 * (w8 & 1) + u; f32x4 acc = (f32x4){0.f, 0.f, 0.f, 0.f};
#pragma unroll
                    for (int ks = 0; ks < 2; ++ks) { const bf16x8 a = *(const LAS bf16x8*)(L + H_PL + ((16 * tt + fr) * 72 + 32 * ks + 8 * fq) * 2);
                        const bf16x8 bv = *(const LAS bf16x8*)(L + H_VT + ((16 * vt + fr) * 72 + 32 * ks + 8 * fq) * 2);
                        acc = __builtin_amdgcn_mfma_f32_16x16x32_bf16(a, bv, acc, 0, 0, 0); }
#pragma unroll
                    for (int ks = 0; ks < 4; ++ks) { const bf16x8 a = *(const LAS bf16x8*)(L + H_QB + ((16 * tt + fr) * 136 + 32 * ks + 8 * fq) * 2);
                        const bf16x8 bs = *(const LAS bf16x8*)(L + H_ST + ((16 * vt + fr) * 136 + 32 * ks + 8 * fq) * 2);
                        acc = __builtin_amdgcn_mfma_f32_16x16x32_bf16(a, bs, acc, 0, 0, 0); }
#pragma unroll
                    for (int r = 0; r < 4; ++r) *(LAS bf16_t*)(L + H_OL + ((16 * tt + 4 * fq + r) * 72 + 16 * vt + fr) * 2) = (bf16_t)f2bf(acc[r]); }
            }
            { const LAS float* DEC = (const LAS float*)(L + H_DEC);
              const f32x4 dk = *(const LAS f32x4*)(DEC + 16 * w8 + 4 * fq), e2 = *(const LAS f32x4*)(DEC + 128 + 16 * w8 + 4 * fq);
#pragma unroll
              for (int vt = 0; vt < 4; ++vt) { f32x4 acc = (f32x4){0.f, 0.f, 0.f, 0.f};
#pragma unroll
                  for (int ks = 0; ks < 2; ++ks) { const bf16x8 a = *(const LAS bf16x8*)(L + H_KINT + ((16 * w8 + fr) * 72 + 32 * ks + 8 * fq) * 2);
                      const bf16x8 bv = *(const LAS bf16x8*)(L + H_VT + ((16 * vt + fr) * 72 + 32 * ks + 8 * fq) * 2);
                      acc = __builtin_amdgcn_mfma_f32_16x16x32_bf16(a, bv, acc, 0, 0, 0); }
                  Sreg[vt] = dk * Sreg[vt] + e2 * acc; } }
            __syncthreads();
#pragma unroll
            for (int vt = 0; vt < 4; ++vt) { u32x2 o; o.x = pk2(Sreg[vt][0], Sreg[vt][1]); o.y = pk2(Sreg[vt][2], Sreg[vt][3]);
                *(LAS u32x2*)(L + H_ST + ((16 * vt + fr) * 136 + 16 * w8 + 4 * fq) * 2) = o; }
            if (!isctx) { const int st = tid >> 3, vc = tid & 7;
                const u32x4 o = *(const LAS u32x4*)(L + H_OL + (st * 72 + 8 * vc) * 2);
                *(u32x4*)(Od + (size_t)(row0 + (d ? HC - 1 - st : st)) * D + hh * 128 + vh * 64 + 8 * vc) = o; }
        }
#undef H_PREFETCH
        __syncthreads();
    }
}

__device__ __forceinline__ void p10_hgrn_read(const Frame& F) {
    bf16_t* OF = (bf16_t*)(F.ws + WS_OF); const bf16_t* OBk = (const bf16_t*)(F.ws + WS_OB); const bf16_t* ZG = (const bf16_t*)(F.ws + WS_ZG);
    const float* nw = F.in[I_HGNW];
    const size_t total = (size_t)ML * 256;
    for (size_t i = (size_t)F.bid * 512 + F.tid; i < total; i += (size_t)F.G * 512) {
        const int row = (int)(i >> 8), c = ((int)i & 255) * 4;
        const u32x2 a = *(const u32x2*)(OF + (size_t)row * D + c), b = *(const u32x2*)(OBk + (size_t)row * D + c);
        const float o[4] = {bflo(a.x) + bflo(b.x), bfhi(a.x) + bfhi(b.x), bflo(a.y) + bflo(b.y), bfhi(a.y) + bfhi(b.y)};
        const float ms = sum32((o[0] * o[0] + o[1] * o[1]) + (o[2] * o[2] + o[3] * o[3])) * (1.f / 128.f);
        const float rs = 1.0f / sqrtf(ms + RMS_EPS);
        const u32x2 gw = *(const u32x2*)(ZG + (size_t)row * NZG + c);
        const float g[4] = {bflo(gw.x), bfhi(gw.x), bflo(gw.y), bfhi(gw.y)};
        const f32x4 w = *(const f32x4*)(nw + c);
        float y[4];
#pragma unroll
        for (int j = 0; j < 4; ++j) y[j] = o[j] * rs * w[j] * (g[j] * sigmoidf_(g[j]));
        u32x2 ww; ww.x = pk2(y[0], y[1]); ww.y = pk2(y[2], y[3]);
        *(u32x2*)(OF + (size_t)row * D + c) = ww;
    }
}

template <bool COOP>
__device__ __forceinline__ void mk_body(const Args& args) {
    extern __shared__ __attribute__((aligned(16))) unsigned char lds_raw[];
    Frame F;
    F.lds = (LAS unsigned char*)lds_raw;
    F.tid = threadIdx.x; F.lane = F.tid & 63; F.wave = __builtin_amdgcn_readfirstlane(F.tid >> 6);
    F.G = gridDim.x; F.bid = blockIdx.x;
    F.in = args.in; F.ws = args.ws; F.dob = (unsigned char*)args.out;
    const int lo = args.ph_lo, hi = args.ph_hi;
    const float* MOD = (const float*)(F.ws + WS_MOD);
    const int gw = F.bid * 8 + F.wave, NGW = F.G * 8;
#define IN(k) (lo <= (k) && (k) < hi)
    XcdBarrier xbar; xbar.bar = (unsigned*)(F.ws + WS_CTL); xbar.x = 0; xbar.st = nullptr;
    if (COOP) {
        volatile LAS unsigned* st = (volatile LAS unsigned*)(F.lds + LDS_BYTES - 16);
        if (F.tid < 4) st[F.tid] = 0u;
        __syncthreads();
        xbar = xcd_barrier_post((unsigned*)(F.ws + WS_CTL), st);
    }
#define SEAM(k) do { if (COOP && IN(k) && IN((k) + 1)) { if ((k) == 0) cg::this_grid().sync(); else xcd_barrier(xbar); } } while (0)

    if (IN(0)) { p0_prologue(F); }
#if (MK_REPMASK >> 0) & 1
    if (COOP) cg::this_grid().sync();
    if (IN(0)) { p0_prologue(F); }
#endif
    SEAM(0);
    if (IN(1)) {
        bf16_t* H = (bf16_t*)(F.dob + DO_H);
        for (int m = gw; m < MR; m += NGW) {
            const bool lat = m < ML; const int b = lat ? (m >> 12) : 8;
            const float* xr = lat ? F.in[I_X] + (size_t)m * D : F.in[I_CTX] + (size_t)(m - ML) * D;
            modnorm_row(xr, F.in[I_N1W], MOD + b * 6144, MOD + b * 6144 + 1024, H + (size_t)m * D, F.lane);
        }
    }
#if (MK_REPMASK >> 1) & 1
    if (COOP) cg::this_grid().sync();
    if (IN(1)) {
        bf16_t* H = (bf16_t*)(F.dob + DO_H);
        for (int m = gw; m < MR; m += NGW) {
            const bool lat = m < ML; const int b = lat ? (m >> 12) : 8;
            const float* xr = lat ? F.in[I_X] + (size_t)m * D : F.in[I_CTX] + (size_t)(m - ML) * D;
            modnorm_row(xr, F.in[I_N1W], MOD + b * 6144, MOD + b * 6144 + 1024, H + (size_t)m * D, F.lane);
        }
    }
#endif
    SEAM(1);
    if (IN(2)) {
        pg8::Sched S; S.init(F.dob + DO_H, F.dob + DO_WIN, nullptr, nullptr, MR, NZR, D, F.G, F.bid, 1);
        pg8::EpiBf16 E{(bf16_t*)(F.ws + WS_R1), NZR};
        pg8::gemm_phase(F.lds, D, S, E);
    }
#if (MK_REPMASK >> 2) & 1
    if (COOP) cg::this_grid().sync();
    if (IN(2)) {
        pg8::Sched S; S.init(F.dob + DO_H, F.dob + DO_WIN, nullptr, nullptr, MR, NZR, D, F.G, F.bid, 1);
        pg8::EpiBf16 E{(bf16_t*)(F.ws + WS_R1), NZR};
        pg8::gemm_phase(F.lds, D, S, E);
    }
#endif
    SEAM(2);
    if (IN(3)) { p3_shift(F); }
#if (MK_REPMASK >> 3) & 1
    if (COOP) cg::this_grid().sync();
    if (IN(3)) { p3_shift(F); }
#endif
    SEAM(3);
    if (IN(4)) { p4_rwkv_scan(F); }
#if (MK_REPMASK >> 4) & 1
    if (COOP) cg::this_grid().sync();
    if (IN(4)) { p4_rwkv_scan(F); }
#endif
    SEAM(4);
    if (IN(5)) { p5_rwkv_norm(F); }
#if (MK_REPMASK >> 5) & 1
    if (COOP) cg::this_grid().sync();
    if (IN(5)) { p5_rwkv_norm(F); }
#endif
    SEAM(5);
    if (IN(6)) {
        pg8::Sched S; S.init(F.ws + WS_XGS, F.dob + DO_GUP, nullptr, nullptr, ML, D, 256, F.G, F.bid, 1);
        pg8::EpiMulBf16 E{(const bf16_t*)(F.ws + WS_YF), (bf16_t*)(F.ws + WS_YRW), D};
        pg8::gemm_phase(F.lds, 256, S, E);
    }
#if (MK_REPMASK >> 6) & 1
    if (COOP) cg::this_grid().sync();
    if (IN(6)) {
        pg8::Sched S; S.init(F.ws + WS_XGS, F.dob + DO_GUP, nullptr, nullptr, ML, D, 256, F.G, F.bid, 1);
        pg8::EpiMulBf16 E{(const bf16_t*)(F.ws + WS_YF), (bf16_t*)(F.ws + WS_YRW), D};
        pg8::gemm_phase(F.lds, 256, S, E);
    }
#endif
    SEAM(6);
    if (IN(7)) {
        pg8::Sched S; S.init(F.dob + DO_H, F.dob + DO_WIN + (size_t)NZR * D * 2, nullptr, nullptr, MR, NZH, D, F.G, F.bid, 1);
        pg8::EpiBf16 E{(bf16_t*)(F.ws + WS_ZH), NZH};
        pg8::gemm_phase(F.lds, D, S, E);
    }
#if (MK_REPMASK >> 7) & 1
    if (COOP) cg::this_grid().sync();
    if (IN(7)) {
        pg8::Sched S; S.init(F.dob + DO_H, F.dob + DO_WIN + (size_t)NZR * D * 2, nullptr, nullptr, MR, NZH, D, F.G, F.bid, 1);
        pg8::EpiBf16 E{(bf16_t*)(F.ws + WS_ZH), NZH};
        pg8::gemm_phase(F.lds, D, S, E);
    }
#endif
    SEAM(7);
    if (IN(8)) { p8_hgrn_scan(F); }
#if (MK_REPMASK >> 8) & 1
    if (COOP) cg::this_grid().sync();
    if (IN(8)) { p8_hgrn_scan(F); }
#endif
    SEAM(8);
    if (IN(9)) {
        pg8::Sched S; S.init(F.dob + DO_H, F.dob + DO_WIN + (size_t)(NZR + NZH) * D * 2, nullptr, nullptr, ML, NZG, D, F.G, F.bid, 1);
        pg8::EpiBf16 E{(bf16_t*)(F.ws + WS_ZG), NZG};
        pg8::gemm_phase(F.lds, D, S, E);
    }
#if (MK_REPMASK >> 9) & 1
    if (COOP) cg::this_grid().sync();
    if (IN(9)) {
        pg8::Sched S; S.init(F.dob + DO_H, F.dob + DO_WIN + (size_t)(NZR + NZH) * D * 2, nullptr, nullptr, ML, NZG, D, F.G, F.bid, 1);
        pg8::EpiBf16 E{(bf16_t*)(F.ws + WS_ZG), NZG};
        pg8::gemm_phase(F.lds, D, S, E);
    }
#endif
    SEAM(9);
    if (IN(10)) { p10_hgrn_read(F); }
#if (MK_REPMASK >> 10) & 1
    if (COOP) cg::this_grid().sync();
    if (IN(10)) { p10_hgrn_read(F); }
#endif
    SEAM(10);
    if (IN(11)) {
        pg8::Sched S; S.init(F.ws + WS_YRW, F.dob + DO_PA, F.ws + WS_OF, F.dob + DO_PB, ML, D, D, F.G, F.bid, 2);
        pg8::EpiMerge E{(const bf16_t*)(F.ws + WS_ZG), (bf16_t*)(F.ws + WS_MRG)};
        pg8::gemm_phase(F.lds, D, S, E);
    }
#if (MK_REPMASK >> 11) & 1
    if (COOP) cg::this_grid().sync();
    if (IN(11)) {
        pg8::Sched S; S.init(F.ws + WS_YRW, F.dob + DO_PA, F.ws + WS_OF, F.dob + DO_PB, ML, D, D, F.G, F.bid, 2);
        pg8::EpiMerge E{(const bf16_t*)(F.ws + WS_ZG), (bf16_t*)(F.ws + WS_MRG)};
        pg8::gemm_phase(F.lds, D, S, E);
    }
#endif
    SEAM(11);
    if (IN(12)) {
        pg8::Sched S; S.init(F.ws + WS_MRG, F.dob + DO_WO, nullptr, nullptr, ML, D, D, F.G, F.bid, 1);
        pg8::EpiResid E{F.in[I_X], (float*)(F.ws + WS_X1), MOD + 2048};
        pg8::gemm_phase(F.lds, D, S, E);
    }
#if (MK_REPMASK >> 12) & 1
    if (COOP) cg::this_grid().sync();
    if (IN(12)) {
        pg8::Sched S; S.init(F.ws + WS_MRG, F.dob + DO_WO, nullptr, nullptr, ML, D, D, F.G, F.bid, 1);
        pg8::EpiResid E{F.in[I_X], (float*)(F.ws + WS_X1), MOD + 2048};
        pg8::gemm_phase(F.lds, D, S, E);
    }
#endif
    SEAM(12);
    if (IN(13)) {
        const float* X1 = (const float*)(F.ws + WS_X1); bf16_t* H2 = (bf16_t*)(F.ws + WS_H2);
        for (int m = gw; m < ML; m += NGW) { const int b = m >> 12;
            modnorm_row(X1 + (size_t)m * D, F.in[I_N2W], MOD + b * 6144 + 3072, MOD + b * 6144 + 4096, H2 + (size_t)m * D, F.lane); }
    }
#if (MK_REPMASK >> 13) & 1
    if (COOP) cg::this_grid().sync();
    if (IN(13)) {
        const float* X1 = (const float*)(F.ws + WS_X1); bf16_t* H2 = (bf16_t*)(F.ws + WS_H2);
        for (int m = gw; m < ML; m += NGW) { const int b = m >> 12;
            modnorm_row(X1 + (size_t)m * D, F.in[I_N2W], MOD + b * 6144 + 3072, MOD + b * 6144 + 4096, H2 + (size_t)m * D, F.lane); }
    }
#endif
    SEAM(13);
    if (IN(14)) {
        pg8::Sched S; S.init(F.ws + WS_H2, F.dob + DO_FC1, nullptr, nullptr, ML, FF, D, F.G, F.bid, 1);
        pg8::EpiSqRelu E{(bf16_t*)(F.ws + WS_U), FF};
        pg8::gemm_phase(F.lds, D, S, E);
    }
#if (MK_REPMASK >> 14) & 1
    if (COOP) cg::this_grid().sync();
    if (IN(14)) {
        pg8::Sched S; S.init(F.ws + WS_H2, F.dob + DO_FC1, nullptr, nullptr, ML, FF, D, F.G, F.bid, 1);
        pg8::EpiSqRelu E{(bf16_t*)(F.ws + WS_U), FF};
        pg8::gemm_phase(F.lds, D, S, E);
    }
#endif
    SEAM(14);
    if (IN(15)) {
        pg8::Sched S; S.init(F.ws + WS_U, F.dob + DO_FC2, nullptr, nullptr, ML, D, FF, F.G, F.bid, 1);
        pg8::EpiResid E{(const float*)(F.ws + WS_X1), (float*)(F.ws + WS_X1), MOD + 5120};
        pg8::gemm_phase(F.lds, FF, S, E);
    }
#if (MK_REPMASK >> 15) & 1
    if (COOP) cg::this_grid().sync();
    if (IN(15)) {
        pg8::Sched S; S.init(F.ws + WS_U, F.dob + DO_FC2, nullptr, nullptr, ML, D, FF, F.G, F.bid, 1);
        pg8::EpiResid E{(const float*)(F.ws + WS_X1), (float*)(F.ws + WS_X1), MOD + 5120};
        pg8::gemm_phase(F.lds, FF, S, E);
    }
#endif
    SEAM(15);
    if (IN(16)) {
        const float* X2 = (const float*)(F.ws + WS_X1); const float* fw = F.in[I_FNW];
        for (int m = gw; m < ML; m += NGW) {
            const float* xr = X2 + (size_t)m * D; float* orow = args.out + (size_t)m * D;
            f32x4 v[4]; float s = 0.f;
#pragma unroll
            for (int j = 0; j < 4; ++j) { v[j] = *(const f32x4*)(xr + 4 * F.lane + 256 * j); s += (v[j].x * v[j].x + v[j].y * v[j].y) + (v[j].z * v[j].z + v[j].w * v[j].w); }
            const float rs = 1.0f / sqrtf(wave_sum(s) * (1.f / D) + RMS_EPS);
#pragma unroll
            for (int j = 0; j < 4; ++j) { const int c = 4 * F.lane + 256 * j; *(f32x4*)(orow + c) = v[j] * rs * *(const f32x4*)(fw + c); }
        }
    }
#if (MK_REPMASK >> 16) & 1
    if (COOP) cg::this_grid().sync();
    if (IN(16)) {
        const float* X2 = (const float*)(F.ws + WS_X1); const float* fw = F.in[I_FNW];
        for (int m = gw; m < ML; m += NGW) {
            const float* xr = X2 + (size_t)m * D; float* orow = args.out + (size_t)m * D;
            f32x4 v[4]; float s = 0.f;
#pragma unroll
            for (int j = 0; j < 4; ++j) { v[j] = *(const f32x4*)(xr + 4 * F.lane + 256 * j); s += (v[j].x * v[j].x + v[j].y * v[j].y) + (v[j].z * v[j].z + v[j].w * v[j].w); }
            const float rs = 1.0f / sqrtf(wave_sum(s) * (1.f / D) + RMS_EPS);
#pragma unroll
            for (int j = 0; j < 4; ++j) { const int c = 4 * F.lane + 256 * j; *(f32x4*)(orow + c) = v[j] * rs * *(const f32x4*)(fw + c); }
        }
    }
#endif

#undef IN
#undef SEAM
}

__global__ void __launch_bounds__(512, 2) mk_multi(Args args) { mk_body<false>(args); }
__global__ void __launch_bounds__(512, 2) mk_one(Args args) { mk_body<true>(args); }

extern "C" void kernel_launch(void* const* d_in, const int* in_sizes, int n_in, void* d_out, int out_size, void* d_ws, size_t ws_size, hipStream_t stream) {
    static int grid = 0;
    if (grid == 0) {
        if (n_in != 28 || out_size != ML * D || ws_size < WS_END) { fprintf(stderr, "kernel_launch: unexpected problem (n_in %d, out %d, ws %zu)\n", n_in, out_size, ws_size); grid = -1; return; }
        int dev = 0, cus = 0;
        if (hipGetDevice(&dev) != hipSuccess || hipDeviceGetAttribute(&cus, hipDeviceAttributeMultiprocessorCount, dev) != hipSuccess) { grid = -1; return; }
        (void)hipFuncSetAttribute((const void*)mk_multi, hipFuncAttributeMaxDynamicSharedMemorySize, LDS_BYTES);
        (void)hipFuncSetAttribute((const void*)mk_one, hipFuncAttributeMaxDynamicSharedMemorySize, LDS_BYTES);
        int per_cu = 0;
        (void)hipOccupancyMaxActiveBlocksPerMultiprocessor(&per_cu, (const void*)mk_one, 512, LDS_BYTES);
        (void)hipGetLastError();
        grid = cus;
        if (per_cu < 1) fprintf(stderr, "kernel_launch: occupancy query reports %d blocks per CU\n", per_cu);
    }
    if (grid < 0) return;
    (void)hipMemsetAsync((char*)d_ws + WS_CTL, 0, XCD_BAR_WORDS * 4, stream);
    Args a{};
    for (int i = 0; i < 28; ++i) a.in[i] = (const float*)d_in[i];
    a.out = (float*)d_out; a.ws = (unsigned char*)d_ws;
#if MK_ONE_LAUNCH
    a.ph_lo = 0; a.ph_hi = NPHASE;
    void* kargs[] = {&a};
    hipError_t e = hipLaunchCooperativeKernel((const void*)mk_one, dim3(grid), dim3(512), kargs, LDS_BYTES, stream);
    if (e != hipSuccess) fprintf(stderr, "cooperative launch failed: %s\n", hipGetErrorString(e));
#else
    for (int p = 0; p < NPHASE; ++p) { a.ph_lo = p; a.ph_hi = p + 1; hipLaunchKernelGGL(mk_multi, dim3(grid), dim3(512), LDS_BYTES, stream, a); }
#endif
}
```

```cpp
#include <hip/hip_runtime.h>
#include <hip/hip_cooperative_groups.h>
#include <cstdio>
#include <cstdint>
namespace cg = cooperative_groups;

#ifndef MK_ONE_LAUNCH
#define MK_ONE_LAUNCH 1
#endif
#ifndef MK_REPMASK
#define MK_REPMASK 0x0u
#endif

#define LAS __attribute__((address_space(3)))
typedef unsigned short bf16_t;
typedef short bf16x8 __attribute__((ext_vector_type(8)));
typedef float f32x4 __attribute__((ext_vector_type(4)));
typedef float f32x2 __attribute__((ext_vector_type(2)));
typedef unsigned u32x4 __attribute__((ext_vector_type(4)));
typedef unsigned u32x2 __attribute__((ext_vector_type(2)));

constexpr int D = 1024, NB = 8, T = 4096, TC = 256, GW = 64;
constexpr int ML = NB * T;
constexpr int MC = NB * TC;
constexpr int MR = ML + MC;
constexpr int NZR = 3328, NZH = 4096, NZG = 3072, NIN = 10496, FF = 4096;
constexpr float RMS_EPS = 1e-6f, GN_EPS = 64e-5f;

constexpr size_t MiB = 1u << 20;
constexpr size_t WS_CTL = 0, WS_MOD = 1 * MiB;
constexpr size_t WS_R1 = 2 * MiB;
constexpr size_t WS_YF = 2 * MiB, WS_YB = 66 * MiB, WS_YRW = 130 * MiB;
constexpr size_t WS_OF = 2 * MiB, WS_OB = 66 * MiB;
constexpr size_t WS_X1 = 2 * MiB;
constexpr size_t WS_H2 = 130 * MiB;
constexpr size_t WS_ZRS = 223 * MiB;
constexpr size_t WS_XGS = 444 * MiB;
constexpr size_t WS_BON = 460 * MiB;
constexpr size_t WS_ZH = 194 * MiB;
constexpr size_t WS_ZG = 194 * MiB;
constexpr size_t WS_MRG = 386 * MiB;
constexpr size_t WS_U = 194 * MiB;
constexpr size_t WS_RN = 464 * MiB;
constexpr size_t WS_END = 468 * MiB;
constexpr size_t DO_H = 0;
constexpr size_t DO_WIN = 68 * MiB;
constexpr size_t DO_PA = DO_WIN + (size_t)NIN * D * 2;
constexpr size_t DO_PB = DO_PA + 2 * MiB, DO_WO = DO_PB + 2 * MiB, DO_FC1 = DO_WO + 2 * MiB, DO_FC2 = DO_FC1 + 8 * MiB, DO_GUP = DO_FC2 + 8 * MiB;
constexpr size_t DO_END = DO_GUP + (size_t)1024 * 256 * 2;
static_assert(DO_END <= 128 * MiB, "d_out scratch overflow");

constexpr int LDS_BYTES = 152 * 1024;
constexpr int NPHASE = 17;

__device__ __forceinline__ unsigned f2bf(float f) { return (unsigned)__builtin_bit_cast(unsigned short, (__bf16)f); }
typedef __bf16 bf16x2_t __attribute__((ext_vector_type(2)));
__device__ __forceinline__ unsigned pk2(float lo, float hi) { const f32x2 v = {lo, hi}; return __builtin_bit_cast(unsigned, __builtin_convertvector(v, bf16x2_t)); }
__device__ __forceinline__ float bflo(unsigned w) { return __builtin_bit_cast(float, w << 16); }
__device__ __forceinline__ float bfhi(unsigned w) { return __builtin_bit_cast(float, w & 0xffff0000u); }
__device__ __forceinline__ float sigmoidf_(float x) { return __builtin_amdgcn_rcpf(1.0f + __expf(-x)); }
__device__ __forceinline__ float wave_sum(float v) {
#pragma unroll
    for (int o = 1; o < 64; o <<= 1) v += __shfl_xor(v, o);
    return v;
}
template <int CTRL> __device__ __forceinline__ float dpp_mov(float v) { return __builtin_bit_cast(float, __builtin_amdgcn_update_dpp(0, __builtin_bit_cast(int, v), CTRL, 0xf, 0xf, true)); }
__device__ __forceinline__ float sum16(float v) { v += dpp_mov<0xB1>(v); v += dpp_mov<0x4E>(v); v += dpp_mov<0x141>(v); v += dpp_mov<0x140>(v); return v; }
__device__ __forceinline__ float sum32(float v) { v = sum16(v); v += __shfl_xor(v, 16); return v; }


#define XB_TMO      128
#define XB_XCNT(j)  (256  + 64 * (j))
#define XB_XSUB(j)  (1280 + 64 * (j))
#define XB_XGEN(j)  (2304 + 64 * (j))
#define XB_TOP      3328
#define XB_TOPGEN   3392
#define XCD_BAR_WORDS 3456
#define XB_SPIN_CAP (1u << 18)
__device__ __forceinline__ unsigned xb_ld(unsigned* p)              { return __hip_atomic_load(p, __ATOMIC_RELAXED, __HIP_MEMORY_SCOPE_AGENT); }
__device__ __forceinline__ unsigned xb_add(unsigned* p, unsigned v) { return __hip_atomic_fetch_add(p, v, __ATOMIC_RELAXED, __HIP_MEMORY_SCOPE_AGENT); }
__device__ __forceinline__ unsigned xb_xcc_id() { return (unsigned)__builtin_amdgcn_s_getreg((3 << 11) | 20) & 0xFu; }
#define XB_SPIN(cond, bar) do { unsigned _sp = 0; while (cond) { __builtin_amdgcn_s_sleep(1); \
    if ((++_sp & 255u) == 0u) { if (xb_ld(&(bar)[XB_TMO])) break; if (_sp > XB_SPIN_CAP) { atomicAdd(&(bar)[XB_TMO], 1u); break; } } } } while (0)
struct XcdBarrier { unsigned* bar; unsigned x; volatile LAS unsigned* st; };
__device__ __forceinline__ XcdBarrier xcd_barrier_post(unsigned* bar, volatile LAS unsigned* st) {
    XcdBarrier b; b.bar = bar; b.x = xb_xcc_id(); b.st = st;
    if (threadIdx.x == 0) (void)xb_add(&bar[XB_XCNT(b.x)], 1u);
    return b;
}
__device__ __forceinline__ void xcd_barrier_complete(unsigned* bar, unsigned x, unsigned& nloc, unsigned& nx) {
    const unsigned G = gridDim.x * gridDim.y * gridDim.z;
    unsigned sum, cnt, mine, sp = 0u;
    for (;;) {
        sum = 0u; cnt = 0u; mine = 0u;
#pragma unroll
        for (unsigned j = 0; j < 16; ++j) { const unsigned c = xb_ld(&bar[XB_XCNT(j)]); sum += c; cnt += (c > 0u) ? 1u : 0u; mine = (j == x) ? c : mine; }
        if (sum == G) break;
        __builtin_amdgcn_s_sleep(1);
        if ((++sp & 255u) == 0u) { if (xb_ld(&bar[XB_TMO])) break; if (sp > XB_SPIN_CAP) { atomicAdd(&bar[XB_TMO], 1u); break; } }
    }
    nloc = mine > 0u ? mine : 1u; nx = cnt > 0u ? cnt : 1u;
}
__device__ __forceinline__ void xcd_barrier(const XcdBarrier& b) {
    asm volatile("s_waitcnt vmcnt(0)" ::: "memory");
    __syncthreads();
    if (threadIdx.x == 0) {
        unsigned* bar = b.bar;
        __builtin_amdgcn_s_waitcnt(0);
        unsigned nloc = b.st[0], nx = b.st[1];
        if (nloc == 0u) { xcd_barrier_complete(bar, b.x, nloc, nx); b.st[0] = nloc; b.st[1] = nx; }
        const unsigned old = xb_add(&bar[XB_XSUB(b.x)], 1u);
        const unsigned gen = old / nloc;
        if (old + 1u == (gen + 1u) * nloc) {
            __builtin_amdgcn_fence(__ATOMIC_RELEASE, "agent");
            asm volatile("s_waitcnt vmcnt(0)" ::: "memory");
            const unsigned og = xb_add(&bar[XB_TOP], 1u);
            const unsigned tg = og / nx;
            if (og + 1u == (tg + 1u) * nx) xb_add(&bar[XB_TOPGEN], 1u);
            else XB_SPIN(xb_ld(&bar[XB_TOPGEN]) == tg, bar);
            __builtin_amdgcn_fence(__ATOMIC_ACQUIRE, "agent");
            xb_add(&bar[XB_XGEN(b.x)], 1u);
            asm volatile("s_waitcnt vmcnt(0)" ::: "memory");
        } else {
            XB_SPIN(xb_ld(&bar[XB_XGEN(b.x)]) == gen, bar);
            __builtin_amdgcn_fence(__ATOMIC_ACQUIRE, "agent");
            asm volatile("s_waitcnt vmcnt(0)" ::: "memory");
        }
    }
    __syncthreads();
}

namespace pg8 {
constexpr int BM = 256, BK = 64, HALF = 128, HTB = HALF * BK * 2, STAGE_BYTES = 8 * HTB, NXCD = 8, WGM = 8;
__host__ __device__ __forceinline__ int lds_byte(int r, int c) { const int st = (r >> 4) * 2 + (c >> 5), rr = r & 15, cc = c & 31, ob = rr * 64 + cc * 2; return st * 1024 + (ob ^ (((ob >> 9) & 1) << 5)); }
__host__ __device__ __forceinline__ void stage_rc(int b, int& R, int& C) { const int st = b / 1024, sb = b % 1024, swz = sb ^ (((sb >> 9) & 1) << 5); R = (st >> 1) * 16 + swz / 64; C = (st & 1) * 32 + (swz % 64) / 2; }
__host__ __device__ __forceinline__ int perm32(int rho) { const int n = rho >> 4, i = rho & 15; return 8 * (i >> 2) + 4 * n + (i & 3); }

struct Unit { int pm, pn, sel; };
struct Sched {
    const char* A0; const char* B0; const char* A1; const char* B1;
    int nM, nN, nwg, G, c, nsel; size_t tstep;
    __device__ void init(const void* a0, const void* b0, const void* a1, const void* b1, int M, int N, int K, int G_, int c_, int nsel_) {
        A0 = (const char*)a0; B0 = (const char*)b0; A1 = (const char*)a1; B1 = (const char*)b1; nM = M / BM; nN = N / BM; nwg = nM * nN; G = G_; c = c_; nsel = nsel_; tstep = (size_t)BM * K * 2; }
    __device__ bool next(int i, Unit& u) const {
        const int j = (nsel == 2) ? (i >> 1) : i;
        const long L = (long)j * G + c; if (L >= nwg) return false;
        int wgid = (int)L; { const int q = nwg / NXCD, r = nwg % NXCD, xcd = wgid % NXCD, off = wgid / NXCD; wgid = (xcd < r ? xcd * (q + 1) : r * (q + 1) + (xcd - r) * q) + off; }
        const int nig = WGM * nN, gid = wgid / nig, fm = gid * WGM, gsz = (nM - fm) < WGM ? (nM - fm) : WGM;
        u.pm = fm + ((wgid % nig) % gsz); u.pn = (wgid % nig) / gsz; u.sel = (nsel == 2) ? (i & 1) : 0; return true;
    }
    __device__ __forceinline__ const char* abase(const Unit& u) const { return (u.sel ? A1 : A0) + (size_t)u.pm * tstep; }
    __device__ __forceinline__ const char* bbase(const Unit& u) const { return (u.sel ? B1 : B0) + (size_t)u.pn * tstep; }
};

template <class Epi>
__device__ __forceinline__ void gemm_phase(LAS unsigned char* lds, const int K, const Sched& S, const Epi& E) {
    const int tid = threadIdx.x, wid = __builtin_amdgcn_readfirstlane(tid >> 6), lane = tid & 63, wr = wid >> 2, wc = wid & 3, fr = lane & 15, fq = lane >> 4;
    const int nt = K / BK;
    unsigned voffA[2], voffB[2];
#pragma unroll
    for (int i = 0; i < 2; ++i) { int R, C; stage_rc(tid * 16 + i * 8192, R, C); const int Rb = Epi::PERM ? ((R & ~31) + perm32(R & 31)) : R;
        voffA[i] = (unsigned)(R * K + C) * 2u; voffB[i] = (unsigned)(Rb * K + C) * 2u; }
    const size_t kstep = (size_t)(BK * 2);
    const size_t hstep = (size_t)HALF * K * 2;
    const unsigned ldsw = (unsigned)wid * 1024u;
    const int aoff = lds_byte(wr * 64 + fr, fq * 8), boff = lds_byte(wc * 32 + fr, fq * 8);
#define PG8_SA(b, h) (((b) * 2 + (h)) * HTB)
#define PG8_SB(b, h) ((4 + (b) * 2 + (h)) * HTB)
#define PG8_STAGE(bufoff, gbase, voff) do { _Pragma("unroll") for (int _i = 0; _i < 2; ++_i) \
        __builtin_amdgcn_global_load_lds((const unsigned*)((const char*)(gbase) + (voff)[_i]), (LAS unsigned*)(lds + (bufoff) + ldsw + _i * 8192), 16, 0, 0); } while (0)
#define PG8_LDA(dst, b, h) do { _Pragma("unroll") for (int m = 0; m < 4; ++m) _Pragma("unroll") for (int k = 0; k < 2; ++k) dst[m][k] = *(const LAS bf16x8*)(lds + PG8_SA(b, h) + aoff + m * 2048 + k * 1024); } while (0)
#define PG8_LDB(dst, b, h) do { _Pragma("unroll") for (int n = 0; n < 2; ++n) _Pragma("unroll") for (int k = 0; k < 2; ++k) dst[n][k] = *(const LAS bf16x8*)(lds + PG8_SB(b, h) + boff + n * 2048 + k * 1024); } while (0)
#define PG8_MMA(ai, bj, At, Bt) do { __builtin_amdgcn_s_setprio(1); _Pragma("unroll") for (int m = 0; m < 4; ++m) _Pragma("unroll") for (int n = 0; n < 2; ++n) _Pragma("unroll") for (int k = 0; k < 2; ++k) \
        acc[ai][bj][m][n] = __builtin_amdgcn_mfma_f32_16x16x32_bf16(Bt[n][k], At[m][k], acc[ai][bj][m][n], 0, 0, 0); __builtin_amdgcn_s_setprio(0); } while (0)
#define PG8_WAIT_V(n) asm volatile("s_waitcnt vmcnt(" #n ")" ::: "memory")
#define PG8_WAIT_L(n) asm volatile("s_waitcnt lgkmcnt(" #n ")" ::: "memory")
#define PG8_BAR __builtin_amdgcn_s_barrier()
#define PG8_SCHED __builtin_amdgcn_sched_barrier(0)
    Unit cur, nxt; int ui = 0;
    if (!S.next(0, cur)) return;
    f32x4 acc[2][2][4][2];
#pragma unroll
    for (int a = 0; a < 2; ++a)
#pragma unroll
        for (int b = 0; b < 2; ++b)
#pragma unroll
            for (int m = 0; m < 4; ++m)
#pragma unroll
                for (int n = 0; n < 2; ++n) acc[a][b][m][n] = (f32x4){0.f, 0.f, 0.f, 0.f};
    bf16x8 At[4][2], B0[2][2], B1[2][2];
    const char* cA = S.abase(cur); const char* cB = S.bbase(cur);
    PG8_STAGE(PG8_SB(0, 0), cB, voffB); PG8_STAGE(PG8_SB(0, 1), cB + hstep, voffB); PG8_STAGE(PG8_SA(0, 0), cA, voffA); PG8_STAGE(PG8_SA(0, 1), cA + hstep, voffA);
    if (wr == 1) PG8_BAR;
    PG8_WAIT_V(2); PG8_BAR;
    PG8_STAGE(PG8_SB(1, 0), cB + kstep, voffB); PG8_STAGE(PG8_SA(1, 0), cA + kstep, voffA); PG8_STAGE(PG8_SB(1, 1), cB + hstep + kstep, voffB);
    PG8_WAIT_V(6); PG8_BAR;
    for (;;) {
        const bool has_next = S.next(ui + 1, nxt);
        const char* nA = has_next ? S.abase(nxt) : cA; const char* nB = has_next ? S.bbase(nxt) : cB;
        for (int t = 0; t < nt; t += 2) {
            const bool last = (t == nt - 2);
            const char* a1 = cA + (size_t)(t + 1) * kstep;
            const char* a2 = last ? nA : cA + (size_t)(t + 2) * kstep; const char* b2 = last ? nB : cB + (size_t)(t + 2) * kstep;
            const char* a3 = a2 + kstep; const char* b3 = b2 + kstep;
            PG8_LDB(B0, 0, 0); PG8_LDB(B1, 0, 1); PG8_SCHED; PG8_LDA(At, 0, 0); PG8_STAGE(PG8_SA(1, 1), a1 + hstep, voffA);
            PG8_WAIT_V(8); PG8_WAIT_L(0); PG8_BAR; PG8_MMA(0, 0, At, B0); PG8_MMA(0, 1, At, B1); PG8_BAR; PG8_SCHED;
            PG8_LDA(At, 0, 1); PG8_STAGE(PG8_SB(0, 0), b2, voffB); PG8_STAGE(PG8_SB(0, 1), b2 + hstep, voffB); PG8_STAGE(PG8_SA(0, 0), a2, voffA);
            PG8_WAIT_V(8); PG8_WAIT_L(0); PG8_BAR; PG8_MMA(1, 0, At, B0); PG8_MMA(1, 1, At, B1); PG8_BAR; PG8_SCHED;
            PG8_LDB(B0, 1, 0); PG8_LDB(B1, 1, 1); PG8_SCHED; PG8_LDA(At, 1, 0); PG8_STAGE(PG8_SA(0, 1), a2 + hstep, voffA);
            PG8_WAIT_V(8); PG8_WAIT_L(0); PG8_BAR; PG8_MMA(0, 0, At, B0); PG8_MMA(0, 1, At, B1); PG8_BAR; PG8_SCHED;
            PG8_LDA(At, 1, 1); PG8_STAGE(PG8_SB(1, 0), b3, voffB); PG8_STAGE(PG8_SB(1, 1), b3 + hstep, voffB); PG8_STAGE(PG8_SA(1, 0), a3, voffA);
            PG8_WAIT_V(8); PG8_WAIT_L(0); PG8_BAR; PG8_MMA(1, 0, At, B0); PG8_MMA(1, 1, At, B1); PG8_BAR; PG8_SCHED;
        }
        if (wr == 0) PG8_BAR;
        E(acc, cur, wr, wc, fr, fq);
        if (!has_next) break;
#pragma unroll
        for (int a = 0; a < 2; ++a)
#pragma unroll
            for (int b = 0; b < 2; ++b)
#pragma unroll
                for (int m = 0; m < 4; ++m)
#pragma unroll
                    for (int n = 0; n < 2; ++n) acc[a][b][m][n] = (f32x4){0.f, 0.f, 0.f, 0.f};
        cur = nxt; cA = nA; cB = nB; ++ui;
        if (wr == 1) PG8_BAR;
    }
    PG8_WAIT_V(0);
    PG8_BAR;
#undef PG8_SA
#undef PG8_SB
#undef PG8_STAGE
#undef PG8_LDA
#undef PG8_LDB
#undef PG8_MMA
#undef PG8_WAIT_V
#undef PG8_WAIT_L
#undef PG8_BAR
#undef PG8_SCHED
}

struct EpiBf16 {
    static constexpr bool PERM = true;
    bf16_t* O; int ldc;
    __device__ __forceinline__ void operator()(const f32x4 (&acc)[2][2][4][2], const Unit& u, int wr, int wc, int fr, int fq) const {
        const int row0 = u.pm * BM + wr * 64 + fr, col0 = u.pn * BM + wc * 32 + 8 * fq;
#pragma unroll
        for (int ai = 0; ai < 2; ++ai)
#pragma unroll
            for (int m = 0; m < 4; ++m) { bf16_t* rowp = O + (size_t)(row0 + ai * HALF + m * 16) * ldc + col0;
#pragma unroll
                for (int bj = 0; bj < 2; ++bj) { const f32x4 v0 = acc[ai][bj][m][0], v1 = acc[ai][bj][m][1];
                    u32x4 w; w.x = pk2(v0[0], v0[1]); w.y = pk2(v0[2], v0[3]); w.z = pk2(v1[0], v1[1]); w.w = pk2(v1[2], v1[3]);
                    *(u32x4*)(rowp + bj * HALF) = w; } }
    }
};
struct EpiSqRelu {
    static constexpr bool PERM = true;
    bf16_t* O; int ldc;
    __device__ __forceinline__ void operator()(const f32x4 (&acc)[2][2][4][2], const Unit& u, int wr, int wc, int fr, int fq) const {
        const int row0 = u.pm * BM + wr * 64 + fr, col0 = u.pn * BM + wc * 32 + 8 * fq;
#pragma unroll
        for (int ai = 0; ai < 2; ++ai)
#pragma unroll
            for (int m = 0; m < 4; ++m) { bf16_t* rowp = O + (size_t)(row0 + ai * HALF + m * 16) * ldc + col0;
#pragma unroll
                for (int bj = 0; bj < 2; ++bj) { f32x4 v0 = acc[ai][bj][m][0], v1 = acc[ai][bj][m][1];
#pragma unroll
                    for (int j = 0; j < 4; ++j) { const float a = fmaxf(v0[j], 0.f), b = fmaxf(v1[j], 0.f); v0[j] = a * a; v1[j] = b * b; }
                    u32x4 w; w.x = pk2(v0[0], v0[1]); w.y = pk2(v0[2], v0[3]); w.z = pk2(v1[0], v1[1]); w.w = pk2(v1[2], v1[3]);
                    *(u32x4*)(rowp + bj * HALF) = w; } }
    }
};
struct EpiMulBf16 {
    static constexpr bool PERM = true;
    const bf16_t* Y; bf16_t* O; int ldc;
    __device__ __forceinline__ void operator()(const f32x4 (&acc)[2][2][4][2], const Unit& u, int wr, int wc, int fr, int fq) const {
        const int row0 = u.pm * BM + wr * 64 + fr, col0 = u.pn * BM + wc * 32 + 8 * fq;
#pragma unroll
        for (int ai = 0; ai < 2; ++ai)
#pragma unroll
            for (int m = 0; m < 4; ++m) { const size_t off = (size_t)(row0 + ai * HALF + m * 16) * ldc + col0;
#pragma unroll
                for (int bj = 0; bj < 2; ++bj) { const f32x4 v0 = acc[ai][bj][m][0], v1 = acc[ai][bj][m][1];
                    const u32x4 y = *(const u32x4*)(Y + off + bj * HALF);
                    u32x4 w; w.x = pk2(v0[0] * bflo(y.x), v0[1] * bfhi(y.x)); w.y = pk2(v0[2] * bflo(y.y), v0[3] * bfhi(y.y));
                    w.z = pk2(v1[0] * bflo(y.z), v1[1] * bfhi(y.z)); w.w = pk2(v1[2] * bflo(y.w), v1[3] * bfhi(y.w));
                    *(u32x4*)(O + off + bj * HALF) = w; }
                asm volatile("" ::: "memory"); }
    }
};
struct EpiMerge {
    static constexpr bool PERM = true;
    const bf16_t* ZG; bf16_t* O;
    __device__ __forceinline__ void operator()(const f32x4 (&acc)[2][2][4][2], const Unit& u, int wr, int wc, int fr, int fq) const {
        const int row0 = u.pm * BM + wr * 64 + fr, col0 = u.pn * BM + wc * 32 + 8 * fq;
        const int goff = u.sel ? 2048 : 1024;
#pragma unroll
        for (int ai = 0; ai < 2; ++ai)
#pragma unroll
            for (int m = 0; m < 4; ++m) { const size_t r = (size_t)(row0 + ai * HALF + m * 16);
#pragma unroll
                for (int bj = 0; bj < 2; ++bj) { const f32x4 v0 = acc[ai][bj][m][0], v1 = acc[ai][bj][m][1];
                    const u32x4 g = *(const u32x4*)(ZG + r * NZG + goff + col0 + bj * HALF);
                    float o[8];
                    o[0] = v0[0] * sigmoidf_(bflo(g.x)); o[1] = v0[1] * sigmoidf_(bfhi(g.x)); o[2] = v0[2] * sigmoidf_(bflo(g.y)); o[3] = v0[3] * sigmoidf_(bfhi(g.y));
                    o[4] = v1[0] * sigmoidf_(bflo(g.z)); o[5] = v1[1] * sigmoidf_(bfhi(g.z)); o[6] = v1[2] * sigmoidf_(bflo(g.w)); o[7] = v1[3] * sigmoidf_(bfhi(g.w));
                    bf16_t* op = O + r * D + col0 + bj * HALF;
                    if (u.sel) { const u32x4 p = *(const u32x4*)op;
                        o[0] += bflo(p.x); o[1] += bfhi(p.x); o[2] += bflo(p.y); o[3] += bfhi(p.y); o[4] += bflo(p.z); o[5] += bfhi(p.z); o[6] += bflo(p.w); o[7] += bfhi(p.w); }
                    u32x4 w; w.x = pk2(o[0], o[1]); w.y = pk2(o[2], o[3]); w.z = pk2(o[4], o[5]); w.w = pk2(o[6], o[7]);
                    *(u32x4*)op = w; }
                asm volatile("" ::: "memory"); }
    }
};
struct EpiResid {
    static constexpr bool PERM = false;
    const float* base; float* out; const float* gate;
    __device__ __forceinline__ void operator()(const f32x4 (&acc)[2][2][4][2], const Unit& u, int wr, int wc, int fr, int fq) const {
        const int row0 = u.pm * BM + wr * 64 + fr, col0 = u.pn * BM + wc * 32 + 4 * fq;
        const float* gp = gate + (size_t)((u.pm * BM) / T) * 6144 + col0;
        f32x4 gv[2][2];
#pragma unroll
        for (int bj = 0; bj < 2; ++bj)
#pragma unroll
            for (int n = 0; n < 2; ++n) gv[bj][n] = *(const f32x4*)(gp + bj * HALF + n * 16);
#pragma unroll
        for (int ai = 0; ai < 2; ++ai)
#pragma unroll
            for (int m = 0; m < 4; ++m) { const size_t off = (size_t)(row0 + ai * HALF + m * 16) * D + col0;
#pragma unroll
                for (int bj = 0; bj < 2; ++bj)
#pragma unroll
                    for (int n = 0; n < 2; ++n) { const f32x4 bs = *(const f32x4*)(base + off + bj * HALF + n * 16);
                        *(f32x4*)(out + off + bj * HALF + n * 16) = bs + gv[bj][n] * acc[ai][bj][m][n]; }
                asm volatile("" ::: "memory"); }
    }
};
}

struct Args { const float* in[28]; float* out; unsigned char* ws; int ph_lo, ph_hi; };

struct Frame {
    LAS unsigned char* lds;
    int tid, lane, wave, G, bid;
    const float* const* in;
    unsigned char* ws; unsigned char* dob;
};
enum { I_X = 0, I_C, I_CTX, I_CCTX, I_N1W, I_N2W, I_WMOD, I_BMOD, I_WIN, I_MU, I_W0, I_WUP, I_A0, I_AUP, I_GUP, I_KK, I_KA, I_RK, I_LNW, I_LNB, I_HGLB, I_HGNW, I_PA, I_PB, I_WOUT, I_FC1, I_FC2, I_FNW };

__device__ __forceinline__ void transpose_item(const float* W, int N, bf16_t* WT, int ldk, LAS float* scr, int item, int lane) {
    const int nblk = N / 32, kb = item / nblk, nb = item % nblk, k0 = 64 * kb, n0 = 32 * nb;
#pragma unroll 8
    for (int i = 0; i < 32; ++i) { const int kk = 2 * i + (lane >> 5); scr[kk * 33 + (lane & 31)] = W[(size_t)(k0 + kk) * N + n0 + (lane & 31)]; }
    asm volatile("s_waitcnt lgkmcnt(0)" ::: "memory");
    const int c = lane & 7;
#pragma unroll
    for (int j = 0; j < 4; ++j) { const int n = (lane >> 3) + 8 * j; const LAS float* s = scr + (8 * c) * 33 + n;
        u32x4 o; o.x = pk2(s[0 * 33], s[1 * 33]); o.y = pk2(s[2 * 33], s[3 * 33]); o.z = pk2(s[4 * 33], s[5 * 33]); o.w = pk2(s[6 * 33], s[7 * 33]);
        *(u32x4*)(WT + (size_t)(n0 + n) * ldk + k0 + 8 * c) = o; }
    asm volatile("s_waitcnt lgkmcnt(0)" ::: "memory");
}

__device__ __forceinline__ void p0_prologue(const Frame& F) {
    float* MOD = (float*)(F.ws + WS_MOD);
    if (F.bid < 96) {
        LAS float* act = (LAS float*)F.lds;
        LAS float* red = act + 9 * 1024;
        for (int i = F.tid; i < 9 * 1024; i += 512) { const float v = (i < 8 * 1024) ? F.in[I_C][i] : F.in[I_CCTX][i - 8 * 1024]; act[i] = v * sigmoidf_(v); }
        __syncthreads();
        const float* wm = F.in[I_WMOD];
        const int n = F.bid * 64 + F.lane;
        float a[9];
#pragma unroll
        for (int r = 0; r < 9; ++r) a[r] = 0.f;
        const int kb = F.wave * 128;
#pragma unroll 4
        for (int k = kb; k < kb + 128; ++k) { const float w = wm[(size_t)k * 6144 + n];
#pragma unroll
            for (int r = 0; r < 9; ++r) a[r] += act[r * 1024 + k] * w; }
#pragma unroll
        for (int r = 0; r < 9; ++r) red[(F.wave * 9 + r) * 64 + F.lane] = a[r];
        __syncthreads();
        for (int i = F.tid; i < 9 * 64; i += 512) { const int r = i >> 6, l = i & 63; float s = 0.f;
#pragma unroll
            for (int w = 0; w < 8; ++w) s += red[(w * 9 + r) * 64 + l];
            MOD[r * 6144 + F.bid * 64 + l] = s + F.in[I_BMOD][F.bid * 64 + l]; }
        __syncthreads();
    }
    LAS float* scr = (LAS float*)(F.lds + 48 * 1024) + F.wave * (64 * 33);
    const int gw = F.bid * 8 + F.wave, NGW = F.G * 8;
    constexpr int I_IN = 16 * (NIN / 32), I_SQ = 16 * 32, I_F1 = 16 * (FF / 32), I_F2 = 64 * 32, I_GU = 2 * 32;
    constexpr int NITEMS = I_IN + 3 * I_SQ + I_F1 + I_F2 + I_GU;
    for (int it = gw; it < NITEMS; it += NGW) {
        int r = it;
        if (r < I_IN) { transpose_item(F.in[I_WIN], NIN, (bf16_t*)(F.dob + DO_WIN), D, scr, r, F.lane); continue; } r -= I_IN;
        if (r < I_SQ) { transpose_item(F.in[I_PA], D, (bf16_t*)(F.dob + DO_PA), D, scr, r, F.lane); continue; } r -= I_SQ;
        if (r < I_SQ) { transpose_item(F.in[I_PB], D, (bf16_t*)(F.dob + DO_PB), D, scr, r, F.lane); continue; } r -= I_SQ;
        if (r < I_SQ) { transpose_item(F.in[I_WOUT], D, (bf16_t*)(F.dob + DO_WO), D, scr, r, F.lane); continue; } r -= I_SQ;
        if (r < I_F1) { transpose_item(F.in[I_FC1], FF, (bf16_t*)(F.dob + DO_FC1), D, scr, r, F.lane); continue; } r -= I_F1;
        if (r < I_F2) { transpose_item(F.in[I_FC2], D, (bf16_t*)(F.dob + DO_FC2), FF, scr, r, F.lane); continue; } r -= I_F2;
        transpose_item(F.in[I_GUP], D, (bf16_t*)(F.dob + DO_GUP), 256, scr, r, F.lane);
    }
    { bf16_t* gu = (bf16_t*)(F.dob + DO_GUP);
      for (int i = F.bid * 512 + F.tid; i < 1024 * 16; i += F.G * 512) { const int n = i >> 4, ch = i & 15; *(u32x4*)(gu + (size_t)n * 256 + 128 + ch * 8) = (u32x4){0u, 0u, 0u, 0u}; } }
}

__device__ __forceinline__ void modnorm_row(const float* xrow, const float* nw, const float* sh, const float* sc, bf16_t* orow, int lane) {
    f32x4 v[4]; float s = 0.f;
#pragma unroll
    for (int j = 0; j < 4; ++j) { v[j] = *(const f32x4*)(xrow + 4 * lane + 256 * j); s += (v[j].x * v[j].x + v[j].y * v[j].y) + (v[j].z * v[j].z + v[j].w * v[j].w); }
    const float rs = __builtin_amdgcn_rsqf(wave_sum(s) * (1.f / D) + RMS_EPS);
#pragma unroll
    for (int j = 0; j < 4; ++j) { const int c = 4 * lane + 256 * j;
        const f32x4 w = *(const f32x4*)(nw + c), a = *(const f32x4*)(sc + c), b = *(const f32x4*)(sh + c);
        const f32x4 y = (v[j] * rs * w) * (1.0f + a) + b;
        u32x2 o; o.x = pk2(y.x, y.y); o.y = pk2(y.z, y.w); *(u32x2*)(orow + c) = o; }
}

__device__ __forceinline__ void unpack8(const u32x4 w, float (&f)[8]) { f[0] = bflo(w.x); f[1] = bfhi(w.x); f[2] = bflo(w.y); f[3] = bfhi(w.y); f[4] = bflo(w.z); f[5] = bfhi(w.z); f[6] = bflo(w.w); f[7] = bfhi(w.w); }
__device__ __forceinline__ void load8f(const float* p, float (&f)[8]) { const f32x4 a = *(const f32x4*)p, b = *(const f32x4*)(p + 4); f[0] = a.x; f[1] = a.y; f[2] = a.z; f[3] = a.w; f[4] = b.x; f[5] = b.y; f[6] = b.z; f[7] = b.w; }
__device__ __forceinline__ void p3_finish(const Frame& F, float (&o)[8], int row, int c0, bool lat) {
    bf16_t* ZS = (bf16_t*)(F.ws + WS_ZRS); bf16_t* XG = (bf16_t*)(F.ws + WS_XGS); float* RN = (float*)(F.ws + WS_RN);
    if (lat && c0 >= 3200) {
        u32x4 w; w.x = pk2(sigmoidf_(o[0]), sigmoidf_(o[1])); w.y = pk2(sigmoidf_(o[2]), sigmoidf_(o[3])); w.z = pk2(sigmoidf_(o[4]), sigmoidf_(o[5])); w.w = pk2(sigmoidf_(o[6]), sigmoidf_(o[7]));
        *(u32x4*)(XG + (size_t)row * 256 + (c0 - 3200)) = w;
        *(u32x4*)(XG + (size_t)row * 256 + 128 + (c0 - 3200)) = (u32x4){0u, 0u, 0u, 0u};
    }
    if (c0 >= 3072 && c0 < 3136) {
#pragma unroll
        for (int j = 0; j < 8; ++j) o[j] = 1.0f - 2.0f * __builtin_amdgcn_rcpf(1.0f + __expf(2.0f * o[j])); }
    {
        const bool isk = c0 >= 1024 && c0 < 2048; float ss = 0.f;
        if (isk) { float kk[8]; load8f(F.in[I_KK] + c0 - 1024, kk);
#pragma unroll
            for (int j = 0; j < 8; ++j) { const float t = o[j] * kk[j]; ss += t * t; } }
        ss += dpp_mov<0xB1>(ss); ss += dpp_mov<0x4E>(ss); ss += dpp_mov<0x141>(ss);
        if (isk && ((c0 >> 3) & 7) == 0) RN[(size_t)row * 16 + ((c0 - 1024) >> 6)] = __builtin_amdgcn_rsqf(fmaxf(ss, 1e-24f));
    }
    u32x4 w; w.x = pk2(o[0], o[1]); w.y = pk2(o[2], o[3]); w.z = pk2(o[4], o[5]); w.w = pk2(o[6], o[7]);
    *(u32x4*)(ZS + (size_t)row * NZR + c0) = w;
}
__device__ __forceinline__ void p3_shift(const Frame& F) {
    const bf16_t* ZR = (const bf16_t*)(F.ws + WS_R1);
    const float* mu = F.in[I_MU];
    const int tid = F.tid;
    LAS unsigned char* RING = F.lds;
    const int tok = tid >> 3, cc = tid & 7;
    for (int item = F.bid; item < NB * (NZR / 64); item += F.G) {
        const int b = item / (NZR / 64), cg = item % (NZR / 64), c0 = cg * 64 + cc * 8;
        float m0[8], m1[8], m2[8], m3[8];
        load8f(mu + c0, m0); load8f(mu + NZR + c0, m1); load8f(mu + 2 * NZR + c0, m2); load8f(mu + 3 * NZR + c0, m3);
        const bf16_t* src = ZR + ((size_t)b * T + tok) * NZR + c0;
        __syncthreads();
        u32x4 nxt = *(const u32x4*)src;
        for (int s = 0; s <= GW; ++s) {
            if (s < GW) *(LAS u32x4*)(RING + (s & 3) * 8192 + tid * 16) = nxt;
            if (s + 1 < GW) nxt = *(const u32x4*)(src + (size_t)(s + 1) * GW * NZR);
            __syncthreads();
            if (s >= 1) {
                const int gr = s - 1;
                const LAS unsigned char* ctr = RING + (gr & 3) * 8192;
                float z[8], a[8], o[8];
                unpack8(*(const LAS u32x4*)(ctr + tid * 16), z);
#pragma unroll
                for (int j = 0; j < 8; ++j) o[j] = z[j];
                if (tok > 0) unpack8(*(const LAS u32x4*)(ctr + tid * 16 - 128), a); else {
#pragma unroll
                    for (int j = 0; j < 8; ++j) a[j] = 0.f; }
#pragma unroll
                for (int j = 0; j < 8; ++j) o[j] += m0[j] * (a[j] - z[j]);
                if (tok < GW - 1) unpack8(*(const LAS u32x4*)(ctr + tid * 16 + 128), a); else {
#pragma unroll
                    for (int j = 0; j < 8; ++j) a[j] = 0.f; }
#pragma unroll
                for (int j = 0; j < 8; ++j) o[j] += m1[j] * (a[j] - z[j]);
                if (gr > 0) unpack8(*(const LAS u32x4*)(RING + ((gr - 1) & 3) * 8192 + tid * 16), a); else {
#pragma unroll
                    for (int j = 0; j < 8; ++j) a[j] = 0.f; }
#pragma unroll
                for (int j = 0; j < 8; ++j) o[j] += m2[j] * (a[j] - z[j]);
                if (gr < GW - 1) unpack8(*(const LAS u32x4*)(RING + ((gr + 1) & 3) * 8192 + tid * 16), a); else {
#pragma unroll
                    for (int j = 0; j < 8; ++j) a[j] = 0.f; }
#pragma unroll
                for (int j = 0; j < 8; ++j) o[j] += m3[j] * (a[j] - z[j]);
                p3_finish(F, o, b * T + gr * GW + tok, c0, true);
            }
        }
    }
    {
        constexpr int CH = NZR / 8;
        const int vb = (F.bid + F.G - (NB * (NZR / 64)) % F.G) % F.G;
        const size_t total = (size_t)MC * CH;
        for (size_t i = (size_t)vb * 512 + tid; i < total; i += (size_t)F.G * 512) {
            const int rowc = (int)(i / CH), ch = (int)(i % CH), c0 = ch * 8, row = ML + rowc, tc = rowc & (TC - 1);
            const bf16_t* p = ZR + (size_t)row * NZR + c0;
            float z[8], a[8], o[8], m0[8], m1[8];
            unpack8(*(const u32x4*)p, z); load8f(mu + c0, m0); load8f(mu + NZR + c0, m1);
#pragma unroll
            for (int j = 0; j < 8; ++j) o[j] = z[j];
            if (tc > 0) unpack8(*(const u32x4*)(p - NZR), a); else {
#pragma unroll
                for (int j = 0; j < 8; ++j) a[j] = 0.f; }
#pragma unroll
            for (int j = 0; j < 8; ++j) o[j] += m0[j] * (a[j] - z[j]);
            if (tc < TC - 1) unpack8(*(const u32x4*)(p + NZR), a); else {
#pragma unroll
                for (int j = 0; j < 8; ++j) a[j] = 0.f; }
#pragma unroll
            for (int j = 0; j < 8; ++j) o[j] += m1[j] * (a[j] - z[j]);
            p3_finish(F, o, row, c0, false);
        }
    }
}

constexpr int QC = 16, NSLOT = 5, NPREP = 6;
constexpr int Q_P2T = 0, Q_BKT = 4608, Q_VV = 9728, Q_HY = 11776, Q_CO = 19968, Q_WC = 20992, Q_SLOT = 21248;
constexpr int Q_YC = NSLOT * Q_SLOT, Q_SL = Q_YC + 8192, Q_PRM = Q_SL + 9216, Q_FLG = Q_PRM + 1280, Q_AF = Q_FLG + 64, Q_END = Q_AF + 16384;
static_assert(Q_END <= LDS_BYTES - 16, "RWKV LDS overflow");
__device__ __forceinline__ void q_wait_ge(volatile LAS unsigned* p, unsigned need) { while ((unsigned)__builtin_amdgcn_readfirstlane((int)*p) < need) __builtin_amdgcn_s_sleep(1); asm volatile("" ::: "memory"); }
__device__ __forceinline__ void q_publish(volatile LAS unsigned* p, unsigned val, int lane) { asm volatile("s_waitcnt lgkmcnt(0)" ::: "memory"); if (lane == 0) *p = val; asm volatile("" ::: "memory"); }
template <int N> __device__ __forceinline__ float dpp_shr_one(float v) {
    return __builtin_bit_cast(float, __builtin_amdgcn_update_dpp(0x3f800000, __builtin_bit_cast(int, v), 0x110 + N, 0xf, 0xf, false)); }
__device__ __forceinline__ bf16x8 qfrag(const f32x4 c) { return __builtin_bit_cast(bf16x8, (u32x4){pk2(c[0], c[1]), pk2(c[2], c[3]), 0u, 0u}); }
__device__ __forceinline__ f32x4 qmm(const f32x4 x, const f32x4 y) { return __builtin_amdgcn_mfma_f32_16x16x32_bf16(qfrag(x), qfrag(y), (f32x4){0.f, 0.f, 0.f, 0.f}, 0, 0, 0); }
__device__ __forceinline__ void p4_rwkv_scan(const Frame& F) {
    const bf16_t* ZS = (const bf16_t*)(F.ws + WS_ZRS);
    float* BON = (float*)(F.ws + WS_BON);
    const float* RN = (const float*)(F.ws + WS_RN);
    LAS unsigned char* L = F.lds;
    LAS float* PRM = (LAS float*)(L + Q_PRM);
    volatile LAS unsigned* FLG = (volatile LAS unsigned*)(L + Q_FLG);
    const int tid = F.tid, lane = F.lane, w8 = F.wave;
    const int fr = lane & 15, fq = lane >> 4;
    constexpr int NCH = (TC + T) / QC, NCTX = TC / QC;
    for (int cid = F.bid; cid < 256; cid += F.G) {
        const int b = cid >> 5, h = (cid >> 1) & 15, d = cid & 1;
        bf16_t* Yd = (bf16_t*)(F.ws + (d ? WS_YB : WS_YF));
        auto chunk_row0 = [&](int ci) { const bool ic = ci < NCTX; const int cj = ic ? ci : ci - NCTX, nch = ic ? NCTX : T / QC;
            const int pos = d ? (nch - 1 - cj) : cj; return (ic ? ML + b * TC : b * T) + pos * QC; };
        __syncthreads();
        if (tid < 64) { PRM[tid] = F.in[I_W0][d * 1024 + h * 64 + tid]; PRM[64 + tid] = F.in[I_A0][d * 1024 + h * 64 + tid];
            PRM[128 + tid] = F.in[I_KK][h * 64 + tid]; PRM[192 + tid] = F.in[I_KA][h * 64 + tid]; PRM[256 + tid] = F.in[I_RK][h * 64 + tid]; }
        if (tid < 16) FLG[tid] = 0u;
        for (int it = tid; it < 1024; it += 512) {
            const int l_ = it & 63, f_ = it >> 6, ks_ = f_ & 1, ct_ = (f_ >> 1) & 3, m_ = f_ >> 3; const float* src = m_ ? F.in[I_AUP] : F.in[I_WUP];
            unsigned wv[4];
#pragma unroll
            for (int jj = 0; jj < 8; jj += 2) { const size_t o = ((size_t)(d * 64 + 32 * ks_ + 8 * (l_ >> 4) + jj)) * 1024 + h * 64 + 16 * ct_ + (l_ & 15); wv[jj >> 1] = pk2(src[o], src[o + 1024]); }
            *(LAS u32x4*)(L + Q_AF + it * 16) = (u32x4){wv[0], wv[1], wv[2], wv[3]};
        }
        __syncthreads();
        if (w8 == 0) {
            __builtin_amdgcn_s_setprio(2);
            f32x4 acc[4][4];
#pragma unroll
            for (int i = 0; i < 4; ++i)
#pragma unroll
                for (int j = 0; j < 4; ++j) acc[i][j] = (f32x4){0.f, 0.f, 0.f, 0.f};
            int slot = 0;
            for (int ci = 0; ci < NCH; ++ci) {
                LAS unsigned char* SLT = L + slot * Q_SLOT;
#pragma unroll
                for (int kt = 0; kt < 4; ++kt)
#pragma unroll
                    for (int vt = 0; vt < 4; ++vt) { u32x2 o; o.x = pk2(acc[kt][vt][0], acc[kt][vt][1]); o.y = pk2(acc[kt][vt][2], acc[kt][vt][3]);
                        *(LAS u32x2*)(L + Q_SL + ((16 * vt + fr) * 72 + 16 * kt + 4 * fq) * 2) = o; }
                q_wait_ge(FLG + slot, (unsigned)ci + 1u);
                if (ci >= 2) q_wait_ge(FLG + 10, (unsigned)ci - 1u);
                asm volatile("s_waitcnt lgkmcnt(0)" ::: "memory");
                f32x4 u[4];
                {
                    bf16x8 af[2][2];
#pragma unroll
                    for (int tt = 0; tt < 2; ++tt)
#pragma unroll
                        for (int ks = 0; ks < 2; ++ks) af[tt][ks] = *(const LAS bf16x8*)(SLT + Q_P2T + ((16 * tt + fr) * 72 + 32 * ks + 8 * fq) * 2);
                    const u32x4 co = *(const LAS u32x4*)(SLT + Q_CO + lane * 16);
                    const bf16x8 fminv = __builtin_bit_cast(bf16x8, (u32x4){co.x, co.y, 0u, 0u}), ft2 = __builtin_bit_cast(bf16x8, (u32x4){co.z, co.w, 0u, 0u});
                    LAS f32x4* YC = (LAS f32x4*)(L + Q_YC + (ci & 1) * 4096);
#pragma unroll
                    for (int vt = 0; vt < 4; ++vt) {
                        const bf16x8 b0 = *(const LAS bf16x8*)(L + Q_SL + ((16 * vt + fr) * 72 + 8 * fq) * 2), b1 = *(const LAS bf16x8*)(L + Q_SL + ((16 * vt + fr) * 72 + 32 + 8 * fq) * 2);
                        const f32x4 hh = *(const LAS f32x4*)(SLT + Q_HY + (vt * 64 + lane) * 16), yv = *(const LAS f32x4*)(SLT + Q_HY + 4096 + (vt * 64 + lane) * 16);
                        f32x4 g = hh, y = yv;
                        g = __builtin_amdgcn_mfma_f32_16x16x32_bf16(af[0][0], b0, g, 0, 0, 0); g = __builtin_amdgcn_mfma_f32_16x16x32_bf16(af[0][1], b1, g, 0, 0, 0);
                        y = __builtin_amdgcn_mfma_f32_16x16x32_bf16(af[1][0], b0, y, 0, 0, 0); y = __builtin_amdgcn_mfma_f32_16x16x32_bf16(af[1][1], b1, y, 0, 0, 0);
                        u[vt] = __builtin_amdgcn_mfma_f32_16x16x32_bf16(fminv, qfrag(g), (f32x4){0.f, 0.f, 0.f, 0.f}, 0, 0, 0);
                        y = __builtin_amdgcn_mfma_f32_16x16x32_bf16(ft2, qfrag(u[vt]), y, 0, 0, 0);
                        YC[vt * 64 + lane] = y;
                    }
                }
                q_publish(FLG + 8, (unsigned)ci + 1u, lane);
                {
                    bf16x8 bu[4];
#pragma unroll
                    for (int vt = 0; vt < 4; ++vt) { const u32x2 vv = *(const LAS u32x2*)(SLT + Q_VV + ((16 * vt + fr) * 16 + 4 * fq) * 2);
                        bu[vt] = __builtin_bit_cast(bf16x8, (u32x4){pk2(u[vt][0], u[vt][1]), pk2(u[vt][2], u[vt][3]), vv.x, vv.y}); }
#pragma unroll
                    for (int kt = 0; kt < 4; ++kt) {
                        const bf16x8 ak = *(const LAS bf16x8*)(SLT + Q_BKT + ((16 * kt + fr) * 40 + 8 * fq) * 2);
                        const f32x4 wc = *(const LAS f32x4*)(SLT + Q_WC + (16 * kt + 4 * fq) * 4);
#pragma unroll
                        for (int vt = 0; vt < 4; ++vt) acc[kt][vt] = __builtin_amdgcn_mfma_f32_16x16x32_bf16(ak, bu[vt], acc[kt][vt] * wc, 0, 0, 0);
                    }
                }
                q_publish(FLG + 9, (unsigned)ci + 1u, lane);
                slot = (slot + 1 == NSLOT) ? 0 : slot + 1;
            }
            __builtin_amdgcn_s_setprio(0);
        } else if (w8 == 1) {
            for (int ci = 0; ci < NCH; ++ci) {
                q_wait_ge(FLG + 8, (unsigned)ci + 1u);
                if (ci >= NCTX) {
                    const LAS f32x4* YC = (const LAS f32x4*)(L + Q_YC + (ci & 1) * 4096);
                    const int row0 = chunk_row0(ci);
#pragma unroll
                    for (int vt = 0; vt < 4; ++vt) { const f32x4 y = YC[vt * 64 + lane];
#pragma unroll
                        for (int r = 0; r < 4; ++r) { const int t = 4 * fq + r; Yd[(size_t)(row0 + (d ? QC - 1 - t : t)) * D + h * 64 + 16 * vt + fr] = (bf16_t)f2bf(y[r]); } }
                }
                q_publish(FLG + 10, (unsigned)ci + 1u, lane);
            }
        } else {
            const int pw = w8 - 2;
            u32x4 tw0, tw1, xa0, xa1; u32x2 gr0, gk0, gv0, gr1, gk1, gv1, gr2, gk2, gv2, gr3, gk3, gv3; float rnv = 0.f;
#define Q_PREFETCH(ci_) do { const int r_ = chunk_row0(ci_) + (d ? QC - 1 - fr : fr); const bf16_t* p_ = ZS + (size_t)r_ * NZR; const bf16_t* q_ = p_ + h * 64 + 4 * fq; \
                tw0 = *(const u32x4*)(p_ + 3072 + 8 * fq); tw1 = *(const u32x4*)(p_ + 3104 + 8 * fq); xa0 = *(const u32x4*)(p_ + 3136 + 8 * fq); xa1 = *(const u32x4*)(p_ + 3168 + 8 * fq); \
                gr0 = *(const u32x2*)(q_); gk0 = *(const u32x2*)(q_ + 1024); gv0 = *(const u32x2*)(q_ + 2048); gr1 = *(const u32x2*)(q_ + 16); gk1 = *(const u32x2*)(q_ + 1040); gv1 = *(const u32x2*)(q_ + 2064); \
                gr2 = *(const u32x2*)(q_ + 32); gk2 = *(const u32x2*)(q_ + 1056); gv2 = *(const u32x2*)(q_ + 2080); gr3 = *(const u32x2*)(q_ + 48); gk3 = *(const u32x2*)(q_ + 1072); gv3 = *(const u32x2*)(q_ + 2096); \
                rnv = RN[(size_t)r_ * 16 + h]; } while (0)
            if (pw < NCH) Q_PREFETCH(pw);
            int slot = pw % NSLOT;
            for (int ci = pw; ci < NCH; ci += NPREP) {
                const bool isctx = ci < NCTX;
                const int row = chunk_row0(ci) + (d ? QC - 1 - fr : fr);
                LAS unsigned char* SLT = L + slot * Q_SLOT;
                if (ci >= NSLOT) { q_wait_ge(FLG + 9, (unsigned)(ci - NSLOT) + 1u); q_wait_ge(FLG + 10, (unsigned)(ci - NSLOT) + 1u); }
                f32x4 gN = (f32x4){0.f, 0.f, 0.f, 0.f}, gNT = gN, gT1 = gN, gT2 = gN, gT3 = gN; float bon = 0.f;
                unsigned fal[4], fbe[4], fka[4], frh[4];
                LAS unsigned char* pP2T = SLT + Q_P2T + (fr * 72 + 4 * fq) * 2;
                LAS unsigned char* pBKT = SLT + Q_BKT + (4 * fq * 40 + 8 * (fr >> 2) + (fr & 3)) * 2;
                LAS unsigned char* pVV = SLT + Q_VV + (4 * fq * 16 + fr) * 2;
                LAS unsigned char* pWC = SLT + Q_WC + 16 * fq;
                const LAS float* pPRM = PRM + 4 * fq;
#define Q_GROUP(ct, u_, GR, GK, GV) do { \
                    f32x4 zw = (f32x4){0.f, 0.f, 0.f, 0.f}, za = (f32x4){0.f, 0.f, 0.f, 0.f}; \
                    { const LAS bf16x8* af = (const LAS bf16x8*)(L + Q_AF) + lane; \
                      zw = __builtin_amdgcn_mfma_f32_16x16x32_bf16(af[(2 * (ct)) * 64], __builtin_bit_cast(bf16x8, tw0), zw, 0, 0, 0); \
                      zw = __builtin_amdgcn_mfma_f32_16x16x32_bf16(af[(2 * (ct) + 1) * 64], __builtin_bit_cast(bf16x8, tw1), zw, 0, 0, 0); \
                      za = __builtin_amdgcn_mfma_f32_16x16x32_bf16(af[(8 + 2 * (ct)) * 64], __builtin_bit_cast(bf16x8, xa0), za, 0, 0, 0); \
                      za = __builtin_amdgcn_mfma_f32_16x16x32_bf16(af[(8 + 2 * (ct) + 1) * 64], __builtin_bit_cast(bf16x8, xa1), za, 0, 0, 0); } \
                    const f32x4 w0v = *(const LAS f32x4*)(pPRM + 16 * (ct)), a0v = *(const LAS f32x4*)(pPRM + 64 + 16 * (ct)), kkw = *(const LAS f32x4*)(pPRM + 128 + 16 * (ct)), \
                                kav = *(const LAS f32x4*)(pPRM + 192 + 16 * (ct)), rkv = *(const LAS f32x4*)(pPRM + 256 + 16 * (ct)); \
                    const float kr[4] = {bflo(GK.x), bfhi(GK.x), bflo(GK.y), bfhi(GK.y)}; \
                    const float rr[4] = {bflo(GR.x), bfhi(GR.x), bflo(GR.y), bfhi(GR.y)}; \
                    const float vv[4] = {bflo(GV.x), bfhi(GV.x), bflo(GV.y), bfhi(GV.y)}; \
                    float al[4], be[4], ka[4], rh[4], bw[4], kw[4]; f32x4 wcv; \
                    _Pragma("unroll") for (int i = 0; i < 4; ++i) { \
                        const float kk = kr[i] * kkw[i] * rnv; \
                        const float sw = sigmoidf_(zw[i] + w0v[i]); \
                        const float dec = __expf(-0.6065306597126334f * sw); \
                        const float a = sigmoidf_(za[i] + a0v[i]); \
                        const float kd = kr[i] * (1.0f + (a - 1.0f) * kav[i]); \
                        bon += rr[i] * kd * rkv[i]; \
                        float W = dec; \
                        W *= dpp_shr_one<1>(W); W *= dpp_shr_one<2>(W); W *= dpp_shr_one<4>(W); W *= dpp_shr_one<8>(W); \
                        const float Wp = dpp_shr_one<1>(W); \
                        const float WC = __shfl(W, (lane & 48) | 15); \
                        const float iW = __builtin_amdgcn_rcpf(W); \
                        al[i] = Wp * kk; be[i] = kk * a * iW; ka[i] = kd * iW; rh[i] = W * rr[i]; bw[i] = be[i] * WC; kw[i] = ka[i] * WC; wcv[i] = WC; } \
                    fal[2 * (u_)] = pk2(al[0], al[1]); fal[2 * (u_) + 1] = pk2(al[2], al[3]); fbe[2 * (u_)] = pk2(be[0], be[1]); fbe[2 * (u_) + 1] = pk2(be[2], be[3]); \
                    fka[2 * (u_)] = pk2(ka[0], ka[1]); fka[2 * (u_) + 1] = pk2(ka[2], ka[3]); frh[2 * (u_)] = pk2(rh[0], rh[1]); frh[2 * (u_) + 1] = pk2(rh[2], rh[3]); \
                    *(LAS u32x2*)(pP2T + 32 * (ct)) = (u32x2){fal[2 * (u_)], fal[2 * (u_) + 1]}; \
                    *(LAS u32x2*)(pP2T + 16 * 72 * 2 + 32 * (ct)) = (u32x2){frh[2 * (u_)], frh[2 * (u_) + 1]}; \
                    _Pragma("unroll") for (int i = 0; i < 4; ++i) { \
                        *(LAS bf16_t*)(pBKT + (16 * (ct) + i) * 80) = (bf16_t)f2bf(bw[i]); \
                        *(LAS bf16_t*)(pBKT + (16 * (ct) + i) * 80 + 8) = (bf16_t)f2bf(kw[i]); \
                        *(LAS bf16_t*)(pVV + (16 * (ct) + i) * 32) = (bf16_t)f2bf(vv[i]); } \
                    if (fr == 0) *(LAS f32x4*)(pWC + 64 * (ct)) = wcv; } while (0)
#define Q_GRAM() do { \
                    const bf16x8 xal = __builtin_bit_cast(bf16x8, (u32x4){fal[0], fal[1], fal[2], fal[3]}), xbe = __builtin_bit_cast(bf16x8, (u32x4){fbe[0], fbe[1], fbe[2], fbe[3]}); \
                    const bf16x8 xka = __builtin_bit_cast(bf16x8, (u32x4){fka[0], fka[1], fka[2], fka[3]}), xrh = __builtin_bit_cast(bf16x8, (u32x4){frh[0], frh[1], frh[2], frh[3]}); \
                    gN = __builtin_amdgcn_mfma_f32_16x16x32_bf16(xbe, xal, gN, 0, 0, 0);        \
                    gNT = __builtin_amdgcn_mfma_f32_16x16x32_bf16(xal, xbe, gNT, 0, 0, 0);      \
                    gT2 = __builtin_amdgcn_mfma_f32_16x16x32_bf16(xbe, xrh, gT2, 0, 0, 0);      \
                    gT1 = __builtin_amdgcn_mfma_f32_16x16x32_bf16(xka, xal, gT1, 0, 0, 0);      \
                    gT3 = __builtin_amdgcn_mfma_f32_16x16x32_bf16(xka, xrh, gT3, 0, 0, 0);      } while (0)
                Q_GROUP(0, 0, gr0, gk0, gv0); __builtin_amdgcn_sched_barrier(0); Q_GROUP(1, 1, gr1, gk1, gv1); __builtin_amdgcn_sched_barrier(0); Q_GRAM();
                __builtin_amdgcn_sched_barrier(0);
                Q_GROUP(2, 0, gr2, gk2, gv2); __builtin_amdgcn_sched_barrier(0); Q_GROUP(3, 1, gr3, gk3, gv3); __builtin_amdgcn_sched_barrier(0); Q_GRAM();
                __builtin_amdgcn_sched_barrier(0);
#undef Q_GROUP
#undef Q_GRAM
                bon += __shfl_xor(bon, 16); bon += __shfl_xor(bon, 32);
                if (!isctx && fq == 0) BON[((size_t)d * ML + row) * 16 + h] = bon;
                if (ci + NPREP < NCH) Q_PREFETCH(ci + NPREP);
                f32x4 idn;
#pragma unroll
                for (int r = 0; r < 4; ++r) { const int i = 4 * fq + r; if (!(i < fr)) { gN[r] = 0.f; gT1[r] = 0.f; } if (!(i <= fr)) { gT2[r] = 0.f; gT3[r] = 0.f; } if (!(i > fr)) gNT[r] = 0.f; idn[r] = (i == fr) ? 1.f : 0.f; }
                f32x4 minv;
                { const f32x4 n2 = qmm(gNT, gN), n2t = qmm(gN, gNT);
                  const f32x4 n4 = qmm(n2t, n2), n4t = qmm(n2, n2t);
                  const f32x4 n8t = qmm(n4, n4t);
                  const f32x4 r1 = qmm(idn + n2t, idn - gN);
                  const f32x4 r2 = qmm(idn + n4t, r1);
                  minv = qmm(idn + n8t, r2); }
                *(LAS u32x4*)(SLT + Q_CO + lane * 16) = (u32x4){pk2(-minv[0], -minv[1]), pk2(-minv[2], -minv[3]), pk2(gT2[0], gT2[1]), pk2(gT2[2], gT2[3])};
                asm volatile("s_waitcnt lgkmcnt(0)" ::: "memory");
                {
                    const bf16x8 a1 = qfrag(gT1), a3 = qfrag(gT3);
                    const LAS unsigned char* pVVr = SLT + Q_VV + (fr * 16 + 4 * fq) * 2; LAS unsigned char* pHY = SLT + Q_HY + lane * 16;
#pragma unroll
                    for (int vt = 0; vt < 4; ++vt) {
                        const u32x2 vv = *(const LAS u32x2*)(pVVr + vt * 512);
                        const bf16x8 bv = __builtin_bit_cast(bf16x8, (u32x4){vv.x, vv.y, 0u, 0u});
                        f32x4 hh = (f32x4){0.f, 0.f, 0.f, 0.f}, yv = hh;
                        hh = __builtin_amdgcn_mfma_f32_16x16x32_bf16(a1, bv, hh, 0, 0, 0); yv = __builtin_amdgcn_mfma_f32_16x16x32_bf16(a3, bv, yv, 0, 0, 0);
                        *(LAS f32x4*)(pHY + vt * 1024) = hh; *(LAS f32x4*)(pHY + 4096 + vt * 1024) = yv;
                    }
                }
                q_publish(FLG + slot, (unsigned)ci + 1u, lane);
                slot = (slot + NPREP) % NSLOT;
            }
#undef Q_PREFETCH
        }
        __syncthreads();
    }
}

__device__ __forceinline__ void p5_rwkv_norm(const Frame& F) {
    bf16_t* YF = (bf16_t*)(F.ws + WS_YF); const bf16_t* YBk = (const bf16_t*)(F.ws + WS_YB); const bf16_t* ZS = (const bf16_t*)(F.ws + WS_ZRS);
    const float* BON = (const float*)(F.ws + WS_BON);
    const float* lnw = F.in[I_LNW]; const float* lnb = F.in[I_LNB];
    const size_t total = (size_t)ML * 256;
    for (size_t i = (size_t)F.bid * 512 + F.tid; i < total; i += (size_t)F.G * 512) {
        const int row = (int)(i >> 8), c = ((int)i & 255) * 4, h = c >> 6;
        const u32x2 a = *(const u32x2*)(YF + (size_t)row * D + c), b = *(const u32x2*)(YBk + (size_t)row * D + c);
        float y[4] = {bflo(a.x) + bflo(b.x), bfhi(a.x) + bfhi(b.x), bflo(a.y) + bflo(b.y), bfhi(a.y) + bfhi(b.y)};
        const float mean = sum16((y[0] + y[1]) + (y[2] + y[3])) * (1.f / 64.f);
        float q = 0.f;
#pragma unroll
        for (int j = 0; j < 4; ++j) { y[j] -= mean; q += y[j] * y[j]; }
        const float rstd = __builtin_amdgcn_rsqf(sum16(q) * (1.f / 64.f) + GN_EPS);
        const float bon = BON[(size_t)row * 16 + h] + BON[((size_t)ML + row) * 16 + h];
        const u32x2 vw = *(const u32x2*)(ZS + (size_t)row * NZR + 2048 + c);
        const float v[4] = {bflo(vw.x), bfhi(vw.x), bflo(vw.y), bfhi(vw.y)};
        const f32x4 lw = *(const f32x4*)(lnw + c), lb = *(const f32x4*)(lnb + c);
        float o[4];
#pragma unroll
        for (int j = 0; j < 4; ++j) o[j] = y[j] * rstd * lw[j] + lb[j] + bon * v[j];
        u32x2 w; w.x = pk2(o[0], o[1]); w.y = pk2(o[2], o[3]);
        *(u32x2*)(YF + (size_t)row * D + c) = w;
    }
}

constexpr int HC = 64;
constexpr int H_RAWQ = 0, H_RAWF = 16384, H_RAWI = 32768;
constexpr int H_PL = 0;
constexpr int H_TOT = 40960;
constexpr int H_DEC = H_TOT + 2048;
constexpr int H_QIN = H_DEC + 1024, H_KIN = H_QIN + 17408, H_QB = H_KIN + 17408;
constexpr int H_KINT = H_QB + 17408;
constexpr int H_VT = H_KINT + 18432;
constexpr int H_ST = H_VT + 9216;
constexpr int H_OL = H_ST + 17408;
constexpr int H_END = H_OL + 9216;
static_assert(H_END <= LDS_BYTES - 16, "HGRN2 LDS overflow");
__device__ __forceinline__ void p8_hgrn_scan(const Frame& F) {
    const bf16_t* ZH = (const bf16_t*)(F.ws + WS_ZH);
    LAS unsigned char* L = F.lds;
    const int tid = F.tid, lane = F.lane, w8 = F.wave;
    const float* hglb = F.in[I_HGLB];
    const int fr = lane & 15, fq = lane >> 4;
    for (int cid = F.bid; cid < 256; cid += F.G) {
        const int b = cid >> 5, hh = (cid >> 2) & 7, d = (cid >> 1) & 1, vh = cid & 1;
        bf16_t* Od = (bf16_t*)(F.ws + (d ? WS_OB : WS_OF));
        const int k1 = tid & 127, seg = tid >> 7;
        const float lbk = sigmoidf_(hglb[hh * 128 + k1] - hglb[1024 + hh * 128 + k1]);
        f32x4 Sreg[4];
#pragma unroll
        for (int i = 0; i < 4; ++i) Sreg[i] = (f32x4){0.f, 0.f, 0.f, 0.f};
        __syncthreads();
        for (int i = tid; i < 17408 / 4; i += 512) ((LAS unsigned*)(L + H_ST))[i] = 0u;
        constexpr int NCH = (TC + T) / HC;
        u32x4 pq0, pq1, pf0, pf1, pi0;
        auto chunk_row0 = [&](int ci) { const bool isctx = ci < TC / HC; const int cj = isctx ? ci : ci - TC / HC, nch = isctx ? TC / HC : T / HC;
            const int pos = d ? (nch - 1 - cj) : cj; return (isctx ? ML + b * TC : b * T) + pos * HC; };
#define H_PREFETCH(ci_) do { const int r0_ = chunk_row0(ci_); \
            { const int st = tid >> 4, kc = tid & 15; const bf16_t* g0 = ZH + (size_t)(r0_ + (d ? HC - 1 - st : st)) * NZH + hh * 128 + 8 * kc; \
              const bf16_t* g1 = ZH + (size_t)(r0_ + (d ? HC - 1 - (st + 32) : (st + 32))) * NZH + hh * 128 + 8 * kc; \
              pq0 = *(const u32x4*)g0; pq1 = *(const u32x4*)g1; pf0 = *(const u32x4*)(g0 + (d ? 2048 : 1024)); pf1 = *(const u32x4*)(g1 + (d ? 2048 : 1024)); } \
            { const int st = tid >> 3, vc = tid & 7; pi0 = *(const u32x4*)(ZH + (size_t)(r0_ + (d ? HC - 1 - st : st)) * NZH + 3072 + hh * 128 + vh * 64 + 8 * vc); } } while (0)
        H_PREFETCH(0);
        for (int ci = 0; ci < NCH; ++ci) {
            const bool isctx = ci < TC / HC;
            const int row0 = chunk_row0(ci);
            { const int st = tid >> 4, kc = tid & 15;
              *(LAS u32x4*)(L + H_RAWQ + (st * 128 + 8 * kc) * 2) = pq0; *(LAS u32x4*)(L + H_RAWQ + ((st + 32) * 128 + 8 * kc) * 2) = pq1;
              *(LAS u32x4*)(L + H_RAWF + (st * 128 + 8 * kc) * 2) = pf0; *(LAS u32x4*)(L + H_RAWF + ((st + 32) * 128 + 8 * kc) * 2) = pf1; }
            { const int st = tid >> 3, vc = tid & 7; *(LAS u32x4*)(L + H_RAWI + (st * 64 + 8 * vc) * 2) = pi0; }
            if (ci + 1 < NCH) H_PREFETCH(ci + 1);
            __syncthreads();
            float cc[16], kfv[16], qv[16];
            { float c = 0.f;
#pragma unroll
              for (int j = 0; j < 16; ++j) { const int st = 16 * seg + j;
                  const float fz = __builtin_bit_cast(float, (unsigned)(*(const LAS bf16_t*)(L + H_RAWF + (st * 128 + k1) * 2)) << 16);
                  qv[j] = __builtin_bit_cast(float, (unsigned)(*(const LAS bf16_t*)(L + H_RAWQ + (st * 128 + k1) * 2)) << 16);
                  const float f = lbk + (1.0f - lbk) * sigmoidf_(fz);
                  c += __logf(f); cc[j] = c; kfv[j] = 1.0f - f; }
              ((LAS float*)(L + H_TOT))[seg * 128 + k1] = c; }
            __syncthreads();
            { const LAS float* TOT = (const LAS float*)(L + H_TOT);
              const float t0 = TOT[k1], t1 = TOT[128 + k1], t2 = TOT[256 + k1], t3 = TOT[384 + k1];
              const float off = (seg > 0 ? t0 : 0.f) + (seg > 1 ? t1 : 0.f) + (seg > 2 ? t2 : 0.f);
              const float bref = t0 + t1, blast = (t0 + t1) + (t2 + t3);
              unsigned kp[8];
#pragma unroll
              for (int j = 0; j < 16; ++j) { const int st = 16 * seg + j; const float bb = cc[j] + off;
                  const float eq = __expf(bb - bref), ek = __expf(bref - bb), eb = __expf(bb);
                  const unsigned qin = f2bf(qv[j] * eq), kin = f2bf(kfv[j] * ek), qb = f2bf(qv[j] * eb);
                  *(LAS bf16_t*)(L + H_QIN + (st * 136 + k1) * 2) = (bf16_t)qin; *(LAS bf16_t*)(L + H_KIN + (st * 136 + k1) * 2) = (bf16_t)kin; *(LAS bf16_t*)(L + H_QB + (st * 136 + k1) * 2) = (bf16_t)qb;
                  if (j & 1) kp[j >> 1] |= kin << 16; else kp[j >> 1] = kin; }
              *(LAS u32x4*)(L + H_KINT + (k1 * 72 + 16 * seg) * 2) = (u32x4){kp[0], kp[1], kp[2], kp[3]};
              *(LAS u32x4*)(L + H_KINT + (k1 * 72 + 16 * seg + 8) * 2) = (u32x4){kp[4], kp[5], kp[6], kp[7]};
              if (seg == 0) { ((LAS float*)(L + H_DEC))[k1] = __expf(blast); ((LAS float*)(L + H_DEC))[128 + k1] = __expf(blast - bref); } }
            { const int v = tid & 63, s8 = tid >> 6; unsigned vp[4];
#pragma unroll
              for (int j = 0; j < 8; ++j) { const unsigned x = *(const LAS bf16_t*)(L + H_RAWI + ((8 * s8 + j) * 64 + v) * 2); if (j & 1) vp[j >> 1] |= x << 16; else vp[j >> 1] = x; }
              *(LAS u32x4*)(L + H_VT + (v * 72 + 8 * s8) * 2) = (u32x4){vp[0], vp[1], vp[2], vp[3]}; }
            __syncthreads();
            if (!isctx) {
                const int tt = w8 >> 1;
#pragma unroll
                for (int u = 0; u < 2; ++u) { const int stl = 2 * (w8 & 1) + u; f32x4 acc = (f32x4){0.f, 0.f, 0.f, 0.f};
                    if (stl <= tt) {
#pragma unroll
                        for (int ks = 0; ks < 4; ++ks) { const bf16x8 a = *(const LAS bf16x8*)(L + H_QIN + ((16 * tt + fr) * 136 + 32 * ks + 8 * fq) * 2);
                            const bf16x8 bq = *(const LAS bf16x8*)(L + H_KIN + ((16 * stl + fr) * 136 + 32 * ks + 8 * fq) * 2);
                            acc = __builtin_amdgcn_mfma_f32_16x16x32_bf16(a, bq, acc, 0, 0, 0); } }
#pragma unroll
                    for (int r = 0; r < 4; ++r) { const int t = 16 * tt + 4 * fq + r, s = 16 * stl + fr; const float pv = (s <= t && stl <= tt) ? acc[r] : 0.f;
                        *(LAS bf16_t*)(L + H_PL + (t * 72 + s) * 2) = (bf16_t)f2bf(pv); } }
            }
            __syncthreads();
            if (!isctx) {
                const int tt = w8 >> 1;
#pragma unroll
                for (int u = 0; u < 2; ++u) { const int vt = 2 * (w8 & 1) + u; f32x4 acc = (f32x4){0.f, 0.f, 0.f, 0.f};
#pragma unroll
                    for (int ks = 0; ks < 2; ++ks) { const bf16x8 a = *(const LAS bf16x8*)(L + H_PL + ((16 * tt + fr) * 72 + 32 * ks + 8 * fq) * 2);
                        const bf16x8 bv = *(const LAS bf16x8*)(L + H_VT + ((16 * vt + fr) * 72 + 32 * ks + 8 * fq) * 2);
                        acc = __builtin_amdgcn_mfma_f32_16x16x32_bf16(a, bv, acc, 0, 0, 0); }
#pragma unroll
                    for (int ks = 0; ks < 4; ++ks) { const bf16x8 a = *(const LAS bf16x8*)(L + H_QB + ((16 * tt + fr) * 136 + 32 * ks + 8 * fq) * 2);
                        const bf16x8 bs = *(const LAS bf16x8*)(L + H_ST + ((16 * vt + fr) * 136 + 32 * ks + 8 * fq) * 2);
                        acc = __builtin_amdgcn_mfma_f32_16x16x32_bf16(a, bs, acc, 0, 0, 0); }
#pragma unroll
                    for (int r = 0; r < 4; ++r) *(LAS bf16_t*)(L + H_OL + ((16 * tt + 4 * fq + r) * 72 + 16 * vt + fr) * 2) = (bf16_t)f2bf(acc[r]); }
            }
            { const LAS float* DEC = (const LAS float*)(L + H_DEC);
              const f32x4 dk = *(const LAS f32x4*)(DEC + 16 * w8 + 4 * fq), e2 = *(const LAS f32x4*)(DEC + 128 + 16 * w8 + 4 * fq);
#pragma unroll
              for (int vt = 0; vt < 4; ++vt) { f32x4 acc = (f32x4){0.f, 0.f, 0.f, 0.f};
#pragma unroll
                  for (int ks = 0; ks < 2; ++ks) { const bf16x8 a = *(const LAS bf16x8*)(L + H_KINT + ((16 * w8 + fr) * 72 + 32 * ks + 8 * fq) * 2);
                      const bf16x8 bv = *(const LAS bf16x8*)(L + H_VT + ((16 * vt + fr) * 72 + 32 * ks + 8 * fq) * 2);
                      acc = __builtin_amdgcn_mfma_f32_16x16x32_bf16(a, bv, acc, 0, 0, 0); }
                  Sreg[vt] = dk * Sreg[vt] + e2 * acc; } }
            __syncthreads();
#pragma unroll
            for (int vt = 0; vt < 4; ++vt) { u32x2 o; o.x = pk2(Sreg[vt][0], Sreg[vt][1]); o.y = pk2(Sreg[vt][2], Sreg[vt][3]);
                *(LAS u32x2*)(L + H_ST + ((16 * vt + fr) * 136 + 16 * w8 + 4 * fq) * 2) = o; }
            if (!isctx) { const int st = tid >> 3, vc = tid & 7;
                const u32x4 o = *(const LAS u32x4*)(L + H_OL + (st * 72 + 8 * vc) * 2);
                *(u32x4*)(Od + (size_t)(row0 + (d ? HC - 1 - st : st)) * D + hh * 128 + vh * 64 + 8 * vc) = o; }
        }
#undef H_PREFETCH
        __syncthreads();
    }
}

__device__ __forceinline__ void p10_hgrn_read(const Frame& F) {
    bf16_t* OF = (bf16_t*)(F.ws + WS_OF); const bf16_t* OBk = (const bf16_t*)(F.ws + WS_OB); const bf16_t* ZG = (const bf16_t*)(F.ws + WS_ZG);
    const float* nw = F.in[I_HGNW];
    const size_t total = (size_t)ML * 256;
    for (size_t i = (size_t)F.bid * 512 + F.tid; i < total; i += (size_t)F.G * 512) {
        const int row = (int)(i >> 8), c = ((int)i & 255) * 4;
        const u32x2 a = *(const u32x2*)(OF + (size_t)row * D + c), b = *(const u32x2*)(OBk + (size_t)row * D + c);
        const float o[4] = {bflo(a.x) + bflo(b.x), bfhi(a.x) + bfhi(b.x), bflo(a.y) + bflo(b.y), bfhi(a.y) + bfhi(b.y)};
        const float ms = sum32((o[0] * o[0] + o[1] * o[1]) + (o[2] * o[2] + o[3] * o[3])) * (1.f / 128.f);
        const float rs = __builtin_amdgcn_rsqf(ms + RMS_EPS);
        const u32x2 gw = *(const u32x2*)(ZG + (size_t)row * NZG + c);
        const float g[4] = {bflo(gw.x), bfhi(gw.x), bflo(gw.y), bfhi(gw.y)};
        const f32x4 w = *(const f32x4*)(nw + c);
        float y[4];
#pragma unroll
        for (int j = 0; j < 4; ++j) y[j] = o[j] * rs * w[j] * (g[j] * sigmoidf_(g[j]));
        u32x2 ww; ww.x = pk2(y[0], y[1]); ww.y = pk2(y[2], y[3]);
        *(u32x2*)(OF + (size_t)row * D + c) = ww;
    }
}

template <bool COOP>
__device__ __forceinline__ void mk_body(const Args& args) {
    extern __shared__ __attribute__((aligned(16))) unsigned char lds_raw[];
    Frame F;
    F.lds = (LAS unsigned char*)lds_raw;
    F.tid = threadIdx.x; F.lane = F.tid & 63; F.wave = __builtin_amdgcn_readfirstlane(F.tid >> 6);
    F.G = gridDim.x; F.bid = blockIdx.x;
    F.in = args.in; F.ws = args.ws; F.dob = (unsigned char*)args.out;
    const int lo = args.ph_lo, hi = args.ph_hi;
    const float* MOD = (const float*)(F.ws + WS_MOD);
    const int gw = F.bid * 8 + F.wave, NGW = F.G * 8;
#define IN(k) (lo <= (k) && (k) < hi)
    XcdBarrier xbar; xbar.bar = (unsigned*)(F.ws + WS_CTL); xbar.x = 0; xbar.st = nullptr;
    if (COOP) {
        volatile LAS unsigned* st = (volatile LAS unsigned*)(F.lds + LDS_BYTES - 16);
        if (F.tid < 4) st[F.tid] = 0u;
        __syncthreads();
        xbar = xcd_barrier_post((unsigned*)(F.ws + WS_CTL), st);
    }
#define SEAM(k) do { if (COOP && IN(k) && IN((k) + 1)) { if ((k) == 0) cg::this_grid().sync(); else xcd_barrier(xbar); } } while (0)

    if (IN(0)) { p0_prologue(F); }
#if (MK_REPMASK >> 0) & 1
    if (COOP) cg::this_grid().sync();
    if (IN(0)) { p0_prologue(F); }
#endif
    SEAM(0);
    if (IN(1)) {
        bf16_t* H = (bf16_t*)(F.dob + DO_H);
        for (int m = gw; m < MR; m += NGW) {
            const bool lat = m < ML; const int b = lat ? (m >> 12) : 8;
            const float* xr = lat ? F.in[I_X] + (size_t)m * D : F.in[I_CTX] + (size_t)(m - ML) * D;
            modnorm_row(xr, F.in[I_N1W], MOD + b * 6144, MOD + b * 6144 + 1024, H + (size_t)m * D, F.lane);
        }
    }
#if (MK_REPMASK >> 1) & 1
    if (COOP) cg::this_grid().sync();
    if (IN(1)) {
        bf16_t* H = (bf16_t*)(F.dob + DO_H);
        for (int m = gw; m < MR; m += NGW) {
            const bool lat = m < ML; const int b = lat ? (m >> 12) : 8;
            const float* xr = lat ? F.in[I_X] + (size_t)m * D : F.in[I_CTX] + (size_t)(m - ML) * D;
            modnorm_row(xr, F.in[I_N1W], MOD + b * 6144, MOD + b * 6144 + 1024, H + (size_t)m * D, F.lane);
        }
    }
#endif
    SEAM(1);
    if (IN(2)) {
        pg8::Sched S; S.init(F.dob + DO_H, F.dob + DO_WIN, nullptr, nullptr, MR, NZR, D, F.G, F.bid, 1);
        pg8::EpiBf16 E{(bf16_t*)(F.ws + WS_R1), NZR};
        pg8::gemm_phase(F.lds, D, S, E);
    }
#if (MK_REPMASK >> 2) & 1
    if (COOP) cg::this_grid().sync();
    if (IN(2)) {
        pg8::Sched S; S.init(F.dob + DO_H, F.dob + DO_WIN, nullptr, nullptr, MR, NZR, D, F.G, F.bid, 1);
        pg8::EpiBf16 E{(bf16_t*)(F.ws + WS_R1), NZR};
        pg8::gemm_phase(F.lds, D, S, E);
    }
#endif
    SEAM(2);
    if (IN(3)) { p3_shift(F); }
#if (MK_REPMASK >> 3) & 1
    if (COOP) cg::this_grid().sync();
    if (IN(3)) { p3_shift(F); }
#endif
    SEAM(3);
    if (IN(4)) { p4_rwkv_scan(F); }
#if (MK_REPMASK >> 4) & 1
    if (COOP) cg::this_grid().sync();
    if (IN(4)) { p4_rwkv_scan(F); }
#endif
    SEAM(4);
    if (IN(5)) { p5_rwkv_norm(F); }
#if (MK_REPMASK >> 5) & 1
    if (COOP) cg::this_grid().sync();
    if (IN(5)) { p5_rwkv_norm(F); }
#endif
    SEAM(5);
    if (IN(6)) {
        pg8::Sched S; S.init(F.ws + WS_XGS, F.dob + DO_GUP, nullptr, nullptr, ML, D, 256, F.G, F.bid, 1);
        pg8::EpiMulBf16 E{(const bf16_t*)(F.ws + WS_YF), (bf16_t*)(F.ws + WS_YRW), D};
        pg8::gemm_phase(F.lds, 256, S, E);
    }
#if (MK_REPMASK >> 6) & 1
    if (COOP) cg::this_grid().sync();
    if (IN(6)) {
        pg8::Sched S; S.init(F.ws + WS_XGS, F.dob + DO_GUP, nullptr, nullptr, ML, D, 256, F.G, F.bid, 1);
        pg8::EpiMulBf16 E{(const bf16_t*)(F.ws + WS_YF), (bf16_t*)(F.ws + WS_YRW), D};
        pg8::gemm_phase(F.lds, 256, S, E);
    }
#endif
    SEAM(6);
    if (IN(7)) {
        pg8::Sched S; S.init(F.dob + DO_H, F.dob + DO_WIN + (size_t)NZR * D * 2, nullptr, nullptr, MR, NZH, D, F.G, F.bid, 1);
        pg8::EpiBf16 E{(bf16_t*)(F.ws + WS_ZH), NZH};
        pg8::gemm_phase(F.lds, D, S, E);
    }
#if (MK_REPMASK >> 7) & 1
    if (COOP) cg::this_grid().sync();
    if (IN(7)) {
        pg8::Sched S; S.init(F.dob + DO_H, F.dob + DO_WIN + (size_t)NZR * D * 2, nullptr, nullptr, MR, NZH, D, F.G, F.bid, 1);
        pg8::EpiBf16 E{(bf16_t*)(F.ws + WS_ZH), NZH};
        pg8::gemm_phase(F.lds, D, S, E);
    }
#endif
    SEAM(7);
    if (IN(8)) { p8_hgrn_scan(F); }
#if (MK_REPMASK >> 8) & 1
    if (COOP) cg::this_grid().sync();
    if (IN(8)) { p8_hgrn_scan(F); }
#endif
    SEAM(8);
    if (IN(9)) {
        pg8::Sched S; S.init(F.dob + DO_H, F.dob + DO_WIN + (size_t)(NZR + NZH) * D * 2, nullptr, nullptr, ML, NZG, D, F.G, F.bid, 1);
        pg8::EpiBf16 E{(bf16_t*)(F.ws + WS_ZG), NZG};
        pg8::gemm_phase(F.lds, D, S, E);
    }
#if (MK_REPMASK >> 9) & 1
    if (COOP) cg::this_grid().sync();
    if (IN(9)) {
        pg8::Sched S; S.init(F.dob + DO_H, F.dob + DO_WIN + (size_t)(NZR + NZH) * D * 2, nullptr, nullptr, ML, NZG, D, F.G, F.bid, 1);
        pg8::EpiBf16 E{(bf16_t*)(F.ws + WS_ZG), NZG};
        pg8::gemm_phase(F.lds, D, S, E);
    }
#endif
    SEAM(9);
    if (IN(10)) { p10_hgrn_read(F); }
#if (MK_REPMASK >> 10) & 1
    if (COOP) cg::this_grid().sync();
    if (IN(10)) { p10_hgrn_read(F); }
#endif
    SEAM(10);
    if (IN(11)) {
        pg8::Sched S; S.init(F.ws + WS_YRW, F.dob + DO_PA, F.ws + WS_OF, F.dob + DO_PB, ML, D, D, F.G, F.bid, 2);
        pg8::EpiMerge E{(const bf16_t*)(F.ws + WS_ZG), (bf16_t*)(F.ws + WS_MRG)};
        pg8::gemm_phase(F.lds, D, S, E);
    }
#if (MK_REPMASK >> 11) & 1
    if (COOP) cg::this_grid().sync();
    if (IN(11)) {
        pg8::Sched S; S.init(F.ws + WS_YRW, F.dob + DO_PA, F.ws + WS_OF, F.dob + DO_PB, ML, D, D, F.G, F.bid, 2);
        pg8::EpiMerge E{(const bf16_t*)(F.ws + WS_ZG), (bf16_t*)(F.ws + WS_MRG)};
        pg8::gemm_phase(F.lds, D, S, E);
    }
#endif
    SEAM(11);
    if (IN(12)) {
        pg8::Sched S; S.init(F.ws + WS_MRG, F.dob + DO_WO, nullptr, nullptr, ML, D, D, F.G, F.bid, 1);
        pg8::EpiResid E{F.in[I_X], (float*)(F.ws + WS_X1), MOD + 2048};
        pg8::gemm_phase(F.lds, D, S, E);
    }
#if (MK_REPMASK >> 12) & 1
    if (COOP) cg::this_grid().sync();
    if (IN(12)) {
        pg8::Sched S; S.init(F.ws + WS_MRG, F.dob + DO_WO, nullptr, nullptr, ML, D, D, F.G, F.bid, 1);
        pg8::EpiResid E{F.in[I_X], (float*)(F.ws + WS_X1), MOD + 2048};
        pg8::gemm_phase(F.lds, D, S, E);
    }
#endif
    SEAM(12);
    if (IN(13)) {
        const float* X1 = (const float*)(F.ws + WS_X1); bf16_t* H2 = (bf16_t*)(F.ws + WS_H2);
        for (int m = gw; m < ML; m += NGW) { const int b = m >> 12;
            modnorm_row(X1 + (size_t)m * D, F.in[I_N2W], MOD + b * 6144 + 3072, MOD + b * 6144 + 4096, H2 + (size_t)m * D, F.lane); }
    }
#if (MK_REPMASK >> 13) & 1
    if (COOP) cg::this_grid().sync();
    if (IN(13)) {
        const float* X1 = (const float*)(F.ws + WS_X1); bf16_t* H2 = (bf16_t*)(F.ws + WS_H2);
        for (int m = gw; m < ML; m += NGW) { const int b = m >> 12;
            modnorm_row(X1 + (size_t)m * D, F.in[I_N2W], MOD + b * 6144 + 3072, MOD + b * 6144 + 4096, H2 + (size_t)m * D, F.lane); }
    }
#endif
    SEAM(13);
    if (IN(14)) {
        pg8::Sched S; S.init(F.ws + WS_H2, F.dob + DO_FC1, nullptr, nullptr, ML, FF, D, F.G, F.bid, 1);
        pg8::EpiSqRelu E{(bf16_t*)(F.ws + WS_U), FF};
        pg8::gemm_phase(F.lds, D, S, E);
    }
#if (MK_REPMASK >> 14) & 1
    if (COOP) cg::this_grid().sync();
    if (IN(14)) {
        pg8::Sched S; S.init(F.ws + WS_H2, F.dob + DO_FC1, nullptr, nullptr, ML, FF, D, F.G, F.bid, 1);
        pg8::EpiSqRelu E{(bf16_t*)(F.ws + WS_U), FF};
        pg8::gemm_phase(F.lds, D, S, E);
    }
#endif
    SEAM(14);
    if (IN(15)) {
        pg8::Sched S; S.init(F.ws + WS_U, F.dob + DO_FC2, nullptr, nullptr, ML, D, FF, F.G, F.bid, 1);
        pg8::EpiResid E{(const float*)(F.ws + WS_X1), (float*)(F.ws + WS_X1), MOD + 5120};
        pg8::gemm_phase(F.lds, FF, S, E);
    }
#if (MK_REPMASK >> 15) & 1
    if (COOP) cg::this_grid().sync();
    if (IN(15)) {
        pg8::Sched S; S.init(F.ws + WS_U, F.dob + DO_FC2, nullptr, nullptr, ML, D, FF, F.G, F.bid, 1);
        pg8::EpiResid E{(const float*)(F.ws + WS_X1), (float*)(F.ws + WS_X1), MOD + 5120};
        pg8::gemm_phase(F.lds, FF, S, E);
    }
#endif
    SEAM(15);
    if (IN(16)) {
        const float* X2 = (const float*)(F.ws + WS_X1); const float* fw = F.in[I_FNW];
        for (int m = gw; m < ML; m += NGW) {
            const float* xr = X2 + (size_t)m * D; float* orow = args.out + (size_t)m * D;
            f32x4 v[4]; float s = 0.f;
#pragma unroll
            for (int j = 0; j < 4; ++j) { v[j] = *(const f32x4*)(xr + 4 * F.lane + 256 * j); s += (v[j].x * v[j].x + v[j].y * v[j].y) + (v[j].z * v[j].z + v[j].w * v[j].w); }
            const float rs = __builtin_amdgcn_rsqf(wave_sum(s) * (1.f / D) + RMS_EPS);
#pragma unroll
            for (int j = 0; j < 4; ++j) { const int c = 4 * F.lane + 256 * j; *(f32x4*)(orow + c) = v[j] * rs * *(const f32x4*)(fw + c); }
        }
    }
#if (MK_REPMASK >> 16) & 1
    if (COOP) cg::this_grid().sync();
    if (IN(16)) {
        const float* X2 = (const float*)(F.ws + WS_X1); const float* fw = F.in[I_FNW];
        for (int m = gw; m < ML; m += NGW) {
            const float* xr = X2 + (size_t)m * D; float* orow = args.out + (size_t)m * D;
            f32x4 v[4]; float s = 0.f;
#pragma unroll
            for (int j = 0; j < 4; ++j) { v[j] = *(const f32x4*)(xr + 4 * F.lane + 256 * j); s += (v[j].x * v[j].x + v[j].y * v[j].y) + (v[j].z * v[j].z + v[j].w * v[j].w); }
            const float rs = __builtin_amdgcn_rsqf(wave_sum(s) * (1.f / D) + RMS_EPS);
#pragma unroll
            for (int j = 0; j < 4; ++j) { const int c = 4 * F.lane + 256 * j; *(f32x4*)(orow + c) = v[j] * rs * *(const f32x4*)(fw + c); }
        }
    }
#endif

#undef IN
#undef SEAM
}

__global__ void __launch_bounds__(512, 2) mk_multi(Args args) { mk_body<false>(args); }
__global__ void __launch_bounds__(512, 2) mk_one(Args args) { mk_body<true>(args); }

extern "C" void kernel_launch(void* const* d_in, const int* in_sizes, int n_in, void* d_out, int out_size, void* d_ws, size_t ws_size, hipStream_t stream) {
    static int grid = 0;
    if (grid == 0) {
        if (n_in != 28 || out_size != ML * D || ws_size < WS_END) { fprintf(stderr, "kernel_launch: unexpected problem (n_in %d, out %d, ws %zu)\n", n_in, out_size, ws_size); grid = -1; return; }
        int dev = 0, cus = 0;
        if (hipGetDevice(&dev) != hipSuccess || hipDeviceGetAttribute(&cus, hipDeviceAttributeMultiprocessorCount, dev) != hipSuccess) { grid = -1; return; }
        (void)hipFuncSetAttribute((const void*)mk_multi, hipFuncAttributeMaxDynamicSharedMemorySize, LDS_BYTES);
        (void)hipFuncSetAttribute((const void*)mk_one, hipFuncAttributeMaxDynamicSharedMemorySize, LDS_BYTES);
        int per_cu = 0;
        (void)hipOccupancyMaxActiveBlocksPerMultiprocessor(&per_cu, (const void*)mk_one, 512, LDS_BYTES);
        (void)hipGetLastError();
        grid = cus;
        if (per_cu < 1) fprintf(stderr, "kernel_launch: occupancy query reports %d blocks per CU\n", per_cu);
    }
    if (grid < 0) return;
    (void)hipMemsetAsync((char*)d_ws + WS_CTL, 0, XCD_BAR_WORDS * 4, stream);
    Args a{};
    for (int i = 0; i < 28; ++i) a.in[i] = (const float*)d_in[i];
    a.out = (float*)d_out; a.ws = (unsigned char*)d_ws;
#if MK_ONE_LAUNCH
    a.ph_lo = 0; a.ph_hi = NPHASE;
    void* kargs[] = {&a};
    hipError_t e = hipLaunchCooperativeKernel((const void*)mk_one, dim3(grid), dim3(512), kargs, LDS_BYTES, stream);
    if (e != hipSuccess) fprintf(stderr, "cooperative launch failed: %s\n", hipGetErrorString(e));
#else
    for (int p = 0; p < NPHASE; ++p) { a.ph_lo = p; a.ph_hi = p + 1; hipLaunchKernelGGL(mk_multi, dim3(grid), dim3(512), LDS_BYTES, stream, a); }
#endif
}
```

```cpp
#include <hip/hip_runtime.h>
#include <hip/hip_cooperative_groups.h>
#include <cstdio>
#include <cstdint>
namespace cg = cooperative_groups;

#ifndef MK_ONE_LAUNCH
#define MK_ONE_LAUNCH 1
#endif
#ifndef MK_REPMASK
#define MK_REPMASK 0x0u
#endif

#define LAS __attribute__((address_space(3)))
typedef unsigned short bf16_t;
typedef short bf16x8 __attribute__((ext_vector_type(8)));
typedef float f32x4 __attribute__((ext_vector_type(4)));
typedef float f32x2 __attribute__((ext_vector_type(2)));
typedef unsigned u32x4 __attribute__((ext_vector_type(4)));
typedef unsigned u32x2 __attribute__((ext_vector_type(2)));

constexpr int D = 1024, NB = 8, T = 4096, TC = 256, GW = 64;
constexpr int ML = NB * T;
constexpr int MC = NB * TC;
constexpr int MR = ML + MC;
constexpr int NZR = 3328, NZH = 4096, NZG = 3072, NIN = 10496, FF = 4096;
constexpr float RMS_EPS = 1e-6f, GN_EPS = 64e-5f;

constexpr size_t MiB = 1u << 20;
constexpr size_t WS_CTL = 0, WS_MOD = 1 * MiB;
constexpr size_t WS_R1 = 2 * MiB;
constexpr size_t WS_YF = 2 * MiB, WS_YB = 66 * MiB, WS_YRW = 130 * MiB;
constexpr size_t WS_OF = 2 * MiB, WS_OB = 66 * MiB;
constexpr size_t WS_X1 = 2 * MiB;
constexpr size_t WS_H2 = 130 * MiB;
constexpr size_t WS_ZRS = 223 * MiB;
constexpr size_t WS_XGS = 444 * MiB;
constexpr size_t WS_BON = 460 * MiB;
constexpr size_t WS_ZH = 194 * MiB;
constexpr size_t WS_ZG = 194 * MiB;
constexpr size_t WS_MRG = 386 * MiB;
constexpr size_t WS_U = 194 * MiB;
constexpr size_t WS_RN = 464 * MiB;
constexpr size_t WS_END = 468 * MiB;
constexpr size_t DO_H = 0;
constexpr size_t DO_WIN = 68 * MiB;
constexpr size_t DO_PA = DO_WIN + (size_t)NIN * D * 2;
constexpr size_t DO_PB = DO_PA + 2 * MiB, DO_WO = DO_PB + 2 * MiB, DO_FC1 = DO_WO + 2 * MiB, DO_FC2 = DO_FC1 + 8 * MiB, DO_GUP = DO_FC2 + 8 * MiB;
constexpr size_t DO_END = DO_GUP + (size_t)1024 * 256 * 2;
static_assert(DO_END <= 128 * MiB, "d_out scratch overflow");

constexpr int LDS_BYTES = 152 * 1024;
constexpr int NPHASE = 17;

__device__ __forceinline__ unsigned f2bf(float f) { return (unsigned)__builtin_bit_cast(unsigned short, (__bf16)f); }
typedef __bf16 bf16x2_t __attribute__((ext_vector_type(2)));
__device__ __forceinline__ unsigned pk2(float lo, float hi) { const f32x2 v = {lo, hi}; return __builtin_bit_cast(unsigned, __builtin_convertvector(v, bf16x2_t)); }
__device__ __forceinline__ float bflo(unsigned w) { return __builtin_bit_cast(float, w << 16); }
__device__ __forceinline__ float bfhi(unsigned w) { return __builtin_bit_cast(float, w & 0xffff0000u); }
__device__ __forceinline__ float fexp(float x) { return __builtin_amdgcn_exp2f(x * 1.4426950408889634f); }
__device__ __forceinline__ float flog(float x) { return __builtin_amdgcn_logf(x) * 0.6931471805599453f; }
__device__ __forceinline__ float sigmoidf_(float x) { return __builtin_amdgcn_rcpf(1.0f + fexp(-x)); }
__device__ __forceinline__ float wave_sum(float v) {
#pragma unroll
    for (int o = 1; o < 64; o <<= 1) v += __shfl_xor(v, o);
    return v;
}
template <int CTRL> __device__ __forceinline__ float dpp_mov(float v) { return __builtin_bit_cast(float, __builtin_amdgcn_update_dpp(0, __builtin_bit_cast(int, v), CTRL, 0xf, 0xf, true)); }
__device__ __forceinline__ float sum16(float v) { v += dpp_mov<0xB1>(v); v += dpp_mov<0x4E>(v); v += dpp_mov<0x141>(v); v += dpp_mov<0x140>(v); return v; }
__device__ __forceinline__ float sum32(float v) { v = sum16(v); v += __shfl_xor(v, 16); return v; }


#define XB_TMO      128
#define XB_XCNT(j)  (256  + 64 * (j))
#define XB_XSUB(j)  (1280 + 64 * (j))
#define XB_XGEN(j)  (2304 + 64 * (j))
#define XB_TOP      3328
#define XB_TOPGEN   3392
#define XCD_BAR_WORDS 3456
#define XB_SPIN_CAP (1u << 18)
__device__ __forceinline__ unsigned xb_ld(unsigned* p)              { return __hip_atomic_load(p, __ATOMIC_RELAXED, __HIP_MEMORY_SCOPE_AGENT); }
__device__ __forceinline__ unsigned xb_add(unsigned* p, unsigned v) { return __hip_atomic_fetch_add(p, v, __ATOMIC_RELAXED, __HIP_MEMORY_SCOPE_AGENT); }
__device__ __forceinline__ unsigned xb_xcc_id() { return (unsigned)__builtin_amdgcn_s_getreg((3 << 11) | 20) & 0xFu; }
#define XB_SPIN(cond, bar) do { unsigned _sp = 0; while (cond) { __builtin_amdgcn_s_sleep(1); \
    if ((++_sp & 255u) == 0u) { if (xb_ld(&(bar)[XB_TMO])) break; if (_sp > XB_SPIN_CAP) { atomicAdd(&(bar)[XB_TMO], 1u); break; } } } } while (0)
struct XcdBarrier { unsigned* bar; unsigned x; volatile LAS unsigned* st; };
__device__ __forceinline__ XcdBarrier xcd_barrier_post(unsigned* bar, volatile LAS unsigned* st) {
    XcdBarrier b; b.bar = bar; b.x = xb_xcc_id(); b.st = st;
    if (threadIdx.x == 0) (void)xb_add(&bar[XB_XCNT(b.x)], 1u);
    return b;
}
__device__ __forceinline__ void xcd_barrier_complete(unsigned* bar, unsigned x, unsigned& nloc, unsigned& nx) {
    const unsigned G = gridDim.x * gridDim.y * gridDim.z;
    unsigned sum, cnt, mine, sp = 0u;
    for (;;) {
        sum = 0u; cnt = 0u; mine = 0u;
#pragma unroll
        for (unsigned j = 0; j < 16; ++j) { const unsigned c = xb_ld(&bar[XB_XCNT(j)]); sum += c; cnt += (c > 0u) ? 1u : 0u; mine = (j == x) ? c : mine; }
        if (sum == G) break;
        __builtin_amdgcn_s_sleep(1);
        if ((++sp & 255u) == 0u) { if (xb_ld(&bar[XB_TMO])) break; if (sp > XB_SPIN_CAP) { atomicAdd(&bar[XB_TMO], 1u); break; } }
    }
    nloc = mine > 0u ? mine : 1u; nx = cnt > 0u ? cnt : 1u;
}
__device__ __forceinline__ void xcd_barrier(const XcdBarrier& b) {
    asm volatile("s_waitcnt vmcnt(0)" ::: "memory");
    __syncthreads();
    if (threadIdx.x == 0) {
        unsigned* bar = b.bar;
        __builtin_amdgcn_s_waitcnt(0);
        unsigned nloc = b.st[0], nx = b.st[1];
        if (nloc == 0u) { xcd_barrier_complete(bar, b.x, nloc, nx); b.st[0] = nloc; b.st[1] = nx; }
        const unsigned old = xb_add(&bar[XB_XSUB(b.x)], 1u);
        const unsigned gen = old / nloc;
        if (old + 1u == (gen + 1u) * nloc) {
            __builtin_amdgcn_fence(__ATOMIC_RELEASE, "agent");
            asm volatile("s_waitcnt vmcnt(0)" ::: "memory");
            const unsigned og = xb_add(&bar[XB_TOP], 1u);
            const unsigned tg = og / nx;
            if (og + 1u == (tg + 1u) * nx) xb_add(&bar[XB_TOPGEN], 1u);
            else XB_SPIN(xb_ld(&bar[XB_TOPGEN]) == tg, bar);
            __builtin_amdgcn_fence(__ATOMIC_ACQUIRE, "agent");
            xb_add(&bar[XB_XGEN(b.x)], 1u);
            asm volatile("s_waitcnt vmcnt(0)" ::: "memory");
        } else {
            XB_SPIN(xb_ld(&bar[XB_XGEN(b.x)]) == gen, bar);
            __builtin_amdgcn_fence(__ATOMIC_ACQUIRE, "agent");
            asm volatile("s_waitcnt vmcnt(0)" ::: "memory");
        }
    }
    __syncthreads();
}

namespace pg8 {
constexpr int BM = 256, BK = 64, HALF = 128, HTB = HALF * BK * 2, STAGE_BYTES = 8 * HTB, NXCD = 8, WGM = 8;
__host__ __device__ __forceinline__ int lds_byte(int r, int c) { const int st = (r >> 4) * 2 + (c >> 5), rr = r & 15, cc = c & 31, ob = rr * 64 + cc * 2; return st * 1024 + (ob ^ (((ob >> 9) & 1) << 5)); }
__host__ __device__ __forceinline__ void stage_rc(int b, int& R, int& C) { const int st = b / 1024, sb = b % 1024, swz = sb ^ (((sb >> 9) & 1) << 5); R = (st >> 1) * 16 + swz / 64; C = (st & 1) * 32 + (swz % 64) / 2; }
__host__ __device__ __forceinline__ int perm32(int rho) { const int n = rho >> 4, i = rho & 15; return 8 * (i >> 2) + 4 * n + (i & 3); }

struct Unit { int pm, pn, sel; };
struct Sched {
    const char* A0; const char* B0; const char* A1; const char* B1;
    int nM, nN, nwg, G, c, nsel; size_t tstep;
    __device__ void init(const void* a0, const void* b0, const void* a1, const void* b1, int M, int N, int K, int G_, int c_, int nsel_) {
        A0 = (const char*)a0; B0 = (const char*)b0; A1 = (const char*)a1; B1 = (const char*)b1; nM = M / BM; nN = N / BM; nwg = nM * nN; G = G_; c = c_; nsel = nsel_; tstep = (size_t)BM * K * 2; }
    __device__ bool next(int i, Unit& u) const {
        const int j = (nsel == 2) ? (i >> 1) : i;
        const long L = (long)j * G + c; if (L >= nwg) return false;
        int wgid = (int)L; { const int q = nwg / NXCD, r = nwg % NXCD, xcd = wgid % NXCD, off = wgid / NXCD; wgid = (xcd < r ? xcd * (q + 1) : r * (q + 1) + (xcd - r) * q) + off; }
        const int nig = WGM * nN, gid = wgid / nig, fm = gid * WGM, gsz = (nM - fm) < WGM ? (nM - fm) : WGM;
        u.pm = fm + ((wgid % nig) % gsz); u.pn = (wgid % nig) / gsz; u.sel = (nsel == 2) ? (i & 1) : 0; return true;
    }
    __device__ __forceinline__ const char* abase(const Unit& u) const { return (u.sel ? A1 : A0) + (size_t)u.pm * tstep; }
    __device__ __forceinline__ const char* bbase(const Unit& u) const { return (u.sel ? B1 : B0) + (size_t)u.pn * tstep; }
};

template <class Epi>
__device__ __forceinline__ void gemm_phase(LAS unsigned char* lds, const int K, const Sched& S, const Epi& E) {
    const int tid = threadIdx.x, wid = __builtin_amdgcn_readfirstlane(tid >> 6), lane = tid & 63, wr = wid >> 2, wc = wid & 3, fr = lane & 15, fq = lane >> 4;
    const int nt = K / BK;
    unsigned voffA[2], voffB[2];
#pragma unroll
    for (int i = 0; i < 2; ++i) { int R, C; stage_rc(tid * 16 + i * 8192, R, C); const int Rb = Epi::PERM ? ((R & ~31) + perm32(R & 31)) : R;
        voffA[i] = (unsigned)(R * K + C) * 2u; voffB[i] = (unsigned)(Rb * K + C) * 2u; }
    const size_t kstep = (size_t)(BK * 2);
    const size_t hstep = (size_t)HALF * K * 2;
    const unsigned ldsw = (unsigned)wid * 1024u;
    const int aoff = lds_byte(wr * 64 + fr, fq * 8), boff = lds_byte(wc * 32 + fr, fq * 8);
#define PG8_SA(b, h) (((b) * 2 + (h)) * HTB)
#define PG8_SB(b, h) ((4 + (b) * 2 + (h)) * HTB)
#define PG8_STAGE(bufoff, gbase, voff) do { _Pragma("unroll") for (int _i = 0; _i < 2; ++_i) \
        __builtin_amdgcn_global_load_lds((const unsigned*)((const char*)(gbase) + (voff)[_i]), (LAS unsigned*)(lds + (bufoff) + ldsw + _i * 8192), 16, 0, 0); } while (0)
#define PG8_LDA(dst, b, h) do { _Pragma("unroll") for (int m = 0; m < 4; ++m) _Pragma("unroll") for (int k = 0; k < 2; ++k) dst[m][k] = *(const LAS bf16x8*)(lds + PG8_SA(b, h) + aoff + m * 2048 + k * 1024); } while (0)
#define PG8_LDB(dst, b, h) do { _Pragma("unroll") for (int n = 0; n < 2; ++n) _Pragma("unroll") for (int k = 0; k < 2; ++k) dst[n][k] = *(const LAS bf16x8*)(lds + PG8_SB(b, h) + boff + n * 2048 + k * 1024); } while (0)
#define PG8_MMA(ai, bj, At, Bt) do { __builtin_amdgcn_s_setprio(1); _Pragma("unroll") for (int m = 0; m < 4; ++m) _Pragma("unroll") for (int n = 0; n < 2; ++n) _Pragma("unroll") for (int k = 0; k < 2; ++k) \
        acc[ai][bj][m][n] = __builtin_amdgcn_mfma_f32_16x16x32_bf16(Bt[n][k], At[m][k], acc[ai][bj][m][n], 0, 0, 0); __builtin_amdgcn_s_setprio(0); } while (0)
#define PG8_WAIT_V(n) asm volatile("s_waitcnt vmcnt(" #n ")" ::: "memory")
#define PG8_WAIT_L(n) asm volatile("s_waitcnt lgkmcnt(" #n ")" ::: "memory")
#define PG8_BAR __builtin_amdgcn_s_barrier()
#define PG8_SCHED __builtin_amdgcn_sched_barrier(0)
    Unit cur, nxt; int ui = 0;
    if (!S.next(0, cur)) return;
    f32x4 acc[2][2][4][2];
#pragma unroll
    for (int a = 0; a < 2; ++a)
#pragma unroll
        for (int b = 0; b < 2; ++b)
#pragma unroll
            for (int m = 0; m < 4; ++m)
#pragma unroll
                for (int n = 0; n < 2; ++n) acc[a][b][m][n] = (f32x4){0.f, 0.f, 0.f, 0.f};
    bf16x8 At[4][2], B0[2][2], B1[2][2];
    const char* cA = S.abase(cur); const char* cB = S.bbase(cur);
    PG8_STAGE(PG8_SB(0, 0), cB, voffB); PG8_STAGE(PG8_SB(0, 1), cB + hstep, voffB); PG8_STAGE(PG8_SA(0, 0), cA, voffA); PG8_STAGE(PG8_SA(0, 1), cA + hstep, voffA);
    if (wr == 1) PG8_BAR;
    PG8_WAIT_V(2); PG8_BAR;
    PG8_STAGE(PG8_SB(1, 0), cB + kstep, voffB); PG8_STAGE(PG8_SA(1, 0), cA + kstep, voffA); PG8_STAGE(PG8_SB(1, 1), cB + hstep + kstep, voffB);
    PG8_WAIT_V(6); PG8_BAR;
    for (;;) {
        const bool has_next = S.next(ui + 1, nxt);
        const char* nA = has_next ? S.abase(nxt) : cA; const char* nB = has_next ? S.bbase(nxt) : cB;
        for (int t = 0; t < nt; t += 2) {
            const bool last = (t == nt - 2);
            const char* a1 = cA + (size_t)(t + 1) * kstep;
            const char* a2 = last ? nA : cA + (size_t)(t + 2) * kstep; const char* b2 = last ? nB : cB + (size_t)(t + 2) * kstep;
            const char* a3 = a2 + kstep; const char* b3 = b2 + kstep;
            PG8_LDB(B0, 0, 0); PG8_LDB(B1, 0, 1); PG8_SCHED; PG8_LDA(At, 0, 0); PG8_STAGE(PG8_SA(1, 1), a1 + hstep, voffA);
            PG8_WAIT_V(8); PG8_WAIT_L(0); PG8_BAR; PG8_MMA(0, 0, At, B0); PG8_MMA(0, 1, At, B1); PG8_BAR; PG8_SCHED;
            PG8_LDA(At, 0, 1); PG8_STAGE(PG8_SB(0, 0), b2, voffB); PG8_STAGE(PG8_SB(0, 1), b2 + hstep, voffB); PG8_STAGE(PG8_SA(0, 0), a2, voffA);
            PG8_WAIT_V(8); PG8_WAIT_L(0); PG8_BAR; PG8_MMA(1, 0, At, B0); PG8_MMA(1, 1, At, B1); PG8_BAR; PG8_SCHED;
            PG8_LDB(B0, 1, 0); PG8_LDB(B1, 1, 1); PG8_SCHED; PG8_LDA(At, 1, 0); PG8_STAGE(PG8_SA(0, 1), a2 + hstep, voffA);
            PG8_WAIT_V(8); PG8_WAIT_L(0); PG8_BAR; PG8_MMA(0, 0, At, B0); PG8_MMA(0, 1, At, B1); PG8_BAR; PG8_SCHED;
            PG8_LDA(At, 1, 1); PG8_STAGE(PG8_SB(1, 0), b3, voffB); PG8_STAGE(PG8_SB(1, 1), b3 + hstep, voffB); PG8_STAGE(PG8_SA(1, 0), a3, voffA);
            PG8_WAIT_V(8); PG8_WAIT_L(0); PG8_BAR; PG8_MMA(1, 0, At, B0); PG8_MMA(1, 1, At, B1); PG8_BAR; PG8_SCHED;
        }
        if (wr == 0) PG8_BAR;
        E(acc, cur, wr, wc, fr, fq);
        if (!has_next) break;
#pragma unroll
        for (int a = 0; a < 2; ++a)
#pragma unroll
            for (int b = 0; b < 2; ++b)
#pragma unroll
                for (int m = 0; m < 4; ++m)
#pragma unroll
                    for (int n = 0; n < 2; ++n) acc[a][b][m][n] = (f32x4){0.f, 0.f, 0.f, 0.f};
        cur = nxt; cA = nA; cB = nB; ++ui;
        if (wr == 1) PG8_BAR;
    }
    PG8_WAIT_V(0);
    PG8_BAR;
#undef PG8_SA
#undef PG8_SB
#undef PG8_STAGE
#undef PG8_LDA
#undef PG8_LDB
#undef PG8_MMA
#undef PG8_WAIT_V
#undef PG8_WAIT_L
#undef PG8_BAR
#undef PG8_SCHED
}

struct EpiBf16 {
    static constexpr bool PERM = true;
    bf16_t* O; int ldc;
    __device__ __forceinline__ void operator()(const f32x4 (&acc)[2][2][4][2], const Unit& u, int wr, int wc, int fr, int fq) const {
        const int row0 = u.pm * BM + wr * 64 + fr, col0 = u.pn * BM + wc * 32 + 8 * fq;
#pragma unroll
        for (int ai = 0; ai < 2; ++ai)
#pragma unroll
            for (int m = 0; m < 4; ++m) { bf16_t* rowp = O + (size_t)(row0 + ai * HALF + m * 16) * ldc + col0;
#pragma unroll
                for (int bj = 0; bj < 2; ++bj) { const f32x4 v0 = acc[ai][bj][m][0], v1 = acc[ai][bj][m][1];
                    u32x4 w; w.x = pk2(v0[0], v0[1]); w.y = pk2(v0[2], v0[3]); w.z = pk2(v1[0], v1[1]); w.w = pk2(v1[2], v1[3]);
                    *(u32x4*)(rowp + bj * HALF) = w; } }
    }
};
struct EpiSqRelu {
    static constexpr bool PERM = true;
    bf16_t* O; int ldc;
    __device__ __forceinline__ void operator()(const f32x4 (&acc)[2][2][4][2], const Unit& u, int wr, int wc, int fr, int fq) const {
        const int row0 = u.pm * BM + wr * 64 + fr, col0 = u.pn * BM + wc * 32 + 8 * fq;
#pragma unroll
        for (int ai = 0; ai < 2; ++ai)
#pragma unroll
            for (int m = 0; m < 4; ++m) { bf16_t* rowp = O + (size_t)(row0 + ai * HALF + m * 16) * ldc + col0;
#pragma unroll
                for (int bj = 0; bj < 2; ++bj) { f32x4 v0 = acc[ai][bj][m][0], v1 = acc[ai][bj][m][1];
#pragma unroll
                    for (int j = 0; j < 4; ++j) { const float a = fmaxf(v0[j], 0.f), b = fmaxf(v1[j], 0.f); v0[j] = a * a; v1[j] = b * b; }
                    u32x4 w; w.x = pk2(v0[0], v0[1]); w.y = pk2(v0[2], v0[3]); w.z = pk2(v1[0], v1[1]); w.w = pk2(v1[2], v1[3]);
                    *(u32x4*)(rowp + bj * HALF) = w; } }
    }
};
struct EpiMulBf16 {
    static constexpr bool PERM = true;
    const bf16_t* Y; bf16_t* O; int ldc;
    __device__ __forceinline__ void operator()(const f32x4 (&acc)[2][2][4][2], const Unit& u, int wr, int wc, int fr, int fq) const {
        const int row0 = u.pm * BM + wr * 64 + fr, col0 = u.pn * BM + wc * 32 + 8 * fq;
#pragma unroll
        for (int ai = 0; ai < 2; ++ai)
#pragma unroll
            for (int m = 0; m < 4; ++m) { const size_t off = (size_t)(row0 + ai * HALF + m * 16) * ldc + col0;
#pragma unroll
                for (int bj = 0; bj < 2; ++bj) { const f32x4 v0 = acc[ai][bj][m][0], v1 = acc[ai][bj][m][1];
                    const u32x4 y = *(const u32x4*)(Y + off + bj * HALF);
                    u32x4 w; w.x = pk2(v0[0] * bflo(y.x), v0[1] * bfhi(y.x)); w.y = pk2(v0[2] * bflo(y.y), v0[3] * bfhi(y.y));
                    w.z = pk2(v1[0] * bflo(y.z), v1[1] * bfhi(y.z)); w.w = pk2(v1[2] * bflo(y.w), v1[3] * bfhi(y.w));
                    *(u32x4*)(O + off + bj * HALF) = w; }
                asm volatile("" ::: "memory"); }
    }
};
struct EpiMerge {
    static constexpr bool PERM = true;
    const bf16_t* ZG; bf16_t* O;
    __device__ __forceinline__ void operator()(const f32x4 (&acc)[2][2][4][2], const Unit& u, int wr, int wc, int fr, int fq) const {
        const int row0 = u.pm * BM + wr * 64 + fr, col0 = u.pn * BM + wc * 32 + 8 * fq;
        const int goff = u.sel ? 2048 : 1024;
#pragma unroll
        for (int ai = 0; ai < 2; ++ai)
#pragma unroll
            for (int m = 0; m < 4; ++m) { const size_t r = (size_t)(row0 + ai * HALF + m * 16);
#pragma unroll
                for (int bj = 0; bj < 2; ++bj) { const f32x4 v0 = acc[ai][bj][m][0], v1 = acc[ai][bj][m][1];
                    const u32x4 g = *(const u32x4*)(ZG + r * NZG + goff + col0 + bj * HALF);
                    float o[8];
                    o[0] = v0[0] * sigmoidf_(bflo(g.x)); o[1] = v0[1] * sigmoidf_(bfhi(g.x)); o[2] = v0[2] * sigmoidf_(bflo(g.y)); o[3] = v0[3] * sigmoidf_(bfhi(g.y));
                    o[4] = v1[0] * sigmoidf_(bflo(g.z)); o[5] = v1[1] * sigmoidf_(bfhi(g.z)); o[6] = v1[2] * sigmoidf_(bflo(g.w)); o[7] = v1[3] * sigmoidf_(bfhi(g.w));
                    bf16_t* op = O + r * D + col0 + bj * HALF;
                    if (u.sel) { const u32x4 p = *(const u32x4*)op;
                        o[0] += bflo(p.x); o[1] += bfhi(p.x); o[2] += bflo(p.y); o[3] += bfhi(p.y); o[4] += bflo(p.z); o[5] += bfhi(p.z); o[6] += bflo(p.w); o[7] += bfhi(p.w); }
                    u32x4 w; w.x = pk2(o[0], o[1]); w.y = pk2(o[2], o[3]); w.z = pk2(o[4], o[5]); w.w = pk2(o[6], o[7]);
                    *(u32x4*)op = w; }
                asm volatile("" ::: "memory"); }
    }
};
struct EpiResid {
    static constexpr bool PERM = false;
    const float* base; float* out; const float* gate;
    __device__ __forceinline__ void operator()(const f32x4 (&acc)[2][2][4][2], const Unit& u, int wr, int wc, int fr, int fq) const {
        const int row0 = u.pm * BM + wr * 64 + fr, col0 = u.pn * BM + wc * 32 + 4 * fq;
        const float* gp = gate + (size_t)((u.pm * BM) / T) * 6144 + col0;
        f32x4 gv[2][2];
#pragma unroll
        for (int bj = 0; bj < 2; ++bj)
#pragma unroll
            for (int n = 0; n < 2; ++n) gv[bj][n] = *(const f32x4*)(gp + bj * HALF + n * 16);
#pragma unroll
        for (int ai = 0; ai < 2; ++ai)
#pragma unroll
            for (int m = 0; m < 4; ++m) { const size_t off = (size_t)(row0 + ai * HALF + m * 16) * D + col0;
#pragma unroll
                for (int bj = 0; bj < 2; ++bj)
#pragma unroll
                    for (int n = 0; n < 2; ++n) { const f32x4 bs = *(const f32x4*)(base + off + bj * HALF + n * 16);
                        *(f32x4*)(out + off + bj * HALF + n * 16) = bs + gv[bj][n] * acc[ai][bj][m][n]; }
                asm volatile("" ::: "memory"); }
    }
};
}

struct Args { const float* in[28]; float* out; unsigned char* ws; int ph_lo, ph_hi; };

struct Frame {
    LAS unsigned char* lds;
    int tid, lane, wave, G, bid;
    const float* const* in;
    unsigned char* ws; unsigned char* dob;
};
enum { I_X = 0, I_C, I_CTX, I_CCTX, I_N1W, I_N2W, I_WMOD, I_BMOD, I_WIN, I_MU, I_W0, I_WUP, I_A0, I_AUP, I_GUP, I_KK, I_KA, I_RK, I_LNW, I_LNB, I_HGLB, I_HGNW, I_PA, I_PB, I_WOUT, I_FC1, I_FC2, I_FNW };

__device__ __forceinline__ void transpose_item(const float* W, int N, bf16_t* WT, int ldk, LAS float* scr, int item, int lane) {
    const int nblk = N / 32, kb = item / nblk, nb = item % nblk, k0 = 64 * kb, n0 = 32 * nb;
#pragma unroll 8
    for (int i = 0; i < 32; ++i) { const int kk = 2 * i + (lane >> 5); scr[kk * 33 + (lane & 31)] = W[(size_t)(k0 + kk) * N + n0 + (lane & 31)]; }
    asm volatile("s_waitcnt lgkmcnt(0)" ::: "memory");
    const int c = lane & 7;
#pragma unroll
    for (int j = 0; j < 4; ++j) { const int n = (lane >> 3) + 8 * j; const LAS float* s = scr + (8 * c) * 33 + n;
        u32x4 o; o.x = pk2(s[0 * 33], s[1 * 33]); o.y = pk2(s[2 * 33], s[3 * 33]); o.z = pk2(s[4 * 33], s[5 * 33]); o.w = pk2(s[6 * 33], s[7 * 33]);
        *(u32x4*)(WT + (size_t)(n0 + n) * ldk + k0 + 8 * c) = o; }
    asm volatile("s_waitcnt lgkmcnt(0)" ::: "memory");
}

__device__ __forceinline__ void p0_prologue(const Frame& F) {
    float* MOD = (float*)(F.ws + WS_MOD);
    if (F.bid < 96) {
        LAS float* act = (LAS float*)F.lds;
        LAS float* red = act + 9 * 1024;
        for (int i = F.tid; i < 9 * 1024; i += 512) { const float v = (i < 8 * 1024) ? F.in[I_C][i] : F.in[I_CCTX][i - 8 * 1024]; act[i] = v * sigmoidf_(v); }
        __syncthreads();
        const float* wm = F.in[I_WMOD];
        const int n = F.bid * 64 + F.lane;
        float a[9];
#pragma unroll
        for (int r = 0; r < 9; ++r) a[r] = 0.f;
        const int kb = F.wave * 128;
#pragma unroll 4
        for (int k = kb; k < kb + 128; ++k) { const float w = wm[(size_t)k * 6144 + n];
#pragma unroll
            for (int r = 0; r < 9; ++r) a[r] += act[r * 1024 + k] * w; }
#pragma unroll
        for (int r = 0; r < 9; ++r) red[(F.wave * 9 + r) * 64 + F.lane] = a[r];
        __syncthreads();
        for (int i = F.tid; i < 9 * 64; i += 512) { const int r = i >> 6, l = i & 63; float s = 0.f;
#pragma unroll
            for (int w = 0; w < 8; ++w) s += red[(w * 9 + r) * 64 + l];
            MOD[r * 6144 + F.bid * 64 + l] = s + F.in[I_BMOD][F.bid * 64 + l]; }
        __syncthreads();
    }
    LAS float* scr = (LAS float*)(F.lds + 48 * 1024) + F.wave * (64 * 33);
    const int gw = F.bid * 8 + F.wave, NGW = F.G * 8;
    constexpr int I_IN = 16 * (NIN / 32), I_SQ = 16 * 32, I_F1 = 16 * (FF / 32), I_F2 = 64 * 32, I_GU = 2 * 32;
    constexpr int NITEMS = I_IN + 3 * I_SQ + I_F1 + I_F2 + I_GU;
    for (int it = gw; it < NITEMS; it += NGW) {
        int r = it;
        if (r < I_IN) { transpose_item(F.in[I_WIN], NIN, (bf16_t*)(F.dob + DO_WIN), D, scr, r, F.lane); continue; } r -= I_IN;
        if (r < I_SQ) { transpose_item(F.in[I_PA], D, (bf16_t*)(F.dob + DO_PA), D, scr, r, F.lane); continue; } r -= I_SQ;
        if (r < I_SQ) { transpose_item(F.in[I_PB], D, (bf16_t*)(F.dob + DO_PB), D, scr, r, F.lane); continue; } r -= I_SQ;
        if (r < I_SQ) { transpose_item(F.in[I_WOUT], D, (bf16_t*)(F.dob + DO_WO), D, scr, r, F.lane); continue; } r -= I_SQ;
        if (r < I_F1) { transpose_item(F.in[I_FC1], FF, (bf16_t*)(F.dob + DO_FC1), D, scr, r, F.lane); continue; } r -= I_F1;
        if (r < I_F2) { transpose_item(F.in[I_FC2], D, (bf16_t*)(F.dob + DO_FC2), FF, scr, r, F.lane); continue; } r -= I_F2;
        transpose_item(F.in[I_GUP], D, (bf16_t*)(F.dob + DO_GUP), 256, scr, r, F.lane);
    }
    { bf16_t* gu = (bf16_t*)(F.dob + DO_GUP);
      for (int i = F.bid * 512 + F.tid; i < 1024 * 16; i += F.G * 512) { const int n = i >> 4, ch = i & 15; *(u32x4*)(gu + (size_t)n * 256 + 128 + ch * 8) = (u32x4){0u, 0u, 0u, 0u}; } }
}

__device__ __forceinline__ void modnorm_row(const float* xrow, const float* nw, const float* sh, const float* sc, bf16_t* orow, int lane) {
    f32x4 v[4]; float s = 0.f;
#pragma unroll
    for (int j = 0; j < 4; ++j) { v[j] = *(const f32x4*)(xrow + 4 * lane + 256 * j); s += (v[j].x * v[j].x + v[j].y * v[j].y) + (v[j].z * v[j].z + v[j].w * v[j].w); }
    const float rs = __builtin_amdgcn_rsqf(wave_sum(s) * (1.f / D) + RMS_EPS);
#pragma unroll
    for (int j = 0; j < 4; ++j) { const int c = 4 * lane + 256 * j;
        const f32x4 w = *(const f32x4*)(nw + c), a = *(const f32x4*)(sc + c), b = *(const f32x4*)(sh + c);
        const f32x4 y = (v[j] * rs * w) * (1.0f + a) + b;
        u32x2 o; o.x = pk2(y.x, y.y); o.y = pk2(y.z, y.w); *(u32x2*)(orow + c) = o; }
}

__device__ __forceinline__ void unpack8(const u32x4 w, float (&f)[8]) { f[0] = bflo(w.x); f[1] = bfhi(w.x); f[2] = bflo(w.y); f[3] = bfhi(w.y); f[4] = bflo(w.z); f[5] = bfhi(w.z); f[6] = bflo(w.w); f[7] = bfhi(w.w); }
__device__ __forceinline__ void load8f(const float* p, float (&f)[8]) { const f32x4 a = *(const f32x4*)p, b = *(const f32x4*)(p + 4); f[0] = a.x; f[1] = a.y; f[2] = a.z; f[3] = a.w; f[4] = b.x; f[5] = b.y; f[6] = b.z; f[7] = b.w; }
__device__ __forceinline__ void p3_finish(const Frame& F, float (&o)[8], int row, int c0, bool lat) {
    bf16_t* ZS = (bf16_t*)(F.ws + WS_ZRS); bf16_t* XG = (bf16_t*)(F.ws + WS_XGS); float* RN = (float*)(F.ws + WS_RN);
    if (lat && c0 >= 3200) {
        u32x4 w; w.x = pk2(sigmoidf_(o[0]), sigmoidf_(o[1])); w.y = pk2(sigmoidf_(o[2]), sigmoidf_(o[3])); w.z = pk2(sigmoidf_(o[4]), sigmoidf_(o[5])); w.w = pk2(sigmoidf_(o[6]), sigmoidf_(o[7]));
        *(u32x4*)(XG + (size_t)row * 256 + (c0 - 3200)) = w;
        *(u32x4*)(XG + (size_t)row * 256 + 128 + (c0 - 3200)) = (u32x4){0u, 0u, 0u, 0u};
    }
    if (c0 >= 3072 && c0 < 3136) {
#pragma unroll
        for (int j = 0; j < 8; ++j) o[j] = 1.0f - 2.0f * __builtin_amdgcn_rcpf(1.0f + fexp(2.0f * o[j])); }
    {
        const bool isk = c0 >= 1024 && c0 < 2048; float ss = 0.f;
        if (isk) { float kk[8]; load8f(F.in[I_KK] + c0 - 1024, kk);
#pragma unroll
            for (int j = 0; j < 8; ++j) { const float t = o[j] * kk[j]; ss += t * t; } }
        ss += dpp_mov<0xB1>(ss); ss += dpp_mov<0x4E>(ss); ss += dpp_mov<0x141>(ss);
        if (isk && ((c0 >> 3) & 7) == 0) RN[(size_t)row * 16 + ((c0 - 1024) >> 6)] = __builtin_amdgcn_rsqf(fmaxf(ss, 1e-24f));
    }
    u32x4 w; w.x = pk2(o[0], o[1]); w.y = pk2(o[2], o[3]); w.z = pk2(o[4], o[5]); w.w = pk2(o[6], o[7]);
    *(u32x4*)(ZS + (size_t)row * NZR + c0) = w;
}
__device__ __forceinline__ void p3_shift(const Frame& F) {
    const bf16_t* ZR = (const bf16_t*)(F.ws + WS_R1);
    const float* mu = F.in[I_MU];
    const int tid = F.tid;
    LAS unsigned char* RING = F.lds;
    const int tok = tid >> 3, cc = tid & 7;
    for (int item = F.bid; item < NB * (NZR / 64); item += F.G) {
        const int b = item / (NZR / 64), cg = item % (NZR / 64), c0 = cg * 64 + cc * 8;
        float m0[8], m1[8], m2[8], m3[8];
        load8f(mu + c0, m0); load8f(mu + NZR + c0, m1); load8f(mu + 2 * NZR + c0, m2); load8f(mu + 3 * NZR + c0, m3);
        const bf16_t* src = ZR + ((size_t)b * T + tok) * NZR + c0;
        __syncthreads();
        u32x4 nxt = *(const u32x4*)src;
        for (int s = 0; s <= GW; ++s) {
            if (s < GW) *(LAS u32x4*)(RING + (s & 3) * 8192 + tid * 16) = nxt;
            if (s + 1 < GW) nxt = *(const u32x4*)(src + (size_t)(s + 1) * GW * NZR);
            __syncthreads();
            if (s >= 1) {
                const int gr = s - 1;
                const LAS unsigned char* ctr = RING + (gr & 3) * 8192;
                float z[8], a[8], o[8];
                unpack8(*(const LAS u32x4*)(ctr + tid * 16), z);
#pragma unroll
                for (int j = 0; j < 8; ++j) o[j] = z[j];
                if (tok > 0) unpack8(*(const LAS u32x4*)(ctr + tid * 16 - 128), a); else {
#pragma unroll
                    for (int j = 0; j < 8; ++j) a[j] = 0.f; }
#pragma unroll
                for (int j = 0; j < 8; ++j) o[j] += m0[j] * (a[j] - z[j]);
                if (tok < GW - 1) unpack8(*(const LAS u32x4*)(ctr + tid * 16 + 128), a); else {
#pragma unroll
                    for (int j = 0; j < 8; ++j) a[j] = 0.f; }
#pragma unroll
                for (int j = 0; j < 8; ++j) o[j] += m1[j] * (a[j] - z[j]);
                if (gr > 0) unpack8(*(const LAS u32x4*)(RING + ((gr - 1) & 3) * 8192 + tid * 16), a); else {
#pragma unroll
                    for (int j = 0; j < 8; ++j) a[j] = 0.f; }
#pragma unroll
                for (int j = 0; j < 8; ++j) o[j] += m2[j] * (a[j] - z[j]);
                if (gr < GW - 1) unpack8(*(const LAS u32x4*)(RING + ((gr + 1) & 3) * 8192 + tid * 16), a); else {
#pragma unroll
                    for (int j = 0; j < 8; ++j) a[j] = 0.f; }
#pragma unroll
                for (int j = 0; j < 8; ++j) o[j] += m3[j] * (a[j] - z[j]);
                p3_finish(F, o, b * T + gr * GW + tok, c0, true);
            }
        }
    }
    {
        constexpr int CH = NZR / 8;
        const int vb = (F.bid + F.G - (NB * (NZR / 64)) % F.G) % F.G;
        const size_t total = (size_t)MC * CH;
        for (size_t i = (size_t)vb * 512 + tid; i < total; i += (size_t)F.G * 512) {
            const int rowc = (int)(i / CH), ch = (int)(i % CH), c0 = ch * 8, row = ML + rowc, tc = rowc & (TC - 1);
            const bf16_t* p = ZR + (size_t)row * NZR + c0;
            float z[8], a[8], o[8], m0[8], m1[8];
            unpack8(*(const u32x4*)p, z); load8f(mu + c0, m0); load8f(mu + NZR + c0, m1);
#pragma unroll
            for (int j = 0; j < 8; ++j) o[j] = z[j];
            if (tc > 0) unpack8(*(const u32x4*)(p - NZR), a); else {
#pragma unroll
                for (int j = 0; j < 8; ++j) a[j] = 0.f; }
#pragma unroll
            for (int j = 0; j < 8; ++j) o[j] += m0[j] * (a[j] - z[j]);
            if (tc < TC - 1) unpack8(*(const u32x4*)(p + NZR), a); else {
#pragma unroll
                for (int j = 0; j < 8; ++j) a[j] = 0.f; }
#pragma unroll
            for (int j = 0; j < 8; ++j) o[j] += m1[j] * (a[j] - z[j]);
            p3_finish(F, o, row, c0, false);
        }
    }
}

constexpr int QC = 16, NSLOT = 6, NPREP = 6;
constexpr int Q_P2T = 0, Q_BKT = 4608, Q_VV = 9728, Q_HY = 11776, Q_CO = 15872, Q_WC = 16896, Q_SLOT = 17152;
constexpr int Q_SL = NSLOT * Q_SLOT, Q_PRM = Q_SL + 9216, Q_FLG = Q_PRM + 1280, Q_AF = Q_FLG + 64, Q_END = Q_AF + 16384;
static_assert(Q_END <= LDS_BYTES - 16, "RWKV LDS overflow");
__device__ __forceinline__ void q_wait_ge(volatile LAS unsigned* p, unsigned need) { while ((unsigned)__builtin_amdgcn_readfirstlane((int)*p) < need) __builtin_amdgcn_s_sleep(1); asm volatile("" ::: "memory"); }
__device__ __forceinline__ void q_publish(volatile LAS unsigned* p, unsigned val, int lane) { asm volatile("s_waitcnt lgkmcnt(0)" ::: "memory"); if (lane == 0) *p = val; asm volatile("" ::: "memory"); }
template <int N> __device__ __forceinline__ float dpp_shr_one(float v) {
    return __builtin_bit_cast(float, __builtin_amdgcn_update_dpp(0x3f800000, __builtin_bit_cast(int, v), 0x110 + N, 0xf, 0xf, false)); }
__device__ __forceinline__ bf16x8 qfrag(const f32x4 c) { return __builtin_bit_cast(bf16x8, (u32x4){pk2(c[0], c[1]), pk2(c[2], c[3]), 0u, 0u}); }
__device__ __forceinline__ f32x4 qmm(const f32x4 x, const f32x4 y) { return __builtin_amdgcn_mfma_f32_16x16x32_bf16(qfrag(x), qfrag(y), (f32x4){0.f, 0.f, 0.f, 0.f}, 0, 0, 0); }
__device__ __forceinline__ void p4_rwkv_scan(const Frame& F) {
    const bf16_t* ZS = (const bf16_t*)(F.ws + WS_ZRS);
    float* BON = (float*)(F.ws + WS_BON);
    const float* RN = (const float*)(F.ws + WS_RN);
    LAS unsigned char* L = F.lds;
    LAS float* PRM = (LAS float*)(L + Q_PRM);
    volatile LAS unsigned* FLG = (volatile LAS unsigned*)(L + Q_FLG);
    const int tid = F.tid, lane = F.lane, w8 = F.wave;
    const int fr = lane & 15, fq = lane >> 4;
    constexpr int NCH = (TC + T) / QC, NCTX = TC / QC;
    for (int cid = F.bid; cid < 256; cid += F.G) {
        const int b = cid >> 5, h = (cid >> 1) & 15, d = cid & 1;
        bf16_t* Yd = (bf16_t*)(F.ws + (d ? WS_YB : WS_YF));
        auto chunk_row0 = [&](int ci) { const bool ic = ci < NCTX; const int cj = ic ? ci : ci - NCTX, nch = ic ? NCTX : T / QC;
            const int pos = d ? (nch - 1 - cj) : cj; return (ic ? ML + b * TC : b * T) + pos * QC; };
        __syncthreads();
        if (tid < 64) { PRM[tid] = F.in[I_W0][d * 1024 + h * 64 + tid]; PRM[64 + tid] = F.in[I_A0][d * 1024 + h * 64 + tid];
            PRM[128 + tid] = F.in[I_KK][h * 64 + tid]; PRM[192 + tid] = F.in[I_KA][h * 64 + tid]; PRM[256 + tid] = F.in[I_RK][h * 64 + tid]; }
        if (tid < 16) FLG[tid] = 0u;
        for (int it = tid; it < 1024; it += 512) {
            const int l_ = it & 63, f_ = it >> 6, ks_ = f_ & 1, ct_ = (f_ >> 1) & 3, m_ = f_ >> 3; const float* src = m_ ? F.in[I_AUP] : F.in[I_WUP];
            unsigned wv[4];
#pragma unroll
            for (int jj = 0; jj < 8; jj += 2) { const size_t o = ((size_t)(d * 64 + 32 * ks_ + 8 * (l_ >> 4) + jj)) * 1024 + h * 64 + 16 * ct_ + (l_ & 15); wv[jj >> 1] = pk2(src[o], src[o + 1024]); }
            *(LAS u32x4*)(L + Q_AF + it * 16) = (u32x4){wv[0], wv[1], wv[2], wv[3]};
        }
        __syncthreads();
        if (w8 < 2) {
            __builtin_amdgcn_s_setprio(2);
            const int sw = w8;
            f32x4 acc[4][2];
#pragma unroll
            for (int i = 0; i < 4; ++i)
#pragma unroll
                for (int j = 0; j < 2; ++j) acc[i][j] = (f32x4){0.f, 0.f, 0.f, 0.f};
            LAS unsigned char* SLW = L + Q_SL + sw * 4608;
            int slot = 0;
            for (int ci = 0; ci < NCH; ++ci) {
                LAS unsigned char* SLT = L + slot * Q_SLOT;
#pragma unroll
                for (int kt = 0; kt < 4; ++kt)
#pragma unroll
                    for (int j = 0; j < 2; ++j) { u32x2 o; o.x = pk2(acc[kt][j][0], acc[kt][j][1]); o.y = pk2(acc[kt][j][2], acc[kt][j][3]);
                        *(LAS u32x2*)(SLW + ((16 * j + fr) * 72 + 16 * kt + 4 * fq) * 2) = o; }
                q_wait_ge(FLG + slot, (unsigned)ci + 1u);
                asm volatile("s_waitcnt lgkmcnt(0)" ::: "memory");
                f32x4 u[2];
                {
                    bf16x8 af[2][2];
#pragma unroll
                    for (int tt = 0; tt < 2; ++tt)
#pragma unroll
                        for (int ks = 0; ks < 2; ++ks) af[tt][ks] = *(const LAS bf16x8*)(SLT + Q_P2T + ((16 * tt + fr) * 72 + 32 * ks + 8 * fq) * 2);
                    const u32x4 co = *(const LAS u32x4*)(SLT + Q_CO + lane * 16);
                    const bf16x8 fminv = __builtin_bit_cast(bf16x8, (u32x4){co.x, co.y, 0u, 0u}), ft2 = __builtin_bit_cast(bf16x8, (u32x4){co.z, co.w, 0u, 0u});
                    const int row0 = chunk_row0(ci);
#pragma unroll
                    for (int j = 0; j < 2; ++j) {
                        const int vt = 2 * sw + j;
                        const bf16x8 b0 = *(const LAS bf16x8*)(SLW + ((16 * j + fr) * 72 + 8 * fq) * 2), b1 = *(const LAS bf16x8*)(SLW + ((16 * j + fr) * 72 + 32 + 8 * fq) * 2);
                        const u32x2 hw = *(const LAS u32x2*)(SLT + Q_HY + (vt * 64 + lane) * 8), yw = *(const LAS u32x2*)(SLT + Q_HY + 2048 + (vt * 64 + lane) * 8);
                        f32x4 g = (f32x4){bflo(hw.x), bfhi(hw.x), bflo(hw.y), bfhi(hw.y)}, y = (f32x4){bflo(yw.x), bfhi(yw.x), bflo(yw.y), bfhi(yw.y)};
                        g = __builtin_amdgcn_mfma_f32_16x16x32_bf16(af[0][0], b0, g, 0, 0, 0); g = __builtin_amdgcn_mfma_f32_16x16x32_bf16(af[0][1], b1, g, 0, 0, 0);
                        y = __builtin_amdgcn_mfma_f32_16x16x32_bf16(af[1][0], b0, y, 0, 0, 0); y = __builtin_amdgcn_mfma_f32_16x16x32_bf16(af[1][1], b1, y, 0, 0, 0);
                        u[j] = __builtin_amdgcn_mfma_f32_16x16x32_bf16(fminv, qfrag(g), (f32x4){0.f, 0.f, 0.f, 0.f}, 0, 0, 0);
                        y = __builtin_amdgcn_mfma_f32_16x16x32_bf16(ft2, qfrag(u[j]), y, 0, 0, 0);
                        if (ci >= NCTX) {
#pragma unroll
                            for (int r = 0; r < 4; ++r) { const int t = 4 * fq + r; Yd[(size_t)(row0 + (d ? QC - 1 - t : t)) * D + h * 64 + 16 * vt + fr] = (bf16_t)f2bf(y[r]); } }
                    }
                }
                {
                    bf16x8 bu[2];
#pragma unroll
                    for (int j = 0; j < 2; ++j) { const u32x2 vv = *(const LAS u32x2*)(SLT + Q_VV + ((32 * sw + 16 * j + fr) * 16 + 4 * fq) * 2);
                        bu[j] = __builtin_bit_cast(bf16x8, (u32x4){pk2(u[j][0], u[j][1]), pk2(u[j][2], u[j][3]), vv.x, vv.y}); }
#pragma unroll
                    for (int kt = 0; kt < 4; ++kt) {
                        const bf16x8 ak = *(const LAS bf16x8*)(SLT + Q_BKT + ((16 * kt + fr) * 40 + 8 * fq) * 2);
                        const f32x4 wc = *(const LAS f32x4*)(SLT + Q_WC + (16 * kt + 4 * fq) * 4);
#pragma unroll
                        for (int j = 0; j < 2; ++j) { acc[kt][j] = acc[kt][j] * wc; asm volatile("" : "+v"(acc[kt][j])); acc[kt][j] = __builtin_amdgcn_mfma_f32_16x16x32_bf16(ak, bu[j], acc[kt][j], 0, 0, 0); }
                    }
                }
                q_publish(FLG + 8 + sw, (unsigned)ci + 1u, lane);
                slot = (slot + 1 == NSLOT) ? 0 : slot + 1;
            }
            __builtin_amdgcn_s_setprio(0);
        } else {
            const int pw = w8 - 2;
            u32x4 tw0, tw1, xa0, xa1; u32x2 gr0, gk0, gv0, gr1, gk1, gv1, gr2, gk2, gv2, gr3, gk3, gv3; float rnv = 0.f;
#define Q_PREFETCH(ci_) do { const int r_ = chunk_row0(ci_) + (d ? QC - 1 - fr : fr); const bf16_t* p_ = ZS + (size_t)r_ * NZR; const bf16_t* q_ = p_ + h * 64 + 4 * fq; \
                tw0 = *(const u32x4*)(p_ + 3072 + 8 * fq); tw1 = *(const u32x4*)(p_ + 3104 + 8 * fq); xa0 = *(const u32x4*)(p_ + 3136 + 8 * fq); xa1 = *(const u32x4*)(p_ + 3168 + 8 * fq); \
                gr0 = *(const u32x2*)(q_); gk0 = *(const u32x2*)(q_ + 1024); gv0 = *(const u32x2*)(q_ + 2048); gr1 = *(const u32x2*)(q_ + 16); gk1 = *(const u32x2*)(q_ + 1040); gv1 = *(const u32x2*)(q_ + 2064); \
                gr2 = *(const u32x2*)(q_ + 32); gk2 = *(const u32x2*)(q_ + 1056); gv2 = *(const u32x2*)(q_ + 2080); gr3 = *(const u32x2*)(q_ + 48); gk3 = *(const u32x2*)(q_ + 1072); gv3 = *(const u32x2*)(q_ + 2096); \
                rnv = RN[(size_t)r_ * 16 + h]; } while (0)
            if (pw < NCH) Q_PREFETCH(pw);
            int slot = pw % NSLOT;
            for (int ci = pw; ci < NCH; ci += NPREP) {
                const bool isctx = ci < NCTX;
                const int row = chunk_row0(ci) + (d ? QC - 1 - fr : fr);
                LAS unsigned char* SLT = L + slot * Q_SLOT;
                if (ci >= NSLOT) { q_wait_ge(FLG + 8, (unsigned)(ci - NSLOT) + 1u); q_wait_ge(FLG + 9, (unsigned)(ci - NSLOT) + 1u); }
                f32x4 gN = (f32x4){0.f, 0.f, 0.f, 0.f}, gNT = gN, gT1 = gN, gT2 = gN, gT3 = gN; float bon = 0.f;
                unsigned fal[4], fbe[4], fka[4], frh[4];
                LAS unsigned char* pP2T = SLT + Q_P2T + (fr * 72 + 4 * fq) * 2;
                LAS unsigned char* pBKT = SLT + Q_BKT + (4 * fq * 40 + 8 * (fr >> 2) + (fr & 3)) * 2;
                LAS unsigned char* pVV = SLT + Q_VV + (4 * fq * 16 + fr) * 2;
                LAS unsigned char* pWC = SLT + Q_WC + 16 * fq;
                const LAS float* pPRM = PRM + 4 * fq;
#define Q_GROUP(ct, u_, GR, GK, GV) do { \
                    f32x4 zw = (f32x4){0.f, 0.f, 0.f, 0.f}, za = (f32x4){0.f, 0.f, 0.f, 0.f}; \
                    { const LAS bf16x8* af = (const LAS bf16x8*)(L + Q_AF) + lane; \
                      zw = __builtin_amdgcn_mfma_f32_16x16x32_bf16(af[(2 * (ct)) * 64], __builtin_bit_cast(bf16x8, tw0), zw, 0, 0, 0); \
                      zw = __builtin_amdgcn_mfma_f32_16x16x32_bf16(af[(2 * (ct) + 1) * 64], __builtin_bit_cast(bf16x8, tw1), zw, 0, 0, 0); \
                      za = __builtin_amdgcn_mfma_f32_16x16x32_bf16(af[(8 + 2 * (ct)) * 64], __builtin_bit_cast(bf16x8, xa0), za, 0, 0, 0); \
                      za = __builtin_amdgcn_mfma_f32_16x16x32_bf16(af[(8 + 2 * (ct) + 1) * 64], __builtin_bit_cast(bf16x8, xa1), za, 0, 0, 0); } \
                    const f32x4 w0v = *(const LAS f32x4*)(pPRM + 16 * (ct)), a0v = *(const LAS f32x4*)(pPRM + 64 + 16 * (ct)), kkw = *(const LAS f32x4*)(pPRM + 128 + 16 * (ct)), \
                                kav = *(const LAS f32x4*)(pPRM + 192 + 16 * (ct)), rkv = *(const LAS f32x4*)(pPRM + 256 + 16 * (ct)); \
                    const float kr[4] = {bflo(GK.x), bfhi(GK.x), bflo(GK.y), bfhi(GK.y)}; \
                    const float rr[4] = {bflo(GR.x), bfhi(GR.x), bflo(GR.y), bfhi(GR.y)}; \
                    const float vv[4] = {bflo(GV.x), bfhi(GV.x), bflo(GV.y), bfhi(GV.y)}; \
                    float al[4], be[4], ka[4], rh[4], bw[4], kw[4]; f32x4 wcv; \
                    _Pragma("unroll") for (int i = 0; i < 4; ++i) { \
                        const float kk = kr[i] * kkw[i] * rnv; \
                        const float sw = sigmoidf_(zw[i] + w0v[i]); \
                        const float dec = fexp(-0.6065306597126334f * sw); \
                        const float a = sigmoidf_(za[i] + a0v[i]); \
                        const float kd = kr[i] * (1.0f + (a - 1.0f) * kav[i]); \
                        bon += rr[i] * kd * rkv[i]; \
                        float W = dec; \
                        W *= dpp_shr_one<1>(W); W *= dpp_shr_one<2>(W); W *= dpp_shr_one<4>(W); W *= dpp_shr_one<8>(W); \
                        const float Wp = dpp_shr_one<1>(W); \
                        const float WC = __shfl(W, (lane & 48) | 15); \
                        const float iW = __builtin_amdgcn_rcpf(W); \
                        al[i] = Wp * kk; be[i] = kk * a * iW; ka[i] = kd * iW; rh[i] = W * rr[i]; bw[i] = be[i] * WC; kw[i] = ka[i] * WC; wcv[i] = WC; } \
                    fal[2 * (u_)] = pk2(al[0], al[1]); fal[2 * (u_) + 1] = pk2(al[2], al[3]); fbe[2 * (u_)] = pk2(be[0], be[1]); fbe[2 * (u_) + 1] = pk2(be[2], be[3]); \
                    fka[2 * (u_)] = pk2(ka[0], ka[1]); fka[2 * (u_) + 1] = pk2(ka[2], ka[3]); frh[2 * (u_)] = pk2(rh[0], rh[1]); frh[2 * (u_) + 1] = pk2(rh[2], rh[3]); \
                    *(LAS u32x2*)(pP2T + 32 * (ct)) = (u32x2){fal[2 * (u_)], fal[2 * (u_) + 1]}; \
                    *(LAS u32x2*)(pP2T + 16 * 72 * 2 + 32 * (ct)) = (u32x2){frh[2 * (u_)], frh[2 * (u_) + 1]}; \
                    _Pragma("unroll") for (int i = 0; i < 4; ++i) { \
                        *(LAS bf16_t*)(pBKT + (16 * (ct) + i) * 80) = (bf16_t)f2bf(bw[i]); \
                        *(LAS bf16_t*)(pBKT + (16 * (ct) + i) * 80 + 8) = (bf16_t)f2bf(kw[i]); \
                        *(LAS bf16_t*)(pVV + (16 * (ct) + i) * 32) = (bf16_t)f2bf(vv[i]); } \
                    if (fr == 0) *(LAS f32x4*)(pWC + 64 * (ct)) = wcv; } while (0)
#define Q_GRAM() do { \
                    const bf16x8 xal = __builtin_bit_cast(bf16x8, (u32x4){fal[0], fal[1], fal[2], fal[3]}), xbe = __builtin_bit_cast(bf16x8, (u32x4){fbe[0], fbe[1], fbe[2], fbe[3]}); \
                    const bf16x8 xka = __builtin_bit_cast(bf16x8, (u32x4){fka[0], fka[1], fka[2], fka[3]}), xrh = __builtin_bit_cast(bf16x8, (u32x4){frh[0], frh[1], frh[2], frh[3]}); \
                    gN = __builtin_amdgcn_mfma_f32_16x16x32_bf16(xbe, xal, gN, 0, 0, 0);        \
                    gNT = __builtin_amdgcn_mfma_f32_16x16x32_bf16(xal, xbe, gNT, 0, 0, 0);      \
                    gT2 = __builtin_amdgcn_mfma_f32_16x16x32_bf16(xbe, xrh, gT2, 0, 0, 0);      \
                    gT1 = __builtin_amdgcn_mfma_f32_16x16x32_bf16(xka, xal, gT1, 0, 0, 0);      \
                    gT3 = __builtin_amdgcn_mfma_f32_16x16x32_bf16(xka, xrh, gT3, 0, 0, 0);      } while (0)
                Q_GROUP(0, 0, gr0, gk0, gv0); __builtin_amdgcn_sched_barrier(0); Q_GROUP(1, 1, gr1, gk1, gv1); __builtin_amdgcn_sched_barrier(0); Q_GRAM();
                __builtin_amdgcn_sched_barrier(0);
                Q_GROUP(2, 0, gr2, gk2, gv2); __builtin_amdgcn_sched_barrier(0); Q_GROUP(3, 1, gr3, gk3, gv3); __builtin_amdgcn_sched_barrier(0); Q_GRAM();
                __builtin_amdgcn_sched_barrier(0);
#undef Q_GROUP
#undef Q_GRAM
                bon += __shfl_xor(bon, 16); bon += __shfl_xor(bon, 32);
                if (!isctx && fq == 0) BON[((size_t)d * ML + row) * 16 + h] = bon;
                if (ci + NPREP < NCH) Q_PREFETCH(ci + NPREP);
                f32x4 idn;
#pragma unroll
                for (int r = 0; r < 4; ++r) { const int i = 4 * fq + r; if (!(i < fr)) { gN[r] = 0.f; gT1[r] = 0.f; } if (!(i <= fr)) { gT2[r] = 0.f; gT3[r] = 0.f; } if (!(i > fr)) gNT[r] = 0.f; idn[r] = (i == fr) ? 1.f : 0.f; }
                f32x4 minv;
                { const f32x4 n2 = qmm(gNT, gN), n2t = qmm(gN, gNT);
                  const f32x4 n4 = qmm(n2t, n2), n4t = qmm(n2, n2t);
                  const f32x4 n8t = qmm(n4, n4t);
                  const f32x4 r1 = qmm(idn + n2t, idn - gN);
                  const f32x4 r2 = qmm(idn + n4t, r1);
                  minv = qmm(idn + n8t, r2); }
                *(LAS u32x4*)(SLT + Q_CO + lane * 16) = (u32x4){pk2(-minv[0], -minv[1]), pk2(-minv[2], -minv[3]), pk2(gT2[0], gT2[1]), pk2(gT2[2], gT2[3])};
                asm volatile("s_waitcnt lgkmcnt(0)" ::: "memory");
                {
                    const bf16x8 a1 = qfrag(gT1), a3 = qfrag(gT3);
                    const LAS unsigned char* pVVr = SLT + Q_VV + (fr * 16 + 4 * fq) * 2; LAS unsigned char* pHY = SLT + Q_HY + lane * 8;
#pragma unroll
                    for (int vt = 0; vt < 4; ++vt) {
                        const u32x2 vv = *(const LAS u32x2*)(pVVr + vt * 512);
                        const bf16x8 bv = __builtin_bit_cast(bf16x8, (u32x4){vv.x, vv.y, 0u, 0u});
                        f32x4 hh = (f32x4){0.f, 0.f, 0.f, 0.f}, yv = hh;
                        hh = __builtin_amdgcn_mfma_f32_16x16x32_bf16(a1, bv, hh, 0, 0, 0); yv = __builtin_amdgcn_mfma_f32_16x16x32_bf16(a3, bv, yv, 0, 0, 0);
                        *(LAS u32x2*)(pHY + vt * 512) = (u32x2){pk2(hh[0], hh[1]), pk2(hh[2], hh[3])}; *(LAS u32x2*)(pHY + 2048 + vt * 512) = (u32x2){pk2(yv[0], yv[1]), pk2(yv[2], yv[3])};
                    }
                }
                q_publish(FLG + slot, (unsigned)ci + 1u, lane);
                slot = (slot + NPREP) % NSLOT;
            }
#undef Q_PREFETCH
        }
        __syncthreads();
    }
}

__device__ __forceinline__ void p5_rwkv_norm(const Frame& F) {
    bf16_t* YF = (bf16_t*)(F.ws + WS_YF); const bf16_t* YBk = (const bf16_t*)(F.ws + WS_YB); const bf16_t* ZS = (const bf16_t*)(F.ws + WS_ZRS);
    const float* BON = (const float*)(F.ws + WS_BON);
    const float* lnw = F.in[I_LNW]; const float* lnb = F.in[I_LNB];
    const size_t total = (size_t)ML * 256;
    for (size_t i = (size_t)F.bid * 512 + F.tid; i < total; i += (size_t)F.G * 512) {
        const int row = (int)(i >> 8), c = ((int)i & 255) * 4, h = c >> 6;
        const u32x2 a = *(const u32x2*)(YF + (size_t)row * D + c), b = *(const u32x2*)(YBk + (size_t)row * D + c);
        float y[4] = {bflo(a.x) + bflo(b.x), bfhi(a.x) + bfhi(b.x), bflo(a.y) + bflo(b.y), bfhi(a.y) + bfhi(b.y)};
        const float mean = sum16((y[0] + y[1]) + (y[2] + y[3])) * (1.f / 64.f);
        float q = 0.f;
#pragma unroll
        for (int j = 0; j < 4; ++j) { y[j] -= mean; q += y[j] * y[j]; }
        const float rstd = __builtin_amdgcn_rsqf(sum16(q) * (1.f / 64.f) + GN_EPS);
        const float bon = BON[(size_t)row * 16 + h] + BON[((size_t)ML + row) * 16 + h];
        const u32x2 vw = *(const u32x2*)(ZS + (size_t)row * NZR + 2048 + c);
        const float v[4] = {bflo(vw.x), bfhi(vw.x), bflo(vw.y), bfhi(vw.y)};
        const f32x4 lw = *(const f32x4*)(lnw + c), lb = *(const f32x4*)(lnb + c);
        float o[4];
#pragma unroll
        for (int j = 0; j < 4; ++j) o[j] = y[j] * rstd * lw[j] + lb[j] + bon * v[j];
        u32x2 w; w.x = pk2(o[0], o[1]); w.y = pk2(o[2], o[3]);
        *(u32x2*)(YF + (size_t)row * D + c) = w;
    }
}

constexpr int HC = 64;
constexpr int H_RAWQ = 0, H_RAWF = 16384, H_RAWI = 32768;
constexpr int H_PL = 0;
constexpr int H_TOT = 40960;
constexpr int H_DEC = H_TOT + 2048;
constexpr int H_QIN = H_DEC + 1024, H_KIN = H_QIN + 17408, H_QB = H_KIN + 17408;
constexpr int H_KINT = H_QB + 17408;
constexpr int H_VT = H_KINT + 18432;
constexpr int H_ST = H_VT + 9216;
constexpr int H_OL = H_ST + 17408;
constexpr int H_END = H_OL + 9216;
static_assert(H_END <= LDS_BYTES - 16, "HGRN2 LDS overflow");
__device__ __forceinline__ void p8_hgrn_scan(const Frame& F) {
    const bf16_t* ZH = (const bf16_t*)(F.ws + WS_ZH);
    LAS unsigned char* L = F.lds;
    const int tid = F.tid, lane = F.lane, w8 = F.wave;
    const float* hglb = F.in[I_HGLB];
    const int fr = lane & 15, fq = lane >> 4;
    for (int cid = F.bid; cid < 256; cid += F.G) {
        const int b = cid >> 5, hh = (cid >> 2) & 7, d = (cid >> 1) & 1, vh = cid & 1;
        bf16_t* Od = (bf16_t*)(F.ws + (d ? WS_OB : WS_OF));
        const int k1 = tid & 127, seg = tid >> 7;
        const float lbk = sigmoidf_(hglb[hh * 128 + k1] - hglb[1024 + hh * 128 + k1]);
        f32x4 Sreg[4];
#pragma unroll
        for (int i = 0; i < 4; ++i) Sreg[i] = (f32x4){0.f, 0.f, 0.f, 0.f};
        __syncthreads();
        for (int i = tid; i < 17408 / 4; i += 512) ((LAS unsigned*)(L + H_ST))[i] = 0u;
        constexpr int NCH = (TC + T) / HC;
        u32x4 pq0, pq1, pf0, pf1, pi0;
        auto chunk_row0 = [&](int ci) { const bool isctx = ci < TC / HC; const int cj = isctx ? ci : ci - TC / HC, nch = isctx ? TC / HC : T / HC;
            const int pos = d ? (nch - 1 - cj) : cj; return (isctx ? ML + b * TC : b * T) + pos * HC; };
#define H_PREFETCH(ci_) do { const int r0_ = chunk_row0(ci_); \
            { const int st = tid >> 4, kc = tid & 15; const bf16_t* g0 = ZH + (size_t)(r0_ + (d ? HC - 1 - st : st)) * NZH + hh * 128 + 8 * kc; \
              const bf16_t* g1 = ZH + (size_t)(r0_ + (d ? HC - 1 - (st + 32) : (st + 32))) * NZH + hh * 128 + 8 * kc; \
              pq0 = *(const u32x4*)g0; pq1 = *(const u32x4*)g1; pf0 = *(const u32x4*)(g0 + (d ? 2048 : 1024)); pf1 = *(const u32x4*)(g1 + (d ? 2048 : 1024)); } \
            { const int st = tid >> 3, vc = tid & 7; pi0 = *(const u32x4*)(ZH + (size_t)(r0_ + (d ? HC - 1 - st : st)) * NZH + 3072 + hh * 128 + vh * 64 + 8 * vc); } } while (0)
        H_PREFETCH(0);
        for (int ci = 0; ci < NCH; ++ci) {
            const bool isctx = ci < TC / HC;
            const int row0 = chunk_row0(ci);
            { const int st = tid >> 4, kc = tid & 15;
              *(LAS u32x4*)(L + H_RAWQ + (st * 128 + 8 * kc) * 2) = pq0; *(LAS u32x4*)(L + H_RAWQ + ((st + 32) * 128 + 8 * kc) * 2) = pq1;
              *(LAS u32x4*)(L + H_RAWF + (st * 128 + 8 * kc) * 2) = pf0; *(LAS u32x4*)(L + H_RAWF + ((st + 32) * 128 + 8 * kc) * 2) = pf1; }
            { const int st = tid >> 3, vc = tid & 7; *(LAS u32x4*)(L + H_RAWI + (st * 64 + 8 * vc) * 2) = pi0; }
            if (ci + 1 < NCH) H_PREFETCH(ci + 1);
            __syncthreads();
            float cc[16], kfv[16], qv[16];
            { float c = 0.f;
#pragma unroll
              for (int j = 0; j < 16; ++j) { const int st = 16 * seg + j;
                  const float fz = __builtin_bit_cast(float, (unsigned)(*(const LAS bf16_t*)(L + H_RAWF + (st * 128 + k1) * 2)) << 16);
                  qv[j] = __builtin_bit_cast(float, (unsigned)(*(const LAS bf16_t*)(L + H_RAWQ + (st * 128 + k1) * 2)) << 16);
                  const float f = lbk + (1.0f - lbk) * sigmoidf_(fz);
                  c += flog(f); cc[j] = c; kfv[j] = 1.0f - f; }
              ((LAS float*)(L + H_TOT))[seg * 128 + k1] = c; }
            __syncthreads();
            { const LAS float* TOT = (const LAS float*)(L + H_TOT);
              const float t0 = TOT[k1], t1 = TOT[128 + k1], t2 = TOT[256 + k1], t3 = TOT[384 + k1];
              const float off = (seg > 0 ? t0 : 0.f) + (seg > 1 ? t1 : 0.f) + (seg > 2 ? t2 : 0.f);
              const float bref = t0 + t1, blast = (t0 + t1) + (t2 + t3);
              const float ebref = fexp(bref);
              unsigned kp[8];
#pragma unroll
              for (int j = 0; j < 16; ++j) { const int st = 16 * seg + j; const float bb = cc[j] + off;
                  const float eq = fexp(bb - bref), ek = __builtin_amdgcn_rcpf(eq), eb = eq * ebref;
                  const unsigned qin = f2bf(qv[j] * eq), kin = f2bf(kfv[j] * ek), qb = f2bf(qv[j] * eb);
                  *(LAS bf16_t*)(L + H_QIN + (st * 136 + k1) * 2) = (bf16_t)qin; *(LAS bf16_t*)(L + H_KIN + (st * 136 + k1) * 2) = (bf16_t)kin; *(LAS bf16_t*)(L + H_QB + (st * 136 + k1) * 2) = (bf16_t)qb;
                  if (j & 1) kp[j >> 1] |= kin << 16; else kp[j >> 1] = kin; }
              *(LAS u32x4*)(L + H_KINT + (k1 * 72 + 16 * seg) * 2) = (u32x4){kp[0], kp[1], kp[2], kp[3]};
              *(LAS u32x4*)(L + H_KINT + (k1 * 72 + 16 * seg + 8) * 2) = (u32x4){kp[4], kp[5], kp[6], kp[7]};
              if (seg == 0) { ((LAS float*)(L + H_DEC))[k1] = fexp(blast); ((LAS float*)(L + H_DEC))[128 + k1] = fexp(blast - bref); } }
            { const int v = tid & 63, s8 = tid >> 6; unsigned vp[4];
#pragma unroll
              for (int j = 0; j < 8; ++j) { const unsigned x = *(const LAS bf16_t*)(L + H_RAWI + ((8 * s8 + j) * 64 + v) * 2); if (j & 1) vp[j >> 1] |= x << 16; else vp[j >> 1] = x; }
              *(LAS u32x4*)(L + H_VT + (v * 72 + 8 * s8) * 2) = (u32x4){vp[0], vp[1], vp[2], vp[3]}; }
            __syncthreads();
            if (!isctx) {
                const int tt = w8 >> 1;
#pragma unroll
                for (int u = 0; u < 2; ++u) { const int stl = 2 * (w8 & 1) + u; f32x4 acc = (f32x4){0.f, 0.f, 0.f, 0.f};
                    if (stl <= tt) {
#pragma unroll
                        for (int ks = 0; ks < 4; ++ks) { const bf16x8 a = *(const LAS bf16x8*)(L + H_QIN + ((16 * tt + fr) * 136 + 32 * ks + 8 * fq) * 2);
                            const bf16x8 bq = *(const LAS bf16x8*)(L + H_KIN + ((16 * stl + fr) * 136 + 32 * ks + 8 * fq) * 2);
                            acc = __builtin_amdgcn_mfma_f32_16x16x32_bf16(a, bq, acc, 0, 0, 0); } }
#pragma unroll
                    for (int r = 0; r < 4; ++r) { const int t = 16 * tt + 4 * fq + r, s = 16 * stl + fr; const float pv = (s <= t && stl <= tt) ? acc[r] : 0.f;
                        *(LAS bf16_t*)(L + H_PL + (t * 72 + s) * 2) = (bf16_t)f2bf(pv); } }
            }
            __syncthreads();
            if (!isctx) {
                const int tt = w8 >> 1;
#pragma unroll
                for (int u = 0; u < 2; ++u) { const int vt = 2 * (w8 & 1) + u; f32x4 acc = (f32x4){0.f, 0.f, 0.f, 0.f};
#pragma unroll
                    for (int ks = 0; ks < 2; ++ks) { const bf16x8 a = *(const LAS bf16x8*)(L + H_PL + ((16 * tt + fr) * 72 + 32 * ks + 8 * fq) * 2);
                        const bf16x8 bv = *(const LAS bf16x8*)(L + H_VT + ((16 * vt + fr) * 72 + 32 * ks + 8 * fq) * 2);
                        acc = __builtin_amdgcn_mfma_f32_16x16x32_bf16(a, bv, acc, 0, 0, 0); }
#pragma unroll
                    for (int ks = 0; ks < 4; ++ks) { const bf16x8 a = *(const LAS bf16x8*)(L + H_QB + ((16 * tt + fr) * 136 + 32 * ks + 8 * fq) * 2);
                        const bf16x8 bs = *(const LAS bf16x8*)(L + H_ST + ((16 * vt + fr) * 136 + 32 * ks + 8 * fq) * 2);
                        acc = __builtin_amdgcn_mfma_f32_16x16x32_bf16(a, bs, acc, 0, 0, 0); }
#pragma unroll
                    for (int r = 0; r < 4; ++r) *(LAS bf16_t*)(L + H_OL + ((16 * tt + 4 * fq + r) * 72 + 16 * vt + fr) * 2) = (bf16_t)f2bf(acc[r]); }
            }
            { const LAS float* DEC = (const LAS float*)(L + H_DEC);
              const f32x4 dk = *(const LAS f32x4*)(DEC + 16 * w8 + 4 * fq), e2 = *(const LAS f32x4*)(DEC + 128 + 16 * w8 + 4 * fq);
#pragma unroll
              for (int vt = 0; vt < 4; ++vt) { f32x4 acc = (f32x4){0.f, 0.f, 0.f, 0.f};
#pragma unroll
                  for (int ks = 0; ks < 2; ++ks) { const bf16x8 a = *(const LAS bf16x8*)(L + H_KINT + ((16 * w8 + fr) * 72 + 32 * ks + 8 * fq) * 2);
                      const bf16x8 bv = *(const LAS bf16x8*)(L + H_VT + ((16 * vt + fr) * 72 + 32 * ks + 8 * fq) * 2);
                      acc = __builtin_amdgcn_mfma_f32_16x16x32_bf16(a, bv, acc, 0, 0, 0); }
                  Sreg[vt] = dk * Sreg[vt] + e2 * acc; } }
            __syncthreads();
#pragma unroll
            for (int vt = 0; vt < 4; ++vt) { u32x2 o; o.x = pk2(Sreg[vt][0], Sreg[vt][1]); o.y = pk2(Sreg[vt][2], Sreg[vt][3]);
                *(LAS u32x2*)(L + H_ST + ((16 * vt + fr) * 136 + 16 * w8 + 4 * fq) * 2) = o; }
            if (!isctx) { const int st = tid >> 3, vc = tid & 7;
                const u32x4 o = *(const LAS u32x4*)(L + H_OL + (st * 72 + 8 * vc) * 2);
                *(u32x4*)(Od + (size_t)(row0 + (d ? HC - 1 - st : st)) * D + hh * 128 + vh * 64 + 8 * vc) = o; }
        }
#undef H_PREFETCH
        __syncthreads();
    }
}

__device__ __forceinline__ void p10_hgrn_read(const Frame& F) {
    bf16_t* OF = (bf16_t*)(F.ws + WS_OF); const bf16_t* OBk = (const bf16_t*)(F.ws + WS_OB); const bf16_t* ZG = (const bf16_t*)(F.ws + WS_ZG);
    const float* nw = F.in[I_HGNW];
    const size_t total = (size_t)ML * 256;
    for (size_t i = (size_t)F.bid * 512 + F.tid; i < total; i += (size_t)F.G * 512) {
        const int row = (int)(i >> 8), c = ((int)i & 255) * 4;
        const u32x2 a = *(const u32x2*)(OF + (size_t)row * D + c), b = *(const u32x2*)(OBk + (size_t)row * D + c);
        const float o[4] = {bflo(a.x) + bflo(b.x), bfhi(a.x) + bfhi(b.x), bflo(a.y) + bflo(b.y), bfhi(a.y) + bfhi(b.y)};
        const float ms = sum32((o[0] * o[0] + o[1] * o[1]) + (o[2] * o[2] + o[3] * o[3])) * (1.f / 128.f);
        const float rs = __builtin_amdgcn_rsqf(ms + RMS_EPS);
        const u32x2 gw = *(const u32x2*)(ZG + (size_t)row * NZG + c);
        const float g[4] = {bflo(gw.x), bfhi(gw.x), bflo(gw.y), bfhi(gw.y)};
        const f32x4 w = *(const f32x4*)(nw + c);
        float y[4];
#pragma unroll
        for (int j = 0; j < 4; ++j) y[j] = o[j] * rs * w[j] * (g[j] * sigmoidf_(g[j]));
        u32x2 ww; ww.x = pk2(y[0], y[1]); ww.y = pk2(y[2], y[3]);
        *(u32x2*)(OF + (size_t)row * D + c) = ww;
    }
}

template <bool COOP>
__device__ __forceinline__ void mk_body(const Args& args) {
    extern __shared__ __attribute__((aligned(16))) unsigned char lds_raw[];
    Frame F;
    F.lds = (LAS unsigned char*)lds_raw;
    F.tid = threadIdx.x; F.lane = F.tid & 63; F.wave = __builtin_amdgcn_readfirstlane(F.tid >> 6);
    F.G = gridDim.x; F.bid = blockIdx.x;
    F.in = args.in; F.ws = args.ws; F.dob = (unsigned char*)args.out;
    const int lo = args.ph_lo, hi = args.ph_hi;
    const float* MOD = (const float*)(F.ws + WS_MOD);
    const int gw = F.bid * 8 + F.wave, NGW = F.G * 8;
#define IN(k) (lo <= (k) && (k) < hi)
    XcdBarrier xbar; xbar.bar = (unsigned*)(F.ws + WS_CTL); xbar.x = 0; xbar.st = nullptr;
    if (COOP) {
        volatile LAS unsigned* st = (volatile LAS unsigned*)(F.lds + LDS_BYTES - 16);
        if (F.tid < 4) st[F.tid] = 0u;
        __syncthreads();
        xbar = xcd_barrier_post((unsigned*)(F.ws + WS_CTL), st);
    }
#define SEAM(k) do { if (COOP && IN(k) && IN((k) + 1)) { if ((k) == 0) cg::this_grid().sync(); else xcd_barrier(xbar); } } while (0)

    if (IN(0)) { p0_prologue(F); }
#if (MK_REPMASK >> 0) & 1
    if (COOP) cg::this_grid().sync();
    if (IN(0)) { p0_prologue(F); }
#endif
    SEAM(0);
    if (IN(1)) {
        bf16_t* H = (bf16_t*)(F.dob + DO_H);
        for (int m = gw; m < MR; m += NGW) {
            const bool lat = m < ML; const int b = lat ? (m >> 12) : 8;
            const float* xr = lat ? F.in[I_X] + (size_t)m * D : F.in[I_CTX] + (size_t)(m - ML) * D;
            modnorm_row(xr, F.in[I_N1W], MOD + b * 6144, MOD + b * 6144 + 1024, H + (size_t)m * D, F.lane);
        }
    }
#if (MK_REPMASK >> 1) & 1
    if (COOP) cg::this_grid().sync();
    if (IN(1)) {
        bf16_t* H = (bf16_t*)(F.dob + DO_H);
        for (int m = gw; m < MR; m += NGW) {
            const bool lat = m < ML; const int b = lat ? (m >> 12) : 8;
            const float* xr = lat ? F.in[I_X] + (size_t)m * D : F.in[I_CTX] + (size_t)(m - ML) * D;
            modnorm_row(xr, F.in[I_N1W], MOD + b * 6144, MOD + b * 6144 + 1024, H + (size_t)m * D, F.lane);
        }
    }
#endif
    SEAM(1);
    if (IN(2)) {
        pg8::Sched S; S.init(F.dob + DO_H, F.dob + DO_WIN, nullptr, nullptr, MR, NZR, D, F.G, F.bid, 1);
        pg8::EpiBf16 E{(bf16_t*)(F.ws + WS_R1), NZR};
        pg8::gemm_phase(F.lds, D, S, E);
    }
#if (MK_REPMASK >> 2) & 1
    if (COOP) cg::this_grid().sync();
    if (IN(2)) {
        pg8::Sched S; S.init(F.dob + DO_H, F.dob + DO_WIN, nullptr, nullptr, MR, NZR, D, F.G, F.bid, 1);
        pg8::EpiBf16 E{(bf16_t*)(F.ws + WS_R1), NZR};
        pg8::gemm_phase(F.lds, D, S, E);
    }
#endif
    SEAM(2);
    if (IN(3)) { p3_shift(F); }
#if (MK_REPMASK >> 3) & 1
    if (COOP) cg::this_grid().sync();
    if (IN(3)) { p3_shift(F); }
#endif
    SEAM(3);
    if (IN(4)) { p4_rwkv_scan(F); }
#if (MK_REPMASK >> 4) & 1
    if (COOP) cg::this_grid().sync();
    if (IN(4)) { p4_rwkv_scan(F); }
#endif
    SEAM(4);
    if (IN(5)) { p5_rwkv_norm(F); }
#if (MK_REPMASK >> 5) & 1
    if (COOP) cg::this_grid().sync();
    if (IN(5)) { p5_rwkv_norm(F); }
#endif
    SEAM(5);
    if (IN(6)) {
        pg8::Sched S; S.init(F.ws + WS_XGS, F.dob + DO_GUP, nullptr, nullptr, ML, D, 256, F.G, F.bid, 1);
        pg8::EpiMulBf16 E{(const bf16_t*)(F.ws + WS_YF), (bf16_t*)(F.ws + WS_YRW), D};
        pg8::gemm_phase(F.lds, 256, S, E);
    }
#if (MK_REPMASK >> 6) & 1
    if (COOP) cg::this_grid().sync();
    if (IN(6)) {
        pg8::Sched S; S.init(F.ws + WS_XGS, F.dob + DO_GUP, nullptr, nullptr, ML, D, 256, F.G, F.bid, 1);
        pg8::EpiMulBf16 E{(const bf16_t*)(F.ws + WS_YF), (bf16_t*)(F.ws + WS_YRW), D};
        pg8::gemm_phase(F.lds, 256, S, E);
    }
#endif
    SEAM(6);
    if (IN(7)) {
        pg8::Sched S; S.init(F.dob + DO_H, F.dob + DO_WIN + (size_t)NZR * D * 2, nullptr, nullptr, MR, NZH, D, F.G, F.bid, 1);
        pg8::EpiBf16 E{(bf16_t*)(F.ws + WS_ZH), NZH};
        pg8::gemm_phase(F.lds, D, S, E);
    }
#if (MK_REPMASK >> 7) & 1
    if (COOP) cg::this_grid().sync();
    if (IN(7)) {
        pg8::Sched S; S.init(F.dob + DO_H, F.dob + DO_WIN + (size_t)NZR * D * 2, nullptr, nullptr, MR, NZH, D, F.G, F.bid, 1);
        pg8::EpiBf16 E{(bf16_t*)(F.ws + WS_ZH), NZH};
        pg8::gemm_phase(F.lds, D, S, E);
    }
#endif
    SEAM(7);
    if (IN(8)) { p8_hgrn_scan(F); }
#if (MK_REPMASK >> 8) & 1
    if (COOP) cg::this_grid().sync();
    if (IN(8)) { p8_hgrn_scan(F); }
#endif
    SEAM(8);
    if (IN(9)) {
        pg8::Sched S; S.init(F.dob + DO_H, F.dob + DO_WIN + (size_t)(NZR + NZH) * D * 2, nullptr, nullptr, ML, NZG, D, F.G, F.bid, 1);
        pg8::EpiBf16 E{(bf16_t*)(F.ws + WS_ZG), NZG};
        pg8::gemm_phase(F.lds, D, S, E);
    }
#if (MK_REPMASK >> 9) & 1
    if (COOP) cg::this_grid().sync();
    if (IN(9)) {
        pg8::Sched S; S.init(F.dob + DO_H, F.dob + DO_WIN + (size_t)(NZR + NZH) * D * 2, nullptr, nullptr, ML, NZG, D, F.G, F.bid, 1);
        pg8::EpiBf16 E{(bf16_t*)(F.ws + WS_ZG), NZG};
        pg8::gemm_phase(F.lds, D, S, E);
    }
#endif
    SEAM(9);
    if (IN(10)) { p10_hgrn_read(F); }
#if (MK_REPMASK >> 10) & 1
    if (COOP) cg::this_grid().sync();
    if (IN(10)) { p10_hgrn_read(F); }
#endif
    SEAM(10);
    if (IN(11)) {
        pg8::Sched S; S.init(F.ws + WS_YRW, F.dob + DO_PA, F.ws + WS_OF, F.dob + DO_PB, ML, D, D, F.G, F.bid, 2);
        pg8::EpiMerge E{(const bf16_t*)(F.ws + WS_ZG), (bf16_t*)(F.ws + WS_MRG)};
        pg8::gemm_phase(F.lds, D, S, E);
    }
#if (MK_REPMASK >> 11) & 1
    if (COOP) cg::this_grid().sync();
    if (IN(11)) {
        pg8::Sched S; S.init(F.ws + WS_YRW, F.dob + DO_PA, F.ws + WS_OF, F.dob + DO_PB, ML, D, D, F.G, F.bid, 2);
        pg8::EpiMerge E{(const bf16_t*)(F.ws + WS_ZG), (bf16_t*)(F.ws + WS_MRG)};
        pg8::gemm_phase(F.lds, D, S, E);
    }
#endif
    SEAM(11);
    if (IN(12)) {
        pg8::Sched S; S.init(F.ws + WS_MRG, F.dob + DO_WO, nullptr, nullptr, ML, D, D, F.G, F.bid, 1);
        pg8::EpiResid E{F.in[I_X], (float*)(F.ws + WS_X1), MOD + 2048};
        pg8::gemm_phase(F.lds, D, S, E);
    }
#if (MK_REPMASK >> 12) & 1
    if (COOP) cg::this_grid().sync();
    if (IN(12)) {
        pg8::Sched S; S.init(F.ws + WS_MRG, F.dob + DO_WO, nullptr, nullptr, ML, D, D, F.G, F.bid, 1);
        pg8::EpiResid E{F.in[I_X], (float*)(F.ws + WS_X1), MOD + 2048};
        pg8::gemm_phase(F.lds, D, S, E);
    }
#endif
    SEAM(12);
    if (IN(13)) {
        const float* X1 = (const float*)(F.ws + WS_X1); bf16_t* H2 = (bf16_t*)(F.ws + WS_H2);
        for (int m = gw; m < ML; m += NGW) { const int b = m >> 12;
            modnorm_row(X1 + (size_t)m * D, F.in[I_N2W], MOD + b * 6144 + 3072, MOD + b * 6144 + 4096, H2 + (size_t)m * D, F.lane); }
    }
#if (MK_REPMASK >> 13) & 1
    if (COOP) cg::this_grid().sync();
    if (IN(13)) {
        const float* X1 = (const float*)(F.ws + WS_X1); bf16_t* H2 = (bf16_t*)(F.ws + WS_H2);
        for (int m = gw; m < ML; m += NGW) { const int b = m >> 12;
            modnorm_row(X1 + (size_t)m * D, F.in[I_N2W], MOD + b * 6144 + 3072, MOD + b * 6144 + 4096, H2 + (size_t)m * D, F.lane); }
    }
#endif
    SEAM(13);
    if (IN(14)) {
        pg8::Sched S; S.init(F.ws + WS_H2, F.dob + DO_FC1, nullptr, nullptr, ML, FF, D, F.G, F.bid, 1);
        pg8::EpiSqRelu E{(bf16_t*)(F.ws + WS_U), FF};
        pg8::gemm_phase(F.lds, D, S, E);
    }
#if (MK_REPMASK >> 14) & 1
    if (COOP) cg::this_grid().sync();
    if (IN(14)) {
        pg8::Sched S; S.init(F.ws + WS_H2, F.dob + DO_FC1, nullptr, nullptr, ML, FF, D, F.G, F.bid, 1);
        pg8::EpiSqRelu E{(bf16_t*)(F.ws + WS_U), FF};
        pg8::gemm_phase(F.lds, D, S, E);
    }
#endif
    SEAM(14);
    if (IN(15)) {
        pg8::Sched S; S.init(F.ws + WS_U, F.dob + DO_FC2, nullptr, nullptr, ML, D, FF, F.G, F.bid, 1);
        pg8::EpiResid E{(const float*)(F.ws + WS_X1), (float*)(F.ws + WS_X1), MOD + 5120};
        pg8::gemm_phase(F.lds, FF, S, E);
    }
#if (MK_REPMASK >> 15) & 1
    if (COOP) cg::this_grid().sync();
    if (IN(15)) {
        pg8::Sched S; S.init(F.ws + WS_U, F.dob + DO_FC2, nullptr, nullptr, ML, D, FF, F.G, F.bid, 1);
        pg8::EpiResid E{(const float*)(F.ws + WS_X1), (float*)(F.ws + WS_X1), MOD + 5120};
        pg8::gemm_phase(F.lds, FF, S, E);
    }
#endif
    SEAM(15);
    if (IN(16)) {
        const float* X2 = (const float*)(F.ws + WS_X1); const float* fw = F.in[I_FNW];
        for (int m = gw; m < ML; m += NGW) {
            const float* xr = X2 + (size_t)m * D; float* orow = args.out + (size_t)m * D;
            f32x4 v[4]; float s = 0.f;
#pragma unroll
            for (int j = 0; j < 4; ++j) { v[j] = *(const f32x4*)(xr + 4 * F.lane + 256 * j); s += (v[j].x * v[j].x + v[j].y * v[j].y) + (v[j].z * v[j].z + v[j].w * v[j].w); }
            const float rs = __builtin_amdgcn_rsqf(wave_sum(s) * (1.f / D) + RMS_EPS);
#pragma unroll
            for (int j = 0; j < 4; ++j) { const int c = 4 * F.lane + 256 * j; *(f32x4*)(orow + c) = v[j] * rs * *(const f32x4*)(fw + c); }
        }
    }
#if (MK_REPMASK >> 16) & 1
    if (COOP) cg::this_grid().sync();
    if (IN(16)) {
        const float* X2 = (const float*)(F.ws + WS_X1); const float* fw = F.in[I_FNW];
        for (int m = gw; m < ML; m += NGW) {
            const float* xr = X2 + (size_t)m * D; float* orow = args.out + (size_t)m * D;
            f32x4 v[4]; float s = 0.f;
#pragma unroll
            for (int j = 0; j < 4; ++j) { v[j] = *(const f32x4*)(xr + 4 * F.lane + 256 * j); s += (v[j].x * v[j].x + v[j].y * v[j].y) + (v[j].z * v[j].z + v[j].w * v[j].w); }
            const float rs = __builtin_amdgcn_rsqf(wave_sum(s) * (1.f / D) + RMS_EPS);
#pragma unroll
            for (int j = 0; j < 4; ++j) { const int c = 4 * F.lane + 256 * j; *(f32x4*)(orow + c) = v[j] * rs * *(const f32x4*)(fw + c); }
        }
    }
#endif

#undef IN
#undef SEAM
}

__global__ void __launch_bounds__(512, 2) mk_multi(Args args) { mk_body<false>(args); }
__global__ void __launch_bounds__(512, 2) mk_one(Args args) { mk_body<true>(args); }

extern "C" void kernel_launch(void* const* d_in, const int* in_sizes, int n_in, void* d_out, int out_size, void* d_ws, size_t ws_size, hipStream_t stream) {
    static int grid = 0;
    if (grid == 0) {
        if (n_in != 28 || out_size != ML * D || ws_size < WS_END) { fprintf(stderr, "kernel_launch: unexpected problem (n_in %d, out %d, ws %zu)\n", n_in, out_size, ws_size); grid = -1; return; }
        int dev = 0, cus = 0;
        if (hipGetDevice(&dev) != hipSuccess || hipDeviceGetAttribute(&cus, hipDeviceAttributeMultiprocessorCount, dev) != hipSuccess) { grid = -1; return; }
        (void)hipFuncSetAttribute((const void*)mk_multi, hipFuncAttributeMaxDynamicSharedMemorySize, LDS_BYTES);
        (void)hipFuncSetAttribute((const void*)mk_one, hipFuncAttributeMaxDynamicSharedMemorySize, LDS_BYTES);
        int per_cu = 0;
        (void)hipOccupancyMaxActiveBlocksPerMultiprocessor(&per_cu, (const void*)mk_one, 512, LDS_BYTES);
        (void)hipGetLastError();
        grid = cus;
        if (per_cu < 1) fprintf(stderr, "kernel_launch: occupancy query reports %d blocks per CU\n", per_cu);
    }
    if (grid < 0) return;
    (void)hipMemsetAsync((char*)d_ws + WS_CTL, 0, XCD_BAR_WORDS * 4, stream);
    Args a{};
    for (int i = 0; i < 28; ++i) a.in[i] = (const float*)d_in[i];
    a.out = (float*)d_out; a.ws = (unsigned char*)d_ws;
#if MK_ONE_LAUNCH
    a.ph_lo = 0; a.ph_hi = NPHASE;
    void* kargs[] = {&a};
    hipError_t e = hipLaunchCooperativeKernel((const void*)mk_one, dim3(grid), dim3(512), kargs, LDS_BYTES, stream);
    if (e != hipSuccess) fprintf(stderr, "cooperative launch failed: %s\n", hipGetErrorString(e));
#else
    for (int p = 0; p < NPHASE; ++p) { a.ph_lo = p; a.ph_hi = p + 1; hipLaunchKernelGGL(mk_multi, dim3(grid), dim3(512), LDS_BYTES, stream, a); }
#endif
}
```
